# Optimizing an MI355X kernel written in HIP

```python
import math
import jax, jax.numpy as jnp
from jax import lax
import numpy as np

D_MODEL = 1024
BATCH = 2
SEQ = 8192
DEPTH = 1

MEM_LEN = 256
D_FF = 2816
EPS = 1e-6
GLA_HEADS = 4
GLA_DK = 128
GLA_DV = 256
GLA_RANK = 16
GLA_TAU = 16.0
GLA_CHUNK = 64
DSA_HEADS = 8
DSA_DH = 64
IDX_HEADS = 8
IDX_DH = 64
TOPK_MAX = 256
Q_BLOCK = 128
REL_BUCKETS = 32
REL_MAX_DIST = 128
X_HEADS = 4
X_DH = 128

GLA_QK_W = GLA_HEADS * GLA_DK
GLA_V_W = GLA_HEADS * GLA_DV
DSA_W = DSA_HEADS * DSA_DH
IDX_QW = IDX_HEADS * IDX_DH
IN_SPLITS = (GLA_QK_W, GLA_QK_W, GLA_V_W, GLA_V_W, GLA_RANK,
             DSA_W, DSA_W, DSA_W, IDX_QW, IDX_DH, IDX_HEADS, D_MODEL, D_MODEL)
IN_WIDTH = GLA_QK_W * 2 + GLA_V_W * 2 + GLA_RANK + DSA_W * 3 + IDX_QW + IDX_DH + IDX_HEADS + 2 * D_MODEL

kernel_name = 'hybrid_gla_dsa_macaron_block'


def rmsnorm(x, g):
    xf = x.astype(jnp.float32)
    y = xf * lax.rsqrt(jnp.mean(xf * xf, axis=-1, keepdims=True) + EPS)
    return (y * g.astype(jnp.float32)).astype(x.dtype)


def swiglu(x, w_in, w_out):
    a, b = jnp.split(x @ w_in, 2, axis=-1)
    return (jax.nn.silu(a) * b) @ w_out


def gla_chunked(q, k, v, log_a):
    B, T, H, dk = q.shape
    dv = v.shape[-1]
    C = GLA_CHUNK
    N = T // C

    def to_chunks(t):
        t = t.astype(jnp.float32).reshape(B, N, C, H, t.shape[-1])
        return t.transpose(1, 0, 3, 2, 4)

    qc = to_chunks(q) * (dk ** -0.5)
    kc, vc, ac = to_chunks(k), to_chunks(v), to_chunks(log_a)
    causal = jnp.tril(jnp.ones((C, C), dtype=bool))[:, :, None]

    def step(S, inp):
        qi, ki, vi, ai = inp
        b = jnp.cumsum(ai, axis=2)
        diff = b[:, :, :, None, :] - b[:, :, None, :, :]
        decay = jnp.exp(jnp.where(causal, diff, -jnp.inf))
        scores = jnp.einsum('bhid,bhjd,bhijd->bhij', qi, ki, decay)
        o = scores @ vi + jnp.einsum('bhid,bhde->bhie', qi * jnp.exp(b), S)
        b_last = b[:, :, -1:, :]
        S = jnp.exp(b_last[:, :, 0, :])[..., None] * S + jnp.einsum('bhjd,bhje->bhde', ki * jnp.exp(b_last - b), vi)
        return S, o

    S0 = jnp.zeros((B, H, dk, dv), jnp.float32)
    _, o = lax.scan(step, S0, (qc, kc, vc, ac))
    return o.transpose(1, 0, 3, 2, 4).reshape(B, T, H, dv)


def t5_bucket(rel):
    max_exact = REL_BUCKETS // 2
    relf = jnp.maximum(rel, 1).astype(jnp.float32)
    large = max_exact + (jnp.log(relf / max_exact) / math.log(REL_MAX_DIST / max_exact)
                         * (REL_BUCKETS - max_exact)).astype(jnp.int32)
    large = jnp.minimum(large, REL_BUCKETS - 1)
    return jnp.where(rel < max_exact, rel, large)


def dsa_sparse_attention(q, k, v, iq, ik, iw, rel_table):
    B, T, H, dh = q.shape
    nb = T // Q_BLOCK
    topk = min(TOPK_MAX, T // 4)
    key_pos = jnp.arange(T)
    ikf = ik.astype(jnp.float32)

    def blocks(t):
        return t.reshape((B, nb, Q_BLOCK) + t.shape[2:]).swapaxes(0, 1)

    def one_block(inp):
        blk, qb, iqb, iwb = inp
        q_pos = blk * Q_BLOCK + jnp.arange(Q_BLOCK)
        causal = key_pos[None, :] <= q_pos[:, None]
        idx_dot = jnp.einsum('bqhd,bsd->bqhs', iqb.astype(jnp.float32), ikf) * (IDX_DH ** -0.5)
        idx_w = iwb.astype(jnp.float32) * (IDX_HEADS ** -0.5)
        idx_score = jnp.einsum('bqhs,bqh->bqs', jax.nn.relu(idx_dot), idx_w)
        idx_score = jnp.where(causal[None], idx_score, -jnp.inf)
        _, sel = lax.top_k(idx_score, topk)
        valid = sel <= q_pos[None, :, None]
        k_sel = jax.vmap(lambda kb, ib: kb[ib])(k, sel)
        v_sel = jax.vmap(lambda vb, ib: vb[ib])(v, sel)
        logits = jnp.einsum('bqhd,bqkhd->bhqk', qb, k_sel).astype(jnp.float32) * (dh ** -0.5)
        rel = jnp.maximum(q_pos[None, :, None] - sel, 0)
        bias = rel_table[t5_bucket(rel)].astype(jnp.float32)
        logits = logits + bias.transpose(0, 3, 1, 2)
        logits = jnp.where(valid[:, None], logits, -jnp.inf)
        p = jax.nn.softmax(logits, axis=-1).astype(v.dtype)
        return jnp.einsum('bhqk,bqkhd->bqhd', p, v_sel)

    out = lax.map(one_block, (jnp.arange(nb), blocks(q), blocks(iq), blocks(iw)))
    return out.swapaxes(0, 1).reshape(B, T, H, dh)


def token_mixer(xn, w_in, w_alpha_up, b_alpha, gla_norm, w_gla_proj, w_dsa_proj, rel_table, w_out):
    B, T, _ = xn.shape
    offsets = []
    acc = 0
    for w in IN_SPLITS[:-1]:
        acc += w
        offsets.append(acc)
    (gq, gk, gv, gr, ga, dq, dk, dv, iq, ik, iw, gate_a, gate_b) = jnp.split(xn @ w_in, offsets, axis=-1)
    log_a = jax.nn.log_sigmoid((ga @ w_alpha_up + b_alpha).astype(jnp.float32)) / GLA_TAU
    o_a = gla_chunked(gq.reshape(B, T, GLA_HEADS, GLA_DK), gk.reshape(B, T, GLA_HEADS, GLA_DK),
                      gv.reshape(B, T, GLA_HEADS, GLA_DV), log_a.reshape(B, T, GLA_HEADS, GLA_DK))
    o_a = rmsnorm(o_a, gla_norm).astype(xn.dtype).reshape(B, T, GLA_V_W) * jax.nn.silu(gr)
    y_a = o_a @ w_gla_proj
    o_b = dsa_sparse_attention(dq.reshape(B, T, DSA_HEADS, DSA_DH), dk.reshape(B, T, DSA_HEADS, DSA_DH),
                               dv.reshape(B, T, DSA_HEADS, DSA_DH), iq.reshape(B, T, IDX_HEADS, IDX_DH),
                               ik, iw, rel_table)
    y_b = o_b.reshape(B, T, DSA_W) @ w_dsa_proj
    merged = jax.nn.sigmoid(gate_a) * y_a + jax.nn.sigmoid(gate_b) * y_b
    return merged @ w_out


def cross_attention(xn, memn, w_cq, w_ckv, w_co):
    B, T, _ = xn.shape
    M = memn.shape[1]
    q = (xn @ w_cq).reshape(B, T, X_HEADS, X_DH)
    k, v = jnp.split(memn @ w_ckv, 2, axis=-1)
    k = k.reshape(B, M, X_HEADS, X_DH)
    v = v.reshape(B, M, X_HEADS, X_DH)
    logits = jnp.einsum('bthd,bmhd->bhtm', q, k).astype(jnp.float32) * (X_DH ** -0.5)
    p = jax.nn.softmax(logits, axis=-1).astype(v.dtype)
    o = jnp.einsum('bhtm,bmhd->bthd', p, v).reshape(B, T, X_HEADS * X_DH)
    return o @ w_co


def setup_inputs(seed: int = 0) -> dict:
    key = jax.random.key(seed)
    ks = jax.random.split(key, 32)
    L = DEPTH

    def w(k, shape, fan_in):
        return jax.random.normal(k, shape, jnp.float32) * (fan_in ** -0.5)

    def gain(k, shape):
        return 1.0 + 0.05 * jax.random.normal(k, shape, jnp.float32)

    return {
        'x': jax.random.normal(ks[0], (BATCH, SEQ, D_MODEL), jnp.float32),
        'mem': jax.random.normal(ks[1], (BATCH, MEM_LEN, D_MODEL), jnp.float32),
        'ffn1_pre': gain(ks[2], (L, D_MODEL)),
        'ffn1_post': gain(ks[3], (L, D_MODEL)),
        'ffn1_w_in': w(ks[4], (L, D_MODEL, 2 * D_FF), D_MODEL),
        'ffn1_w_out': w(ks[5], (L, D_FF, D_MODEL), D_FF),
        'mix_pre': gain(ks[6], (L, D_MODEL)),
        'mix_post': gain(ks[7], (L, D_MODEL)),
        'w_in': w(ks[8], (L, D_MODEL, IN_WIDTH), D_MODEL),
        'w_alpha_up': w(ks[9], (L, GLA_RANK, GLA_QK_W), GLA_RANK),
        'b_alpha': 0.1 * jax.random.normal(ks[10], (L, GLA_QK_W), jnp.float32),
        'gla_norm': gain(ks[11], (L, GLA_HEADS, GLA_DV)),
        'w_gla_proj': w(ks[12], (L, GLA_V_W, D_MODEL), GLA_V_W),
        'w_dsa_proj': w(ks[13], (L, DSA_W, D_MODEL), DSA_W),
        'rel_bias_table': 0.5 * jax.random.normal(ks[14], (REL_BUCKETS, DSA_HEADS), jnp.float32),
        'w_out': w(ks[15], (L, D_MODEL, D_MODEL), D_MODEL),
        'mem_norm': gain(ks[16], (L, D_MODEL)),
        'cross_pre': gain(ks[17], (L, D_MODEL)),
        'cross_post': gain(ks[18], (L, D_MODEL)),
        'w_cq': w(ks[19], (L, D_MODEL, X_HEADS * X_DH), D_MODEL),
        'w_ckv': w(ks[20], (L, D_MODEL, 2 * X_HEADS * X_DH), D_MODEL),
        'w_co': w(ks[21], (L, X_HEADS * X_DH, D_MODEL), X_HEADS * X_DH),
        'ffn2_pre': gain(ks[22], (L, D_MODEL)),
        'ffn2_post': gain(ks[23], (L, D_MODEL)),
        'ffn2_w_in': w(ks[24], (L, D_MODEL, 2 * D_FF), D_MODEL),
        'ffn2_w_out': w(ks[25], (L, D_FF, D_MODEL), D_FF),
    }


def reference(x, mem, ffn1_pre, ffn1_post, ffn1_w_in, ffn1_w_out, mix_pre, mix_post, w_in,
              w_alpha_up, b_alpha, gla_norm, w_gla_proj, w_dsa_proj, rel_bias_table, w_out,
              mem_norm, cross_pre, cross_post, w_cq, w_ckv, w_co, ffn2_pre, ffn2_post,
              ffn2_w_in, ffn2_w_out):
    h = x
    for l in range(DEPTH):
        h = h + 0.5 * rmsnorm(swiglu(rmsnorm(h, ffn1_pre[l]), ffn1_w_in[l], ffn1_w_out[l]), ffn1_post[l])
        mix = token_mixer(rmsnorm(h, mix_pre[l]), w_in[l], w_alpha_up[l], b_alpha[l], gla_norm[l],
                          w_gla_proj[l], w_dsa_proj[l], rel_bias_table, w_out[l])
        h = h + rmsnorm(mix, mix_post[l])
        xa = cross_attention(rmsnorm(h, cross_pre[l]), rmsnorm(mem, mem_norm[l]), w_cq[l], w_ckv[l], w_co[l])
        h = h + rmsnorm(xa, cross_post[l])
        h = h + 0.5 * rmsnorm(swiglu(rmsnorm(h, ffn2_pre[l]), ffn2_w_in[l], ffn2_w_out[l]), ffn2_post[l])
    return h
```

```cpp
#define MK_ONE_LAUNCH 1
#pragma clang diagnostic ignored "-Wint-to-pointer-cast"
#include <hip/hip_runtime.h>
#include <cstdio>
#include <cstdint>

#define DI __device__ __forceinline__
#define LAS __attribute__((address_space(3)))
#define GAS __attribute__((address_space(1)))
typedef unsigned short bf16;
typedef short bf16x8 __attribute__((ext_vector_type(8)));
typedef short s16x4 __attribute__((ext_vector_type(4)));
typedef float f32x4 __attribute__((ext_vector_type(4)));
typedef float f32x2 __attribute__((ext_vector_type(2)));
typedef float f32x16 __attribute__((ext_vector_type(16)));
typedef unsigned u32x4 __attribute__((ext_vector_type(4)));
typedef unsigned u32x2 __attribute__((ext_vector_type(2)));
typedef __bf16 bf16x2_t __attribute__((ext_vector_type(2)));

DI unsigned pk2(float lo, float hi) { f32x2 v = {lo, hi}; bf16x2_t b = __builtin_convertvector(v, bf16x2_t); return __builtin_bit_cast(unsigned, b); }
DI float bflo(unsigned w) { return __uint_as_float(w << 16); }
DI float bfhi(unsigned w) { return __uint_as_float(w & 0xffff0000u); }
DI float bf2f(bf16 v) { return __uint_as_float(((unsigned)v) << 16); }
DI float wave_sum(float v) {
#pragma unroll
    for (int o = 1; o < 64; o <<= 1) v += __shfl_xor(v, o);
    return v;
}
DI float fast_exp2(float x) { return __builtin_amdgcn_exp2f(x); }
DI float fast_exp(float x) { return __builtin_amdgcn_exp2f(x * 1.4426950408889634f); }
DI float fast_rcp(float x) { return __builtin_amdgcn_rcpf(x); }
DI float sigmoid_f(float x) { return fast_rcp(1.0f + fast_exp(-x)); }
#define MFMA32(a, b, c) __builtin_amdgcn_mfma_f32_32x32x16_bf16((a), (b), (c), 0, 0, 0)
DI int crow(int r, int hi) { return (r & 3) + 8 * (r >> 2) + 4 * hi; }
DI bf16x8 pack8(float a0, float a1, float a2, float a3, float a4, float a5, float a6, float a7) {
    u32x4 p; p.x = pk2(a0, a1); p.y = pk2(a2, a3); p.z = pk2(a4, a5); p.w = pk2(a6, a7); return __builtin_bit_cast(bf16x8, p);
}
DI bf16x8 pack_step(const f32x16& x, int s) { return pack8(x[8 * s], x[8 * s + 1], x[8 * s + 2], x[8 * s + 3], x[8 * s + 4], x[8 * s + 5], x[8 * s + 6], x[8 * s + 7]); }
typedef short v4i16_t __attribute__((ext_vector_type(4)));
DI s16x4 vtr(unsigned lds_byte_addr) { return __builtin_bit_cast(s16x4, __builtin_amdgcn_ds_read_tr16_b64_v4i16((LAS v4i16_t*)lds_byte_addr)); }
DI bf16x8 cat4(s16x4 lo, s16x4 hi) { return __builtin_shufflevector(lo, hi, 0, 1, 2, 3, 4, 5, 6, 7); }
DI bf16x8 lds_b128(unsigned lds_byte_addr) { return *(const LAS bf16x8*)lds_byte_addr; }

namespace pg8 {
#define PG8_LAS __attribute__((address_space(3)))
typedef unsigned short bf16_t;
constexpr int BM = 256, BK = 64, HALF = 128, HTB = HALF * BK * 2  , STAGE_BYTES = 8 * HTB, NXCD = 8, WGM = 8;

__host__ __device__ __forceinline__ int lds_byte(int r, int c) { const int st = (r >> 4) * 2 + (c >> 5), rr = r & 15, cc = c & 31, ob = rr * 64 + cc * 2; return st * 1024 + (ob ^ (((ob >> 9) & 1) << 5)); }
__host__ __device__ __forceinline__ void stage_rc(int b, int& R, int& C) { const int st = b / 1024, sb = b % 1024, swz = sb ^ (((sb >> 9) & 1) << 5); R = (st >> 1) * 16 + swz / 64; C = (st & 1) * 32 + (swz % 64) / 2; }
__host__ __device__ __forceinline__ int perm32(int rho) { const int n = rho >> 4, i = rho & 15; return 8 * (i >> 2) + 4 * n + (i & 3); }

struct Unit { int pm, pn, g; };
struct GDesc { const bf16_t* A; const bf16_t* Bt; int lda, ldb, K, nM, nN; };

__device__ __forceinline__ void tile_of(int l, int nM, int nN, int& pm, int& pn) {
    const int nwg = nM * nN; int wgid = l;
    { const int q = nwg / NXCD, r = nwg % NXCD, xcd = wgid % NXCD, off = wgid / NXCD; wgid = (xcd < r ? xcd * (q + 1) : r * (q + 1) + (xcd - r) * q) + off; }
    const int nig = WGM * nN, gid = wgid / nig, fm = gid * WGM, gsz = (nM - fm) < WGM ? (nM - fm) : WGM;
    pm = fm + ((wgid % nig) % gsz); pn = (wgid % nig) / gsz;
}
struct Order1 {
    GDesc d0; int G, c;
    __device__ __forceinline__ void init(const GDesc& a, int G_, int c_) { d0 = a; G = G_; c = c_; }
    __device__ __forceinline__ GDesc desc(int) const { return d0; }
    __device__ __forceinline__ bool next(int i, Unit& u) const {
        const long L = (long)i * G + c; if (L >= (long)(d0.nM * d0.nN)) return false;
        tile_of((int)L, d0.nM, d0.nN, u.pm, u.pn); u.g = 0; return true;
    }
};
struct Order2 {
    GDesc d0, d1; int G, c;
    __device__ __forceinline__ GDesc desc(int g) const { GDesc r; r.A = g == 0 ? d0.A : d1.A; r.Bt = g == 0 ? d0.Bt : d1.Bt; r.lda = d0.lda; r.ldb = d0.ldb; r.K = d0.K; r.nM = g == 0 ? d0.nM : d1.nM; r.nN = g == 0 ? d0.nN : d1.nN; return r; }
    __device__ __forceinline__ bool next(int i, Unit& u) const {
        const int n0 = d0.nM * d0.nN, n1 = d1.nM * d1.nN;
        const long L = (long)i * G + c; if (L >= (long)(n0 + n1)) return false;
        int l = (int)L, g = 0; if (l >= n0) { l -= n0; g = 1; }
        tile_of(l, g == 0 ? d0.nM : d1.nM, g == 0 ? d0.nN : d1.nN, u.pm, u.pn); u.g = g; return true;
    }
};
struct PairOrder {
    GDesc d0, d1; int G, c;
    __device__ __forceinline__ GDesc desc(int g) const { GDesc r; r.A = g == 0 ? d0.A : d1.A; r.Bt = g == 0 ? d0.Bt : d1.Bt; r.lda = g == 0 ? d0.lda : d1.lda; r.ldb = g == 0 ? d0.ldb : d1.ldb; r.K = g == 0 ? d0.K : d1.K; r.nM = d0.nM; r.nN = d0.nN; return r; }
    __device__ __forceinline__ bool next(int i, Unit& u) const {
        const long L = (long)(i >> 1) * G + c; if (L >= (long)(d0.nM * d0.nN)) return false;
        tile_of((int)L, d0.nM, d0.nN, u.pm, u.pn); u.g = i & 1; return true;
    }
};

template <bool UNIFORM  , class Epi, class Sched>
__device__ __forceinline__ void gemm_phase(PG8_LAS unsigned char* lds, const Sched& S, const Epi& E) {
    const int tid = threadIdx.x, wid = __builtin_amdgcn_readfirstlane(tid >> 6), lane = tid & 63, wr = wid >> 2, wc = wid & 3, fr = lane & 15, fq = lane >> 4;
    auto voff = [tid](int i, int ld, bool perm) -> unsigned { int R, C; stage_rc(tid * 16 + i * 8192, R, C); if (perm) R = (R & ~31) + perm32(R & 31); return (unsigned)(R * ld + C) * 2u; };
    const size_t kstep = (size_t)(BK * 2);
    const unsigned ldsw = (unsigned)wid * 1024u;
    const int aoff = lds_byte(wr * 64 + fr, fq * 8), boff = lds_byte(wc * 32 + fr, fq * 8);
#define PG8_SA(b, h) (((b) * 2 + (h)) * HTB)
#define PG8_SB(b, h) ((4 + (b) * 2 + (h)) * HTB)
#define PG8_STAGE(bufoff, gbase, v0, v1) do { \
        __builtin_amdgcn_global_load_lds((const unsigned*)((const char*)(gbase) + (v0)), (PG8_LAS unsigned*)(lds + (bufoff) + ldsw), 16, 0, 0); \
        __builtin_amdgcn_global_load_lds((const unsigned*)((const char*)(gbase) + (v1)), (PG8_LAS unsigned*)(lds + (bufoff) + ldsw + 8192), 16, 0, 0); } while (0)
#define PG8_LDA(dst, b, h) do { _Pragma("unroll") for (int m = 0; m < 4; ++m) _Pragma("unroll") for (int k = 0; k < 2; ++k) dst[m][k] = *(const PG8_LAS bf16x8*)(lds + PG8_SA(b, h) + aoff + m * 2048 + k * 1024); } while (0)
#define PG8_LDB(dst, b, h) do { _Pragma("unroll") for (int n = 0; n < 2; ++n) _Pragma("unroll") for (int k = 0; k < 2; ++k) dst[n][k] = *(const PG8_LAS bf16x8*)(lds + PG8_SB(b, h) + boff + n * 2048 + k * 1024); } while (0)
#define PG8_MMA(ai, bj, At, Bt) do { __builtin_amdgcn_s_setprio(1); _Pragma("unroll") for (int m = 0; m < 4; ++m) _Pragma("unroll") for (int n = 0; n < 2; ++n) _Pragma("unroll") for (int k = 0; k < 2; ++k) \
        acc[ai][bj][m][n] = __builtin_amdgcn_mfma_f32_16x16x32_bf16(Bt[n][k], At[m][k], acc[ai][bj][m][n], 0, 0, 0); __builtin_amdgcn_s_setprio(0); } while (0)
#define PG8_WAIT_V(n) asm volatile("s_waitcnt vmcnt(" #n ")" ::: "memory")
#define PG8_WAIT_L(n) asm volatile("s_waitcnt lgkmcnt(" #n ")" ::: "memory")
#define PG8_BAR __builtin_amdgcn_s_barrier()
#define PG8_SCHED __builtin_amdgcn_sched_barrier(0)
    Unit cur, nxt; int ui = 0;
    if (!S.next(0, cur)) return;
    GDesc dc = S.desc(cur.g);
    f32x4 acc[2][2][4][2];
#pragma unroll
    for (int a = 0; a < 2; ++a)
#pragma unroll
        for (int b = 0; b < 2; ++b)
#pragma unroll
            for (int m = 0; m < 4; ++m)
#pragma unroll
                for (int n = 0; n < 2; ++n) acc[a][b][m][n] = (f32x4){0.f, 0.f, 0.f, 0.f};
    bf16x8 At[4][2], B0[2][2], B1[2][2];
    unsigned vA0 = voff(0, dc.lda, false), vA1 = voff(1, dc.lda, false), vB0 = voff(0, dc.ldb, true), vB1 = voff(1, dc.ldb, true);
    size_t hA = (size_t)HALF * dc.lda * 2, hB = (size_t)HALF * dc.ldb * 2;
    const char* cA = (const char*)dc.A + (size_t)cur.pm * 2 * hA; const char* cB = (const char*)dc.Bt + (size_t)cur.pn * 2 * hB;
    PG8_STAGE(PG8_SB(0, 0), cB, vB0, vB1); PG8_STAGE(PG8_SB(0, 1), cB + hB, vB0, vB1); PG8_STAGE(PG8_SA(0, 0), cA, vA0, vA1); PG8_STAGE(PG8_SA(0, 1), cA + hA, vA0, vA1);
    if (wr == 1) PG8_BAR;
    PG8_WAIT_V(2); PG8_BAR;
    PG8_STAGE(PG8_SB(1, 0), cB + kstep, vB0, vB1); PG8_STAGE(PG8_SA(1, 0), cA + kstep, vA0, vA1); PG8_STAGE(PG8_SB(1, 1), cB + hB + kstep, vB0, vB1);
    PG8_WAIT_V(6); PG8_BAR;
    for (;;) {
        const bool has_next = S.next(ui + 1, nxt);
        GDesc dn = dc; if (has_next) dn = S.desc(nxt.g);
        unsigned nvA0 = vA0, nvA1 = vA1, nvB0 = vB0, nvB1 = vB1; size_t nhA = hA, nhB = hB;
        if constexpr (!UNIFORM) { if (has_next) { nvA0 = voff(0, dn.lda, false); nvA1 = voff(1, dn.lda, false); nvB0 = voff(0, dn.ldb, true); nvB1 = voff(1, dn.ldb, true); nhA = (size_t)HALF * dn.lda * 2; nhB = (size_t)HALF * dn.ldb * 2; } }
        const char* nA = has_next ? (const char*)dn.A + (size_t)nxt.pm * 2 * nhA : cA; const char* nB = has_next ? (const char*)dn.Bt + (size_t)nxt.pn * 2 * nhB : cB;
        const int nt = dc.K / BK;
        for (int t = 0; t < nt; t += 2) {
            const bool last = (t == nt - 2);
            const char* a1 = cA + (size_t)(t + 1) * kstep;
            const char* a2 = last ? nA : cA + (size_t)(t + 2) * kstep; const char* b2 = last ? nB : cB + (size_t)(t + 2) * kstep;
            const char* a3 = a2 + kstep; const char* b3 = b2 + kstep;
            unsigned xA0 = vA0, xA1 = vA1, xB0 = vB0, xB1 = vB1; size_t xhA = hA, xhB = hB;
            if constexpr (!UNIFORM) { if (last) { xA0 = nvA0; xA1 = nvA1; xB0 = nvB0; xB1 = nvB1; xhA = nhA; xhB = nhB; } }
            PG8_LDB(B0, 0, 0); PG8_LDB(B1, 0, 1); PG8_SCHED; PG8_LDA(At, 0, 0); PG8_STAGE(PG8_SA(1, 1), a1 + hA, vA0, vA1);
            PG8_WAIT_V(8); PG8_WAIT_L(0); PG8_BAR; PG8_MMA(0, 0, At, B0); PG8_MMA(0, 1, At, B1); PG8_BAR; PG8_SCHED;
            PG8_LDA(At, 0, 1); PG8_STAGE(PG8_SB(0, 0), b2, xB0, xB1); PG8_STAGE(PG8_SB(0, 1), b2 + xhB, xB0, xB1); PG8_STAGE(PG8_SA(0, 0), a2, xA0, xA1);
            PG8_WAIT_V(8); PG8_WAIT_L(0); PG8_BAR; PG8_MMA(1, 0, At, B0); PG8_MMA(1, 1, At, B1); PG8_BAR; PG8_SCHED;
            PG8_LDB(B0, 1, 0); PG8_LDB(B1, 1, 1); PG8_SCHED; PG8_LDA(At, 1, 0); PG8_STAGE(PG8_SA(0, 1), a2 + xhA, xA0, xA1);
            PG8_WAIT_V(8); PG8_WAIT_L(0); PG8_BAR; PG8_MMA(0, 0, At, B0); PG8_MMA(0, 1, At, B1); PG8_BAR; PG8_SCHED;
            PG8_LDA(At, 1, 1); PG8_STAGE(PG8_SB(1, 0), b3, xB0, xB1); PG8_STAGE(PG8_SB(1, 1), b3 + xhB, xB0, xB1); PG8_STAGE(PG8_SA(1, 0), a3, xA0, xA1);
            PG8_WAIT_V(8); PG8_WAIT_L(0); PG8_BAR; PG8_MMA(1, 0, At, B0); PG8_MMA(1, 1, At, B1); PG8_BAR; PG8_SCHED;
        }
        if (wr == 0) PG8_BAR;
        const bool keep = E(acc, cur, wr, wc, fr, fq);
        if (!has_next) break;
        if (!keep) {
#pragma unroll
            for (int a = 0; a < 2; ++a)
#pragma unroll
                for (int b = 0; b < 2; ++b)
#pragma unroll
                    for (int m = 0; m < 4; ++m)
#pragma unroll
                        for (int n = 0; n < 2; ++n) acc[a][b][m][n] = (f32x4){0.f, 0.f, 0.f, 0.f};
        }
        cur = nxt; dc = dn; cA = nA; cB = nB; vA0 = nvA0; vA1 = nvA1; vB0 = nvB0; vB1 = nvB1; hA = nhA; hB = nhB; ++ui;
        if (wr == 1) PG8_BAR;
    }
    PG8_WAIT_V(0);
    PG8_BAR;
#undef PG8_SA
#undef PG8_SB
#undef PG8_STAGE
#undef PG8_LDA
#undef PG8_LDB
#undef PG8_MMA
#undef PG8_WAIT_V
#undef PG8_WAIT_L
#undef PG8_BAR
#undef PG8_SCHED
}
}

constexpr int NWAVES = 8, NT = 512;
constexpr int BATCH = 2, T = 8192, D = 1024, M = BATCH * T, FF = 2816, MEML = 256;
constexpr float EPS = 1e-6f;
constexpr float LOG2E = 1.4426950408889634f;
constexpr int NIN = 5376;
constexpr size_t KiB = 1024, MiB = 1u << 20;
constexpr size_t WS_CTL = 0, CTL_ZERO_BYTES = 1 * MiB;
constexpr size_t WS_XN = 1 * MiB;
constexpr size_t WS_HID = 33 * MiB;
constexpr size_t WS_Y = 121 * MiB;
constexpr size_t WS_QKG = 33 * MiB, WS_GV = 65 * MiB, WS_GR = 97 * MiB, WS_DQKV = 129 * MiB, WS_IQ = 177 * MiB, WS_SM = 193 * MiB, WS_GST = 197 * MiB;
constexpr size_t WS_W1A = 153 * MiB, WS_W1B = 164 * MiB;
constexpr size_t WS_WIN = 229 * MiB, WS_WGT = 229 * MiB + 10752 * KiB, WS_WG = WS_WGT + 4 * MiB, WS_WD = WS_WG + 2 * MiB, WS_WO = WS_WD + 1 * MiB,
                 WS_WCQ = WS_WO + 2 * MiB, WS_WCKV = WS_WCQ + 1 * MiB, WS_WCO = WS_WCKV + 2 * MiB, WS_MEMN = WS_WCO + 1 * MiB, WS_KVM = WS_MEMN + 1 * MiB, WS_DEC = WS_KVM + 1 * MiB;
constexpr size_t WS_SGA = WS_QKG, WS_SGB = WS_GV, WS_MRG = WS_GST, WS_Y2 = WS_QKG;
constexpr size_t WS_QC = 65 * MiB, WS_OX = 81 * MiB, WS_Y3 = 97 * MiB;
constexpr size_t WS_END = 256 * MiB;
static_assert(WS_DEC + 128 * KiB <= WS_END && WS_W1B + (size_t)D * FF * 2 <= WS_IQ && WS_HID + (size_t)M * FF * 2 <= WS_Y, "d_ws map");
constexpr int CW_BAR = 4096;
constexpr int LDS_BYTES = 147456;
constexpr int MISC_OFF = LDS_BYTES - 256;

#define XB_TMO      128
#define XB_XCNT(j)  (256  + 64 * (j))
#define XB_XSUB(j)  (1280 + 64 * (j))
#define XB_XGEN(j)  (2304 + 64 * (j))
#define XB_TOP      3328
#define XB_TOPGEN   3392
#define XCD_BAR_WORDS 3456
#define XB_SPIN_CAP (1u << 18)

__device__ __forceinline__ unsigned xb_ld(unsigned* p)              { return __hip_atomic_load(p, __ATOMIC_RELAXED, __HIP_MEMORY_SCOPE_AGENT); }
__device__ __forceinline__ unsigned xb_add(unsigned* p, unsigned v) { return __hip_atomic_fetch_add(p, v, __ATOMIC_RELAXED, __HIP_MEMORY_SCOPE_AGENT); }
__device__ __forceinline__ unsigned xb_xcc_id() { return (unsigned)__builtin_amdgcn_s_getreg((3 << 11) | 20) & 0xFu; }
#define XB_SPIN(cond, bar) do { unsigned _sp = 0; while (cond) { __builtin_amdgcn_s_sleep(1); \
    if ((++_sp & 255u) == 0u) { if (xb_ld(&(bar)[XB_TMO])) break; if (_sp > XB_SPIN_CAP) { atomicAdd(&(bar)[XB_TMO], 1u); break; } } } } while (0)

struct XcdBarrier {
    unsigned* bar; unsigned x;
    volatile LAS unsigned* st;
};

__device__ __forceinline__ XcdBarrier xcd_barrier_post(unsigned* bar, volatile LAS unsigned* st) {
    XcdBarrier b; b.bar = bar; b.x = xb_xcc_id(); b.st = st;
    if (threadIdx.x == 0) (void)xb_add(&bar[XB_XCNT(b.x)], 1u);
    return b;
}
__device__ __forceinline__ void xcd_barrier_complete(unsigned* bar, unsigned x, unsigned& nloc, unsigned& nx) {
    const unsigned G = gridDim.x * gridDim.y * gridDim.z;
    unsigned sum, cnt, mine, sp = 0u;
    for (;;) {
        sum = 0u; cnt = 0u; mine = 0u;
#pragma unroll
        for (unsigned j = 0; j < 16; ++j) { const unsigned c = xb_ld(&bar[XB_XCNT(j)]); sum += c; cnt += (c > 0u) ? 1u : 0u; mine = (j == x) ? c : mine; }
        if (sum == G) break;
        __builtin_amdgcn_s_sleep(1);
        if ((++sp & 255u) == 0u) { if (xb_ld(&bar[XB_TMO])) break; if (sp > XB_SPIN_CAP) { atomicAdd(&bar[XB_TMO], 1u); break; } }
    }
    nloc = mine > 0u ? mine : 1u; nx = cnt > 0u ? cnt : 1u;
}

__device__ __forceinline__ void xcd_barrier(const XcdBarrier& b) {
    asm volatile("s_waitcnt vmcnt(0)" ::: "memory");
    __syncthreads();
    if (threadIdx.x == 0) {
        unsigned* bar = b.bar;
        __builtin_amdgcn_s_waitcnt(0);
        unsigned nloc = b.st[0], nx = b.st[1];
        if (nloc == 0u) { xcd_barrier_complete(bar, b.x, nloc, nx); b.st[0] = nloc; b.st[1] = nx; }
        const unsigned old = xb_add(&bar[XB_XSUB(b.x)], 1u);
        const unsigned gen = old / nloc;
        if (old + 1u == (gen + 1u) * nloc) {
            __builtin_amdgcn_fence(__ATOMIC_RELEASE, "agent");
            asm volatile("s_waitcnt vmcnt(0)" ::: "memory");
            const unsigned og = xb_add(&bar[XB_TOP], 1u);
            const unsigned tg = og / nx;
            if (og + 1u == (tg + 1u) * nx) xb_add(&bar[XB_TOPGEN], 1u);
            else XB_SPIN(xb_ld(&bar[XB_TOPGEN]) == tg, bar);
            __builtin_amdgcn_fence(__ATOMIC_ACQUIRE, "agent");
            xb_add(&bar[XB_XGEN(b.x)], 1u);
            asm volatile("s_waitcnt vmcnt(0)" ::: "memory");
        } else {
            XB_SPIN(xb_ld(&bar[XB_XGEN(b.x)]) == gen, bar);
            __builtin_amdgcn_fence(__ATOMIC_ACQUIRE, "agent");
            asm volatile("s_waitcnt vmcnt(0)" ::: "memory");
        }
    }
    __syncthreads();
}

struct Args { const float* in[26]; float* out; unsigned char* ws; int ph_lo, ph_hi; };
struct Frame {
    LAS unsigned char* lds;
    unsigned char* ws;
    int tid, lane, wave, G, c;
};
#define LDS_WAIT() asm volatile("s_waitcnt lgkmcnt(0)" ::: "memory")
#define VM_WAIT() asm volatile("s_waitcnt vmcnt(0)" ::: "memory")

template <class ColFn>
DI void conv_item(const float* W, int ldw, int k0, bf16* WT, int ldt, int dr0, int dk0, ColFn srccol, LAS float* scr, int lane) {
    const int n_in = lane & 31; const int sc = srccol(dr0 + n_in);
#pragma unroll 8
    for (int i = 0; i < 32; ++i) { const int kk = 2 * i + (lane >> 5); scr[kk * 33 + n_in] = sc >= 0 ? W[(size_t)(k0 + kk) * ldw + sc] : 0.f; }
    LDS_WAIT(); asm volatile("" ::: "memory");
    const int c = lane & 7;
#pragma unroll
    for (int j = 0; j < 4; ++j) { const int n = (lane >> 3) + 8 * j; const LAS float* s = scr + (8 * c) * 33 + n;
        u32x4 o; o.x = pk2(s[0 * 33], s[1 * 33]); o.y = pk2(s[2 * 33], s[3 * 33]); o.z = pk2(s[4 * 33], s[5 * 33]); o.w = pk2(s[6 * 33], s[7 * 33]);
        *(u32x4*)(WT + (size_t)(dr0 + n) * ldt + dk0 + k0 + 8 * c) = o; }
    LDS_WAIT(); asm volatile("" ::: "memory");
}
struct ColIdent { int c0; DI int operator()(int r) const { return c0 + r; } };
struct ColFfn { DI int operator()(int r) const { const int tile = r >> 8, j = r & 255; return j < 128 ? tile * 128 + j : FF + tile * 128 + (j - 128); } };
struct ColInproj { DI int operator()(int r) const { return r < 3072 ? r : (r < 5192 ? r + 16 : (r < 5208 ? 3072 + (r - 5192) : -1)); } };
template <class ColFn>
DI bool conv_job(int& it, const float* W, int ldw, int K, int nb, bf16* WT, int ldt, ColFn f, LAS float* scr, int lane) {
    const int n_items = (K / 64) * nb;
    if (it >= n_items) { it -= n_items; return false; }
    const int kb = it / nb, b = it % nb;
    conv_item(W, ldw, 64 * kb, WT, ldt, 32 * b, 0, f, scr, lane);
    return true;
}
DI void rms_row_bf16(const float* xrow, const float* g, bf16* orow, int lane) {
    const f32x4* xr = (const f32x4*)xrow + lane; const f32x4* gr = (const f32x4*)g + lane;
    f32x4 v[4]; float s = 0.f;
#pragma unroll
    for (int j = 0; j < 4; ++j) { v[j] = xr[64 * j]; s += (v[j].x * v[j].x + v[j].y * v[j].y) + (v[j].z * v[j].z + v[j].w * v[j].w); }
    const float r = __builtin_amdgcn_rsqf(wave_sum(s) * (1.f / D) + EPS);
    u32x2* o8 = (u32x2*)orow + lane;
#pragma unroll
    for (int j = 0; j < 4; ++j) { const f32x4 gg = gr[64 * j]; u32x2 w; w.x = pk2(v[j].x * r * gg.x, v[j].y * r * gg.y); w.y = pk2(v[j].z * r * gg.z, v[j].w * r * gg.w); o8[64 * j] = w; }
}
DI void resnorm_row(const float* hin, const bf16* yrow, const float* gpost, float coef, float* hout, const float* gpre, bf16* xn, int lane) {
    const u32x2* yr = (const u32x2*)yrow + lane; const f32x4* hr = (const f32x4*)hin + lane; const f32x4* gp = (const f32x4*)gpost + lane;
    f32x4 y[4]; float s = 0.f;
#pragma unroll
    for (int j = 0; j < 4; ++j) { const u32x2 w = yr[64 * j]; y[j] = (f32x4){bflo(w.x), bfhi(w.x), bflo(w.y), bfhi(w.y)}; s += (y[j].x * y[j].x + y[j].y * y[j].y) + (y[j].z * y[j].z + y[j].w * y[j].w); }
    const float r = __builtin_amdgcn_rsqf(wave_sum(s) * (1.f / D) + EPS) * coef;
    f32x4 h[4]; float s2 = 0.f;
#pragma unroll
    for (int j = 0; j < 4; ++j) { const f32x4 gg = gp[64 * j]; h[j] = hr[64 * j] + y[j] * r * gg; s2 += (h[j].x * h[j].x + h[j].y * h[j].y) + (h[j].z * h[j].z + h[j].w * h[j].w); }
    f32x4* ho = (f32x4*)hout + lane;
#pragma unroll
    for (int j = 0; j < 4; ++j) ho[64 * j] = h[j];
    if (xn) {
        const float r2 = __builtin_amdgcn_rsqf(wave_sum(s2) * (1.f / D) + EPS);
        const f32x4* gq = (const f32x4*)gpre + lane; u32x2* o8 = (u32x2*)xn + lane;
#pragma unroll
        for (int j = 0; j < 4; ++j) { const f32x4 gg = gq[64 * j]; u32x2 w; w.x = pk2(h[j].x * r2 * gg.x, h[j].y * r2 * gg.y); w.y = pk2(h[j].z * r2 * gg.z, h[j].w * r2 * gg.w); o8[64 * j] = w; }
    }
}
DI void resnorm_phase(Frame& F, const float* hin, const bf16* y, const float* gpost, float coef, float* hout, const float* gpre, bf16* xn) {
    const int gw = F.c * NWAVES + F.wave, NGW = F.G * NWAVES;
    for (int m = gw; m < M; m += NGW) resnorm_row(hin + (size_t)m * D, y + (size_t)m * D, gpost, coef, hout + (size_t)m * D, gpre, xn ? xn + (size_t)m * D : nullptr, F.lane);
}

using pg8::Unit;
typedef f32x4 Acc[2][2][4][2];
struct EpiStore {
    bf16* O; int ldo;
    DI bool operator()(Acc& acc, const Unit& u, int wr, int wc, int fr, int fq) const {
        const int row0 = u.pm * 256 + wr * 64 + fr, col0 = u.pn * 256 + wc * 32 + 8 * fq;
#pragma unroll
        for (int ai = 0; ai < 2; ++ai)
#pragma unroll
            for (int m = 0; m < 4; ++m) { bf16* rowp = O + (size_t)(row0 + ai * 128 + m * 16) * ldo + col0;
#pragma unroll
                for (int bj = 0; bj < 2; ++bj) { const f32x4 v0 = acc[ai][bj][m][0], v1 = acc[ai][bj][m][1];
                    u32x4 w; w.x = pk2(v0[0], v0[1]); w.y = pk2(v0[2], v0[3]); w.z = pk2(v1[0], v1[1]); w.w = pk2(v1[2], v1[3]);
                    *(u32x4*)(rowp + bj * 128) = w; } }
        return false;
    }
};
struct EpiGates {
    bf16* SGA; bf16* SGB;
    DI bool operator()(Acc& acc, const Unit& u, int wr, int wc, int fr, int fq) const {
        bf16* O = u.pn < 4 ? SGA : SGB;
        const int row0 = u.pm * 256 + wr * 64 + fr, col0 = (u.pn & 3) * 256 + wc * 32 + 8 * fq;
#pragma unroll
        for (int ai = 0; ai < 2; ++ai)
#pragma unroll
            for (int m = 0; m < 4; ++m) { bf16* rowp = O + (size_t)(row0 + ai * 128 + m * 16) * 1024 + col0;
#pragma unroll
                for (int bj = 0; bj < 2; ++bj) { const f32x4 v0 = acc[ai][bj][m][0], v1 = acc[ai][bj][m][1];
                    u32x4 w; w.x = pk2(sigmoid_f(v0[0]), sigmoid_f(v0[1])); w.y = pk2(sigmoid_f(v0[2]), sigmoid_f(v0[3])); w.z = pk2(sigmoid_f(v1[0]), sigmoid_f(v1[1])); w.w = pk2(sigmoid_f(v1[2]), sigmoid_f(v1[3]));
                    *(u32x4*)(rowp + bj * 128) = w; } }
        return false;
    }
};
struct EpiSwiglu {
    bf16* H;
    DI bool operator()(Acc& acc, const Unit& u, int wr, int wc, int fr, int fq) const {
        const int row0 = u.pm * 256 + wr * 64 + fr, col0 = u.pn * 128 + wc * 32 + 8 * fq;
#pragma unroll
        for (int ai = 0; ai < 2; ++ai)
#pragma unroll
            for (int m = 0; m < 4; ++m) { bf16* rowp = H + (size_t)(row0 + ai * 128 + m * 16) * FF + col0;
                float o[8];
#pragma unroll
                for (int n = 0; n < 2; ++n)
#pragma unroll
                    for (int e = 0; e < 4; ++e) { const float a = acc[ai][0][m][n][e], b = acc[ai][1][m][n][e]; o[4 * n + e] = a * sigmoid_f(a) * b; }
                u32x4 w; w.x = pk2(o[0], o[1]); w.y = pk2(o[2], o[3]); w.z = pk2(o[4], o[5]); w.w = pk2(o[6], o[7]);
                *(u32x4*)rowp = w; }
        return false;
    }
};
struct EpiInproj {
    unsigned char* ws;
    DI bool operator()(Acc& acc, const Unit& u, int wr, int wc, int fr, int fq) const {
        bf16* O; int ldo, ct; bool half_only = false;
        if (u.g == 1) { O = (bf16*)(ws + WS_KVM); ldo = 1024; ct = u.pn; }
        else if (u.pn < 4) { O = (bf16*)(ws + WS_QKG); ldo = 1024; ct = u.pn; }
        else if (u.pn < 8) { O = (bf16*)(ws + WS_GV); ldo = 1024; ct = u.pn - 4; }
        else if (u.pn < 12) { O = (bf16*)(ws + WS_GR); ldo = 1024; ct = u.pn - 8; }
        else if (u.pn < 18) { O = (bf16*)(ws + WS_DQKV); ldo = 1536; ct = u.pn - 12; }
        else if (u.pn < 20) { O = (bf16*)(ws + WS_IQ); ldo = 512; ct = u.pn - 18; }
        else { O = (bf16*)(ws + WS_SM); ldo = 128; ct = 0; half_only = true; }
        const int row0 = u.pm * 256 + wr * 64 + fr, col0 = ct * 256 + wc * 32 + 8 * fq;
#pragma unroll
        for (int ai = 0; ai < 2; ++ai)
#pragma unroll
            for (int m = 0; m < 4; ++m) { bf16* rowp = O + (size_t)(row0 + ai * 128 + m * 16) * ldo + col0;
#pragma unroll
                for (int bj = 0; bj < 2; ++bj) { const f32x4 v0 = acc[ai][bj][m][0], v1 = acc[ai][bj][m][1];
                    u32x4 w; w.x = pk2(v0[0], v0[1]); w.y = pk2(v0[2], v0[3]); w.z = pk2(v1[0], v1[1]); w.w = pk2(v1[2], v1[3]);
                    if (bj == 0 || !half_only) *(u32x4*)(rowp + bj * 128) = w; } }
        return false;
    }
};
struct EpiMerge {
    const bf16* SGA; const bf16* SGB; bf16* O;
    DI bool operator()(Acc& acc, const Unit& u, int wr, int wc, int fr, int fq) const {
        const int row0 = u.pm * 256 + wr * 64 + fr, col0 = u.pn * 256 + wc * 32 + 8 * fq;
#pragma unroll
        for (int ai = 0; ai < 2; ++ai)
#pragma unroll
            for (int m = 0; m < 4; ++m) { const size_t off = (size_t)(row0 + ai * 128 + m * 16) * 1024 + col0;
#pragma unroll
                for (int bj = 0; bj < 2; ++bj) {
                    const u32x4 gb = *(const u32x4*)(SGB + off + bj * 128);
                    const float b[8] = {bflo(gb.x), bfhi(gb.x), bflo(gb.y), bfhi(gb.y), bflo(gb.z), bfhi(gb.z), bflo(gb.w), bfhi(gb.w)};
                    if (u.g == 0) {
                        const u32x4 ga = *(const u32x4*)(SGA + off + bj * 128);
                        const float a[8] = {bflo(ga.x), bfhi(ga.x), bflo(ga.y), bfhi(ga.y), bflo(ga.z), bfhi(ga.z), bflo(ga.w), bfhi(ga.w)};
#pragma unroll
                        for (int n = 0; n < 2; ++n)
#pragma unroll
                            for (int e = 0; e < 4; ++e) acc[ai][bj][m][n][e] *= a[4 * n + e] * fast_rcp(fmaxf(b[4 * n + e], 1e-30f));
                    } else {
                        const f32x4 v0 = acc[ai][bj][m][0], v1 = acc[ai][bj][m][1];
                        u32x4 w; w.x = pk2(v0[0] * b[0], v0[1] * b[1]); w.y = pk2(v0[2] * b[2], v0[3] * b[3]); w.z = pk2(v1[0] * b[4], v1[1] * b[5]); w.w = pk2(v1[2] * b[6], v1[3] * b[7]);
                        *(u32x4*)(O + off + bj * 128) = w;
                    } } }
        return u.g == 0;
    }
};

constexpr int GP = 272;
struct GlaW { float wu0[16], wu1[16], bb0, bb1; };
DI void gla_la(const bf16* SM, size_t row, const GlaW& W, float& l0, float& l1) {
    const u32x4* gp = (const u32x4*)(SM + row * 128 + 72);
    const u32x4 g0 = gp[0], g1 = gp[1];
    const float ga[16] = {bflo(g0.x), bfhi(g0.x), bflo(g0.y), bfhi(g0.y), bflo(g0.z), bfhi(g0.z), bflo(g0.w), bfhi(g0.w), bflo(g1.x), bfhi(g1.x), bflo(g1.y), bfhi(g1.y), bflo(g1.z), bfhi(g1.z), bflo(g1.w), bfhi(g1.w)};
    float x0 = W.bb0, x1 = W.bb1;
#pragma unroll
    for (int r = 0; r < 16; ++r) { x0 = fmaf(ga[r], W.wu0[r], x0); x1 = fmaf(ga[r], W.wu1[r], x1); }
    l0 = (fminf(x0, 0.f) - __logf(1.f + fast_exp(-fabsf(x0)))) * 0.0625f; l1 = (fminf(x1, 0.f) - __logf(1.f + fast_exp(-fabsf(x1)))) * 0.0625f;
}
struct GlaPre { float pre0, pre1, end0, end1; };
DI void gla_totals(Frame& F, const float* const* in, int h, size_t row0, LAS float* tot, GlaW& W, GlaPre& P) {
    const int l = F.lane, w = F.wave;
    const bf16* SM = (const bf16*)(F.ws + WS_SM);
    const float* wup = in[9]; const float* bal = in[10];
#pragma unroll
    for (int r = 0; r < 16; ++r) { W.wu0[r] = wup[r * 512 + h * 128 + l]; W.wu1[r] = wup[r * 512 + h * 128 + 64 + l]; }
    W.bb0 = bal[h * 128 + l]; W.bb1 = bal[h * 128 + 64 + l];
    float run0 = 0.f, run1 = 0.f;
#pragma unroll 2
    for (int tt = 0; tt < 32; ++tt) { float l0, l1; gla_la(SM, row0 + 32 * w + tt, W, l0, l1); run0 += l0; run1 += l1; }
    tot[w * 128 + l] = run0; tot[w * 128 + 64 + l] = run1;
    __syncthreads();
    float p0 = 0.f, p1 = 0.f, e0 = 0.f, e1 = 0.f;
#pragma unroll
    for (int ww = 0; ww < 8; ++ww) { const float a = tot[ww * 128 + l], b = tot[ww * 128 + 64 + l]; e0 += a; e1 += b; if (ww < w) { p0 += a; p1 += b; } }
    P.pre0 = p0; P.pre1 = p1; P.end0 = e0; P.end1 = e1;
}
DI unsigned tr_lane(int pitch, int hmul, int lane) { const int i16 = lane & 15, q = i16 >> 2, p = i16 & 3, blk = (lane >> 4) & 1; return (unsigned)((hmul * (lane >> 5) + q) * pitch + (16 * blk + 4 * p) * 2); }
DI bf16x8 tr_frag(unsigned base_lane, int pitch, int row_lo, int row_hi, int n0) {
    return cat4(vtr(base_lane + (unsigned)(row_lo * pitch + n0 * 2)), vtr(base_lane + (unsigned)(row_hi * pitch + n0 * 2)));
}
DI void gla_load_v_half(Frame& F, unsigned vh, size_t row0, int h, int half) {
    const bf16* GV = (const bf16*)(F.ws + WS_GV);
#pragma unroll
    for (int it = 0; it < 8; ++it) { const int idx = it * NT + F.tid, row = idx >> 4, ch = idx & 15;
        const u32x4 v = *(const u32x4*)(GV + (row0 + row) * 1024 + h * 256 + half * 128 + ch * 8);
        *(LAS u32x4*)(vh + row * GP + ch * 16) = v; }
}
DI void gla_state_unit(Frame& F, const float* const* in, int u) {
    const int l = F.lane, w = F.wave, hh = l >> 5;
    const int bh = u >> 5, b = bh >> 2, h = bh & 3, sc = u & 31; const size_t row0 = (size_t)b * T + sc * 256;
    const unsigned KH = (unsigned)(size_t)F.lds, VH = KH + 256 * GP; LAS float* tot = (LAS float*)(F.lds + 2 * 256 * GP);
    const bf16* QKG = (const bf16*)(F.ws + WS_QKG);
    float* GST = (float*)(F.ws + WS_GST); float* DEC = (float*)(F.ws + WS_DEC);
    GlaW W; GlaPre P; gla_totals(F, in, h, row0, tot, W, P);
    {
        const bf16* SM = (const bf16*)(F.ws + WS_SM);
        float B0 = P.pre0, B1 = P.pre1;
#pragma unroll 2
        for (int tt = 0; tt < 32; ++tt) { const size_t row = row0 + 32 * w + tt;
            float l0, l1; gla_la(SM, row, W, l0, l1); B0 += l0; B1 += l1;
            const float k0 = bf2f(QKG[row * 1024 + 512 + h * 128 + l]), k1 = bf2f(QKG[row * 1024 + 512 + h * 128 + 64 + l]);
            const float f0 = k0 * fast_exp(P.end0 - B0), f1 = k1 * fast_exp(P.end1 - B1);
            *(LAS bf16*)(KH + (32 * w + tt) * GP + l * 2) = (bf16)(pk2(f0, 0.f) & 0xffffu); *(LAS bf16*)(KH + (32 * w + tt) * GP + (64 + l) * 2) = (bf16)(pk2(f1, 0.f) & 0xffffu); }
    }
    if (w == 0) { DEC[u * 128 + l] = fast_exp(P.end0); DEC[u * 128 + 64 + l] = fast_exp(P.end1); }
    const int etile = w >> 1, dt0 = 2 * (w & 1);
    const unsigned vhl = VH + tr_lane(GP, 8, l) + etile * 64, khl = KH + tr_lane(GP, 8, l) + dt0 * 64;
    for (int half = 0; half < 2; ++half) {
        gla_load_v_half(F, VH, row0, h, half);
        __syncthreads();
        f32x16 acc0, acc1;
#pragma unroll
        for (int r = 0; r < 16; ++r) { acc0[r] = 0.f; acc1[r] = 0.f; }
#pragma unroll 4
        for (int s = 0; s < 16; ++s) {
            const bf16x8 a = tr_frag(vhl, GP, 16 * s, 16 * s + 4, 0);
            const bf16x8 b0 = tr_frag(khl, GP, 16 * s, 16 * s + 4, 0), b1 = tr_frag(khl, GP, 16 * s, 16 * s + 4, 32);
            acc0 = MFMA32(a, b0, acc0); acc1 = MFMA32(a, b1, acc1);
        }
#pragma unroll
        for (int r = 0; r < 16; ++r) { const int e = half * 128 + etile * 32 + crow(r, hh); float* o = GST + ((size_t)u * 256 + e) * 128 + dt0 * 32 + (l & 31); o[0] = acc0[r]; o[32] = acc1[r]; }
        __syncthreads();
    }
}
DI void gla_scan_phase(Frame& F) {
    float* GST = (float*)(F.ws + WS_GST); const float* DEC = (const float*)(F.ws + WS_DEC);
    for (int idx = F.c * NT + F.tid; idx < 8 * 16384; idx += F.G * NT) {
        const int bh = idx >> 14, rem = idx & 16383, e = rem >> 6, d = (rem & 63) * 2;
        f32x2 st = {0.f, 0.f};
#pragma unroll 4
        for (int sc = 0; sc < 32; ++sc) { const int u = bh * 32 + sc; f32x2* p = (f32x2*)(GST + ((size_t)u * 256 + e) * 128 + d);
            const f32x2 uu = *p; const f32x2 dc = *(const f32x2*)(DEC + u * 128 + d); *p = st; st = dc * st + uu; }
    }
}
DI void gla_out_unit(Frame& F, const float* const* in, int u) {
    const int l = F.lane, w = F.wave, hh = l >> 5;
    const int bh = u >> 5, b = bh >> 2, h = bh & 3, sc = u & 31; const size_t row0 = (size_t)b * T + sc * 256;
    const unsigned QS = (unsigned)(size_t)F.lds, KS = QS + 256 * GP; LAS float* tot = (LAS float*)(F.lds + 2 * 256 * GP);
    const bf16* QKG = (const bf16*)(F.ws + WS_QKG); const float* GST = (const float*)(F.ws + WS_GST); bf16* GR = (bf16*)(F.ws + WS_GR);
    {
        GlaW W; GlaPre P; gla_totals(F, in, h, row0, tot, W, P);
        const bf16* SM = (const bf16*)(F.ws + WS_SM);
        const float qs = 0.08838834764831845f;
        float B0 = P.pre0, B1 = P.pre1;
#pragma unroll 2
        for (int tt = 0; tt < 32; ++tt) { const size_t row = row0 + 32 * w + tt;
            float l0, l1; gla_la(SM, row, W, l0, l1); B0 += l0; B1 += l1;
            const float q0 = bf2f(QKG[row * 1024 + h * 128 + l]), q1 = bf2f(QKG[row * 1024 + h * 128 + 64 + l]);
            const float k0 = bf2f(QKG[row * 1024 + 512 + h * 128 + l]), k1 = bf2f(QKG[row * 1024 + 512 + h * 128 + 64 + l]);
            const unsigned a = QS + (32 * w + tt) * GP + l * 2, bb = KS + (32 * w + tt) * GP + l * 2;
            *(LAS bf16*)(a) = (bf16)(pk2(q0 * qs * fast_exp(B0), 0.f) & 0xffffu); *(LAS bf16*)(a + 128) = (bf16)(pk2(q1 * qs * fast_exp(B1), 0.f) & 0xffffu);
            *(LAS bf16*)(bb) = (bf16)(pk2(k0 * fast_exp(-B0), 0.f) & 0xffffu); *(LAS bf16*)(bb + 128) = (bf16)(pk2(k1 * fast_exp(-B1), 0.f) & 0xffffu); }
    }
    __syncthreads();
    bf16x8 qf[8];
#pragma unroll
    for (int s = 0; s < 8; ++s) qf[s] = lds_b128(QS + (32 * w + (l & 31)) * GP + (16 * s + 8 * hh) * 2);
    __syncthreads();
    f32x16 acc[8];
#pragma unroll
    for (int et = 0; et < 8; ++et)
#pragma unroll
        for (int r = 0; r < 16; ++r) acc[et][r] = 0.f;
    const unsigned VH = QS;
#pragma unroll
    for (int half = 0; half < 2; ++half) {
        gla_load_v_half(F, VH, row0, h, half);
        __syncthreads();
        for (int j = 0; j <= w; ++j) {
            f32x16 X;
#pragma unroll
            for (int r = 0; r < 16; ++r) X[r] = 0.f;
            const unsigned ksj = KS + (l & 31) * GP + 16 * hh + 32 * j * GP, vhj = VH + tr_lane(GP, 4, l) + 32 * j * GP;
#pragma unroll
            for (int s = 0; s < 8; ++s) X = MFMA32(lds_b128(ksj + 32 * s), qf[s], X);
            if (j == w) {
#pragma unroll
                for (int r = 0; r < 16; ++r) if (crow(r, hh) > (l & 31)) X[r] = 0.f;
            }
            const bf16x8 xb0 = pack_step(X, 0), xb1 = pack_step(X, 1);
#pragma unroll
            for (int et = 0; et < 4; ++et) {
                const bf16x8 a0 = tr_frag(vhj, GP, 0, 8, et * 32), a1 = tr_frag(vhj, GP, 16, 24, et * 32);
                acc[half * 4 + et] = MFMA32(a0, xb0, acc[half * 4 + et]); acc[half * 4 + et] = MFMA32(a1, xb1, acc[half * 4 + et]);
            }
        }
        __syncthreads();
    }
    {
        const int soff = (l & 31) * 128 + 8 * hh;
#pragma unroll
        for (int et = 0; et < 8; ++et) {
            const float* sp = GST + (size_t)u * 32768 + et * 4096 + soff;
#pragma unroll
            for (int s = 0; s < 8; s += 2) {
                const f32x4 x0 = *(const f32x4*)(sp + 16 * s), x1 = *(const f32x4*)(sp + 16 * s + 4), x2 = *(const f32x4*)(sp + 16 * s + 16), x3 = *(const f32x4*)(sp + 16 * s + 20);
                acc[et] = MFMA32(pack8(x0.x, x0.y, x0.z, x0.w, x1.x, x1.y, x1.z, x1.w), qf[s], acc[et]);
                acc[et] = MFMA32(pack8(x2.x, x2.y, x2.z, x2.w, x3.x, x3.y, x3.z, x3.w), qf[s + 1], acc[et]);
                asm volatile("" ::: "memory");
            }
        }
    }
    float ss = 0.f;
#pragma unroll
    for (int et = 0; et < 8; ++et)
#pragma unroll
        for (int r = 0; r < 16; ++r) ss += acc[et][r] * acc[et][r];
    ss += __shfl_xor(ss, 32);
    const float rinv = __builtin_amdgcn_rsqf(ss * (1.f / 256.f) + EPS);
    const float* gn = in[11] + h * 256 + 4 * hh;
    bf16* orow = GR + (row0 + 32 * w + (l & 31)) * 1024 + h * 256 + 4 * hh;
#pragma unroll
    for (int et = 0; et < 8; ++et)
#pragma unroll
        for (int g = 0; g < 4; ++g) { const int e = et * 32 + 8 * g;
            const u32x2 gw = *(const u32x2*)(orow + e); const f32x4 gg = *(const f32x4*)(gn + e);
            const float r0 = bflo(gw.x), r1 = bfhi(gw.x), r2 = bflo(gw.y), r3 = bfhi(gw.y);
            u32x2 o; o.x = pk2(acc[et][4 * g] * rinv * gg.x * r0 * sigmoid_f(r0), acc[et][4 * g + 1] * rinv * gg.y * r1 * sigmoid_f(r1));
            o.y = pk2(acc[et][4 * g + 2] * rinv * gg.z * r2 * sigmoid_f(r2), acc[et][4 * g + 3] * rinv * gg.w * r3 * sigmoid_f(r3));
            *(u32x2*)(orow + e) = o; if (g == 3) __builtin_amdgcn_sched_barrier(0); }
}

DI void hist_find(LAS unsigned* H, int lane, unsigned k, unsigned& bin, unsigned& above) {
    const u32x4 c = *(const LAS u32x4*)(H + 4 * lane);
    const unsigned s = c.x + c.y + c.z + c.w; unsigned suf = s;
#pragma unroll
    for (int o = 1; o < 64; o <<= 1) { const unsigned v = __shfl_down(suf, o); if (lane + o < 64) suf += v; }
    const unsigned excl = suf - s;
    const bool cross = excl < k && suf >= k;
    unsigned a = excl, bn = 0, ab = 0;
    if (a + c.w >= k) { bn = 4 * lane + 3; ab = a; } else { a += c.w;
        if (a + c.z >= k) { bn = 4 * lane + 2; ab = a; } else { a += c.z;
            if (a + c.y >= k) { bn = 4 * lane + 1; ab = a; } else { a += c.y; bn = 4 * lane; ab = a; } } }
    const unsigned long long m = __ballot(cross);
    const int src = m ? __builtin_ctzll(m) : 0;
    bin = __shfl(bn, src); above = __shfl(ab, src);
}
DI void idx_unit(Frame& F, int u) {
    const int l = F.lane, w = F.wave, hh = l >> 5;
    const int b = u >> 10, t0 = (u & 1023) * 8; const size_t row0 = (size_t)b * T + t0;
    const bf16* IQ = (const bf16*)(F.ws + WS_IQ); const bf16* SM = (const bf16*)(F.ws + WS_SM);
    const unsigned SC = (unsigned)(size_t)F.lds; LAS unsigned* HIST = (LAS unsigned*)(F.lds + 131072);
    bf16x8 af[2][4]; float wv[2][16];
    {
        const int rho = l & 31;
#pragma unroll
        for (int tl = 0; tl < 2; ++tl) { const int q = 4 * tl + (rho >> 4) + 2 * ((rho >> 2) & 1), head = (rho & 3) + 4 * ((rho >> 3) & 1);
#pragma unroll
            for (int s = 0; s < 4; ++s) af[tl][s] = *(const bf16x8*)(IQ + (row0 + q) * 512 + head * 64 + 16 * s + 8 * hh);
#pragma unroll
            for (int r = 0; r < 16; ++r) { const int qq = 4 * tl + (r >> 3) + 2 * hh, hd = (r & 3) + 4 * ((r >> 2) & 1); wv[tl][r] = bf2f(SM[(row0 + qq) * 128 + 64 + hd]); } }
    }
    const int ntile = t0 / 32 + 1;
    for (int kt = w; kt < ntile; kt += 8) {
        const int key = 32 * kt + (l & 31); const bf16* kp = SM + ((size_t)b * T + key) * 128 + 8 * hh;
        bf16x8 bfr[4];
#pragma unroll
        for (int s = 0; s < 4; ++s) bfr[s] = *(const bf16x8*)(kp + 16 * s);
        f32x16 C0, C1;
#pragma unroll
        for (int r = 0; r < 16; ++r) { C0[r] = 0.f; C1[r] = 0.f; }
#pragma unroll
        for (int s = 0; s < 4; ++s) { C0 = MFMA32(af[0][s], bfr[s], C0); C1 = MFMA32(af[1][s], bfr[s], C1); }
#pragma unroll
        for (int tl = 0; tl < 2; ++tl)
#pragma unroll
            for (int b4 = 0; b4 < 2; ++b4) {
                float sc = 0.f;
#pragma unroll
                for (int r = 0; r < 8; ++r) sc = fmaf(wv[tl][8 * b4 + r], fmaxf(tl ? C1[8 * b4 + r] : C0[8 * b4 + r], 0.f), sc);
                const int q = 4 * tl + b4 + 2 * hh;
                sc = fminf(fmaxf(sc, -60000.f), 60000.f);
                const _Float16 hf = (_Float16)sc; unsigned h16 = (unsigned)__builtin_bit_cast(unsigned short, hf);
                unsigned k16 = (h16 & 0x8000u) ? (~h16 & 0xffffu) : (h16 | 0x8000u);
                if (key > t0 + q) k16 = 0u;
                *(LAS unsigned short*)(SC + q * 16384 + key * 2) = (unsigned short)k16;
            }
    }
    __syncthreads();
    {
        const int t = t0 + w, n = t + 1, nit = (n + 255) >> 8;
        unsigned char* mrow = (unsigned char*)(F.ws + WS_IQ) + (row0 + w) * 1024;
        const unsigned scq = SC + w * 16384 + l * 8;
        LAS unsigned* H = HIST + w * 256;
        unsigned thr = 0u, rneed = 0u;
        if (n > 256) {
            unsigned B, above, L, above2;
            H[l] = 0u; H[l + 64] = 0u; H[l + 128] = 0u; H[l + 192] = 0u; LDS_WAIT();
            for (int it = 0; it < nit; ++it) { const u32x2 kk = *(const LAS u32x2*)(scq + it * 512); const int i0 = 256 * it + 4 * l;
                const unsigned k0 = kk.x & 0xffffu, k1 = kk.x >> 16, k2 = kk.y & 0xffffu, k3 = kk.y >> 16;
                if (i0 < n) __hip_atomic_fetch_add(H + (k0 >> 8), 1u, __ATOMIC_RELAXED, __HIP_MEMORY_SCOPE_WORKGROUP);
                if (i0 + 1 < n) __hip_atomic_fetch_add(H + (k1 >> 8), 1u, __ATOMIC_RELAXED, __HIP_MEMORY_SCOPE_WORKGROUP);
                if (i0 + 2 < n) __hip_atomic_fetch_add(H + (k2 >> 8), 1u, __ATOMIC_RELAXED, __HIP_MEMORY_SCOPE_WORKGROUP);
                if (i0 + 3 < n) __hip_atomic_fetch_add(H + (k3 >> 8), 1u, __ATOMIC_RELAXED, __HIP_MEMORY_SCOPE_WORKGROUP); }
            LDS_WAIT(); hist_find(H, l, 256u, B, above);
            LDS_WAIT(); H[l] = 0u; H[l + 64] = 0u; H[l + 128] = 0u; H[l + 192] = 0u; LDS_WAIT();
            for (int it = 0; it < nit; ++it) { const u32x2 kk = *(const LAS u32x2*)(scq + it * 512); const int i0 = 256 * it + 4 * l;
                const unsigned k0 = kk.x & 0xffffu, k1 = kk.x >> 16, k2 = kk.y & 0xffffu, k3 = kk.y >> 16;
                if (i0 < n && (k0 >> 8) == B) __hip_atomic_fetch_add(H + (k0 & 255u), 1u, __ATOMIC_RELAXED, __HIP_MEMORY_SCOPE_WORKGROUP);
                if (i0 + 1 < n && (k1 >> 8) == B) __hip_atomic_fetch_add(H + (k1 & 255u), 1u, __ATOMIC_RELAXED, __HIP_MEMORY_SCOPE_WORKGROUP);
                if (i0 + 2 < n && (k2 >> 8) == B) __hip_atomic_fetch_add(H + (k2 & 255u), 1u, __ATOMIC_RELAXED, __HIP_MEMORY_SCOPE_WORKGROUP);
                if (i0 + 3 < n && (k3 >> 8) == B) __hip_atomic_fetch_add(H + (k3 & 255u), 1u, __ATOMIC_RELAXED, __HIP_MEMORY_SCOPE_WORKGROUP); }
            LDS_WAIT(); hist_find(H, l, 256u - above, L, above2);
            thr = (B << 8) | L; rneed = 256u - above - above2;
        }
        unsigned running = 0u;
        for (int it = 0; it < nit; ++it) {
            const u32x2 kk = *(const LAS u32x2*)(scq + it * 512); const int i0 = 256 * it + 4 * l;
            const unsigned ks[4] = {kk.x & 0xffffu, kk.x >> 16, kk.y & 0xffffu, kk.y >> 16};
            unsigned nib = 0u;
            if (n <= 256) {
#pragma unroll
                for (int j = 0; j < 4; ++j) nib |= (i0 + j < n) ? (1u << j) : 0u;
            } else {
                bool eq[4]; unsigned long long mk[4];
#pragma unroll
                for (int j = 0; j < 4; ++j) { eq[j] = (i0 + j < n) && ks[j] == thr; mk[j] = __ballot(eq[j]); }
                const unsigned long long below = (1ull << l) - 1ull;
                unsigned cum = running + (unsigned)(__popcll(mk[0] & below) + __popcll(mk[1] & below) + __popcll(mk[2] & below) + __popcll(mk[3] & below));
#pragma unroll
                for (int j = 0; j < 4; ++j) { const bool gt = (i0 + j < n) && ks[j] > thr; const bool take = gt || (eq[j] && cum < rneed); if (eq[j]) ++cum; nib |= take ? (1u << j) : 0u; }
                running += (unsigned)(__popcll(mk[0]) + __popcll(mk[1]) + __popcll(mk[2]) + __popcll(mk[3]));
            }
            const unsigned up = __shfl_down(nib, 1);
            if ((l & 1) == 0) mrow[it * 32 + (l >> 1)] = (unsigned char)(nib | (up << 4));
        }
    }
    __syncthreads();
}

template <int DH, bool DSA>
DI void attn_unit(Frame& F, const bf16* Qp, int ldq, const bf16* Kp, const bf16* Vp, int ldkv, int nst, bf16* Op, int ldo, float c1,
                  const unsigned* mask0  , int tq0, const LAS float* BT, float cfar) {
    constexpr int PK = DH * 2 + 16, SB = 64 * PK, NS = DH / 16, ND = DH / 32, CH = DH / 8  , NLD = 64 * CH / NT;
    const int l = F.lane, w = F.wave, hh = l >> 5, tid = F.tid;
    const unsigned KT = (unsigned)(size_t)F.lds, VT = KT + 2 * SB;
    const unsigned klane = (unsigned)((l & 31) * PK + 16 * hh), vlane = tr_lane(PK, 4, l);
    bf16x8 qf[NS];
#pragma unroll
    for (int s = 0; s < NS; ++s) qf[s] = *(const bf16x8*)(Qp + (size_t)(32 * w + (l & 31)) * ldq + 16 * s + 8 * hh);
    f32x16 O[ND];
#pragma unroll
    for (int d = 0; d < ND; ++d)
#pragma unroll
        for (int r = 0; r < 16; ++r) O[d][r] = 0.f;
    float lsum = 0.f;
    const int tq = tq0 + 32 * w + (l & 31), tq_hi = tq0 + 32 * w + 31, tq_lo = tq0 + 32 * w;
    const unsigned* mrow = DSA ? mask0 + (size_t)(32 * w + (l & 31)) * 256 : nullptr;
    u32x4 kr[NLD], vr[NLD];
#pragma unroll
    for (int i = 0; i < NLD; ++i) { const int idx = i * NT + tid, row = idx / CH, ch = idx % CH;
        kr[i] = *(const u32x4*)(Kp + (size_t)row * ldkv + ch * 8); vr[i] = *(const u32x4*)(Vp + (size_t)row * ldkv + ch * 8); }
#pragma unroll
    for (int i = 0; i < NLD; ++i) { const int idx = i * NT + tid, row = idx / CH, ch = idx % CH;
        *(LAS u32x4*)(KT + row * PK + ch * 16) = kr[i]; *(LAS u32x4*)(VT + row * PK + ch * 16) = vr[i]; }
    __syncthreads();
    for (int st = 0; st < nst; ++st) {
        const unsigned kt = KT + (st & 1) * SB, vt = VT + (st & 1) * SB;
        const bool more = st + 1 < nst;
        if (more) {
#pragma unroll
            for (int i = 0; i < NLD; ++i) { const int idx = i * NT + tid, row = 64 * (st + 1) + idx / CH, ch = idx % CH;
                kr[i] = *(const u32x4*)(Kp + (size_t)row * ldkv + ch * 8); vr[i] = *(const u32x4*)(Vp + (size_t)row * ldkv + ch * 8); }
        }
#pragma unroll
        for (int kb = 0; kb < 2; ++kb) {
            const int key0 = 64 * st + 32 * kb;
            if (DSA && key0 > tq_hi) continue;
            f32x16 X;
#pragma unroll
            for (int r = 0; r < 16; ++r) X[r] = 0.f;
#pragma unroll
            for (int s = 0; s < NS; ++s) X = MFMA32(lds_b128(kt + klane + 32 * kb * PK + 32 * s), qf[s], X);
            if (DSA) {
                const unsigned mw = mrow[key0 >> 5] >> (4 * hh);
                if (tq_lo - (key0 + 31) >= 113) {
#pragma unroll
                    for (int r = 0; r < 16; ++r) { const float p = fast_exp2(fmaf(X[r], c1, cfar)); const int bits = __builtin_amdgcn_sbfe((int)mw, (r & 3) + 8 * (r >> 2), 1);
                        const float pm = __uint_as_float(__float_as_uint(p) & (unsigned)bits); lsum += pm; X[r] = pm; }
                } else {
#pragma unroll
                    for (int r = 0; r < 16; ++r) { int di = tq - (key0 + crow(r, hh)); di = di < 0 ? 0 : (di > 127 ? 127 : di);
                        const float p = fast_exp2(fmaf(X[r], c1, BT[di])); const int bits = __builtin_amdgcn_sbfe((int)mw, (r & 3) + 8 * (r >> 2), 1);
                        const float pm = __uint_as_float(__float_as_uint(p) & (unsigned)bits); lsum += pm; X[r] = pm; }
                }
            } else {
#pragma unroll
                for (int r = 0; r < 16; ++r) { const float p = fast_exp2(X[r] * c1); lsum += p; X[r] = p; }
            }
            const bf16x8 xb0 = pack_step(X, 0), xb1 = pack_step(X, 1);
#pragma unroll
            for (int d = 0; d < ND; ++d) {
                const bf16x8 a0 = tr_frag(vt + vlane, PK, 32 * kb, 32 * kb + 8, 32 * d), a1 = tr_frag(vt + vlane, PK, 32 * kb + 16, 32 * kb + 24, 32 * d);
                O[d] = MFMA32(a0, xb0, O[d]); O[d] = MFMA32(a1, xb1, O[d]);
            }
        }
        if (more) {
            const unsigned kn = KT + ((st + 1) & 1) * SB, vn = VT + ((st + 1) & 1) * SB;
#pragma unroll
            for (int i = 0; i < NLD; ++i) { const int idx = i * NT + tid, row = idx / CH, ch = idx % CH;
                *(LAS u32x4*)(kn + row * PK + ch * 16) = kr[i]; *(LAS u32x4*)(vn + row * PK + ch * 16) = vr[i]; }
        }
        __syncthreads();
    }
    lsum += __shfl_xor(lsum, 32);
    const float inv = fast_rcp(lsum);
    bf16* orow = Op + (size_t)(32 * w + (l & 31)) * ldo;
#pragma unroll
    for (int d = 0; d < ND; ++d)
#pragma unroll
        for (int g = 0; g < 4; ++g) { u32x2 o; o.x = pk2(O[d][4 * g] * inv, O[d][4 * g + 1] * inv); o.y = pk2(O[d][4 * g + 2] * inv, O[d][4 * g + 3] * inv);
            *(u32x2*)(orow + 32 * d + 8 * g + 4 * hh) = o; }
}
DI int t5_bucket(int rel) {
    if (rel < 16) return rel;
    const float v = logf((float)rel * (1.f / 16.f)) / 2.0794415416798357f * 16.f;
    int lg = 16 + (int)v; return lg > 31 ? 31 : lg;
}
DI void dsa_att_unit(Frame& F, const float* const* in, int bh, int qb) {
    const int b = bh >> 3, h = bh & 7;
    LAS float* BT = (LAS float*)(F.lds + 4 * 64 * 144);
    const float* tab = in[14];
    __syncthreads();
    if (F.tid < 128) BT[F.tid] = tab[t5_bucket(F.tid) * 8 + h] * LOG2E;
    __syncthreads();
    const float cfar = tab[31 * 8 + h] * LOG2E;
    bf16* DQ = (bf16*)(F.ws + WS_DQKV);
    const size_t rowq = (size_t)b * T + qb * 256, rowk = (size_t)b * T;
    attn_unit<64, true>(F, DQ + rowq * 1536 + h * 64, 1536, DQ + rowk * 1536 + 512 + h * 64, DQ + rowk * 1536 + 1024 + h * 64, 1536, 4 * (qb + 1),
                        DQ + rowq * 1536 + h * 64, 1536, 0.125f * LOG2E, (const unsigned*)(F.ws + WS_IQ) + rowq * 256, qb * 256, BT, cfar);
}
DI void cross_att_unit(Frame& F, int u) {
    const int b = u >> 7, h = (u >> 5) & 3, qb = u & 31;
    const bf16* QC = (const bf16*)(F.ws + WS_QC); const bf16* KVM = (const bf16*)(F.ws + WS_KVM); bf16* OX = (bf16*)(F.ws + WS_OX);
    const size_t rowq = (size_t)b * T + qb * 256;
    __syncthreads();
    attn_unit<128, false>(F, QC + rowq * 512 + h * 128, 512, KVM + (size_t)b * MEML * 1024 + h * 128, KVM + (size_t)b * MEML * 1024 + 512 + h * 128, 1024, MEML / 64,
                          OX + rowq * 512 + h * 128, 512, 0.08838834764831845f * LOG2E, nullptr, 0, nullptr, 0.f);
}

constexpr int N_PHASES = 19;
#ifndef MK_ONE_LAUNCH
#define MK_ONE_LAUNCH 1
#endif
__global__ void __launch_bounds__(NT, 2) mega_fwd(Args args) {
    extern __shared__ __attribute__((aligned(16))) unsigned char lds_raw[];
    Frame F;
    F.lds = (LAS unsigned char*)lds_raw; F.ws = args.ws;
    F.tid = threadIdx.x; F.lane = F.tid & 63; F.wave = __builtin_amdgcn_readfirstlane(F.tid >> 6);
    F.G = gridDim.x; F.c = blockIdx.x;
    volatile LAS unsigned* MISC = (volatile LAS unsigned*)(F.lds + MISC_OFF);
    if (F.tid < 64) MISC[F.tid] = 0u;
    __syncthreads();
    unsigned* ctl = (unsigned*)(args.ws + WS_CTL);
    const int lo = args.ph_lo, hi = args.ph_hi;
    XcdBarrier bar; bar.bar = ctl + CW_BAR; bar.x = 0; bar.st = MISC + 8;
    if (hi - lo > 1) bar = xcd_barrier_post(ctl + CW_BAR, MISC + 8);
    const float* const* in = args.in;
    unsigned char* ws = args.ws;
    const int gw = F.c * NWAVES + F.wave, NGW = F.G * NWAVES;
#ifndef PHMASK
#define PHMASK 0x7ffff
#endif
#define IN(k) (((PHMASK >> (k)) & 1) && lo <= (k) && (k) < hi)
#define SEAM(k) do { if ((k) + 1 < hi) xcd_barrier(bar); } while (0)
    bf16* XN = (bf16*)(ws + WS_XN); bf16* HID = (bf16*)(ws + WS_HID); bf16* Y = (bf16*)(ws + WS_Y);
    bf16* W1A = (bf16*)(ws + WS_W1A); bf16* W1B = (bf16*)(ws + WS_W1B);

    if (IN(0)) {
        LAS float* scr = (LAS float*)(F.lds + F.wave * 16384);
        constexpr int NITEMS = 10240;
        for (int it0 = gw; it0 < NITEMS; it0 += NGW) { int it = it0;
            if (conv_job(it, in[4], 2 * FF, D, 2 * FF / 32, W1A, D, ColFfn{}, scr, F.lane)) continue;
            if (conv_job(it, in[5], D, FF, D / 32, W1B, FF, ColIdent{0}, scr, F.lane)) continue;
            if (conv_job(it, in[8], 7256, D, NIN / 32, (bf16*)(ws + WS_WIN), D, ColInproj{}, scr, F.lane)) continue;
            if (conv_job(it, in[8], 7256, D, 2048 / 32, (bf16*)(ws + WS_WGT), D, ColIdent{5208}, scr, F.lane)) continue;
            if (conv_job(it, in[12], D, D, D / 32, (bf16*)(ws + WS_WG), D, ColIdent{0}, scr, F.lane)) continue;
            if (conv_job(it, in[13], D, 512, D / 32, (bf16*)(ws + WS_WD), 512, ColIdent{0}, scr, F.lane)) continue;
            if (conv_job(it, in[15], D, D, D / 32, (bf16*)(ws + WS_WO), D, ColIdent{0}, scr, F.lane)) continue;
            if (conv_job(it, in[19], 512, D, 512 / 32, (bf16*)(ws + WS_WCQ), D, ColIdent{0}, scr, F.lane)) continue;
            if (conv_job(it, in[20], D, D, D / 32, (bf16*)(ws + WS_WCKV), D, ColIdent{0}, scr, F.lane)) continue;
            conv_job(it, in[21], D, 512, D / 32, (bf16*)(ws + WS_WCO), 512, ColIdent{0}, scr, F.lane);
        }
        for (int m = gw; m < M; m += NGW) rms_row_bf16(in[0] + (size_t)m * D, in[2], XN + (size_t)m * D, F.lane);
        for (int m = gw; m < BATCH * MEML; m += NGW) rms_row_bf16(in[1] + (size_t)m * D, in[16], (bf16*)(ws + WS_MEMN) + (size_t)m * D, F.lane);
        SEAM(0);
    }
    if (IN(1)) {
        pg8::Order1 S; S.init(pg8::GDesc{XN, W1A, D, D, D, M / 256, 2 * FF / 256}, F.G, F.c);
        pg8::gemm_phase<true>(F.lds, S, EpiSwiglu{HID});
        SEAM(1);
    }
    if (IN(2)) {
        pg8::Order1 S; S.init(pg8::GDesc{HID, W1B, FF, FF, FF, M / 256, D / 256}, F.G, F.c);
        pg8::gemm_phase<true>(F.lds, S, EpiStore{Y, D});
        SEAM(2);
    }
    if (IN(3)) { resnorm_phase(F, in[0], Y, in[3], 0.5f, args.out, in[6], XN); SEAM(3); }
    if (IN(4)) {
        pg8::Order2 S; S.d0 = pg8::GDesc{XN, (const bf16*)(ws + WS_WIN), D, D, D, M / 256, NIN / 256};
        S.d1 = pg8::GDesc{(const bf16*)(ws + WS_MEMN), (const bf16*)(ws + WS_WCKV), D, D, D, BATCH * MEML / 256, D / 256}; S.G = F.G; S.c = F.c;
        pg8::gemm_phase<true>(F.lds, S, EpiInproj{ws});
        SEAM(4);
    }
    if (IN(5)) {
        for (int u = F.c; u < 256; u += F.G) gla_state_unit(F, in, u);
        __syncthreads();
        for (int u = F.c; u < 2048; u += F.G) idx_unit(F, u);
        SEAM(5);
    }
    if (IN(6)) {
        gla_scan_phase(F);
        for (int p = F.c; p < 256; p += F.G) { const int bh = p >> 4, x = p & 15; dsa_att_unit(F, in, bh, x); dsa_att_unit(F, in, bh, 31 - x); }
        SEAM(6);
    }
    if (IN(7)) {
        for (int u = F.c; u < 256; u += F.G) { gla_out_unit(F, in, u); __syncthreads(); }
        SEAM(7);
    }
    if (IN(8)) {
        pg8::Order1 S; S.init(pg8::GDesc{XN, (const bf16*)(ws + WS_WGT), D, D, D, M / 256, 2048 / 256}, F.G, F.c);
        pg8::gemm_phase<true>(F.lds, S, EpiGates{(bf16*)(ws + WS_SGA), (bf16*)(ws + WS_SGB)});
        SEAM(8);
    }
    if (IN(9)) {
        pg8::PairOrder S; S.d0 = pg8::GDesc{(const bf16*)(ws + WS_GR), (const bf16*)(ws + WS_WG), D, D, D, M / 256, D / 256};
        S.d1 = pg8::GDesc{(const bf16*)(ws + WS_DQKV), (const bf16*)(ws + WS_WD), 1536, 512, 512, M / 256, D / 256}; S.G = F.G; S.c = F.c;
        pg8::gemm_phase<false>(F.lds, S, EpiMerge{(const bf16*)(ws + WS_SGA), (const bf16*)(ws + WS_SGB), (bf16*)(ws + WS_MRG)});
        SEAM(9);
    }
    if (IN(10)) {
        pg8::Order1 S; S.init(pg8::GDesc{(const bf16*)(ws + WS_MRG), (const bf16*)(ws + WS_WO), D, D, D, M / 256, D / 256}, F.G, F.c);
        pg8::gemm_phase<true>(F.lds, S, EpiStore{(bf16*)(ws + WS_Y2), D});
        SEAM(10);
    }
    if (IN(11)) {
        resnorm_phase(F, args.out, (const bf16*)(ws + WS_Y2), in[7], 1.0f, args.out, in[17], XN);
        LAS float* scr = (LAS float*)(F.lds + F.wave * 16384);
        constexpr int NITEMS = 2816 + 1408;
        for (int it0 = gw; it0 < NITEMS; it0 += NGW) { int it = it0;
            if (conv_job(it, in[24], 2 * FF, D, 2 * FF / 32, W1A, D, ColFfn{}, scr, F.lane)) continue;
            conv_job(it, in[25], D, FF, D / 32, W1B, FF, ColIdent{0}, scr, F.lane);
        }
        SEAM(11);
    }
    if (IN(12)) {
        pg8::Order1 S; S.init(pg8::GDesc{XN, (const bf16*)(ws + WS_WCQ), D, D, D, M / 256, 512 / 256}, F.G, F.c);
        pg8::gemm_phase<true>(F.lds, S, EpiStore{(bf16*)(ws + WS_QC), 512});
        SEAM(12);
    }
    if (IN(13)) {
        for (int u = F.c; u < 256; u += F.G) cross_att_unit(F, u);
        SEAM(13);
    }
    if (IN(14)) {
        pg8::Order1 S; S.init(pg8::GDesc{(const bf16*)(ws + WS_OX), (const bf16*)(ws + WS_WCO), 512, 512, 512, M / 256, D / 256}, F.G, F.c);
        pg8::gemm_phase<true>(F.lds, S, EpiStore{(bf16*)(ws + WS_Y3), D});
        SEAM(14);
    }
    if (IN(15)) { resnorm_phase(F, args.out, (const bf16*)(ws + WS_Y3), in[18], 1.0f, args.out, in[22], XN); SEAM(15); }
    if (IN(16)) {
        pg8::Order1 S; S.init(pg8::GDesc{XN, W1A, D, D, D, M / 256, 2 * FF / 256}, F.G, F.c);
        pg8::gemm_phase<true>(F.lds, S, EpiSwiglu{HID});
        SEAM(16);
    }
    if (IN(17)) {
        pg8::Order1 S; S.init(pg8::GDesc{HID, W1B, FF, FF, FF, M / 256, D / 256}, F.G, F.c);
        pg8::gemm_phase<true>(F.lds, S, EpiStore{Y, D});
        SEAM(17);
    }
    if (IN(18)) { resnorm_phase(F, args.out, Y, in[23], 0.5f, args.out, nullptr, nullptr); }
#undef IN
#undef SEAM
}

extern "C" void kernel_launch(void* const* d_in, const int* in_sizes, int n_in, void* d_out, int out_size, void* d_ws, size_t ws_size, hipStream_t stream) {
    static int grid = 0;
    if (grid == 0) {
        if (n_in != 26 || out_size != M * D || ws_size < WS_END) { fprintf(stderr, "kernel_launch: unexpected problem shape (n_in %d, out %d, ws %zu); nothing launched\n", n_in, out_size, ws_size); grid = -1; return; }
        int dev = 0, cus = 0, per_cu = 0;
        if (hipGetDevice(&dev) != hipSuccess || hipDeviceGetAttribute(&cus, hipDeviceAttributeMultiprocessorCount, dev) != hipSuccess) { grid = -1; return; }
        if (hipFuncSetAttribute((const void*)mega_fwd, hipFuncAttributeMaxDynamicSharedMemorySize, LDS_BYTES) != hipSuccess) { fprintf(stderr, "kernel_launch: hipFuncSetAttribute failed\n"); grid = -1; return; }
        if (hipOccupancyMaxActiveBlocksPerMultiprocessor(&per_cu, (const void*)mega_fwd, NT, LDS_BYTES) != hipSuccess || per_cu < 1) fprintf(stderr, "kernel_launch: occupancy query reports %d workgroups per CU\n", per_cu);
        (void)hipGetLastError();
        grid = cus;
    }
    if (grid < 0) return;
    (void)hipMemsetAsync((char*)d_ws + WS_CTL, 0, 65536, stream);
    Args a{};
    for (int i = 0; i < 26; ++i) a.in[i] = (const float*)d_in[i];
    a.out = (float*)d_out; a.ws = (unsigned char*)d_ws;
#if MK_ONE_LAUNCH
    a.ph_lo = 0; a.ph_hi = N_PHASES;
    hipLaunchKernelGGL(mega_fwd, dim3(grid), dim3(NT), LDS_BYTES, stream, a);
#else
    for (int p = 0; p < N_PHASES; ++p) { a.ph_lo = p; a.ph_hi = p + 1; hipLaunchKernelGGL(mega_fwd, dim3(grid), dim3(NT), LDS_BYTES, stream, a); }
#endif
}
```

```cpp
#define MK_ONE_LAUNCH 1
#pragma clang diagnostic ignored "-Wint-to-pointer-cast"
#include <hip/hip_runtime.h>
#include <cstdio>
#include <cstdint>

#define DI __device__ __forceinline__
#define LAS __attribute__((address_space(3)))
#define GAS __attribute__((address_space(1)))
typedef unsigned short bf16;
typedef short bf16x8 __attribute__((ext_vector_type(8)));
typedef short s16x4 __attribute__((ext_vector_type(4)));
typedef float f32x4 __attribute__((ext_vector_type(4)));
typedef float f32x2 __attribute__((ext_vector_type(2)));
typedef float f32x16 __attribute__((ext_vector_type(16)));
typedef unsigned u32x4 __attribute__((ext_vector_type(4)));
typedef unsigned u32x2 __attribute__((ext_vector_type(2)));
typedef __bf16 bf16x2_t __attribute__((ext_vector_type(2)));

DI unsigned pk2(float lo, float hi) { f32x2 v = {lo, hi}; bf16x2_t b = __builtin_convertvector(v, bf16x2_t); return __builtin_bit_cast(unsigned, b); }
DI float bflo(unsigned w) { return __uint_as_float(w << 16); }
DI float bfhi(unsigned w) { return __uint_as_float(w & 0xffff0000u); }
DI float bf2f(bf16 v) { return __uint_as_float(((unsigned)v) << 16); }
DI float wave_sum(float v) {
#pragma unroll
    for (int o = 1; o < 64; o <<= 1) v += __shfl_xor(v, o);
    return v;
}
DI float fast_exp2(float x) { return __builtin_amdgcn_exp2f(x); }
DI float fast_exp(float x) { return __builtin_amdgcn_exp2f(x * 1.4426950408889634f); }
DI float fast_rcp(float x) { return __builtin_amdgcn_rcpf(x); }
DI float sigmoid_f(float x) { return fast_rcp(1.0f + fast_exp(-x)); }
#define MFMA32(a, b, c) __builtin_amdgcn_mfma_f32_32x32x16_bf16((a), (b), (c), 0, 0, 0)
DI int crow(int r, int hi) { return (r & 3) + 8 * (r >> 2) + 4 * hi; }
DI bf16x8 pack8(float a0, float a1, float a2, float a3, float a4, float a5, float a6, float a7) {
    u32x4 p; p.x = pk2(a0, a1); p.y = pk2(a2, a3); p.z = pk2(a4, a5); p.w = pk2(a6, a7); return __builtin_bit_cast(bf16x8, p);
}
DI bf16x8 pack_step(const f32x16& x, int s) { return pack8(x[8 * s], x[8 * s + 1], x[8 * s + 2], x[8 * s + 3], x[8 * s + 4], x[8 * s + 5], x[8 * s + 6], x[8 * s + 7]); }
typedef short v4i16_t __attribute__((ext_vector_type(4)));
DI s16x4 vtr(unsigned lds_byte_addr) { return __builtin_bit_cast(s16x4, __builtin_amdgcn_ds_read_tr16_b64_v4i16((LAS v4i16_t*)lds_byte_addr)); }
DI bf16x8 cat4(s16x4 lo, s16x4 hi) { return __builtin_shufflevector(lo, hi, 0, 1, 2, 3, 4, 5, 6, 7); }
DI bf16x8 lds_b128(unsigned lds_byte_addr) { return *(const LAS bf16x8*)lds_byte_addr; }

namespace pg8 {
#define PG8_LAS __attribute__((address_space(3)))
typedef unsigned short bf16_t;
constexpr int BM = 256, BK = 64, HALF = 128, HTB = HALF * BK * 2  , STAGE_BYTES = 8 * HTB, NXCD = 8, WGM = 8;

__host__ __device__ __forceinline__ int lds_byte(int r, int c) { const int st = (r >> 4) * 2 + (c >> 5), rr = r & 15, cc = c & 31, ob = rr * 64 + cc * 2; return st * 1024 + (ob ^ (((ob >> 9) & 1) << 5)); }
__host__ __device__ __forceinline__ void stage_rc(int b, int& R, int& C) { const int st = b / 1024, sb = b % 1024, swz = sb ^ (((sb >> 9) & 1) << 5); R = (st >> 1) * 16 + swz / 64; C = (st & 1) * 32 + (swz % 64) / 2; }
__host__ __device__ __forceinline__ int perm32(int rho) { const int n = rho >> 4, i = rho & 15; return 8 * (i >> 2) + 4 * n + (i & 3); }

struct Unit { int pm, pn, g; };
struct GDesc { const bf16_t* A; const bf16_t* Bt; int lda, ldb, K, nM, nN; };

__device__ __forceinline__ void tile_of(int l, int nM, int nN, int& pm, int& pn) {
    const int nwg = nM * nN; int wgid = l;
    { const int q = nwg / NXCD, r = nwg % NXCD, xcd = wgid % NXCD, off = wgid / NXCD; wgid = (xcd < r ? xcd * (q + 1) : r * (q + 1) + (xcd - r) * q) + off; }
    const int nig = WGM * nN, gid = wgid / nig, fm = gid * WGM, gsz = (nM - fm) < WGM ? (nM - fm) : WGM;
    pm = fm + ((wgid % nig) % gsz); pn = (wgid % nig) / gsz;
}
struct Order1 {
    GDesc d0; int G, c;
    __device__ __forceinline__ void init(const GDesc& a, int G_, int c_) { d0 = a; G = G_; c = c_; }
    __device__ __forceinline__ GDesc desc(int) const { return d0; }
    __device__ __forceinline__ bool next(int i, Unit& u) const {
        const long L = (long)i * G + c; if (L >= (long)(d0.nM * d0.nN)) return false;
        tile_of((int)L, d0.nM, d0.nN, u.pm, u.pn); u.g = 0; return true;
    }
};
struct Order2 {
    GDesc d0, d1; int G, c;
    __device__ __forceinline__ GDesc desc(int g) const { GDesc r; r.A = g == 0 ? d0.A : d1.A; r.Bt = g == 0 ? d0.Bt : d1.Bt; r.lda = d0.lda; r.ldb = d0.ldb; r.K = d0.K; r.nM = g == 0 ? d0.nM : d1.nM; r.nN = g == 0 ? d0.nN : d1.nN; return r; }
    __device__ __forceinline__ bool next(int i, Unit& u) const {
        const int n0 = d0.nM * d0.nN, n1 = d1.nM * d1.nN;
        const long L = (long)i * G + c; if (L >= (long)(n0 + n1)) return false;
        int l = (int)L, g = 0; if (l >= n0) { l -= n0; g = 1; }
        tile_of(l, g == 0 ? d0.nM : d1.nM, g == 0 ? d0.nN : d1.nN, u.pm, u.pn); u.g = g; return true;
    }
};
struct PairOrder {
    GDesc d0, d1; int G, c;
    __device__ __forceinline__ GDesc desc(int g) const { GDesc r; r.A = g == 0 ? d0.A : d1.A; r.Bt = g == 0 ? d0.Bt : d1.Bt; r.lda = g == 0 ? d0.lda : d1.lda; r.ldb = g == 0 ? d0.ldb : d1.ldb; r.K = g == 0 ? d0.K : d1.K; r.nM = d0.nM; r.nN = d0.nN; return r; }
    __device__ __forceinline__ bool next(int i, Unit& u) const {
        const long L = (long)(i >> 1) * G + c; if (L >= (long)(d0.nM * d0.nN)) return false;
        tile_of((int)L, d0.nM, d0.nN, u.pm, u.pn); u.g = i & 1; return true;
    }
};

template <bool UNIFORM  , class Epi, class Sched>
__device__ __forceinline__ void gemm_phase(PG8_LAS unsigned char* lds, const Sched& S, const Epi& E) {
    const int tid = threadIdx.x, wid = __builtin_amdgcn_readfirstlane(tid >> 6), lane = tid & 63, wr = wid >> 2, wc = wid & 3, fr = lane & 15, fq = lane >> 4;
    auto voff = [tid](int i, int ld, bool perm) -> unsigned { int R, C; stage_rc(tid * 16 + i * 8192, R, C); if (perm) R = (R & ~31) + perm32(R & 31); return (unsigned)(R * ld + C) * 2u; };
    const size_t kstep = (size_t)(BK * 2);
    const unsigned ldsw = (unsigned)wid * 1024u;
    const int aoff = lds_byte(wr * 64 + fr, fq * 8), boff = lds_byte(wc * 32 + fr, fq * 8);
#define PG8_SA(b, h) (((b) * 2 + (h)) * HTB)
#define PG8_SB(b, h) ((4 + (b) * 2 + (h)) * HTB)
#define PG8_STAGE(bufoff, gbase, v0, v1) do { \
        __builtin_amdgcn_global_load_lds((const unsigned*)((const char*)(gbase) + (v0)), (PG8_LAS unsigned*)(lds + (bufoff) + ldsw), 16, 0, 0); \
        __builtin_amdgcn_global_load_lds((const unsigned*)((const char*)(gbase) + (v1)), (PG8_LAS unsigned*)(lds + (bufoff) + ldsw + 8192), 16, 0, 0); } while (0)
#define PG8_LDA(dst, b, h) do { _Pragma("unroll") for (int m = 0; m < 4; ++m) _Pragma("unroll") for (int k = 0; k < 2; ++k) dst[m][k] = *(const PG8_LAS bf16x8*)(lds + PG8_SA(b, h) + aoff + m * 2048 + k * 1024); } while (0)
#define PG8_LDB(dst, b, h) do { _Pragma("unroll") for (int n = 0; n < 2; ++n) _Pragma("unroll") for (int k = 0; k < 2; ++k) dst[n][k] = *(const PG8_LAS bf16x8*)(lds + PG8_SB(b, h) + boff + n * 2048 + k * 1024); } while (0)
#define PG8_MMA(ai, bj, At, Bt) do { __builtin_amdgcn_s_setprio(1); _Pragma("unroll") for (int m = 0; m < 4; ++m) _Pragma("unroll") for (int n = 0; n < 2; ++n) _Pragma("unroll") for (int k = 0; k < 2; ++k) \
        acc[ai][bj][m][n] = __builtin_amdgcn_mfma_f32_16x16x32_bf16(Bt[n][k], At[m][k], acc[ai][bj][m][n], 0, 0, 0); __builtin_amdgcn_s_setprio(0); } while (0)
#define PG8_WAIT_V(n) asm volatile("s_waitcnt vmcnt(" #n ")" ::: "memory")
#define PG8_WAIT_L(n) asm volatile("s_waitcnt lgkmcnt(" #n ")" ::: "memory")
#define PG8_BAR __builtin_amdgcn_s_barrier()
#define PG8_SCHED __builtin_amdgcn_sched_barrier(0)
    Unit cur, nxt; int ui = 0;
    if (!S.next(0, cur)) return;
    GDesc dc = S.desc(cur.g);
    f32x4 acc[2][2][4][2];
#pragma unroll
    for (int a = 0; a < 2; ++a)
#pragma unroll
        for (int b = 0; b < 2; ++b)
#pragma unroll
            for (int m = 0; m < 4; ++m)
#pragma unroll
                for (int n = 0; n < 2; ++n) acc[a][b][m][n] = (f32x4){0.f, 0.f, 0.f, 0.f};
    bf16x8 At[4][2], B0[2][2], B1[2][2];
    unsigned vA0 = voff(0, dc.lda, false), vA1 = voff(1, dc.lda, false), vB0 = voff(0, dc.ldb, true), vB1 = voff(1, dc.ldb, true);
    size_t hA = (size_t)HALF * dc.lda * 2, hB = (size_t)HALF * dc.ldb * 2;
    const char* cA = (const char*)dc.A + (size_t)cur.pm * 2 * hA; const char* cB = (const char*)dc.Bt + (size_t)cur.pn * 2 * hB;
    PG8_STAGE(PG8_SB(0, 0), cB, vB0, vB1); PG8_STAGE(PG8_SB(0, 1), cB + hB, vB0, vB1); PG8_STAGE(PG8_SA(0, 0), cA, vA0, vA1); PG8_STAGE(PG8_SA(0, 1), cA + hA, vA0, vA1);
    if (wr == 1) PG8_BAR;
    PG8_WAIT_V(2); PG8_BAR;
    PG8_STAGE(PG8_SB(1, 0), cB + kstep, vB0, vB1); PG8_STAGE(PG8_SA(1, 0), cA + kstep, vA0, vA1); PG8_STAGE(PG8_SB(1, 1), cB + hB + kstep, vB0, vB1);
    PG8_WAIT_V(6); PG8_BAR;
    for (;;) {
        const bool has_next = S.next(ui + 1, nxt);
        GDesc dn = dc; if (has_next) dn = S.desc(nxt.g);
        unsigned nvA0 = vA0, nvA1 = vA1, nvB0 = vB0, nvB1 = vB1; size_t nhA = hA, nhB = hB;
        if constexpr (!UNIFORM) { if (has_next) { nvA0 = voff(0, dn.lda, false); nvA1 = voff(1, dn.lda, false); nvB0 = voff(0, dn.ldb, true); nvB1 = voff(1, dn.ldb, true); nhA = (size_t)HALF * dn.lda * 2; nhB = (size_t)HALF * dn.ldb * 2; } }
        const char* nA = has_next ? (const char*)dn.A + (size_t)nxt.pm * 2 * nhA : cA; const char* nB = has_next ? (const char*)dn.Bt + (size_t)nxt.pn * 2 * nhB : cB;
        const int nt = dc.K / BK;
        for (int t = 0; t < nt; t += 2) {
            const bool last = (t == nt - 2);
            const char* a1 = cA + (size_t)(t + 1) * kstep;
            const char* a2 = last ? nA : cA + (size_t)(t + 2) * kstep; const char* b2 = last ? nB : cB + (size_t)(t + 2) * kstep;
            const char* a3 = a2 + kstep; const char* b3 = b2 + kstep;
            unsigned xA0 = vA0, xA1 = vA1, xB0 = vB0, xB1 = vB1; size_t xhA = hA, xhB = hB;
            if constexpr (!UNIFORM) { if (last) { xA0 = nvA0; xA1 = nvA1; xB0 = nvB0; xB1 = nvB1; xhA = nhA; xhB = nhB; } }
            PG8_LDB(B0, 0, 0); PG8_LDB(B1, 0, 1); PG8_SCHED; PG8_LDA(At, 0, 0); PG8_STAGE(PG8_SA(1, 1), a1 + hA, vA0, vA1);
            PG8_WAIT_V(8); PG8_WAIT_L(0); PG8_BAR; PG8_MMA(0, 0, At, B0); PG8_MMA(0, 1, At, B1); PG8_BAR; PG8_SCHED;
            PG8_LDA(At, 0, 1); PG8_STAGE(PG8_SB(0, 0), b2, xB0, xB1); PG8_STAGE(PG8_SB(0, 1), b2 + xhB, xB0, xB1); PG8_STAGE(PG8_SA(0, 0), a2, xA0, xA1);
            PG8_WAIT_V(8); PG8_WAIT_L(0); PG8_BAR; PG8_MMA(1, 0, At, B0); PG8_MMA(1, 1, At, B1); PG8_BAR; PG8_SCHED;
            PG8_LDB(B0, 1, 0); PG8_LDB(B1, 1, 1); PG8_SCHED; PG8_LDA(At, 1, 0); PG8_STAGE(PG8_SA(0, 1), a2 + xhA, xA0, xA1);
            PG8_WAIT_V(8); PG8_WAIT_L(0); PG8_BAR; PG8_MMA(0, 0, At, B0); PG8_MMA(0, 1, At, B1); PG8_BAR; PG8_SCHED;
            PG8_LDA(At, 1, 1); PG8_STAGE(PG8_SB(1, 0), b3, xB0, xB1); PG8_STAGE(PG8_SB(1, 1), b3 + xhB, xB0, xB1); PG8_STAGE(PG8_SA(1, 0), a3, xA0, xA1);
            PG8_WAIT_V(8); PG8_WAIT_L(0); PG8_BAR; PG8_MMA(1, 0, At, B0); PG8_MMA(1, 1, At, B1); PG8_BAR; PG8_SCHED;
        }
        if (wr == 0) PG8_BAR;
        const bool keep = E(acc, cur, wr, wc, fr, fq);
        if (!has_next) break;
        if (!keep) {
#pragma unroll
            for (int a = 0; a < 2; ++a)
#pragma unroll
                for (int b = 0; b < 2; ++b)
#pragma unroll
                    for (int m = 0; m < 4; ++m)
#pragma unroll
                        for (int n = 0; n < 2; ++n) acc[a][b][m][n] = (f32x4){0.f, 0.f, 0.f, 0.f};
        }
        cur = nxt; dc = dn; cA = nA; cB = nB; vA0 = nvA0; vA1 = nvA1; vB0 = nvB0; vB1 = nvB1; hA = nhA; hB = nhB; ++ui;
        if (wr == 1) PG8_BAR;
    }
    PG8_WAIT_V(0);
    PG8_BAR;
#undef PG8_SA
#undef PG8_SB
#undef PG8_STAGE
#undef PG8_LDA
#undef PG8_LDB
#undef PG8_MMA
#undef PG8_WAIT_V
#undef PG8_WAIT_L
#undef PG8_BAR
#undef PG8_SCHED
}
}

constexpr int NWAVES = 8, NT = 512;
constexpr int BATCH = 2, T = 8192, D = 1024, M = BATCH * T, FF = 2816, MEML = 256;
constexpr float EPS = 1e-6f;
constexpr float LOG2E = 1.4426950408889634f;
constexpr int NIN = 5376;
constexpr size_t KiB = 1024, MiB = 1u << 20;
constexpr size_t WS_CTL = 0, CTL_ZERO_BYTES = 1 * MiB;
constexpr size_t WS_XN = 1 * MiB;
constexpr size_t WS_HID = 33 * MiB;
constexpr size_t WS_Y = 121 * MiB;
constexpr size_t WS_QKG = 33 * MiB, WS_GV = 65 * MiB, WS_GR = 97 * MiB, WS_DQKV = 129 * MiB, WS_IQ = 177 * MiB, WS_SM = 193 * MiB, WS_GST = 197 * MiB;
constexpr size_t WS_W1A = 153 * MiB, WS_W1B = 164 * MiB;
constexpr size_t WS_WIN = 229 * MiB, WS_WGT = 229 * MiB + 10752 * KiB, WS_WG = WS_WGT + 4 * MiB, WS_WD = WS_WG + 2 * MiB, WS_WO = WS_WD + 1 * MiB,
                 WS_WCQ = WS_WO + 2 * MiB, WS_WCKV = WS_WCQ + 1 * MiB, WS_WCO = WS_WCKV + 2 * MiB, WS_MEMN = WS_WCO + 1 * MiB, WS_KVM = WS_MEMN + 1 * MiB, WS_DEC = WS_KVM + 1 * MiB;
constexpr size_t WS_SGA = WS_QKG, WS_SGB = WS_GV, WS_MRG = WS_GST, WS_Y2 = WS_QKG;
constexpr size_t WS_QC = 65 * MiB, WS_OX = 81 * MiB, WS_Y3 = 97 * MiB;
constexpr size_t WS_END = 256 * MiB;
static_assert(WS_DEC + 128 * KiB <= WS_END && WS_W1B + (size_t)D * FF * 2 <= WS_IQ && WS_HID + (size_t)M * FF * 2 <= WS_Y, "d_ws map");
constexpr int CW_BAR = 4096;
constexpr int LDS_BYTES = 147456;
constexpr int MISC_OFF = LDS_BYTES - 256;

#define XB_TMO      128
#define XB_XCNT(j)  (256  + 64 * (j))
#define XB_XSUB(j)  (1280 + 64 * (j))
#define XB_XGEN(j)  (2304 + 64 * (j))
#define XB_TOP      3328
#define XB_TOPGEN   3392
#define XCD_BAR_WORDS 3456
#define XB_SPIN_CAP (1u << 18)

__device__ __forceinline__ unsigned xb_ld(unsigned* p)              { return __hip_atomic_load(p, __ATOMIC_RELAXED, __HIP_MEMORY_SCOPE_AGENT); }
__device__ __forceinline__ unsigned xb_add(unsigned* p, unsigned v) { return __hip_atomic_fetch_add(p, v, __ATOMIC_RELAXED, __HIP_MEMORY_SCOPE_AGENT); }
__device__ __forceinline__ unsigned xb_xcc_id() { return (unsigned)__builtin_amdgcn_s_getreg((3 << 11) | 20) & 0xFu; }
#define XB_SPIN(cond, bar) do { unsigned _sp = 0; while (cond) { __builtin_amdgcn_s_sleep(1); \
    if ((++_sp & 255u) == 0u) { if (xb_ld(&(bar)[XB_TMO])) break; if (_sp > XB_SPIN_CAP) { atomicAdd(&(bar)[XB_TMO], 1u); break; } } } } while (0)

struct XcdBarrier {
    unsigned* bar; unsigned x;
    volatile LAS unsigned* st;
};

__device__ __forceinline__ XcdBarrier xcd_barrier_post(unsigned* bar, volatile LAS unsigned* st) {
    XcdBarrier b; b.bar = bar; b.x = xb_xcc_id(); b.st = st;
    if (threadIdx.x == 0) (void)xb_add(&bar[XB_XCNT(b.x)], 1u);
    return b;
}
__device__ __forceinline__ void xcd_barrier_complete(unsigned* bar, unsigned x, unsigned& nloc, unsigned& nx) {
    const unsigned G = gridDim.x * gridDim.y * gridDim.z;
    unsigned sum, cnt, mine, sp = 0u;
    for (;;) {
        sum = 0u; cnt = 0u; mine = 0u;
#pragma unroll
        for (unsigned j = 0; j < 16; ++j) { const unsigned c = xb_ld(&bar[XB_XCNT(j)]); sum += c; cnt += (c > 0u) ? 1u : 0u; mine = (j == x) ? c : mine; }
        if (sum == G) break;
        __builtin_amdgcn_s_sleep(1);
        if ((++sp & 255u) == 0u) { if (xb_ld(&bar[XB_TMO])) break; if (sp > XB_SPIN_CAP) { atomicAdd(&bar[XB_TMO], 1u); break; } }
    }
    nloc = mine > 0u ? mine : 1u; nx = cnt > 0u ? cnt : 1u;
}

__device__ __forceinline__ void xcd_barrier(const XcdBarrier& b) {
    asm volatile("s_waitcnt vmcnt(0)" ::: "memory");
    __syncthreads();
    if (threadIdx.x == 0) {
        unsigned* bar = b.bar;
        __builtin_amdgcn_s_waitcnt(0);
        unsigned nloc = b.st[0], nx = b.st[1];
        if (nloc == 0u) { xcd_barrier_complete(bar, b.x, nloc, nx); b.st[0] = nloc; b.st[1] = nx; }
        const unsigned old = xb_add(&bar[XB_XSUB(b.x)], 1u);
        const unsigned gen = old / nloc;
        if (old + 1u == (gen + 1u) * nloc) {
            __builtin_amdgcn_fence(__ATOMIC_RELEASE, "agent");
            asm volatile("s_waitcnt vmcnt(0)" ::: "memory");
            const unsigned og = xb_add(&bar[XB_TOP], 1u);
            const unsigned tg = og / nx;
            if (og + 1u == (tg + 1u) * nx) xb_add(&bar[XB_TOPGEN], 1u);
            else XB_SPIN(xb_ld(&bar[XB_TOPGEN]) == tg, bar);
            __builtin_amdgcn_fence(__ATOMIC_ACQUIRE, "agent");
            xb_add(&bar[XB_XGEN(b.x)], 1u);
            asm volatile("s_waitcnt vmcnt(0)" ::: "memory");
        } else {
            XB_SPIN(xb_ld(&bar[XB_XGEN(b.x)]) == gen, bar);
            __builtin_amdgcn_fence(__ATOMIC_ACQUIRE, "agent");
            asm volatile("s_waitcnt vmcnt(0)" ::: "memory");
        }
    }
    __syncthreads();
}

struct Args { const float* in[26]; float* out; unsigned char* ws; int ph_lo, ph_hi; };
struct Frame {
    LAS unsigned char* lds;
    unsigned char* ws;
    int tid, lane, wave, G, c;
};
#define LDS_WAIT() asm volatile("s_waitcnt lgkmcnt(0)" ::: "memory")
#define VM_WAIT() asm volatile("s_waitcnt vmcnt(0)" ::: "memory")

template <class ColFn>
DI void conv_item(const float* W, int ldw, int k0, bf16* WT, int ldt, int dr0, int dk0, ColFn srccol, LAS float* scr, int lane) {
    const int n4 = (lane & 7) * 4; const int sc = srccol(dr0 + n4);
#pragma unroll
    for (int i = 0; i < 8; ++i) { const int kk = 8 * i + (lane >> 3);
        const f32x4 v = sc >= 0 ? *(const f32x4*)(W + (size_t)(k0 + kk) * ldw + sc) : (f32x4){0.f, 0.f, 0.f, 0.f};
        LAS float* s = scr + kk * 33 + n4; s[0] = v.x; s[1] = v.y; s[2] = v.z; s[3] = v.w; }
    LDS_WAIT(); asm volatile("" ::: "memory");
    const int c = lane & 7;
#pragma unroll
    for (int j = 0; j < 4; ++j) { const int n = (lane >> 3) + 8 * j; const LAS float* s = scr + (8 * c) * 33 + n;
        u32x4 o; o.x = pk2(s[0 * 33], s[1 * 33]); o.y = pk2(s[2 * 33], s[3 * 33]); o.z = pk2(s[4 * 33], s[5 * 33]); o.w = pk2(s[6 * 33], s[7 * 33]);
        *(u32x4*)(WT + (size_t)(dr0 + n) * ldt + dk0 + k0 + 8 * c) = o; }
    LDS_WAIT(); asm volatile("" ::: "memory");
}
struct ColIdent { int c0; DI int operator()(int r) const { return c0 + r; } };
struct ColFfn { DI int operator()(int r) const { const int tile = r >> 8, j = r & 255; return j < 128 ? tile * 128 + j : FF + tile * 128 + (j - 128); } };
struct ColInproj { DI int operator()(int r) const { return r < 3072 ? r : (r < 5192 ? r + 16 : (r < 5208 ? 3072 + (r - 5192) : -1)); } };
template <class ColFn>
DI bool conv_job(int& it, const float* W, int ldw, int K, int nb, bf16* WT, int ldt, ColFn f, LAS float* scr, int lane) {
    const int n_items = (K / 64) * nb;
    if (it >= n_items) { it -= n_items; return false; }
    const int kb = it / nb, b = it % nb;
    conv_item(W, ldw, 64 * kb, WT, ldt, 32 * b, 0, f, scr, lane);
    return true;
}
template <int NR>
DI void rms_rows_bf16(const float* xrow, const float* g, bf16* orow, int lane, size_t rstride) {
    f32x4 v[NR][4]; float s[NR];
#pragma unroll
    for (int q = 0; q < NR; ++q) { const f32x4* xr = (const f32x4*)(xrow + q * rstride) + lane; float a = 0.f;
#pragma unroll
        for (int j = 0; j < 4; ++j) { v[q][j] = xr[64 * j]; a += (v[q][j].x * v[q][j].x + v[q][j].y * v[q][j].y) + (v[q][j].z * v[q][j].z + v[q][j].w * v[q][j].w); }
        s[q] = a; }
    const f32x4* gr = (const f32x4*)g + lane; f32x4 gg[4];
#pragma unroll
    for (int j = 0; j < 4; ++j) gg[j] = gr[64 * j];
#pragma unroll
    for (int o = 1; o < 64; o <<= 1)
#pragma unroll
        for (int q = 0; q < NR; ++q) s[q] += __shfl_xor(s[q], o);
#pragma unroll
    for (int q = 0; q < NR; ++q) { const float r = __builtin_amdgcn_rsqf(s[q] * (1.f / D) + EPS); u32x2* o8 = (u32x2*)(orow + q * rstride) + lane;
#pragma unroll
        for (int j = 0; j < 4; ++j) { u32x2 w; w.x = pk2(v[q][j].x * r * gg[j].x, v[q][j].y * r * gg[j].y); w.y = pk2(v[q][j].z * r * gg[j].z, v[q][j].w * r * gg[j].w); o8[64 * j] = w; } }
}
template <int NR>
DI void resnorm_rows(const float* hin, const bf16* yrow, const float* gpost, float coef, float* hout, const float* gpre, bf16* xn, int lane, bool do_store, size_t rstride) {
    f32x4 y[NR][4], h[NR][4]; float s[NR], s2[NR];
#pragma unroll
    for (int q = 0; q < NR; ++q) { const u32x2* yr = (const u32x2*)(yrow + q * rstride) + lane; const f32x4* hr = (const f32x4*)(hin + q * rstride) + lane;
#pragma unroll
        for (int j = 0; j < 4; ++j) { const u32x2 w = yr[64 * j]; y[q][j] = (f32x4){bflo(w.x), bfhi(w.x), bflo(w.y), bfhi(w.y)}; h[q][j] = hr[64 * j]; } }
    const f32x4* gp = (const f32x4*)gpost + lane; f32x4 g[4];
#pragma unroll
    for (int j = 0; j < 4; ++j) g[j] = gp[64 * j];
#pragma unroll
    for (int q = 0; q < NR; ++q) { float a = 0.f;
#pragma unroll
        for (int j = 0; j < 4; ++j) a += (y[q][j].x * y[q][j].x + y[q][j].y * y[q][j].y) + (y[q][j].z * y[q][j].z + y[q][j].w * y[q][j].w);
        s[q] = a; }
#pragma unroll
    for (int o = 1; o < 64; o <<= 1)
#pragma unroll
        for (int q = 0; q < NR; ++q) s[q] += __shfl_xor(s[q], o);
#pragma unroll
    for (int q = 0; q < NR; ++q) { const float r = __builtin_amdgcn_rsqf(s[q] * (1.f / D) + EPS) * coef; float a = 0.f;
#pragma unroll
        for (int j = 0; j < 4; ++j) { h[q][j] = h[q][j] + y[q][j] * r * g[j]; a += (h[q][j].x * h[q][j].x + h[q][j].y * h[q][j].y) + (h[q][j].z * h[q][j].z + h[q][j].w * h[q][j].w); }
        s2[q] = a;
        if (do_store) { f32x4* ho = (f32x4*)(hout + q * rstride) + lane;
#pragma unroll
            for (int j = 0; j < 4; ++j) ho[64 * j] = h[q][j]; } }
    if (xn) {
        const f32x4* gq = (const f32x4*)gpre + lane;
#pragma unroll
        for (int j = 0; j < 4; ++j) g[j] = gq[64 * j];
#pragma unroll
        for (int o = 1; o < 64; o <<= 1)
#pragma unroll
            for (int q = 0; q < NR; ++q) s2[q] += __shfl_xor(s2[q], o);
#pragma unroll
        for (int q = 0; q < NR; ++q) { const float r2 = __builtin_amdgcn_rsqf(s2[q] * (1.f / D) + EPS); u32x2* o8 = (u32x2*)(xn + q * rstride) + lane;
#pragma unroll
            for (int j = 0; j < 4; ++j) { u32x2 w; w.x = pk2(h[q][j].x * r2 * g[j].x, h[q][j].y * r2 * g[j].y); w.y = pk2(h[q][j].z * r2 * g[j].z, h[q][j].w * r2 * g[j].w); o8[64 * j] = w; } }
    }
}
DI void resnorm_phase(Frame& F, const float* hin, const bf16* y, const float* gpost, float coef, float* hout, const float* gpre, bf16* xn, bool do_store = true) {
    const int gw = F.c * NWAVES + F.wave, NGW = F.G * NWAVES;
    int m = gw;
    for (; m + NGW < M; m += 2 * NGW) resnorm_rows<2>(hin + (size_t)m * D, y + (size_t)m * D, gpost, coef, hout + (size_t)m * D, gpre, xn ? xn + (size_t)m * D : nullptr, F.lane, do_store, (size_t)NGW * D);
    for (; m < M; m += NGW) resnorm_rows<1>(hin + (size_t)m * D, y + (size_t)m * D, gpost, coef, hout + (size_t)m * D, gpre, xn ? xn + (size_t)m * D : nullptr, F.lane, do_store, 0);
}

using pg8::Unit;
typedef f32x4 Acc[2][2][4][2];
struct EpiStore {
    bf16* O; int ldo;
    DI bool operator()(Acc& acc, const Unit& u, int wr, int wc, int fr, int fq) const {
        const int row0 = u.pm * 256 + wr * 64 + fr, col0 = u.pn * 256 + wc * 32 + 8 * fq;
#pragma unroll
        for (int ai = 0; ai < 2; ++ai)
#pragma unroll
            for (int m = 0; m < 4; ++m) { bf16* rowp = O + (size_t)(row0 + ai * 128 + m * 16) * ldo + col0;
#pragma unroll
                for (int bj = 0; bj < 2; ++bj) { const f32x4 v0 = acc[ai][bj][m][0], v1 = acc[ai][bj][m][1];
                    u32x4 w; w.x = pk2(v0[0], v0[1]); w.y = pk2(v0[2], v0[3]); w.z = pk2(v1[0], v1[1]); w.w = pk2(v1[2], v1[3]);
                    *(u32x4*)(rowp + bj * 128) = w; } }
        return false;
    }
};
struct EpiGates {
    bf16* SGA; bf16* SGB;
    DI bool operator()(Acc& acc, const Unit& u, int wr, int wc, int fr, int fq) const {
        bf16* O = u.pn < 4 ? SGA : SGB;
        const int row0 = u.pm * 256 + wr * 64 + fr, col0 = (u.pn & 3) * 256 + wc * 32 + 8 * fq;
#pragma unroll
        for (int ai = 0; ai < 2; ++ai)
#pragma unroll
            for (int m = 0; m < 4; ++m) { bf16* rowp = O + (size_t)(row0 + ai * 128 + m * 16) * 1024 + col0;
#pragma unroll
                for (int bj = 0; bj < 2; ++bj) { const f32x4 v0 = acc[ai][bj][m][0], v1 = acc[ai][bj][m][1];
                    u32x4 w; w.x = pk2(sigmoid_f(v0[0]), sigmoid_f(v0[1])); w.y = pk2(sigmoid_f(v0[2]), sigmoid_f(v0[3])); w.z = pk2(sigmoid_f(v1[0]), sigmoid_f(v1[1])); w.w = pk2(sigmoid_f(v1[2]), sigmoid_f(v1[3]));
                    *(u32x4*)(rowp + bj * 128) = w; } }
        return false;
    }
};
struct EpiSwiglu {
    bf16* H;
    DI bool operator()(Acc& acc, const Unit& u, int wr, int wc, int fr, int fq) const {
        const int row0 = u.pm * 256 + wr * 64 + fr, col0 = u.pn * 128 + wc * 32 + 8 * fq;
#pragma unroll
        for (int ai = 0; ai < 2; ++ai)
#pragma unroll
            for (int m = 0; m < 4; ++m) { bf16* rowp = H + (size_t)(row0 + ai * 128 + m * 16) * FF + col0;
                float o[8];
#pragma unroll
                for (int n = 0; n < 2; ++n)
#pragma unroll
                    for (int e = 0; e < 4; ++e) { const float a = acc[ai][0][m][n][e], b = acc[ai][1][m][n][e]; o[4 * n + e] = a * sigmoid_f(a) * b; }
                u32x4 w; w.x = pk2(o[0], o[1]); w.y = pk2(o[2], o[3]); w.z = pk2(o[4], o[5]); w.w = pk2(o[6], o[7]);
                *(u32x4*)rowp = w; }
        return false;
    }
};
struct EpiInproj {
    unsigned char* ws;
    DI bool operator()(Acc& acc, const Unit& u, int wr, int wc, int fr, int fq) const {
        bf16* O; int ldo, ct; bool half_only = false;
        if (u.g == 1) { O = (bf16*)(ws + WS_KVM); ldo = 1024; ct = u.pn; }
        else if (u.pn < 4) { O = (bf16*)(ws + WS_QKG); ldo = 1024; ct = u.pn; }
        else if (u.pn < 8) { O = (bf16*)(ws + WS_GV); ldo = 1024; ct = u.pn - 4; }
        else if (u.pn < 12) { O = (bf16*)(ws + WS_GR); ldo = 1024; ct = u.pn - 8; }
        else if (u.pn < 18) { O = (bf16*)(ws + WS_DQKV); ldo = 1536; ct = u.pn - 12; }
        else if (u.pn < 20) { O = (bf16*)(ws + WS_IQ); ldo = 512; ct = u.pn - 18; }
        else { O = (bf16*)(ws + WS_SM); ldo = 128; ct = 0; half_only = true; }
        const int row0 = u.pm * 256 + wr * 64 + fr, col0 = ct * 256 + wc * 32 + 8 * fq;
#pragma unroll
        for (int ai = 0; ai < 2; ++ai)
#pragma unroll
            for (int m = 0; m < 4; ++m) { bf16* rowp = O + (size_t)(row0 + ai * 128 + m * 16) * ldo + col0;
#pragma unroll
                for (int bj = 0; bj < 2; ++bj) { const f32x4 v0 = acc[ai][bj][m][0], v1 = acc[ai][bj][m][1];
                    u32x4 w; w.x = pk2(v0[0], v0[1]); w.y = pk2(v0[2], v0[3]); w.z = pk2(v1[0], v1[1]); w.w = pk2(v1[2], v1[3]);
                    if (bj == 0 || !half_only) *(u32x4*)(rowp + bj * 128) = w; } }
        return false;
    }
};
struct EpiMerge {
    const bf16* SGA; const bf16* SGB; bf16* O;
    DI bool operator()(Acc& acc, const Unit& u, int wr, int wc, int fr, int fq) const {
        const int row0 = u.pm * 256 + wr * 64 + fr, col0 = u.pn * 256 + wc * 32 + 8 * fq;
#pragma unroll
        for (int ai = 0; ai < 2; ++ai)
#pragma unroll
            for (int m = 0; m < 4; ++m) { const size_t off = (size_t)(row0 + ai * 128 + m * 16) * 1024 + col0;
#pragma unroll
                for (int bj = 0; bj < 2; ++bj) {
                    const u32x4 gb = *(const u32x4*)(SGB + off + bj * 128);
                    const float b[8] = {bflo(gb.x), bfhi(gb.x), bflo(gb.y), bfhi(gb.y), bflo(gb.z), bfhi(gb.z), bflo(gb.w), bfhi(gb.w)};
                    if (u.g == 0) {
                        const u32x4 ga = *(const u32x4*)(SGA + off + bj * 128);
                        const float a[8] = {bflo(ga.x), bfhi(ga.x), bflo(ga.y), bfhi(ga.y), bflo(ga.z), bfhi(ga.z), bflo(ga.w), bfhi(ga.w)};
#pragma unroll
                        for (int n = 0; n < 2; ++n)
#pragma unroll
                            for (int e = 0; e < 4; ++e) acc[ai][bj][m][n][e] *= a[4 * n + e] * fast_rcp(fmaxf(b[4 * n + e], 1e-30f));
                    } else {
                        const f32x4 v0 = acc[ai][bj][m][0], v1 = acc[ai][bj][m][1];
                        u32x4 w; w.x = pk2(v0[0] * b[0], v0[1] * b[1]); w.y = pk2(v0[2] * b[2], v0[3] * b[3]); w.z = pk2(v1[0] * b[4], v1[1] * b[5]); w.w = pk2(v1[2] * b[6], v1[3] * b[7]);
                        *(u32x4*)(O + off + bj * 128) = w;
                    } } }
        return u.g == 0;
    }
};

constexpr int GP = 272;
struct GlaW { float wu0[16], wu1[16], bb0, bb1; };
DI void gla_la(const bf16* SM, size_t row, const GlaW& W, float& l0, float& l1) {
    const u32x4* gp = (const u32x4*)(SM + row * 128 + 72);
    const u32x4 g0 = gp[0], g1 = gp[1];
    const float ga[16] = {bflo(g0.x), bfhi(g0.x), bflo(g0.y), bfhi(g0.y), bflo(g0.z), bfhi(g0.z), bflo(g0.w), bfhi(g0.w), bflo(g1.x), bfhi(g1.x), bflo(g1.y), bfhi(g1.y), bflo(g1.z), bfhi(g1.z), bflo(g1.w), bfhi(g1.w)};
    float x0 = W.bb0, x1 = W.bb1;
#pragma unroll
    for (int r = 0; r < 16; ++r) { x0 = fmaf(ga[r], W.wu0[r], x0); x1 = fmaf(ga[r], W.wu1[r], x1); }
    l0 = (fminf(x0, 0.f) - __logf(1.f + fast_exp(-fabsf(x0)))) * 0.0625f; l1 = (fminf(x1, 0.f) - __logf(1.f + fast_exp(-fabsf(x1)))) * 0.0625f;
}
struct GlaPre { float pre0, pre1, end0, end1; };
DI void gla_totals(Frame& F, const float* const* in, int h, size_t row0, LAS float* tot, GlaW& W, GlaPre& P) {
    const int l = F.lane, w = F.wave;
    const bf16* SM = (const bf16*)(F.ws + WS_SM);
    const float* wup = in[9]; const float* bal = in[10];
#pragma unroll
    for (int r = 0; r < 16; ++r) { W.wu0[r] = wup[r * 512 + h * 128 + l]; W.wu1[r] = wup[r * 512 + h * 128 + 64 + l]; }
    W.bb0 = bal[h * 128 + l]; W.bb1 = bal[h * 128 + 64 + l];
    float run0 = 0.f, run1 = 0.f;
#pragma unroll 2
    for (int tt = 0; tt < 32; ++tt) { float l0, l1; gla_la(SM, row0 + 32 * w + tt, W, l0, l1); run0 += l0; run1 += l1; }
    tot[w * 128 + l] = run0; tot[w * 128 + 64 + l] = run1;
    __syncthreads();
    float p0 = 0.f, p1 = 0.f, e0 = 0.f, e1 = 0.f;
#pragma unroll
    for (int ww = 0; ww < 8; ++ww) { const float a = tot[ww * 128 + l], b = tot[ww * 128 + 64 + l]; e0 += a; e1 += b; if (ww < w) { p0 += a; p1 += b; } }
    P.pre0 = p0; P.pre1 = p1; P.end0 = e0; P.end1 = e1;
}
DI unsigned tr_lane(int pitch, int hmul, int lane) { const int i16 = lane & 15, q = i16 >> 2, p = i16 & 3, blk = (lane >> 4) & 1; return (unsigned)((hmul * (lane >> 5) + q) * pitch + (16 * blk + 4 * p) * 2); }
DI bf16x8 tr_frag(unsigned base_lane, int pitch, int row_lo, int row_hi, int n0) {
    return cat4(vtr(base_lane + (unsigned)(row_lo * pitch + n0 * 2)), vtr(base_lane + (unsigned)(row_hi * pitch + n0 * 2)));
}
DI void gla_load_v_half(Frame& F, unsigned vh, size_t row0, int h, int half) {
    const bf16* GV = (const bf16*)(F.ws + WS_GV);
#pragma unroll
    for (int it = 0; it < 8; ++it) { const int idx = it * NT + F.tid, row = idx >> 4, ch = idx & 15;
        const u32x4 v = *(const u32x4*)(GV + (row0 + row) * 1024 + h * 256 + half * 128 + ch * 8);
        *(LAS u32x4*)(vh + row * GP + ch * 16) = v; }
}
DI void gla_state_unit(Frame& F, const float* const* in, int u) {
    const int l = F.lane, w = F.wave, hh = l >> 5;
    const int bh = u >> 5, b = bh >> 2, h = bh & 3, sc = u & 31; const size_t row0 = (size_t)b * T + sc * 256;
    const unsigned KH = (unsigned)(size_t)F.lds, VH = KH + 256 * GP; LAS float* tot = (LAS float*)(F.lds + 2 * 256 * GP);
    const bf16* QKG = (const bf16*)(F.ws + WS_QKG);
    float* GST = (float*)(F.ws + WS_GST); float* DEC = (float*)(F.ws + WS_DEC);
    GlaW W; GlaPre P; gla_totals(F, in, h, row0, tot, W, P);
    {
        const bf16* SM = (const bf16*)(F.ws + WS_SM);
        float B0 = P.pre0, B1 = P.pre1;
#pragma unroll 2
        for (int tt = 0; tt < 32; ++tt) { const size_t row = row0 + 32 * w + tt;
            float l0, l1; gla_la(SM, row, W, l0, l1); B0 += l0; B1 += l1;
            const float k0 = bf2f(QKG[row * 1024 + 512 + h * 128 + l]), k1 = bf2f(QKG[row * 1024 + 512 + h * 128 + 64 + l]);
            const float f0 = k0 * fast_exp(P.end0 - B0), f1 = k1 * fast_exp(P.end1 - B1);
            *(LAS bf16*)(KH + (32 * w + tt) * GP + l * 2) = (bf16)(pk2(f0, 0.f) & 0xffffu); *(LAS bf16*)(KH + (32 * w + tt) * GP + (64 + l) * 2) = (bf16)(pk2(f1, 0.f) & 0xffffu); }
    }
    if (w == 0) { DEC[u * 128 + l] = fast_exp(P.end0); DEC[u * 128 + 64 + l] = fast_exp(P.end1); }
    const int etile = w >> 1, dt0 = 2 * (w & 1);
    const unsigned vhl = VH + tr_lane(GP, 8, l) + etile * 64, khl = KH + tr_lane(GP, 8, l) + dt0 * 64;
    for (int half = 0; half < 2; ++half) {
        gla_load_v_half(F, VH, row0, h, half);
        __syncthreads();
        f32x16 acc0, acc1;
#pragma unroll
        for (int r = 0; r < 16; ++r) { acc0[r] = 0.f; acc1[r] = 0.f; }
#pragma unroll 4
        for (int s = 0; s < 16; ++s) {
            const bf16x8 a = tr_frag(vhl, GP, 16 * s, 16 * s + 4, 0);
            const bf16x8 b0 = tr_frag(khl, GP, 16 * s, 16 * s + 4, 0), b1 = tr_frag(khl, GP, 16 * s, 16 * s + 4, 32);
            acc0 = MFMA32(a, b0, acc0); acc1 = MFMA32(a, b1, acc1);
        }
#pragma unroll
        for (int r = 0; r < 16; ++r) { const int e = half * 128 + etile * 32 + crow(r, hh); float* o = GST + ((size_t)u * 256 + e) * 128 + dt0 * 32 + (l & 31); o[0] = acc0[r]; o[32] = acc1[r]; }
        __syncthreads();
    }
}
DI void gla_scan_phase(Frame& F, bool do_store = true) {
    float* GST = (float*)(F.ws + WS_GST); const float* DEC = (const float*)(F.ws + WS_DEC);
    for (int idx = F.c * NT + F.tid; idx < 8 * 16384; idx += F.G * NT) {
        const int bh = idx >> 14, rem = idx & 16383, e = rem >> 6, d = (rem & 63) * 2;
        f32x2 st = {0.f, 0.f};
#pragma unroll 4
        for (int sc = 0; sc < 32; ++sc) { const int u = bh * 32 + sc; f32x2* p = (f32x2*)(GST + ((size_t)u * 256 + e) * 128 + d);
            const f32x2 uu = *p; const f32x2 dc = *(const f32x2*)(DEC + u * 128 + d); if (do_store) *p = st; st = dc * st + uu; }
        if (!do_store && st.x == 1.2345e-30f) GST[0] = st.y;
    }
}
DI void gla_out_unit(Frame& F, const float* const* in, int u, bool do_store = true) {
    const int l = F.lane, w = F.wave, hh = l >> 5;
    const int bh = u >> 5, b = bh >> 2, h = bh & 3, sc = u & 31; const size_t row0 = (size_t)b * T + sc * 256;
    const unsigned QS = (unsigned)(size_t)F.lds, KS = QS + 256 * GP; LAS float* tot = (LAS float*)(F.lds + 2 * 256 * GP);
    const bf16* QKG = (const bf16*)(F.ws + WS_QKG); const float* GST = (const float*)(F.ws + WS_GST); bf16* GR = (bf16*)(F.ws + WS_GR);
    {
        GlaW W; GlaPre P; gla_totals(F, in, h, row0, tot, W, P);
        const bf16* SM = (const bf16*)(F.ws + WS_SM);
        const float qs = 0.08838834764831845f;
        float B0 = P.pre0, B1 = P.pre1;
#pragma unroll 2
        for (int tt = 0; tt < 32; ++tt) { const size_t row = row0 + 32 * w + tt;
            float l0, l1; gla_la(SM, row, W, l0, l1); B0 += l0; B1 += l1;
            const float q0 = bf2f(QKG[row * 1024 + h * 128 + l]), q1 = bf2f(QKG[row * 1024 + h * 128 + 64 + l]);
            const float k0 = bf2f(QKG[row * 1024 + 512 + h * 128 + l]), k1 = bf2f(QKG[row * 1024 + 512 + h * 128 + 64 + l]);
            const unsigned a = QS + (32 * w + tt) * GP + l * 2, bb = KS + (32 * w + tt) * GP + l * 2;
            *(LAS bf16*)(a) = (bf16)(pk2(q0 * qs * fast_exp(B0), 0.f) & 0xffffu); *(LAS bf16*)(a + 128) = (bf16)(pk2(q1 * qs * fast_exp(B1), 0.f) & 0xffffu);
            *(LAS bf16*)(bb) = (bf16)(pk2(k0 * fast_exp(-B0), 0.f) & 0xffffu); *(LAS bf16*)(bb + 128) = (bf16)(pk2(k1 * fast_exp(-B1), 0.f) & 0xffffu); }
    }
    __syncthreads();
    bf16x8 qf[8];
#pragma unroll
    for (int s = 0; s < 8; ++s) qf[s] = lds_b128(QS + (32 * w + (l & 31)) * GP + (16 * s + 8 * hh) * 2);
    __syncthreads();
    f32x16 acc[8];
#pragma unroll
    for (int et = 0; et < 8; ++et)
#pragma unroll
        for (int r = 0; r < 16; ++r) acc[et][r] = 0.f;
    const unsigned VH = QS;
#pragma unroll
    for (int half = 0; half < 2; ++half) {
        gla_load_v_half(F, VH, row0, h, half);
        __syncthreads();
        for (int j = 0; j <= w; ++j) {
            f32x16 X;
#pragma unroll
            for (int r = 0; r < 16; ++r) X[r] = 0.f;
            const unsigned ksj = KS + (l & 31) * GP + 16 * hh + 32 * j * GP, vhj = VH + tr_lane(GP, 4, l) + 32 * j * GP;
#pragma unroll
            for (int s = 0; s < 8; ++s) X = MFMA32(lds_b128(ksj + 32 * s), qf[s], X);
            if (j == w) {
#pragma unroll
                for (int r = 0; r < 16; ++r) if (crow(r, hh) > (l & 31)) X[r] = 0.f;
            }
            const bf16x8 xb0 = pack_step(X, 0), xb1 = pack_step(X, 1);
#pragma unroll
            for (int et = 0; et < 4; ++et) {
                const bf16x8 a0 = tr_frag(vhj, GP, 0, 8, et * 32), a1 = tr_frag(vhj, GP, 16, 24, et * 32);
                acc[half * 4 + et] = MFMA32(a0, xb0, acc[half * 4 + et]); acc[half * 4 + et] = MFMA32(a1, xb1, acc[half * 4 + et]);
            }
        }
        __syncthreads();
    }
    {
        const int soff = (l & 31) * 128 + 8 * hh;
#pragma unroll
        for (int et = 0; et < 8; ++et) {
            const float* sp = GST + (size_t)u * 32768 + et * 4096 + soff;
#pragma unroll
            for (int s = 0; s < 8; s += 2) {
                const f32x4 x0 = *(const f32x4*)(sp + 16 * s), x1 = *(const f32x4*)(sp + 16 * s + 4), x2 = *(const f32x4*)(sp + 16 * s + 16), x3 = *(const f32x4*)(sp + 16 * s + 20);
                acc[et] = MFMA32(pack8(x0.x, x0.y, x0.z, x0.w, x1.x, x1.y, x1.z, x1.w), qf[s], acc[et]);
                acc[et] = MFMA32(pack8(x2.x, x2.y, x2.z, x2.w, x3.x, x3.y, x3.z, x3.w), qf[s + 1], acc[et]);
                asm volatile("" ::: "memory");
            }
        }
    }
    float ss = 0.f;
#pragma unroll
    for (int et = 0; et < 8; ++et)
#pragma unroll
        for (int r = 0; r < 16; ++r) ss += acc[et][r] * acc[et][r];
    ss += __shfl_xor(ss, 32);
    const float rinv = __builtin_amdgcn_rsqf(ss * (1.f / 256.f) + EPS);
    const float* gn = in[11] + h * 256 + 4 * hh;
    bf16* orow = GR + (row0 + 32 * w + (l & 31)) * 1024 + h * 256 + 4 * hh;
#pragma unroll
    for (int et = 0; et < 8; ++et)
#pragma unroll
        for (int g = 0; g < 4; ++g) { const int e = et * 32 + 8 * g;
            const u32x2 gw = *(const u32x2*)(orow + e); const f32x4 gg = *(const f32x4*)(gn + e);
            const float r0 = bflo(gw.x), r1 = bfhi(gw.x), r2 = bflo(gw.y), r3 = bfhi(gw.y);
            u32x2 o; o.x = pk2(acc[et][4 * g] * rinv * gg.x * r0 * sigmoid_f(r0), acc[et][4 * g + 1] * rinv * gg.y * r1 * sigmoid_f(r1));
            o.y = pk2(acc[et][4 * g + 2] * rinv * gg.z * r2 * sigmoid_f(r2), acc[et][4 * g + 3] * rinv * gg.w * r3 * sigmoid_f(r3));
            if (do_store) *(u32x2*)(orow + e) = o; if (g == 3) __builtin_amdgcn_sched_barrier(0); }
}

DI void hist_find(LAS unsigned* H, int lane, unsigned k, unsigned& bin, unsigned& above) {
    const u32x4 c = *(const LAS u32x4*)(H + 4 * lane);
    const unsigned s = c.x + c.y + c.z + c.w; unsigned suf = s;
#pragma unroll
    for (int o = 1; o < 64; o <<= 1) { const unsigned v = __shfl_down(suf, o); if (lane + o < 64) suf += v; }
    const unsigned excl = suf - s;
    const bool cross = excl < k && suf >= k;
    unsigned a = excl, bn = 0, ab = 0;
    if (a + c.w >= k) { bn = 4 * lane + 3; ab = a; } else { a += c.w;
        if (a + c.z >= k) { bn = 4 * lane + 2; ab = a; } else { a += c.z;
            if (a + c.y >= k) { bn = 4 * lane + 1; ab = a; } else { a += c.y; bn = 4 * lane; ab = a; } } }
    const unsigned long long m = __ballot(cross);
    const int src = m ? __builtin_ctzll(m) : 0;
    bin = __shfl(bn, src); above = __shfl(ab, src);
}
DI void idx_unit(Frame& F, int u, bool do_store = true) {
    const int l = F.lane, w = F.wave, hh = l >> 5;
    const int b = u >> 10, t0 = (u & 1023) * 8; const size_t row0 = (size_t)b * T + t0;
    const bf16* IQ = (const bf16*)(F.ws + WS_IQ); const bf16* SM = (const bf16*)(F.ws + WS_SM);
    const unsigned SC = (unsigned)(size_t)F.lds; LAS unsigned* HIST = (LAS unsigned*)(F.lds + 131072);
    bf16x8 af[2][4]; float wv[2][16];
    {
        const int rho = l & 31;
#pragma unroll
        for (int tl = 0; tl < 2; ++tl) { const int q = 4 * tl + (rho >> 4) + 2 * ((rho >> 2) & 1), head = (rho & 3) + 4 * ((rho >> 3) & 1);
#pragma unroll
            for (int s = 0; s < 4; ++s) af[tl][s] = *(const bf16x8*)(IQ + (row0 + q) * 512 + head * 64 + 16 * s + 8 * hh);
#pragma unroll
            for (int r = 0; r < 16; ++r) { const int qq = 4 * tl + (r >> 3) + 2 * hh, hd = (r & 3) + 4 * ((r >> 2) & 1); wv[tl][r] = bf2f(SM[(row0 + qq) * 128 + 64 + hd]); } }
    }
    const int ntile = t0 / 32 + 1;
    for (int kt = w; kt < ntile; kt += 8) {
        const int key = 32 * kt + (l & 31); const bf16* kp = SM + ((size_t)b * T + key) * 128 + 8 * hh;
        bf16x8 bfr[4];
#pragma unroll
        for (int s = 0; s < 4; ++s) bfr[s] = *(const bf16x8*)(kp + 16 * s);
        f32x16 C0, C1;
#pragma unroll
        for (int r = 0; r < 16; ++r) { C0[r] = 0.f; C1[r] = 0.f; }
#pragma unroll
        for (int s = 0; s < 4; ++s) { C0 = MFMA32(af[0][s], bfr[s], C0); C1 = MFMA32(af[1][s], bfr[s], C1); }
#pragma unroll
        for (int tl = 0; tl < 2; ++tl)
#pragma unroll
            for (int b4 = 0; b4 < 2; ++b4) {
                float sc = 0.f;
#pragma unroll
                for (int r = 0; r < 8; ++r) sc = fmaf(wv[tl][8 * b4 + r], fmaxf(tl ? C1[8 * b4 + r] : C0[8 * b4 + r], 0.f), sc);
                const int q = 4 * tl + b4 + 2 * hh;
                sc = fminf(fmaxf(sc, -60000.f), 60000.f);
                const _Float16 hf = (_Float16)sc; unsigned h16 = (unsigned)__builtin_bit_cast(unsigned short, hf);
                unsigned k16 = (h16 & 0x8000u) ? (~h16 & 0xffffu) : (h16 | 0x8000u);
                if (key > t0 + q) k16 = 0u;
                *(LAS unsigned short*)(SC + q * 16384 + key * 2) = (unsigned short)k16;
            }
    }
    __syncthreads();
    {
        const int t = t0 + w, n = t + 1, nit = (n + 255) >> 8;
        unsigned char* mrow = (unsigned char*)(F.ws + WS_IQ) + (row0 + w) * 1024;
        const unsigned scq = SC + w * 16384 + l * 8;
        LAS unsigned* H = HIST + w * 256;
        unsigned thr = 0u, rneed = 0u;
        if (n > 256) {
            unsigned B, above, L, above2;
            H[l] = 0u; H[l + 64] = 0u; H[l + 128] = 0u; H[l + 192] = 0u; LDS_WAIT();
            for (int it = 0; it < nit; ++it) { const u32x2 kk = *(const LAS u32x2*)(scq + it * 512); const int i0 = 256 * it + 4 * l;
                const unsigned k0 = kk.x & 0xffffu, k1 = kk.x >> 16, k2 = kk.y & 0xffffu, k3 = kk.y >> 16;
                if (i0 < n) __hip_atomic_fetch_add(H + (k0 >> 8), 1u, __ATOMIC_RELAXED, __HIP_MEMORY_SCOPE_WORKGROUP);
                if (i0 + 1 < n) __hip_atomic_fetch_add(H + (k1 >> 8), 1u, __ATOMIC_RELAXED, __HIP_MEMORY_SCOPE_WORKGROUP);
                if (i0 + 2 < n) __hip_atomic_fetch_add(H + (k2 >> 8), 1u, __ATOMIC_RELAXED, __HIP_MEMORY_SCOPE_WORKGROUP);
                if (i0 + 3 < n) __hip_atomic_fetch_add(H + (k3 >> 8), 1u, __ATOMIC_RELAXED, __HIP_MEMORY_SCOPE_WORKGROUP); }
            LDS_WAIT(); hist_find(H, l, 256u, B, above);
            LDS_WAIT(); H[l] = 0u; H[l + 64] = 0u; H[l + 128] = 0u; H[l + 192] = 0u; LDS_WAIT();
            for (int it = 0; it < nit; ++it) { const u32x2 kk = *(const LAS u32x2*)(scq + it * 512); const int i0 = 256 * it + 4 * l;
                const unsigned k0 = kk.x & 0xffffu, k1 = kk.x >> 16, k2 = kk.y & 0xffffu, k3 = kk.y >> 16;
                if (i0 < n && (k0 >> 8) == B) __hip_atomic_fetch_add(H + (k0 & 255u), 1u, __ATOMIC_RELAXED, __HIP_MEMORY_SCOPE_WORKGROUP);
                if (i0 + 1 < n && (k1 >> 8) == B) __hip_atomic_fetch_add(H + (k1 & 255u), 1u, __ATOMIC_RELAXED, __HIP_MEMORY_SCOPE_WORKGROUP);
                if (i0 + 2 < n && (k2 >> 8) == B) __hip_atomic_fetch_add(H + (k2 & 255u), 1u, __ATOMIC_RELAXED, __HIP_MEMORY_SCOPE_WORKGROUP);
                if (i0 + 3 < n && (k3 >> 8) == B) __hip_atomic_fetch_add(H + (k3 & 255u), 1u, __ATOMIC_RELAXED, __HIP_MEMORY_SCOPE_WORKGROUP); }
            LDS_WAIT(); hist_find(H, l, 256u - above, L, above2);
            thr = (B << 8) | L; rneed = 256u - above - above2;
        }
        unsigned running = 0u;
        for (int it = 0; it < nit; ++it) {
            const u32x2 kk = *(const LAS u32x2*)(scq + it * 512); const int i0 = 256 * it + 4 * l;
            const unsigned ks[4] = {kk.x & 0xffffu, kk.x >> 16, kk.y & 0xffffu, kk.y >> 16};
            unsigned nib = 0u;
            if (n <= 256) {
#pragma unroll
                for (int j = 0; j < 4; ++j) nib |= (i0 + j < n) ? (1u << j) : 0u;
            } else {
                bool eq[4]; unsigned long long mk[4];
#pragma unroll
                for (int j = 0; j < 4; ++j) { eq[j] = (i0 + j < n) && ks[j] == thr; mk[j] = __ballot(eq[j]); }
                const unsigned long long below = (1ull << l) - 1ull;
                unsigned cum = running + (unsigned)(__popcll(mk[0] & below) + __popcll(mk[1] & below) + __popcll(mk[2] & below) + __popcll(mk[3] & below));
#pragma unroll
                for (int j = 0; j < 4; ++j) { const bool gt = (i0 + j < n) && ks[j] > thr; const bool take = gt || (eq[j] && cum < rneed); if (eq[j]) ++cum; nib |= take ? (1u << j) : 0u; }
                running += (unsigned)(__popcll(mk[0]) + __popcll(mk[1]) + __popcll(mk[2]) + __popcll(mk[3]));
            }
            const unsigned up = __shfl_down(nib, 1);
            if ((l & 1) == 0 && do_store) mrow[it * 32 + (l >> 1)] = (unsigned char)(nib | (up << 4));
        }
    }
    __syncthreads();
}

template <int DH, bool DSA>
DI void attn_unit(Frame& F, const bf16* Qp, int ldq, const bf16* Kp, const bf16* Vp, int ldkv, int nst, bf16* Op, int ldo, float c1,
                  const unsigned* mask0  , int tq0, const LAS float* BT, float cfar, bool do_store = true) {
    constexpr int PK = DH * 2 + 16, SB = 64 * PK, NS = DH / 16, ND = DH / 32, CH = DH / 8  , NLD = 64 * CH / NT;
    const int l = F.lane, w = F.wave, hh = l >> 5, tid = F.tid;
    const unsigned KT = (unsigned)(size_t)F.lds, VT = KT + 2 * SB;
    const unsigned klane = (unsigned)((l & 31) * PK + 16 * hh), vlane = tr_lane(PK, 4, l);
    bf16x8 qf[NS];
#pragma unroll
    for (int s = 0; s < NS; ++s) qf[s] = *(const bf16x8*)(Qp + (size_t)(32 * w + (l & 31)) * ldq + 16 * s + 8 * hh);
    f32x16 O[ND];
#pragma unroll
    for (int d = 0; d < ND; ++d)
#pragma unroll
        for (int r = 0; r < 16; ++r) O[d][r] = 0.f;
    float lsum = 0.f;
    const int tq = tq0 + 32 * w + (l & 31), tq_hi = tq0 + 32 * w + 31, tq_lo = tq0 + 32 * w;
    const unsigned* mrow = DSA ? mask0 + (size_t)(32 * w + (l & 31)) * 256 : nullptr;
    u32x4 kr[NLD], vr[NLD];
    u32x2 mcur = {0u, 0u}, mnxt = {0u, 0u};
    if (DSA) mcur = *(const u32x2*)mrow;
#pragma unroll
    for (int i = 0; i < NLD; ++i) { const int idx = i * NT + tid, row = idx / CH, ch = idx % CH;
        kr[i] = *(const u32x4*)(Kp + (size_t)row * ldkv + ch * 8); vr[i] = *(const u32x4*)(Vp + (size_t)row * ldkv + ch * 8); }
#pragma unroll
    for (int i = 0; i < NLD; ++i) { const int idx = i * NT + tid, row = idx / CH, ch = idx % CH;
        *(LAS u32x4*)(KT + row * PK + ch * 16) = kr[i]; *(LAS u32x4*)(VT + row * PK + ch * 16) = vr[i]; }
    __syncthreads();
    for (int st = 0; st < nst; ++st) {
        const unsigned kt = KT + (st & 1) * SB, vt = VT + (st & 1) * SB;
        const bool more = st + 1 < nst;
        if (more) {
#pragma unroll
            for (int i = 0; i < NLD; ++i) { const int idx = i * NT + tid, row = 64 * (st + 1) + idx / CH, ch = idx % CH;
                kr[i] = *(const u32x4*)(Kp + (size_t)row * ldkv + ch * 8); vr[i] = *(const u32x4*)(Vp + (size_t)row * ldkv + ch * 8); }
            if (DSA) mnxt = *(const u32x2*)(mrow + 2 * (st + 1));
        }
#pragma unroll
        for (int kb = 0; kb < 2; ++kb) {
            const int key0 = 64 * st + 32 * kb;
            if (DSA && key0 > tq_hi) continue;
            f32x16 X;
#pragma unroll
            for (int r = 0; r < 16; ++r) X[r] = 0.f;
#pragma unroll
            for (int s = 0; s < NS; ++s) X = MFMA32(lds_b128(kt + klane + 32 * kb * PK + 32 * s), qf[s], X);
            if (DSA) {
                const unsigned mw = (kb ? mcur.y : mcur.x) >> (4 * hh);
                if (tq_lo - (key0 + 31) >= 113) {
#pragma unroll
                    for (int r = 0; r < 16; ++r) { const float p = fast_exp2(fmaf(X[r], c1, cfar)); const int bits = __builtin_amdgcn_sbfe((int)mw, (r & 3) + 8 * (r >> 2), 1);
                        const float pm = __uint_as_float(__float_as_uint(p) & (unsigned)bits); lsum += pm; X[r] = pm; }
                } else {
#pragma unroll
                    for (int r = 0; r < 16; ++r) { int di = tq - (key0 + crow(r, hh)); di = di < 0 ? 0 : (di > 127 ? 127 : di);
                        const float p = fast_exp2(fmaf(X[r], c1, BT[di])); const int bits = __builtin_amdgcn_sbfe((int)mw, (r & 3) + 8 * (r >> 2), 1);
                        const float pm = __uint_as_float(__float_as_uint(p) & (unsigned)bits); lsum += pm; X[r] = pm; }
                }
            } else {
#pragma unroll
                for (int r = 0; r < 16; ++r) { const float p = fast_exp2(X[r] * c1); lsum += p; X[r] = p; }
            }
            const bf16x8 xb0 = pack_step(X, 0), xb1 = pack_step(X, 1);
#pragma unroll
            for (int d = 0; d < ND; ++d) {
                const bf16x8 a0 = tr_frag(vt + vlane, PK, 32 * kb, 32 * kb + 8, 32 * d), a1 = tr_frag(vt + vlane, PK, 32 * kb + 16, 32 * kb + 24, 32 * d);
                O[d] = MFMA32(a0, xb0, O[d]); O[d] = MFMA32(a1, xb1, O[d]);
            }
        }
        if (more) {
            const unsigned kn = KT + ((st + 1) & 1) * SB, vn = VT + ((st + 1) & 1) * SB;
#pragma unroll
            for (int i = 0; i < NLD; ++i) { const int idx = i * NT + tid, row = idx / CH, ch = idx % CH;
                *(LAS u32x4*)(kn + row * PK + ch * 16) = kr[i]; *(LAS u32x4*)(vn + row * PK + ch * 16) = vr[i]; }
            mcur = mnxt;
        }
        __syncthreads();
    }
    lsum += __shfl_xor(lsum, 32);
    const float inv = fast_rcp(lsum);
    bf16* orow = Op + (size_t)(32 * w + (l & 31)) * ldo;
#pragma unroll
    for (int d = 0; d < ND; ++d)
#pragma unroll
        for (int g = 0; g < 4; ++g) { u32x2 o; o.x = pk2(O[d][4 * g] * inv, O[d][4 * g + 1] * inv); o.y = pk2(O[d][4 * g + 2] * inv, O[d][4 * g + 3] * inv);
            if (do_store) *(u32x2*)(orow + 32 * d + 8 * g + 4 * hh) = o; }
}
DI int t5_bucket(int rel) {
    if (rel < 16) return rel;
    const float v = logf((float)rel * (1.f / 16.f)) / 2.0794415416798357f * 16.f;
    int lg = 16 + (int)v; return lg > 31 ? 31 : lg;
}
DI void dsa_att_unit(Frame& F, const float* const* in, int bh, int qb, bool do_store = true) {
    const int b = bh >> 3, h = bh & 7;
    LAS float* BT = (LAS float*)(F.lds + 4 * 64 * 144);
    const float* tab = in[14];
    __syncthreads();
    if (F.tid < 128) BT[F.tid] = tab[t5_bucket(F.tid) * 8 + h] * LOG2E;
    __syncthreads();
    const float cfar = tab[31 * 8 + h] * LOG2E;
    bf16* DQ = (bf16*)(F.ws + WS_DQKV);
    const size_t rowq = (size_t)b * T + qb * 256, rowk = (size_t)b * T;
    attn_unit<64, true>(F, DQ + rowq * 1536 + h * 64, 1536, DQ + rowk * 1536 + 512 + h * 64, DQ + rowk * 1536 + 1024 + h * 64, 1536, 4 * (qb + 1),
                        DQ + rowq * 1536 + h * 64, 1536, 0.125f * LOG2E, (const unsigned*)(F.ws + WS_IQ) + rowq * 256, qb * 256, BT, cfar, do_store);
}
DI void cross_att_unit(Frame& F, int u) {
    const int b = u >> 7, h = (u >> 5) & 3, qb = u & 31;
    const bf16* QC = (const bf16*)(F.ws + WS_QC); const bf16* KVM = (const bf16*)(F.ws + WS_KVM); bf16* OX = (bf16*)(F.ws + WS_OX);
    const size_t rowq = (size_t)b * T + qb * 256;
    __syncthreads();
    attn_unit<128, false>(F, QC + rowq * 512 + h * 128, 512, KVM + (size_t)b * MEML * 1024 + h * 128, KVM + (size_t)b * MEML * 1024 + 512 + h * 128, 1024, MEML / 64,
                          OX + rowq * 512 + h * 128, 512, 0.08838834764831845f * LOG2E, nullptr, 0, nullptr, 0.f);
}

constexpr int N_PHASES = 19;
#ifndef MK_ONE_LAUNCH
#define MK_ONE_LAUNCH 1
#endif
__global__ void __launch_bounds__(NT, 2) mega_fwd(Args args) {
    extern __shared__ __attribute__((aligned(16))) unsigned char lds_raw[];
    Frame F;
    F.lds = (LAS unsigned char*)lds_raw; F.ws = args.ws;
    F.tid = threadIdx.x; F.lane = F.tid & 63; F.wave = __builtin_amdgcn_readfirstlane(F.tid >> 6);
    F.G = gridDim.x; F.c = blockIdx.x;
    volatile LAS unsigned* MISC = (volatile LAS unsigned*)(F.lds + MISC_OFF);
    if (F.tid < 64) MISC[F.tid] = 0u;
    __syncthreads();
    unsigned* ctl = (unsigned*)(args.ws + WS_CTL);
    const int lo = args.ph_lo, hi = args.ph_hi;
    XcdBarrier bar; bar.bar = ctl + CW_BAR; bar.x = 0; bar.st = MISC + 8;
    if (hi - lo > 1) bar = xcd_barrier_post(ctl + CW_BAR, MISC + 8);
    const float* const* in = args.in;
    unsigned char* ws = args.ws;
    const int gw = F.c * NWAVES + F.wave, NGW = F.G * NWAVES;
#ifndef PHMASK
#define PHMASK 0x7ffff
#endif
#define IN(k) (((PHMASK >> (k)) & 1) && lo <= (k) && (k) < hi)
#define SEAM(k) do { if ((k) + 1 < hi) xcd_barrier(bar); } while (0)
#ifndef DUP_PHASE
#define DUP_PHASE -1
#endif
#ifndef DUP_N
#define DUP_N 1
#endif
#define REPS(k) ((k) == DUP_PHASE ? 1 + DUP_N : 1)
#define FORREP(k) _Pragma("unroll 1") for (int rep = 0; rep < REPS(k); ++rep)
#define ST(k) (rep == REPS(k) - 1 || hi > 1000)
#define REPBAR(k) do { if (rep + 1 < REPS(k)) xcd_barrier(bar); } while (0)
    bf16* XN = (bf16*)(ws + WS_XN); bf16* HID = (bf16*)(ws + WS_HID); bf16* Y = (bf16*)(ws + WS_Y);
    bf16* W1A = (bf16*)(ws + WS_W1A); bf16* W1B = (bf16*)(ws + WS_W1B);

    if (IN(0)) { FORREP(0) {
        LAS float* scr = (LAS float*)(F.lds + F.wave * 16384);
        constexpr int NITEMS = 10240;
        for (int it0 = gw; it0 < NITEMS; it0 += NGW) { int it = it0;
            if (conv_job(it, in[4], 2 * FF, D, 2 * FF / 32, W1A, D, ColFfn{}, scr, F.lane)) continue;
            if (conv_job(it, in[5], D, FF, D / 32, W1B, FF, ColIdent{0}, scr, F.lane)) continue;
            if (conv_job(it, in[8], 7256, D, NIN / 32, (bf16*)(ws + WS_WIN), D, ColInproj{}, scr, F.lane)) continue;
            if (conv_job(it, in[8], 7256, D, 2048 / 32, (bf16*)(ws + WS_WGT), D, ColIdent{5208}, scr, F.lane)) continue;
            if (conv_job(it, in[12], D, D, D / 32, (bf16*)(ws + WS_WG), D, ColIdent{0}, scr, F.lane)) continue;
            if (conv_job(it, in[13], D, 512, D / 32, (bf16*)(ws + WS_WD), 512, ColIdent{0}, scr, F.lane)) continue;
            if (conv_job(it, in[15], D, D, D / 32, (bf16*)(ws + WS_WO), D, ColIdent{0}, scr, F.lane)) continue;
            if (conv_job(it, in[19], 512, D, 512 / 32, (bf16*)(ws + WS_WCQ), D, ColIdent{0}, scr, F.lane)) continue;
            if (conv_job(it, in[20], D, D, D / 32, (bf16*)(ws + WS_WCKV), D, ColIdent{0}, scr, F.lane)) continue;
            conv_job(it, in[21], D, 512, D / 32, (bf16*)(ws + WS_WCO), 512, ColIdent{0}, scr, F.lane);
        }
        { int m = gw;
          for (; m + 3 * NGW < M; m += 4 * NGW) rms_rows_bf16<4>(in[0] + (size_t)m * D, in[2], XN + (size_t)m * D, F.lane, (size_t)NGW * D);
          for (; m < M; m += NGW) rms_rows_bf16<1>(in[0] + (size_t)m * D, in[2], XN + (size_t)m * D, F.lane, 0); }
        for (int m = gw; m < BATCH * MEML; m += NGW) rms_rows_bf16<1>(in[1] + (size_t)m * D, in[16], (bf16*)(ws + WS_MEMN) + (size_t)m * D, F.lane, 0);
        REPBAR(0); }
        SEAM(0);
    }
    if (IN(1)) {
        pg8::Order1 S; S.init(pg8::GDesc{XN, W1A, D, D, D, M / 256, 2 * FF / 256}, F.G, F.c);
        FORREP(1) { pg8::gemm_phase<true>(F.lds, S, EpiSwiglu{HID}); REPBAR(1); }
        SEAM(1);
    }
    if (IN(2)) {
        pg8::Order1 S; S.init(pg8::GDesc{HID, W1B, FF, FF, FF, M / 256, D / 256}, F.G, F.c);
        FORREP(2) { pg8::gemm_phase<true>(F.lds, S, EpiStore{Y, D}); REPBAR(2); }
        SEAM(2);
    }
    if (IN(3)) { FORREP(3) { resnorm_phase(F, in[0], Y, in[3], 0.5f, args.out, in[6], XN, ST(3)); REPBAR(3); } SEAM(3); }
    if (IN(4)) {
        pg8::Order2 S; S.d0 = pg8::GDesc{XN, (const bf16*)(ws + WS_WIN), D, D, D, M / 256, NIN / 256};
        S.d1 = pg8::GDesc{(const bf16*)(ws + WS_MEMN), (const bf16*)(ws + WS_WCKV), D, D, D, BATCH * MEML / 256, D / 256}; S.G = F.G; S.c = F.c;
        FORREP(4) { pg8::gemm_phase<true>(F.lds, S, EpiInproj{ws}); REPBAR(4); }
        SEAM(4);
    }
    if (IN(5)) {
        FORREP(5) {
#if !defined(DUP_SUB) || DUP_SUB == 0
        for (int u = F.c; u < 256; u += F.G) gla_state_unit(F, in, u);
        __syncthreads();
#else
        if (ST(5)) { for (int u = F.c; u < 256; u += F.G) gla_state_unit(F, in, u); __syncthreads(); }
#endif
#if !defined(DUP_SUB) || DUP_SUB == 1
        for (int u = F.c; u < 2048; u += F.G) idx_unit(F, u, ST(5));
#else
        if (ST(5)) for (int u = F.c; u < 2048; u += F.G) idx_unit(F, u, true);
#endif
        REPBAR(5); }
        SEAM(5);
    }
    if (IN(6)) {
        FORREP(6) {
#if !defined(DUP_SUB) || DUP_SUB == 0
        gla_scan_phase(F, ST(6));
#else
        if (ST(6)) gla_scan_phase(F, true);
#endif
#if !defined(DUP_SUB) || DUP_SUB == 1
        for (int p = F.c; p < 256; p += F.G) { const int bh = p >> 4, x = p & 15; dsa_att_unit(F, in, bh, x, ST(6)); dsa_att_unit(F, in, bh, 31 - x, ST(6)); }
#else
        if (ST(6)) for (int p = F.c; p < 256; p += F.G) { const int bh = p >> 4, x = p & 15; dsa_att_unit(F, in, bh, x, true); dsa_att_unit(F, in, bh, 31 - x, true); }
#endif
        REPBAR(6); }
        SEAM(6);
    }
    if (IN(7)) {
        FORREP(7) { for (int u = F.c; u < 256; u += F.G) { gla_out_unit(F, in, u, ST(7)); __syncthreads(); } REPBAR(7); }
        SEAM(7);
    }
    if (IN(8)) {
        pg8::Order1 S; S.init(pg8::GDesc{XN, (const bf16*)(ws + WS_WGT), D, D, D, M / 256, 2048 / 256}, F.G, F.c);
        FORREP(8) { pg8::gemm_phase<true>(F.lds, S, EpiGates{(bf16*)(ws + WS_SGA), (bf16*)(ws + WS_SGB)}); REPBAR(8); }
        SEAM(8);
    }
    if (IN(9)) {
        pg8::PairOrder S; S.d0 = pg8::GDesc{(const bf16*)(ws + WS_GR), (const bf16*)(ws + WS_WG), D, D, D, M / 256, D / 256};
        S.d1 = pg8::GDesc{(const bf16*)(ws + WS_DQKV), (const bf16*)(ws + WS_WD), 1536, 512, 512, M / 256, D / 256}; S.G = F.G; S.c = F.c;
        FORREP(9) { pg8::gemm_phase<false>(F.lds, S, EpiMerge{(const bf16*)(ws + WS_SGA), (const bf16*)(ws + WS_SGB), (bf16*)(ws + WS_MRG)}); REPBAR(9); }
        SEAM(9);
    }
    if (IN(10)) {
        pg8::Order1 S; S.init(pg8::GDesc{(const bf16*)(ws + WS_MRG), (const bf16*)(ws + WS_WO), D, D, D, M / 256, D / 256}, F.G, F.c);
        FORREP(10) { pg8::gemm_phase<true>(F.lds, S, EpiStore{(bf16*)(ws + WS_Y2), D}); REPBAR(10); }
        SEAM(10);
    }
    if (IN(11)) {
        FORREP(11) {
        resnorm_phase(F, args.out, (const bf16*)(ws + WS_Y2), in[7], 1.0f, args.out, in[17], XN, ST(11));
        LAS float* scr = (LAS float*)(F.lds + F.wave * 16384);
        constexpr int NITEMS = 2816 + 1408;
        for (int it0 = gw; it0 < NITEMS; it0 += NGW) { int it = it0;
            if (conv_job(it, in[24], 2 * FF, D, 2 * FF / 32, W1A, D, ColFfn{}, scr, F.lane)) continue;
            conv_job(it, in[25], D, FF, D / 32, W1B, FF, ColIdent{0}, scr, F.lane);
        }
        REPBAR(11); }
        SEAM(11);
    }
    if (IN(12)) {
        pg8::Order1 S; S.init(pg8::GDesc{XN, (const bf16*)(ws + WS_WCQ), D, D, D, M / 256, 512 / 256}, F.G, F.c);
        FORREP(12) { pg8::gemm_phase<true>(F.lds, S, EpiStore{(bf16*)(ws + WS_QC), 512}); REPBAR(12); }
        SEAM(12);
    }
    if (IN(13)) {
        FORREP(13) { for (int u = F.c; u < 256; u += F.G) cross_att_unit(F, u); REPBAR(13); }
        SEAM(13);
    }
    if (IN(14)) {
        pg8::Order1 S; S.init(pg8::GDesc{(const bf16*)(ws + WS_OX), (const bf16*)(ws + WS_WCO), 512, 512, 512, M / 256, D / 256}, F.G, F.c);
        FORREP(14) { pg8::gemm_phase<true>(F.lds, S, EpiStore{(bf16*)(ws + WS_Y3), D}); REPBAR(14); }
        SEAM(14);
    }
    if (IN(15)) { FORREP(15) { resnorm_phase(F, args.out, (const bf16*)(ws + WS_Y3), in[18], 1.0f, args.out, in[22], XN, ST(15)); REPBAR(15); } SEAM(15); }
    if (IN(16)) {
        pg8::Order1 S; S.init(pg8::GDesc{XN, W1A, D, D, D, M / 256, 2 * FF / 256}, F.G, F.c);
        FORREP(16) { pg8::gemm_phase<true>(F.lds, S, EpiSwiglu{HID}); REPBAR(16); }
        SEAM(16);
    }
    if (IN(17)) {
        pg8::Order1 S; S.init(pg8::GDesc{HID, W1B, FF, FF, FF, M / 256, D / 256}, F.G, F.c);
        FORREP(17) { pg8::gemm_phase<true>(F.lds, S, EpiStore{Y, D}); REPBAR(17); }
        SEAM(17);
    }
    if (IN(18)) { FORREP(18) { resnorm_phase(F, args.out, Y, in[23], 0.5f, args.out, nullptr, nullptr, ST(18)); REPBAR(18); } }
#undef IN
#undef SEAM
}

extern "C" void kernel_launch(void* const* d_in, const int* in_sizes, int n_in, void* d_out, int out_size, void* d_ws, size_t ws_size, hipStream_t stream) {
    static int grid = 0;
    if (grid == 0) {
        if (n_in != 26 || out_size != M * D || ws_size < WS_END) { fprintf(stderr, "kernel_launch: unexpected problem shape (n_in %d, out %d, ws %zu); nothing launched\n", n_in, out_size, ws_size); grid = -1; return; }
        int dev = 0, cus = 0, per_cu = 0;
        if (hipGetDevice(&dev) != hipSuccess || hipDeviceGetAttribute(&cus, hipDeviceAttributeMultiprocessorCount, dev) != hipSuccess) { grid = -1; return; }
        if (hipFuncSetAttribute((const void*)mega_fwd, hipFuncAttributeMaxDynamicSharedMemorySize, LDS_BYTES) != hipSuccess) { fprintf(stderr, "kernel_launch: hipFuncSetAttribute failed\n"); grid = -1; return; }
        if (hipOccupancyMaxActiveBlocksPerMultiprocessor(&per_cu, (const void*)mega_fwd, NT, LDS_BYTES) != hipSuccess || per_cu < 1) fprintf(stderr, "kernel_launch: occupancy query reports %d workgroups per CU\n", per_cu);
        (void)hipGetLastError();
        grid = cus;
    }
    if (grid < 0) return;
    (void)hipMemsetAsync((char*)d_ws + WS_CTL, 0, 65536, stream);
    Args a{};
    for (int i = 0; i < 26; ++i) a.in[i] = (const float*)d_in[i];
    a.out = (float*)d_out; a.ws = (unsigned char*)d_ws;
#if MK_ONE_LAUNCH
    a.ph_lo = 0; a.ph_hi = N_PHASES;
    hipLaunchKernelGGL(mega_fwd, dim3(grid), dim3(NT), LDS_BYTES, stream, a);
#else
    for (int p = 0; p < N_PHASES; ++p) { a.ph_lo = p; a.ph_hi = p + 1; hipLaunchKernelGGL(mega_fwd, dim3(grid), dim3(NT), LDS_BYTES, stream, a); }
#endif
}
```

```cpp
#define MK_ONE_LAUNCH 1
#pragma clang diagnostic ignored "-Wint-to-pointer-cast"
#include <hip/hip_runtime.h>
#include <cstdio>
#include <cstdint>

#define DI __device__ __forceinline__
#define LAS __attribute__((address_space(3)))
#define GAS __attribute__((address_space(1)))
typedef unsigned short bf16;
typedef short bf16x8 __attribute__((ext_vector_type(8)));
typedef short s16x4 __attribute__((ext_vector_type(4)));
typedef float f32x4 __attribute__((ext_vector_type(4)));
typedef float f32x2 __attribute__((ext_vector_type(2)));
typedef float f32x16 __attribute__((ext_vector_type(16)));
typedef unsigned u32x4 __attribute__((ext_vector_type(4)));
typedef unsigned u32x2 __attribute__((ext_vector_type(2)));
typedef __bf16 bf16x2_t __attribute__((ext_vector_type(2)));

DI unsigned pk2(float lo, float hi) { f32x2 v = {lo, hi}; bf16x2_t b = __builtin_convertvector(v, bf16x2_t); return __builtin_bit_cast(unsigned, b); }
DI float bflo(unsigned w) { return __uint_as_float(w << 16); }
DI float bfhi(unsigned w) { return __uint_as_float(w & 0xffff0000u); }
DI float bf2f(bf16 v) { return __uint_as_float(((unsigned)v) << 16); }
DI float wave_sum(float v) {
#pragma unroll
    for (int o = 1; o < 64; o <<= 1) v += __shfl_xor(v, o);
    return v;
}
DI float fast_exp2(float x) { return __builtin_amdgcn_exp2f(x); }
DI float fast_exp(float x) { return __builtin_amdgcn_exp2f(x * 1.4426950408889634f); }
DI float fast_rcp(float x) { return __builtin_amdgcn_rcpf(x); }
DI float sigmoid_f(float x) { return fast_rcp(1.0f + fast_exp(-x)); }
#define MFMA32(a, b, c) __builtin_amdgcn_mfma_f32_32x32x16_bf16((a), (b), (c), 0, 0, 0)
DI int crow(int r, int hi) { return (r & 3) + 8 * (r >> 2) + 4 * hi; }
DI bf16x8 pack8(float a0, float a1, float a2, float a3, float a4, float a5, float a6, float a7) {
    u32x4 p; p.x = pk2(a0, a1); p.y = pk2(a2, a3); p.z = pk2(a4, a5); p.w = pk2(a6, a7); return __builtin_bit_cast(bf16x8, p);
}
DI bf16x8 pack_step(const f32x16& x, int s) { return pack8(x[8 * s], x[8 * s + 1], x[8 * s + 2], x[8 * s + 3], x[8 * s + 4], x[8 * s + 5], x[8 * s + 6], x[8 * s + 7]); }
typedef short v4i16_t __attribute__((ext_vector_type(4)));
DI s16x4 vtr(unsigned lds_byte_addr) { return __builtin_bit_cast(s16x4, __builtin_amdgcn_ds_read_tr16_b64_v4i16((LAS v4i16_t*)lds_byte_addr)); }
DI bf16x8 cat4(s16x4 lo, s16x4 hi) { return __builtin_shufflevector(lo, hi, 0, 1, 2, 3, 4, 5, 6, 7); }
DI bf16x8 lds_b128(unsigned lds_byte_addr) { return *(const LAS bf16x8*)lds_byte_addr; }

namespace pg8 {
#define PG8_LAS __attribute__((address_space(3)))
typedef unsigned short bf16_t;
constexpr int BM = 256, BK = 64, HALF = 128, HTB = HALF * BK * 2  , STAGE_BYTES = 8 * HTB, NXCD = 8, WGM = 8;

__host__ __device__ __forceinline__ int lds_byte(int r, int c) { const int st = (r >> 4) * 2 + (c >> 5), rr = r & 15, cc = c & 31, ob = rr * 64 + cc * 2; return st * 1024 + (ob ^ (((ob >> 9) & 1) << 5)); }
__host__ __device__ __forceinline__ void stage_rc(int b, int& R, int& C) { const int st = b / 1024, sb = b % 1024, swz = sb ^ (((sb >> 9) & 1) << 5); R = (st >> 1) * 16 + swz / 64; C = (st & 1) * 32 + (swz % 64) / 2; }
__host__ __device__ __forceinline__ int perm32(int rho) { const int n = rho >> 4, i = rho & 15; return 8 * (i >> 2) + 4 * n + (i & 3); }

struct Unit { int pm, pn, g; };
struct GDesc { const bf16_t* A; const bf16_t* Bt; int lda, ldb, K, nM, nN; };

__device__ __forceinline__ void tile_of(int l, int nM, int nN, int& pm, int& pn) {
    const int nwg = nM * nN; int wgid = l;
    { const int q = nwg / NXCD, r = nwg % NXCD, xcd = wgid % NXCD, off = wgid / NXCD; wgid = (xcd < r ? xcd * (q + 1) : r * (q + 1) + (xcd - r) * q) + off; }
    const int nig = WGM * nN, gid = wgid / nig, fm = gid * WGM, gsz = (nM - fm) < WGM ? (nM - fm) : WGM;
    pm = fm + ((wgid % nig) % gsz); pn = (wgid % nig) / gsz;
}
struct Order1 {
    GDesc d0; int G, c;
    __device__ __forceinline__ void init(const GDesc& a, int G_, int c_) { d0 = a; G = G_; c = c_; }
    __device__ __forceinline__ GDesc desc(int) const { return d0; }
    __device__ __forceinline__ bool next(int i, Unit& u) const {
        const long L = (long)i * G + c; if (L >= (long)(d0.nM * d0.nN)) return false;
        tile_of((int)L, d0.nM, d0.nN, u.pm, u.pn); u.g = 0; return true;
    }
};
struct Order2 {
    GDesc d0, d1; int G, c;
    __device__ __forceinline__ GDesc desc(int g) const { GDesc r; r.A = g == 0 ? d0.A : d1.A; r.Bt = g == 0 ? d0.Bt : d1.Bt; r.lda = d0.lda; r.ldb = d0.ldb; r.K = d0.K; r.nM = g == 0 ? d0.nM : d1.nM; r.nN = g == 0 ? d0.nN : d1.nN; return r; }
    __device__ __forceinline__ bool next(int i, Unit& u) const {
        const int n0 = d0.nM * d0.nN, n1 = d1.nM * d1.nN;
        const long L = (long)i * G + c; if (L >= (long)(n0 + n1)) return false;
        int l = (int)L, g = 0; if (l >= n0) { l -= n0; g = 1; }
        tile_of(l, g == 0 ? d0.nM : d1.nM, g == 0 ? d0.nN : d1.nN, u.pm, u.pn); u.g = g; return true;
    }
};
struct PairOrder {
    GDesc d0, d1; int G, c;
    __device__ __forceinline__ GDesc desc(int g) const { GDesc r; r.A = g == 0 ? d0.A : d1.A; r.Bt = g == 0 ? d0.Bt : d1.Bt; r.lda = g == 0 ? d0.lda : d1.lda; r.ldb = g == 0 ? d0.ldb : d1.ldb; r.K = g == 0 ? d0.K : d1.K; r.nM = d0.nM; r.nN = d0.nN; return r; }
    __device__ __forceinline__ bool next(int i, Unit& u) const {
        const long L = (long)(i >> 1) * G + c; if (L >= (long)(d0.nM * d0.nN)) return false;
        tile_of((int)L, d0.nM, d0.nN, u.pm, u.pn); u.g = i & 1; return true;
    }
};

template <bool UNIFORM  , class Epi, class Sched>
__device__ __forceinline__ void gemm_phase(PG8_LAS unsigned char* lds, const Sched& S, const Epi& E) {
    const int tid = threadIdx.x, wid = __builtin_amdgcn_readfirstlane(tid >> 6), lane = tid & 63, wr = wid >> 2, wc = wid & 3, fr = lane & 15, fq = lane >> 4;
    auto voff = [tid](int i, int ld, bool perm) -> unsigned { int R, C; stage_rc(tid * 16 + i * 8192, R, C); if (perm) R = (R & ~31) + perm32(R & 31); return (unsigned)(R * ld + C) * 2u; };
    const size_t kstep = (size_t)(BK * 2);
    const unsigned ldsw = (unsigned)wid * 1024u;
    const int aoff = lds_byte(wr * 64 + fr, fq * 8), boff = lds_byte(wc * 32 + fr, fq * 8);
#define PG8_SA(b, h) (((b) * 2 + (h)) * HTB)
#define PG8_SB(b, h) ((4 + (b) * 2 + (h)) * HTB)
#define PG8_STAGE(bufoff, gbase, v0, v1) do { \
        __builtin_amdgcn_global_load_lds((const unsigned*)((const char*)(gbase) + (v0)), (PG8_LAS unsigned*)(lds + (bufoff) + ldsw), 16, 0, 0); \
        __builtin_amdgcn_global_load_lds((const unsigned*)((const char*)(gbase) + (v1)), (PG8_LAS unsigned*)(lds + (bufoff) + ldsw + 8192), 16, 0, 0); } while (0)
#define PG8_LDA(dst, b, h) do { _Pragma("unroll") for (int m = 0; m < 4; ++m) _Pragma("unroll") for (int k = 0; k < 2; ++k) dst[m][k] = *(const PG8_LAS bf16x8*)(lds + PG8_SA(b, h) + aoff + m * 2048 + k * 1024); } while (0)
#define PG8_LDB(dst, b, h) do { _Pragma("unroll") for (int n = 0; n < 2; ++n) _Pragma("unroll") for (int k = 0; k < 2; ++k) dst[n][k] = *(const PG8_LAS bf16x8*)(lds + PG8_SB(b, h) + boff + n * 2048 + k * 1024); } while (0)
#define PG8_MMA(ai, bj, At, Bt) do { __builtin_amdgcn_s_setprio(1); _Pragma("unroll") for (int m = 0; m < 4; ++m) _Pragma("unroll") for (int n = 0; n < 2; ++n) _Pragma("unroll") for (int k = 0; k < 2; ++k) \
        acc[ai][bj][m][n] = __builtin_amdgcn_mfma_f32_16x16x32_bf16(Bt[n][k], At[m][k], acc[ai][bj][m][n], 0, 0, 0); __builtin_amdgcn_s_setprio(0); } while (0)
#define PG8_WAIT_V(n) asm volatile("s_waitcnt vmcnt(" #n ")" ::: "memory")
#define PG8_WAIT_L(n) asm volatile("s_waitcnt lgkmcnt(" #n ")" ::: "memory")
#define PG8_BAR __builtin_amdgcn_s_barrier()
#define PG8_SCHED __builtin_amdgcn_sched_barrier(0)
    Unit cur, nxt; int ui = 0;
    if (!S.next(0, cur)) return;
    GDesc dc = S.desc(cur.g);
    f32x4 acc[2][2][4][2];
#pragma unroll
    for (int a = 0; a < 2; ++a)
#pragma unroll
        for (int b = 0; b < 2; ++b)
#pragma unroll
            for (int m = 0; m < 4; ++m)
#pragma unroll
                for (int n = 0; n < 2; ++n) acc[a][b][m][n] = (f32x4){0.f, 0.f, 0.f, 0.f};
    bf16x8 At[4][2], B0[2][2], B1[2][2];
    unsigned vA0 = voff(0, dc.lda, false), vA1 = voff(1, dc.lda, false), vB0 = voff(0, dc.ldb, true), vB1 = voff(1, dc.ldb, true);
    size_t hA = (size_t)HALF * dc.lda * 2, hB = (size_t)HALF * dc.ldb * 2;
    const char* cA = (const char*)dc.A + (size_t)cur.pm * 2 * hA; const char* cB = (const char*)dc.Bt + (size_t)cur.pn * 2 * hB;
    PG8_STAGE(PG8_SB(0, 0), cB, vB0, vB1); PG8_STAGE(PG8_SB(0, 1), cB + hB, vB0, vB1); PG8_STAGE(PG8_SA(0, 0), cA, vA0, vA1); PG8_STAGE(PG8_SA(0, 1), cA + hA, vA0, vA1);
    if (wr == 1) PG8_BAR;
    PG8_WAIT_V(2); PG8_BAR;
    PG8_STAGE(PG8_SB(1, 0), cB + kstep, vB0, vB1); PG8_STAGE(PG8_SA(1, 0), cA + kstep, vA0, vA1); PG8_STAGE(PG8_SB(1, 1), cB + hB + kstep, vB0, vB1);
    PG8_WAIT_V(6); PG8_BAR;
    for (;;) {
        const bool has_next = S.next(ui + 1, nxt);
        GDesc dn = dc; if (has_next) dn = S.desc(nxt.g);
        unsigned nvA0 = vA0, nvA1 = vA1, nvB0 = vB0, nvB1 = vB1; size_t nhA = hA, nhB = hB;
        if constexpr (!UNIFORM) { if (has_next) { nvA0 = voff(0, dn.lda, false); nvA1 = voff(1, dn.lda, false); nvB0 = voff(0, dn.ldb, true); nvB1 = voff(1, dn.ldb, true); nhA = (size_t)HALF * dn.lda * 2; nhB = (size_t)HALF * dn.ldb * 2; } }
        const char* nA = has_next ? (const char*)dn.A + (size_t)nxt.pm * 2 * nhA : cA; const char* nB = has_next ? (const char*)dn.Bt + (size_t)nxt.pn * 2 * nhB : cB;
        const int nt = dc.K / BK;
        for (int t = 0; t < nt; t += 2) {
            const bool last = (t == nt - 2);
            const char* a1 = cA + (size_t)(t + 1) * kstep;
            const char* a2 = last ? nA : cA + (size_t)(t + 2) * kstep; const char* b2 = last ? nB : cB + (size_t)(t + 2) * kstep;
            const char* a3 = a2 + kstep; const char* b3 = b2 + kstep;
            unsigned xA0 = vA0, xA1 = vA1, xB0 = vB0, xB1 = vB1; size_t xhA = hA, xhB = hB;
            if constexpr (!UNIFORM) { if (last) { xA0 = nvA0; xA1 = nvA1; xB0 = nvB0; xB1 = nvB1; xhA = nhA; xhB = nhB; } }
            PG8_LDB(B0, 0, 0); PG8_LDB(B1, 0, 1); PG8_SCHED; PG8_LDA(At, 0, 0); PG8_STAGE(PG8_SA(1, 1), a1 + hA, vA0, vA1);
            PG8_WAIT_V(8); PG8_WAIT_L(0); PG8_BAR; PG8_MMA(0, 0, At, B0); PG8_MMA(0, 1, At, B1); PG8_BAR; PG8_SCHED;
            PG8_LDA(At, 0, 1); PG8_STAGE(PG8_SB(0, 0), b2, xB0, xB1); PG8_STAGE(PG8_SB(0, 1), b2 + xhB, xB0, xB1); PG8_STAGE(PG8_SA(0, 0), a2, xA0, xA1);
            PG8_WAIT_V(8); PG8_WAIT_L(0); PG8_BAR; PG8_MMA(1, 0, At, B0); PG8_MMA(1, 1, At, B1); PG8_BAR; PG8_SCHED;
            PG8_LDB(B0, 1, 0); PG8_LDB(B1, 1, 1); PG8_SCHED; PG8_LDA(At, 1, 0); PG8_STAGE(PG8_SA(0, 1), a2 + xhA, xA0, xA1);
            PG8_WAIT_V(8); PG8_WAIT_L(0); PG8_BAR; PG8_MMA(0, 0, At, B0); PG8_MMA(0, 1, At, B1); PG8_BAR; PG8_SCHED;
            PG8_LDA(At, 1, 1); PG8_STAGE(PG8_SB(1, 0), b3, xB0, xB1); PG8_STAGE(PG8_SB(1, 1), b3 + xhB, xB0, xB1); PG8_STAGE(PG8_SA(1, 0), a3, xA0, xA1);
            PG8_WAIT_V(8); PG8_WAIT_L(0); PG8_BAR; PG8_MMA(1, 0, At, B0); PG8_MMA(1, 1, At, B1); PG8_BAR; PG8_SCHED;
        }
        if (wr == 0) PG8_BAR;
        const bool keep = E(acc, cur, wr, wc, fr, fq);
        if (!has_next) break;
        if (!keep) {
#pragma unroll
            for (int a = 0; a < 2; ++a)
#pragma unroll
                for (int b = 0; b < 2; ++b)
#pragma unroll
                    for (int m = 0; m < 4; ++m)
#pragma unroll
                        for (int n = 0; n < 2; ++n) acc[a][b][m][n] = (f32x4){0.f, 0.f, 0.f, 0.f};
        }
        cur = nxt; dc = dn; cA = nA; cB = nB; vA0 = nvA0; vA1 = nvA1; vB0 = nvB0; vB1 = nvB1; hA = nhA; hB = nhB; ++ui;
        if (wr == 1) PG8_BAR;
    }
    PG8_WAIT_V(0);
    PG8_BAR;
#undef PG8_SA
#undef PG8_SB
#undef PG8_STAGE
#undef PG8_LDA
#undef PG8_LDB
#undef PG8_MMA
#undef PG8_WAIT_V
#undef PG8_WAIT_L
#undef PG8_BAR
#undef PG8_SCHED
}
}

constexpr int NWAVES = 8, NT = 512;
constexpr int BATCH = 2, T = 8192, D = 1024, M = BATCH * T, FF = 2816, MEML = 256;
constexpr float EPS = 1e-6f;
constexpr float LOG2E = 1.4426950408889634f;
constexpr int NIN = 5376;
constexpr size_t KiB = 1024, MiB = 1u << 20;
constexpr size_t WS_CTL = 0, CTL_ZERO_BYTES = 1 * MiB;
constexpr size_t WS_XN = 1 * MiB;
constexpr size_t WS_HID = 33 * MiB;
constexpr size_t WS_Y = 121 * MiB;
constexpr size_t WS_QKG = 33 * MiB, WS_GV = 65 * MiB, WS_GR = 97 * MiB, WS_DQKV = 129 * MiB, WS_IQ = 177 * MiB, WS_SM = 193 * MiB, WS_GST = 197 * MiB;
constexpr size_t WS_W1A = 153 * MiB, WS_W1B = 164 * MiB;
constexpr size_t WS_WIN = 229 * MiB, WS_WGT = 229 * MiB + 10752 * KiB, WS_WG = WS_WGT + 4 * MiB, WS_WD = WS_WG + 2 * MiB, WS_WO = WS_WD + 1 * MiB,
                 WS_WCQ = WS_WO + 2 * MiB, WS_WCKV = WS_WCQ + 1 * MiB, WS_WCO = WS_WCKV + 2 * MiB, WS_MEMN = WS_WCO + 1 * MiB, WS_KVM = WS_MEMN + 1 * MiB, WS_DEC = WS_KVM + 1 * MiB;
constexpr size_t WS_SGA = WS_QKG, WS_SGB = WS_GV, WS_MRG = WS_GST, WS_Y2 = WS_QKG;
constexpr size_t WS_QC = 65 * MiB, WS_OX = 81 * MiB, WS_Y3 = 97 * MiB;
constexpr size_t WS_END = 256 * MiB;
static_assert(WS_DEC + 128 * KiB <= WS_END && WS_W1B + (size_t)D * FF * 2 <= WS_IQ && WS_HID + (size_t)M * FF * 2 <= WS_Y, "d_ws map");
constexpr int CW_BAR = 4096;
constexpr int LDS_BYTES = 147456;
constexpr int MISC_OFF = LDS_BYTES - 256;

#define XB_TMO      128
#define XB_XCNT(j)  (256  + 64 * (j))
#define XB_XSUB(j)  (1280 + 64 * (j))
#define XB_XGEN(j)  (2304 + 64 * (j))
#define XB_TOP      3328
#define XB_TOPGEN   3392
#define XCD_BAR_WORDS 3456
#define XB_SPIN_CAP (1u << 18)

__device__ __forceinline__ unsigned xb_ld(unsigned* p)              { return __hip_atomic_load(p, __ATOMIC_RELAXED, __HIP_MEMORY_SCOPE_AGENT); }
__device__ __forceinline__ unsigned xb_add(unsigned* p, unsigned v) { return __hip_atomic_fetch_add(p, v, __ATOMIC_RELAXED, __HIP_MEMORY_SCOPE_AGENT); }
__device__ __forceinline__ unsigned xb_xcc_id() { return (unsigned)__builtin_amdgcn_s_getreg((3 << 11) | 20) & 0xFu; }
#define XB_SPIN(cond, bar) do { unsigned _sp = 0; while (cond) { __builtin_amdgcn_s_sleep(1); \
    if ((++_sp & 255u) == 0u) { if (xb_ld(&(bar)[XB_TMO])) break; if (_sp > XB_SPIN_CAP) { atomicAdd(&(bar)[XB_TMO], 1u); break; } } } } while (0)

struct XcdBarrier {
    unsigned* bar; unsigned x;
    volatile LAS unsigned* st;
};

__device__ __forceinline__ XcdBarrier xcd_barrier_post(unsigned* bar, volatile LAS unsigned* st) {
    XcdBarrier b; b.bar = bar; b.x = xb_xcc_id(); b.st = st;
    if (threadIdx.x == 0) (void)xb_add(&bar[XB_XCNT(b.x)], 1u);
    return b;
}
__device__ __forceinline__ void xcd_barrier_complete(unsigned* bar, unsigned x, unsigned& nloc, unsigned& nx) {
    const unsigned G = gridDim.x * gridDim.y * gridDim.z;
    unsigned sum, cnt, mine, sp = 0u;
    for (;;) {
        sum = 0u; cnt = 0u; mine = 0u;
#pragma unroll
        for (unsigned j = 0; j < 16; ++j) { const unsigned c = xb_ld(&bar[XB_XCNT(j)]); sum += c; cnt += (c > 0u) ? 1u : 0u; mine = (j == x) ? c : mine; }
        if (sum == G) break;
        __builtin_amdgcn_s_sleep(1);
        if ((++sp & 255u) == 0u) { if (xb_ld(&bar[XB_TMO])) break; if (sp > XB_SPIN_CAP) { atomicAdd(&bar[XB_TMO], 1u); break; } }
    }
    nloc = mine > 0u ? mine : 1u; nx = cnt > 0u ? cnt : 1u;
}

__device__ __forceinline__ void xcd_barrier(const XcdBarrier& b) {
    asm volatile("s_waitcnt vmcnt(0)" ::: "memory");
    __syncthreads();
    if (threadIdx.x == 0) {
        unsigned* bar = b.bar;
        __builtin_amdgcn_s_waitcnt(0);
        unsigned nloc = b.st[0], nx = b.st[1];
        if (nloc == 0u) { xcd_barrier_complete(bar, b.x, nloc, nx); b.st[0] = nloc; b.st[1] = nx; }
        const unsigned old = xb_add(&bar[XB_XSUB(b.x)], 1u);
        const unsigned gen = old / nloc;
        if (old + 1u == (gen + 1u) * nloc) {
            __builtin_amdgcn_fence(__ATOMIC_RELEASE, "agent");
            asm volatile("s_waitcnt vmcnt(0)" ::: "memory");
            const unsigned og = xb_add(&bar[XB_TOP], 1u);
            const unsigned tg = og / nx;
            if (og + 1u == (tg + 1u) * nx) xb_add(&bar[XB_TOPGEN], 1u);
            else XB_SPIN(xb_ld(&bar[XB_TOPGEN]) == tg, bar);
            __builtin_amdgcn_fence(__ATOMIC_ACQUIRE, "agent");
            xb_add(&bar[XB_XGEN(b.x)], 1u);
            asm volatile("s_waitcnt vmcnt(0)" ::: "memory");
        } else {
            XB_SPIN(xb_ld(&bar[XB_XGEN(b.x)]) == gen, bar);
            __builtin_amdgcn_fence(__ATOMIC_ACQUIRE, "agent");
            asm volatile("s_waitcnt vmcnt(0)" ::: "memory");
        }
    }
    __syncthreads();
}

struct Args { const float* in[26]; float* out; unsigned char* ws; int ph_lo, ph_hi; };
struct Frame {
    LAS unsigned char* lds;
    unsigned char* ws;
    int tid, lane, wave, G, c;
};
#define LDS_WAIT() asm volatile("s_waitcnt lgkmcnt(0)" ::: "memory")
#define VM_WAIT() asm volatile("s_waitcnt vmcnt(0)" ::: "memory")

template <class ColFn>
DI void conv_item(const float* W, int ldw, int k0, bf16* WT, int ldt, int dr0, int dk0, ColFn srccol, LAS float* scr, int lane) {
    const int n4 = (lane & 7) * 4; const int sc = srccol(dr0 + n4);
#pragma unroll
    for (int i = 0; i < 8; ++i) { const int kk = 8 * i + (lane >> 3);
        const f32x4 v = sc >= 0 ? *(const f32x4*)(W + (size_t)(k0 + kk) * ldw + sc) : (f32x4){0.f, 0.f, 0.f, 0.f};
        LAS float* s = scr + kk * 33 + n4; s[0] = v.x; s[1] = v.y; s[2] = v.z; s[3] = v.w; }
    LDS_WAIT(); asm volatile("" ::: "memory");
    const int c = lane & 7;
#pragma unroll
    for (int j = 0; j < 4; ++j) { const int n = (lane >> 3) + 8 * j; const LAS float* s = scr + (8 * c) * 33 + n;
        u32x4 o; o.x = pk2(s[0 * 33], s[1 * 33]); o.y = pk2(s[2 * 33], s[3 * 33]); o.z = pk2(s[4 * 33], s[5 * 33]); o.w = pk2(s[6 * 33], s[7 * 33]);
        *(u32x4*)(WT + (size_t)(dr0 + n) * ldt + dk0 + k0 + 8 * c) = o; }
    LDS_WAIT(); asm volatile("" ::: "memory");
}
struct ColIdent { int c0; DI int operator()(int r) const { return c0 + r; } };
struct ColFfn { DI int operator()(int r) const { const int tile = r >> 8, j = r & 255; return j < 128 ? tile * 128 + j : FF + tile * 128 + (j - 128); } };
struct ColInproj { DI int operator()(int r) const { return r < 3072 ? r : (r < 5192 ? r + 16 : (r < 5208 ? 3072 + (r - 5192) : -1)); } };
template <class ColFn>
DI bool conv_job(int& it, const float* W, int ldw, int K, int nb, bf16* WT, int ldt, ColFn f, LAS float* scr, int lane) {
    const int n_items = (K / 64) * nb;
    if (it >= n_items) { it -= n_items; return false; }
    const int kb = it / nb, b = it % nb;
    conv_item(W, ldw, 64 * kb, WT, ldt, 32 * b, 0, f, scr, lane);
    return true;
}
template <int NR>
DI void rms_rows_bf16(const float* xrow, const float* g, bf16* orow, int lane, size_t rstride) {
    f32x4 v[NR][4]; float s[NR];
#pragma unroll
    for (int q = 0; q < NR; ++q) { const f32x4* xr = (const f32x4*)(xrow + q * rstride) + lane; float a = 0.f;
#pragma unroll
        for (int j = 0; j < 4; ++j) { v[q][j] = xr[64 * j]; a += (v[q][j].x * v[q][j].x + v[q][j].y * v[q][j].y) + (v[q][j].z * v[q][j].z + v[q][j].w * v[q][j].w); }
        s[q] = a; }
    const f32x4* gr = (const f32x4*)g + lane; f32x4 gg[4];
#pragma unroll
    for (int j = 0; j < 4; ++j) gg[j] = gr[64 * j];
#pragma unroll
    for (int o = 1; o < 64; o <<= 1)
#pragma unroll
        for (int q = 0; q < NR; ++q) s[q] += __shfl_xor(s[q], o);
#pragma unroll
    for (int q = 0; q < NR; ++q) { const float r = __builtin_amdgcn_rsqf(s[q] * (1.f / D) + EPS); u32x2* o8 = (u32x2*)(orow + q * rstride) + lane;
#pragma unroll
        for (int j = 0; j < 4; ++j) { u32x2 w; w.x = pk2(v[q][j].x * r * gg[j].x, v[q][j].y * r * gg[j].y); w.y = pk2(v[q][j].z * r * gg[j].z, v[q][j].w * r * gg[j].w); o8[64 * j] = w; } }
}
template <int NR>
DI void resnorm_rows(const float* hin, const bf16* yrow, const float* gpost, float coef, float* hout, const float* gpre, bf16* xn, int lane, bool do_store, size_t rstride) {
    f32x4 y[NR][4], h[NR][4]; float s[NR], s2[NR];
#pragma unroll
    for (int q = 0; q < NR; ++q) { const u32x2* yr = (const u32x2*)(yrow + q * rstride) + lane; const f32x4* hr = (const f32x4*)(hin + q * rstride) + lane;
#pragma unroll
        for (int j = 0; j < 4; ++j) { const u32x2 w = yr[64 * j]; y[q][j] = (f32x4){bflo(w.x), bfhi(w.x), bflo(w.y), bfhi(w.y)}; h[q][j] = hr[64 * j]; } }
    const f32x4* gp = (const f32x4*)gpost + lane; f32x4 g[4];
#pragma unroll
    for (int j = 0; j < 4; ++j) g[j] = gp[64 * j];
#pragma unroll
    for (int q = 0; q < NR; ++q) { float a = 0.f;
#pragma unroll
        for (int j = 0; j < 4; ++j) a += (y[q][j].x * y[q][j].x + y[q][j].y * y[q][j].y) + (y[q][j].z * y[q][j].z + y[q][j].w * y[q][j].w);
        s[q] = a; }
#pragma unroll
    for (int o = 1; o < 64; o <<= 1)
#pragma unroll
        for (int q = 0; q < NR; ++q) s[q] += __shfl_xor(s[q], o);
#pragma unroll
    for (int q = 0; q < NR; ++q) { const float r = __builtin_amdgcn_rsqf(s[q] * (1.f / D) + EPS) * coef; float a = 0.f;
#pragma unroll
        for (int j = 0; j < 4; ++j) { h[q][j] = h[q][j] + y[q][j] * r * g[j]; a += (h[q][j].x * h[q][j].x + h[q][j].y * h[q][j].y) + (h[q][j].z * h[q][j].z + h[q][j].w * h[q][j].w); }
        s2[q] = a;
        if (do_store) { f32x4* ho = (f32x4*)(hout + q * rstride) + lane;
#pragma unroll
            for (int j = 0; j < 4; ++j) ho[64 * j] = h[q][j]; } }
    if (xn) {
        const f32x4* gq = (const f32x4*)gpre + lane;
#pragma unroll
        for (int j = 0; j < 4; ++j) g[j] = gq[64 * j];
#pragma unroll
        for (int o = 1; o < 64; o <<= 1)
#pragma unroll
            for (int q = 0; q < NR; ++q) s2[q] += __shfl_xor(s2[q], o);
#pragma unroll
        for (int q = 0; q < NR; ++q) { const float r2 = __builtin_amdgcn_rsqf(s2[q] * (1.f / D) + EPS); u32x2* o8 = (u32x2*)(xn + q * rstride) + lane;
#pragma unroll
            for (int j = 0; j < 4; ++j) { u32x2 w; w.x = pk2(h[q][j].x * r2 * g[j].x, h[q][j].y * r2 * g[j].y); w.y = pk2(h[q][j].z * r2 * g[j].z, h[q][j].w * r2 * g[j].w); o8[64 * j] = w; } }
    }
}
DI void resnorm_phase(Frame& F, const float* hin, const bf16* y, const float* gpost, float coef, float* hout, const float* gpre, bf16* xn, bool do_store = true) {
    const int gw = F.c * NWAVES + F.wave, NGW = F.G * NWAVES;
    int m = gw;
    for (; m + NGW < M; m += 2 * NGW) resnorm_rows<2>(hin + (size_t)m * D, y + (size_t)m * D, gpost, coef, hout + (size_t)m * D, gpre, xn ? xn + (size_t)m * D : nullptr, F.lane, do_store, (size_t)NGW * D);
    for (; m < M; m += NGW) resnorm_rows<1>(hin + (size_t)m * D, y + (size_t)m * D, gpost, coef, hout + (size_t)m * D, gpre, xn ? xn + (size_t)m * D : nullptr, F.lane, do_store, 0);
}

using pg8::Unit;
typedef f32x4 Acc[2][2][4][2];
struct EpiStore {
    bf16* O; int ldo;
    DI bool operator()(Acc& acc, const Unit& u, int wr, int wc, int fr, int fq) const {
        const int row0 = u.pm * 256 + wr * 64 + fr, col0 = u.pn * 256 + wc * 32 + 8 * fq;
#pragma unroll
        for (int ai = 0; ai < 2; ++ai)
#pragma unroll
            for (int m = 0; m < 4; ++m) { bf16* rowp = O + (size_t)(row0 + ai * 128 + m * 16) * ldo + col0;
#pragma unroll
                for (int bj = 0; bj < 2; ++bj) { const f32x4 v0 = acc[ai][bj][m][0], v1 = acc[ai][bj][m][1];
                    u32x4 w; w.x = pk2(v0[0], v0[1]); w.y = pk2(v0[2], v0[3]); w.z = pk2(v1[0], v1[1]); w.w = pk2(v1[2], v1[3]);
                    *(u32x4*)(rowp + bj * 128) = w; } }
        return false;
    }
};
struct EpiGates {
    bf16* SGA; bf16* SGB;
    DI bool operator()(Acc& acc, const Unit& u, int wr, int wc, int fr, int fq) const {
        bf16* O = u.pn < 4 ? SGA : SGB;
        const int row0 = u.pm * 256 + wr * 64 + fr, col0 = (u.pn & 3) * 256 + wc * 32 + 8 * fq;
#pragma unroll
        for (int ai = 0; ai < 2; ++ai)
#pragma unroll
            for (int m = 0; m < 4; ++m) { bf16* rowp = O + (size_t)(row0 + ai * 128 + m * 16) * 1024 + col0;
#pragma unroll
                for (int bj = 0; bj < 2; ++bj) { const f32x4 v0 = acc[ai][bj][m][0], v1 = acc[ai][bj][m][1];
                    u32x4 w; w.x = pk2(sigmoid_f(v0[0]), sigmoid_f(v0[1])); w.y = pk2(sigmoid_f(v0[2]), sigmoid_f(v0[3])); w.z = pk2(sigmoid_f(v1[0]), sigmoid_f(v1[1])); w.w = pk2(sigmoid_f(v1[2]), sigmoid_f(v1[3]));
                    *(u32x4*)(rowp + bj * 128) = w; } }
        return false;
    }
};
struct EpiSwiglu {
    bf16* H;
    DI bool operator()(Acc& acc, const Unit& u, int wr, int wc, int fr, int fq) const {
        const int row0 = u.pm * 256 + wr * 64 + fr, col0 = u.pn * 128 + wc * 32 + 8 * fq;
#pragma unroll
        for (int ai = 0; ai < 2; ++ai)
#pragma unroll
            for (int m = 0; m < 4; ++m) { bf16* rowp = H + (size_t)(row0 + ai * 128 + m * 16) * FF + col0;
                float o[8];
#pragma unroll
                for (int n = 0; n < 2; ++n)
#pragma unroll
                    for (int e = 0; e < 4; ++e) { const float a = acc[ai][0][m][n][e], b = acc[ai][1][m][n][e]; o[4 * n + e] = a * sigmoid_f(a) * b; }
                u32x4 w; w.x = pk2(o[0], o[1]); w.y = pk2(o[2], o[3]); w.z = pk2(o[4], o[5]); w.w = pk2(o[6], o[7]);
                *(u32x4*)rowp = w; }
        return false;
    }
};
struct EpiInproj {
    unsigned char* ws;
    DI bool operator()(Acc& acc, const Unit& u, int wr, int wc, int fr, int fq) const {
        bf16* O; int ldo, ct; bool half_only = false; float sc = 1.f;
        if (u.g == 1) { O = (bf16*)(ws + WS_KVM); ldo = 1024; ct = u.pn; }
        else if (u.pn < 4) { O = (bf16*)(ws + WS_QKG); ldo = 1024; ct = u.pn; }
        else if (u.pn < 8) { O = (bf16*)(ws + WS_GV); ldo = 1024; ct = u.pn - 4; }
        else if (u.pn < 12) { O = (bf16*)(ws + WS_GR); ldo = 1024; ct = u.pn - 8; }
        else if (u.pn < 18) { O = (bf16*)(ws + WS_DQKV); ldo = 1536; ct = u.pn - 12; if (u.pn < 14) sc = 0.125f * LOG2E; }
        else if (u.pn < 20) { O = (bf16*)(ws + WS_IQ); ldo = 512; ct = u.pn - 18; }
        else { O = (bf16*)(ws + WS_SM); ldo = 128; ct = 0; half_only = true; }
        const int row0 = u.pm * 256 + wr * 64 + fr, col0 = ct * 256 + wc * 32 + 8 * fq;
#pragma unroll
        for (int ai = 0; ai < 2; ++ai)
#pragma unroll
            for (int m = 0; m < 4; ++m) { bf16* rowp = O + (size_t)(row0 + ai * 128 + m * 16) * ldo + col0;
#pragma unroll
                for (int bj = 0; bj < 2; ++bj) { const f32x4 v0 = acc[ai][bj][m][0] * sc, v1 = acc[ai][bj][m][1] * sc;
                    u32x4 w; w.x = pk2(v0[0], v0[1]); w.y = pk2(v0[2], v0[3]); w.z = pk2(v1[0], v1[1]); w.w = pk2(v1[2], v1[3]);
                    if (bj == 0 || !half_only) *(u32x4*)(rowp + bj * 128) = w; } }
        return false;
    }
};
struct EpiMerge {
    const bf16* SGA; const bf16* SGB; bf16* O;
    DI bool operator()(Acc& acc, const Unit& u, int wr, int wc, int fr, int fq) const {
        const int row0 = u.pm * 256 + wr * 64 + fr, col0 = u.pn * 256 + wc * 32 + 8 * fq;
#pragma unroll
        for (int ai = 0; ai < 2; ++ai)
#pragma unroll
            for (int m = 0; m < 4; ++m) { const size_t off = (size_t)(row0 + ai * 128 + m * 16) * 1024 + col0;
#pragma unroll
                for (int bj = 0; bj < 2; ++bj) {
                    const u32x4 gb = *(const u32x4*)(SGB + off + bj * 128);
                    const float b[8] = {bflo(gb.x), bfhi(gb.x), bflo(gb.y), bfhi(gb.y), bflo(gb.z), bfhi(gb.z), bflo(gb.w), bfhi(gb.w)};
                    if (u.g == 0) {
                        const u32x4 ga = *(const u32x4*)(SGA + off + bj * 128);
                        const float a[8] = {bflo(ga.x), bfhi(ga.x), bflo(ga.y), bfhi(ga.y), bflo(ga.z), bfhi(ga.z), bflo(ga.w), bfhi(ga.w)};
#pragma unroll
                        for (int n = 0; n < 2; ++n)
#pragma unroll
                            for (int e = 0; e < 4; ++e) acc[ai][bj][m][n][e] *= a[4 * n + e] * fast_rcp(fmaxf(b[4 * n + e], 1e-30f));
                    } else {
                        const f32x4 v0 = acc[ai][bj][m][0], v1 = acc[ai][bj][m][1];
                        u32x4 w; w.x = pk2(v0[0] * b[0], v0[1] * b[1]); w.y = pk2(v0[2] * b[2], v0[3] * b[3]); w.z = pk2(v1[0] * b[4], v1[1] * b[5]); w.w = pk2(v1[2] * b[6], v1[3] * b[7]);
                        *(u32x4*)(O + off + bj * 128) = w;
                    } } }
        return u.g == 0;
    }
};

constexpr int GP = 272;
struct GlaW { float wu0[16], wu1[16], bb0, bb1; };
DI void gla_la(const bf16* SM, size_t row, const GlaW& W, float& l0, float& l1) {
    const u32x4* gp = (const u32x4*)(SM + row * 128 + 72);
    const u32x4 g0 = gp[0], g1 = gp[1];
    const float ga[16] = {bflo(g0.x), bfhi(g0.x), bflo(g0.y), bfhi(g0.y), bflo(g0.z), bfhi(g0.z), bflo(g0.w), bfhi(g0.w), bflo(g1.x), bfhi(g1.x), bflo(g1.y), bfhi(g1.y), bflo(g1.z), bfhi(g1.z), bflo(g1.w), bfhi(g1.w)};
    float x0 = W.bb0, x1 = W.bb1;
#pragma unroll
    for (int r = 0; r < 16; ++r) { x0 = fmaf(ga[r], W.wu0[r], x0); x1 = fmaf(ga[r], W.wu1[r], x1); }
    l0 = (fminf(x0, 0.f) - __logf(1.f + fast_exp(-fabsf(x0)))) * 0.0625f; l1 = (fminf(x1, 0.f) - __logf(1.f + fast_exp(-fabsf(x1)))) * 0.0625f;
}
struct GlaPre { float pre0, pre1, end0, end1; };
DI void gla_totals(Frame& F, const float* const* in, int h, size_t row0, LAS float* tot, GlaW& W, GlaPre& P) {
    const int l = F.lane, w = F.wave;
    const bf16* SM = (const bf16*)(F.ws + WS_SM);
    const float* wup = in[9]; const float* bal = in[10];
#pragma unroll
    for (int r = 0; r < 16; ++r) { W.wu0[r] = wup[r * 512 + h * 128 + l]; W.wu1[r] = wup[r * 512 + h * 128 + 64 + l]; }
    W.bb0 = bal[h * 128 + l]; W.bb1 = bal[h * 128 + 64 + l];
    float run0 = 0.f, run1 = 0.f;
#pragma unroll 2
    for (int tt = 0; tt < 32; ++tt) { float l0, l1; gla_la(SM, row0 + 32 * w + tt, W, l0, l1); run0 += l0; run1 += l1; }
    tot[w * 128 + l] = run0; tot[w * 128 + 64 + l] = run1;
    __syncthreads();
    float p0 = 0.f, p1 = 0.f, e0 = 0.f, e1 = 0.f;
#pragma unroll
    for (int ww = 0; ww < 8; ++ww) { const float a = tot[ww * 128 + l], b = tot[ww * 128 + 64 + l]; e0 += a; e1 += b; if (ww < w) { p0 += a; p1 += b; } }
    P.pre0 = p0; P.pre1 = p1; P.end0 = e0; P.end1 = e1;
}
DI unsigned tr_lane(int pitch, int hmul, int lane) { const int i16 = lane & 15, q = i16 >> 2, p = i16 & 3, blk = (lane >> 4) & 1; return (unsigned)((hmul * (lane >> 5) + q) * pitch + (16 * blk + 4 * p) * 2); }
DI bf16x8 tr_frag(unsigned base_lane, int pitch, int row_lo, int row_hi, int n0) {
    return cat4(vtr(base_lane + (unsigned)(row_lo * pitch + n0 * 2)), vtr(base_lane + (unsigned)(row_hi * pitch + n0 * 2)));
}
DI void gla_load_v_half(Frame& F, unsigned vh, size_t row0, int h, int half) {
    const bf16* GV = (const bf16*)(F.ws + WS_GV);
#pragma unroll
    for (int it = 0; it < 8; ++it) { const int idx = it * NT + F.tid, row = idx >> 4, ch = idx & 15;
        const u32x4 v = *(const u32x4*)(GV + (row0 + row) * 1024 + h * 256 + half * 128 + ch * 8);
        *(LAS u32x4*)(vh + row * GP + ch * 16) = v; }
}
DI void gla_state_unit(Frame& F, const float* const* in, int u) {
    const int l = F.lane, w = F.wave, hh = l >> 5;
    const int bh = u >> 5, b = bh >> 2, h = bh & 3, sc = u & 31; const size_t row0 = (size_t)b * T + sc * 256;
    const unsigned KH = (unsigned)(size_t)F.lds, VH = KH + 256 * GP; LAS float* tot = (LAS float*)(F.lds + 2 * 256 * GP);
    const bf16* QKG = (const bf16*)(F.ws + WS_QKG);
    float* GST = (float*)(F.ws + WS_GST); float* DEC = (float*)(F.ws + WS_DEC);
    GlaW W; GlaPre P; gla_totals(F, in, h, row0, tot, W, P);
    {
        const bf16* SM = (const bf16*)(F.ws + WS_SM);
        float B0 = P.pre0, B1 = P.pre1;
#pragma unroll 2
        for (int tt = 0; tt < 32; ++tt) { const size_t row = row0 + 32 * w + tt;
            float l0, l1; gla_la(SM, row, W, l0, l1); B0 += l0; B1 += l1;
            const float k0 = bf2f(QKG[row * 1024 + 512 + h * 128 + l]), k1 = bf2f(QKG[row * 1024 + 512 + h * 128 + 64 + l]);
            const float f0 = k0 * fast_exp(P.end0 - B0), f1 = k1 * fast_exp(P.end1 - B1);
            *(LAS bf16*)(KH + (32 * w + tt) * GP + l * 2) = (bf16)(pk2(f0, 0.f) & 0xffffu); *(LAS bf16*)(KH + (32 * w + tt) * GP + (64 + l) * 2) = (bf16)(pk2(f1, 0.f) & 0xffffu); }
    }
    if (w == 0) { DEC[u * 128 + l] = fast_exp(P.end0); DEC[u * 128 + 64 + l] = fast_exp(P.end1); }
    const int etile = w >> 1, dt0 = 2 * (w & 1);
    const unsigned vhl = VH + tr_lane(GP, 8, l) + etile * 64, khl = KH + tr_lane(GP, 8, l) + dt0 * 64;
    for (int half = 0; half < 2; ++half) {
        gla_load_v_half(F, VH, row0, h, half);
        __syncthreads();
        f32x16 acc0, acc1;
#pragma unroll
        for (int r = 0; r < 16; ++r) { acc0[r] = 0.f; acc1[r] = 0.f; }
#pragma unroll 4
        for (int s = 0; s < 16; ++s) {
            const bf16x8 a = tr_frag(vhl, GP, 16 * s, 16 * s + 4, 0);
            const bf16x8 b0 = tr_frag(khl, GP, 16 * s, 16 * s + 4, 0), b1 = tr_frag(khl, GP, 16 * s, 16 * s + 4, 32);
            acc0 = MFMA32(a, b0, acc0); acc1 = MFMA32(a, b1, acc1);
        }
#pragma unroll
        for (int r = 0; r < 16; ++r) { const int e = half * 128 + etile * 32 + crow(r, hh); float* o = GST + ((size_t)u * 256 + e) * 128 + dt0 * 32 + (l & 31); o[0] = acc0[r]; o[32] = acc1[r]; }
        __syncthreads();
    }
}
DI void gla_scan_phase(Frame& F, bool do_store = true) {
    float* GST = (float*)(F.ws + WS_GST); const float* DEC = (const float*)(F.ws + WS_DEC);
    for (int idx = F.c * NT + F.tid; idx < 8 * 16384; idx += F.G * NT) {
        const int bh = idx >> 14, rem = idx & 16383, e = rem >> 6, d = (rem & 63) * 2;
        f32x2 st = {0.f, 0.f};
#pragma unroll 4
        for (int sc = 0; sc < 32; ++sc) { const int u = bh * 32 + sc; f32x2* p = (f32x2*)(GST + ((size_t)u * 256 + e) * 128 + d);
            const f32x2 uu = *p; const f32x2 dc = *(const f32x2*)(DEC + u * 128 + d); if (do_store) *p = st; st = dc * st + uu; }
        if (!do_store && st.x == 1.2345e-30f) GST[0] = st.y;
    }
}
DI void gla_out_unit(Frame& F, const float* const* in, int u, bool do_store = true) {
    const int l = F.lane, w = F.wave, hh = l >> 5;
    const int bh = u >> 5, b = bh >> 2, h = bh & 3, sc = u & 31; const size_t row0 = (size_t)b * T + sc * 256;
    const unsigned QS = (unsigned)(size_t)F.lds, KS = QS + 256 * GP; LAS float* tot = (LAS float*)(F.lds + 2 * 256 * GP);
    const bf16* QKG = (const bf16*)(F.ws + WS_QKG); const float* GST = (const float*)(F.ws + WS_GST); bf16* GR = (bf16*)(F.ws + WS_GR);
    {
        GlaW W; GlaPre P; gla_totals(F, in, h, row0, tot, W, P);
        const bf16* SM = (const bf16*)(F.ws + WS_SM);
        const float qs = 0.08838834764831845f;
        float B0 = P.pre0, B1 = P.pre1;
#pragma unroll 2
        for (int tt = 0; tt < 32; ++tt) { const size_t row = row0 + 32 * w + tt;
            float l0, l1; gla_la(SM, row, W, l0, l1); B0 += l0; B1 += l1;
            const float q0 = bf2f(QKG[row * 1024 + h * 128 + l]), q1 = bf2f(QKG[row * 1024 + h * 128 + 64 + l]);
            const float k0 = bf2f(QKG[row * 1024 + 512 + h * 128 + l]), k1 = bf2f(QKG[row * 1024 + 512 + h * 128 + 64 + l]);
            const unsigned a = QS + (32 * w + tt) * GP + l * 2, bb = KS + (32 * w + tt) * GP + l * 2;
            *(LAS bf16*)(a) = (bf16)(pk2(q0 * qs * fast_exp(B0), 0.f) & 0xffffu); *(LAS bf16*)(a + 128) = (bf16)(pk2(q1 * qs * fast_exp(B1), 0.f) & 0xffffu);
            *(LAS bf16*)(bb) = (bf16)(pk2(k0 * fast_exp(-B0), 0.f) & 0xffffu); *(LAS bf16*)(bb + 128) = (bf16)(pk2(k1 * fast_exp(-B1), 0.f) & 0xffffu); }
    }
    __syncthreads();
    bf16x8 qf[8];
#pragma unroll
    for (int s = 0; s < 8; ++s) qf[s] = lds_b128(QS + (32 * w + (l & 31)) * GP + (16 * s + 8 * hh) * 2);
    __syncthreads();
    f32x16 acc[8];
#pragma unroll
    for (int et = 0; et < 8; ++et)
#pragma unroll
        for (int r = 0; r < 16; ++r) acc[et][r] = 0.f;
    const unsigned VH = QS;
#pragma unroll
    for (int half = 0; half < 2; ++half) {
        gla_load_v_half(F, VH, row0, h, half);
        __syncthreads();
        for (int j = 0; j <= w; ++j) {
            f32x16 X;
#pragma unroll
            for (int r = 0; r < 16; ++r) X[r] = 0.f;
            const unsigned ksj = KS + (l & 31) * GP + 16 * hh + 32 * j * GP, vhj = VH + tr_lane(GP, 4, l) + 32 * j * GP;
#pragma unroll
            for (int s = 0; s < 8; ++s) X = MFMA32(lds_b128(ksj + 32 * s), qf[s], X);
            if (j == w) {
#pragma unroll
                for (int r = 0; r < 16; ++r) if (crow(r, hh) > (l & 31)) X[r] = 0.f;
            }
            const bf16x8 xb0 = pack_step(X, 0), xb1 = pack_step(X, 1);
#pragma unroll
            for (int et = 0; et < 4; ++et) {
                const bf16x8 a0 = tr_frag(vhj, GP, 0, 8, et * 32), a1 = tr_frag(vhj, GP, 16, 24, et * 32);
                acc[half * 4 + et] = MFMA32(a0, xb0, acc[half * 4 + et]); acc[half * 4 + et] = MFMA32(a1, xb1, acc[half * 4 + et]);
            }
        }
        __syncthreads();
    }
    {
        const int soff = (l & 31) * 128 + 8 * hh;
#pragma unroll
        for (int et = 0; et < 8; ++et) {
            const float* sp = GST + (size_t)u * 32768 + et * 4096 + soff;
#pragma unroll
            for (int s = 0; s < 8; s += 2) {
                const f32x4 x0 = *(const f32x4*)(sp + 16 * s), x1 = *(const f32x4*)(sp + 16 * s + 4), x2 = *(const f32x4*)(sp + 16 * s + 16), x3 = *(const f32x4*)(sp + 16 * s + 20);
                acc[et] = MFMA32(pack8(x0.x, x0.y, x0.z, x0.w, x1.x, x1.y, x1.z, x1.w), qf[s], acc[et]);
                acc[et] = MFMA32(pack8(x2.x, x2.y, x2.z, x2.w, x3.x, x3.y, x3.z, x3.w), qf[s + 1], acc[et]);
                asm volatile("" ::: "memory");
            }
        }
    }
    float ss = 0.f;
#pragma unroll
    for (int et = 0; et < 8; ++et)
#pragma unroll
        for (int r = 0; r < 16; ++r) ss += acc[et][r] * acc[et][r];
    ss += __shfl_xor(ss, 32);
    const float rinv = __builtin_amdgcn_rsqf(ss * (1.f / 256.f) + EPS);
    const float* gn = in[11] + h * 256 + 4 * hh;
    bf16* orow = GR + (row0 + 32 * w + (l & 31)) * 1024 + h * 256 + 4 * hh;
#pragma unroll
    for (int et = 0; et < 8; ++et)
#pragma unroll
        for (int g = 0; g < 4; ++g) { const int e = et * 32 + 8 * g;
            const u32x2 gw = *(const u32x2*)(orow + e); const f32x4 gg = *(const f32x4*)(gn + e);
            const float r0 = bflo(gw.x), r1 = bfhi(gw.x), r2 = bflo(gw.y), r3 = bfhi(gw.y);
            u32x2 o; o.x = pk2(acc[et][4 * g] * rinv * gg.x * r0 * sigmoid_f(r0), acc[et][4 * g + 1] * rinv * gg.y * r1 * sigmoid_f(r1));
            o.y = pk2(acc[et][4 * g + 2] * rinv * gg.z * r2 * sigmoid_f(r2), acc[et][4 * g + 3] * rinv * gg.w * r3 * sigmoid_f(r3));
            if (do_store) *(u32x2*)(orow + e) = o; if (g == 3) __builtin_amdgcn_sched_barrier(0); }
}

DI void hist_find(LAS unsigned* H, int lane, unsigned k, unsigned& bin, unsigned& above) {
    const u32x4 c = *(const LAS u32x4*)(H + 4 * lane);
    const unsigned s = c.x + c.y + c.z + c.w; unsigned suf = s;
#pragma unroll
    for (int o = 1; o < 64; o <<= 1) { const unsigned v = __shfl_down(suf, o); if (lane + o < 64) suf += v; }
    const unsigned excl = suf - s;
    const bool cross = excl < k && suf >= k;
    unsigned a = excl, bn = 0, ab = 0;
    if (a + c.w >= k) { bn = 4 * lane + 3; ab = a; } else { a += c.w;
        if (a + c.z >= k) { bn = 4 * lane + 2; ab = a; } else { a += c.z;
            if (a + c.y >= k) { bn = 4 * lane + 1; ab = a; } else { a += c.y; bn = 4 * lane; ab = a; } } }
    const unsigned long long m = __ballot(cross);
    const int src = m ? __builtin_ctzll(m) : 0;
    bin = __shfl(bn, src); above = __shfl(ab, src);
}
DI void idx_unit(Frame& F, int u, bool do_store = true) {
    const int l = F.lane, w = F.wave, hh = l >> 5;
    const int b = u >> 10, t0 = (u & 1023) * 8; const size_t row0 = (size_t)b * T + t0;
    const bf16* IQ = (const bf16*)(F.ws + WS_IQ); const bf16* SM = (const bf16*)(F.ws + WS_SM);
    const unsigned SC = (unsigned)(size_t)F.lds; LAS unsigned* HIST = (LAS unsigned*)(F.lds + 131072);
    bf16x8 af[2][4]; float wv[2][16];
    {
        const int rho = l & 31;
#pragma unroll
        for (int tl = 0; tl < 2; ++tl) { const int q = 4 * tl + (rho >> 4) + 2 * ((rho >> 2) & 1), head = (rho & 3) + 4 * ((rho >> 3) & 1);
#pragma unroll
            for (int s = 0; s < 4; ++s) af[tl][s] = *(const bf16x8*)(IQ + (row0 + q) * 512 + head * 64 + 16 * s + 8 * hh);
#pragma unroll
            for (int r = 0; r < 16; ++r) { const int qq = 4 * tl + (r >> 3) + 2 * hh, hd = (r & 3) + 4 * ((r >> 2) & 1); wv[tl][r] = bf2f(SM[(row0 + qq) * 128 + 64 + hd]); } }
    }
#pragma unroll
    for (int i = 0; i < 4; ++i) HIST[F.tid + i * NT] = 0u;
    __syncthreads();
    const int ntile = t0 / 32 + 1;
    const bf16* kbase = SM + ((size_t)b * T + (l & 31)) * 128 + 8 * hh;
    bf16x8 bfr[4], bnx[4];
    if (w < ntile) {
#pragma unroll
        for (int s = 0; s < 4; ++s) bfr[s] = *(const bf16x8*)(kbase + (size_t)(32 * w) * 128 + 16 * s);
    }
    for (int kt = w; kt < ntile; kt += 8) {
        const int key = 32 * kt + (l & 31);
        if (kt + 8 < ntile) {
#pragma unroll
            for (int s = 0; s < 4; ++s) bnx[s] = *(const bf16x8*)(kbase + (size_t)(32 * (kt + 8)) * 128 + 16 * s);
        }
        f32x16 C0, C1;
#pragma unroll
        for (int r = 0; r < 16; ++r) { C0[r] = 0.f; C1[r] = 0.f; }
#pragma unroll
        for (int s = 0; s < 4; ++s) { C0 = MFMA32(af[0][s], bfr[s], C0); C1 = MFMA32(af[1][s], bfr[s], C1); }
#pragma unroll
        for (int tl = 0; tl < 2; ++tl)
#pragma unroll
            for (int b4 = 0; b4 < 2; ++b4) {
                float sc = 0.f;
#pragma unroll
                for (int r = 0; r < 8; ++r) sc = fmaf(wv[tl][8 * b4 + r], fmaxf(tl ? C1[8 * b4 + r] : C0[8 * b4 + r], 0.f), sc);
                const int q = 4 * tl + b4 + 2 * hh;
                sc = fminf(fmaxf(sc, -60000.f), 60000.f);
                const _Float16 hf = (_Float16)sc; unsigned h16 = (unsigned)__builtin_bit_cast(unsigned short, hf);
                unsigned k16 = (h16 & 0x8000u) ? (~h16 & 0xffffu) : (h16 | 0x8000u);
                const bool valid = key <= t0 + q;
                if (!valid) k16 = 0u;
                *(LAS unsigned short*)(SC + q * 16384 + key * 2) = (unsigned short)k16;
                if (valid) __hip_atomic_fetch_add(HIST + q * 256 + (k16 >> 8), 1u, __ATOMIC_RELAXED, __HIP_MEMORY_SCOPE_WORKGROUP);
            }
#pragma unroll
        for (int s = 0; s < 4; ++s) bfr[s] = bnx[s];
    }
    __syncthreads();
    {
        const int t = t0 + w, n = t + 1, nit = (n + 255) >> 8;
        unsigned char* mrow = (unsigned char*)(F.ws + WS_IQ) + (row0 + w) * 1024;
        const unsigned scq = SC + w * 16384 + l * 8;
        LAS unsigned* H = HIST + w * 256;
        unsigned thr = 0u, rneed = 0u;
        if (n > 256) {
            unsigned B, above, L, above2;
            hist_find(H, l, 256u, B, above);
            LDS_WAIT(); H[l] = 0u; H[l + 64] = 0u; H[l + 128] = 0u; H[l + 192] = 0u; LDS_WAIT();
            for (int it = 0; it < nit; ++it) { const u32x2 kk = *(const LAS u32x2*)(scq + it * 512); const int i0 = 256 * it + 4 * l;
                const unsigned k0 = kk.x & 0xffffu, k1 = kk.x >> 16, k2 = kk.y & 0xffffu, k3 = kk.y >> 16;
                const bool m0 = i0 < n && (k0 >> 8) == B, m1 = i0 + 1 < n && (k1 >> 8) == B, m2 = i0 + 2 < n && (k2 >> 8) == B, m3 = i0 + 3 < n && (k3 >> 8) == B;
                if (__ballot(m0 || m1 || m2 || m3) == 0ull) continue;
                if (m0) __hip_atomic_fetch_add(H + (k0 & 255u), 1u, __ATOMIC_RELAXED, __HIP_MEMORY_SCOPE_WORKGROUP);
                if (m1) __hip_atomic_fetch_add(H + (k1 & 255u), 1u, __ATOMIC_RELAXED, __HIP_MEMORY_SCOPE_WORKGROUP);
                if (m2) __hip_atomic_fetch_add(H + (k2 & 255u), 1u, __ATOMIC_RELAXED, __HIP_MEMORY_SCOPE_WORKGROUP);
                if (m3) __hip_atomic_fetch_add(H + (k3 & 255u), 1u, __ATOMIC_RELAXED, __HIP_MEMORY_SCOPE_WORKGROUP); }
            LDS_WAIT(); hist_find(H, l, 256u - above, L, above2);
            thr = (B << 8) | L; rneed = 256u - above - above2;
        }
        unsigned running = 0u;
        for (int it = 0; it < nit; ++it) {
            const u32x2 kk = *(const LAS u32x2*)(scq + it * 512); const int i0 = 256 * it + 4 * l;
            const unsigned ks[4] = {kk.x & 0xffffu, kk.x >> 16, kk.y & 0xffffu, kk.y >> 16};
            unsigned nib = 0u;
            if (n <= 256) {
#pragma unroll
                for (int j = 0; j < 4; ++j) nib |= (i0 + j < n) ? (1u << j) : 0u;
            } else {
                bool eq[4]; bool anyeq = false;
#pragma unroll
                for (int j = 0; j < 4; ++j) { eq[j] = (i0 + j < n) && ks[j] == thr; anyeq = anyeq || eq[j]; nib |= ((i0 + j < n) && ks[j] > thr) ? (1u << j) : 0u; }
                if (__ballot(anyeq) != 0ull) {
                    unsigned long long mk[4];
#pragma unroll
                    for (int j = 0; j < 4; ++j) mk[j] = __ballot(eq[j]);
                    const unsigned long long below = (1ull << l) - 1ull;
                    unsigned cum = running + (unsigned)(__popcll(mk[0] & below) + __popcll(mk[1] & below) + __popcll(mk[2] & below) + __popcll(mk[3] & below));
#pragma unroll
                    for (int j = 0; j < 4; ++j) { if (eq[j]) { if (cum < rneed) nib |= (1u << j); ++cum; } }
                    running += (unsigned)(__popcll(mk[0]) + __popcll(mk[1]) + __popcll(mk[2]) + __popcll(mk[3]));
                }
            }
            const unsigned up = __shfl_down(nib, 1);
            if ((l & 1) == 0 && do_store) mrow[it * 32 + (l >> 1)] = (unsigned char)(nib | (up << 4));
        }
    }
    __syncthreads();
}

template <int DH, bool DSA, int VAR = 0>
DI void attn_unit(Frame& F, const bf16* Qp, int ldq, const bf16* Kp, const bf16* Vp, int ldkv, int nst, bf16* Op, int ldo, float c1,
                  const unsigned* mask0  , int tq0, const LAS float* BT, float cfar, bool do_store = true) {
    constexpr int PK = DH * 2 + 16  , PV = DH == 64 ? 192 : 320  ;
    constexpr int SBK = 64 * PK, SBV = 64 * PV, NS = DH / 16, ND = DH / 32, CH = DH / 8  , NLD = 64 * CH / NT;
    const int l = F.lane, w = F.wave, hh = l >> 5, tid = F.tid;
    const unsigned KT = (unsigned)(size_t)F.lds, VT = KT + 2 * SBK;
    const unsigned klane = (unsigned)((l & 31) * PK + 16 * hh), vlane = tr_lane(PV, 4, l);
    bf16x8 qf[NS];
#pragma unroll
    for (int s = 0; s < NS; ++s) qf[s] = *(const bf16x8*)(Qp + (size_t)(32 * w + (l & 31)) * ldq + 16 * s + 8 * hh);
    f32x16 O[ND];
#pragma unroll
    for (int d = 0; d < ND; ++d)
#pragma unroll
        for (int r = 0; r < 16; ++r) O[d][r] = 0.f;
    float lsum = 0.f;
    const int tq = tq0 + 32 * w + (l & 31), tq_hi = tq0 + 32 * w + 31, tq_lo = tq0 + 32 * w;
    const unsigned* mrow = DSA ? mask0 + (size_t)(32 * w + (l & 31)) * 256 : nullptr;
    u32x4 kr[NLD], vr[NLD];
    u32x2 mcur = {0u, 0u}, mnxt = {0u, 0u};
    if (DSA) mcur = *(const u32x2*)mrow;
#pragma unroll
    for (int i = 0; i < NLD; ++i) { const int idx = i * NT + tid, row = idx / CH, ch = idx % CH;
        kr[i] = *(const u32x4*)(Kp + (size_t)row * ldkv + ch * 8); vr[i] = *(const u32x4*)(Vp + (size_t)row * ldkv + ch * 8); }
#pragma unroll
    for (int i = 0; i < NLD; ++i) { const int idx = i * NT + tid, row = idx / CH, ch = idx % CH;
        *(LAS u32x4*)(KT + row * PK + ch * 16) = kr[i]; *(LAS u32x4*)(VT + row * PV + ch * 16) = vr[i]; }
    __syncthreads();
    for (int st = 0; st < nst; ++st) {
        const unsigned kt = KT + (st & 1) * SBK, vt = VT + (st & 1) * SBV;
        const bool more = st + 1 < nst;
        if (more) {
#pragma unroll
            for (int i = 0; i < NLD; ++i) { const int idx = i * NT + tid, row = 64 * (st + 1) + idx / CH, ch = idx % CH;
                kr[i] = *(const u32x4*)(Kp + (size_t)row * ldkv + ch * 8); vr[i] = *(const u32x4*)(Vp + (size_t)row * ldkv + ch * 8); }
            if (DSA) mnxt = *(const u32x2*)(mrow + 2 * (st + 1));
        }
#pragma unroll
        for (int kb = 0; kb < 2; ++kb) {
            const int key0 = 64 * st + 32 * kb;
            if (VAR == 3) continue;
            if (DSA && key0 > tq_hi) continue;
            f32x16 X;
#pragma unroll
            for (int r = 0; r < 16; ++r) X[r] = 0.f;
#pragma unroll
            for (int s = 0; s < NS; ++s) X = MFMA32(lds_b128(kt + klane + 32 * kb * PK + 32 * s), qf[s], X);
            if (VAR == 2) { lsum += X[0]; }
            else if (DSA) {
                const unsigned mw = (kb ? mcur.y : mcur.x) >> (4 * hh);
                if (tq_lo - (key0 + 31) >= 113) {
#pragma unroll
                    for (int r = 0; r < 16; ++r) { const float p = fast_exp2(fmaf(X[r], c1, cfar)); const int bits = __builtin_amdgcn_sbfe((int)mw, (r & 3) + 8 * (r >> 2), 1);
                        const float pm = __uint_as_float(__float_as_uint(p) & (unsigned)bits); lsum += pm; X[r] = pm; }
                } else {
#pragma unroll
                    for (int r = 0; r < 16; ++r) { int di = tq - (key0 + crow(r, hh)); di = di < 0 ? 0 : (di > 127 ? 127 : di);
                        const float p = fast_exp2(fmaf(X[r], c1, BT[di])); const int bits = __builtin_amdgcn_sbfe((int)mw, (r & 3) + 8 * (r >> 2), 1);
                        const float pm = __uint_as_float(__float_as_uint(p) & (unsigned)bits); lsum += pm; X[r] = pm; }
                }
            } else {
#pragma unroll
                for (int r = 0; r < 16; ++r) { const float p = fast_exp2(X[r] * c1); lsum += p; X[r] = p; }
            }
            const bf16x8 xb0 = pack_step(X, 0), xb1 = pack_step(X, 1);
            if (VAR == 1) { asm volatile("" :: "v"(xb0), "v"(xb1)); }
            else {
#pragma unroll
            for (int d = 0; d < ND; ++d) {
                const bf16x8 a0 = tr_frag(vt + vlane, PV, 32 * kb, 32 * kb + 8, 32 * d), a1 = tr_frag(vt + vlane, PV, 32 * kb + 16, 32 * kb + 24, 32 * d);
                O[d] = MFMA32(a0, xb0, O[d]); O[d] = MFMA32(a1, xb1, O[d]);
            } }
        }
        if (more) {
            const unsigned kn = KT + ((st + 1) & 1) * SBK, vn = VT + ((st + 1) & 1) * SBV;
#pragma unroll
            for (int i = 0; i < NLD; ++i) { const int idx = i * NT + tid, row = idx / CH, ch = idx % CH;
                *(LAS u32x4*)(kn + row * PK + ch * 16) = kr[i]; *(LAS u32x4*)(vn + row * PV + ch * 16) = vr[i]; }
            mcur = mnxt;
        }
        __syncthreads();
    }
    lsum += __shfl_xor(lsum, 32);
    const float inv = fast_rcp(lsum);
    bf16* orow = Op + (size_t)(32 * w + (l & 31)) * ldo;
#pragma unroll
    for (int d = 0; d < ND; ++d)
#pragma unroll
        for (int g = 0; g < 4; ++g) { u32x2 o; o.x = pk2(O[d][4 * g] * inv, O[d][4 * g + 1] * inv); o.y = pk2(O[d][4 * g + 2] * inv, O[d][4 * g + 3] * inv);
            if (do_store) *(u32x2*)(orow + 32 * d + 8 * g + 4 * hh) = o; }
}
DI int t5_bucket(int rel) {
    if (rel < 16) return rel;
    const float v = logf((float)rel * (1.f / 16.f)) / 2.0794415416798357f * 16.f;
    int lg = 16 + (int)v; return lg > 31 ? 31 : lg;
}
constexpr int A_PK = 144, A_PV = 192, A_SK = 128 * A_PK, A_SV = 128 * A_PV, A_BT = 2 * A_SK + 2 * A_SV;
#define A_SMR(r, pos) { const float p_ = fast_exp2(X[r]); int t_; asm("v_bfe_i32 %0, %1, %2, 1" : "=v"(t_) : "v"(mw_), "i"(pos)); const float pm_ = __uint_as_float(__float_as_uint(p_) & (unsigned)t_); lsum += pm_; X[r] = pm_; }
#define A_SM16() do { A_SMR(0, 0) A_SMR(1, 1) A_SMR(2, 2) A_SMR(3, 3) A_SMR(4, 8) A_SMR(5, 9) A_SMR(6, 10) A_SMR(7, 11) A_SMR(8, 16) A_SMR(9, 17) A_SMR(10, 18) A_SMR(11, 19) A_SMR(12, 24) A_SMR(13, 25) A_SMR(14, 26) A_SMR(15, 27) } while (0)
template <int VAR = 0>
DI void dsa_att_unit(Frame& F, const float* const* in, int bh, int qb, bool do_store = true) {
    const int b = bh >> 3, h = bh & 7, l = F.lane, w = F.wave, hh = l >> 5, tid = F.tid;
    LAS float* BT = (LAS float*)(F.lds + A_BT);
    const float* tab = in[14];
    __syncthreads();
    if (tid < 128) BT[tid] = tab[t5_bucket(tid) * 8 + h] * LOG2E;
    const float cfar = tab[31 * 8 + h] * LOG2E;
    bf16* DQ = (bf16*)(F.ws + WS_DQKV);
    const size_t rowq = (size_t)b * T + qb * 256, rowk = (size_t)b * T;
    const bf16* Kp = DQ + rowk * 1536 + 512 + h * 64; const bf16* Vp = DQ + rowk * 1536 + 1024 + h * 64;
    const unsigned KT = (unsigned)(size_t)F.lds, VT = KT + 2 * A_SK;
    const unsigned klane = (unsigned)((l & 31) * A_PK + 16 * hh), vlane = tr_lane(A_PV, 4, l);
    bf16x8 qf[4];
#pragma unroll
    for (int s = 0; s < 4; ++s) qf[s] = *(const bf16x8*)(DQ + (rowq + 32 * w + (l & 31)) * 1536 + h * 64 + 16 * s + 8 * hh);
    f32x16 O[2], cf16;
#pragma unroll
    for (int r = 0; r < 16; ++r) { O[0][r] = 0.f; O[1][r] = 0.f; cf16[r] = cfar; }
    float lsum = 0.f;
    const int tq = qb * 256 + 32 * w + (l & 31), tq_lo = qb * 256 + 32 * w, tq_hi = tq_lo + 31, nst = 2 * (qb + 1);
    const u32x4* mrow = (const u32x4*)((const unsigned*)(F.ws + WS_IQ) + (rowq + 32 * w + (l & 31)) * 256);
    u32x4 kr[2], vr[2], mcur = mrow[0], mnxt = mcur;
#pragma unroll
    for (int i = 0; i < 2; ++i) { const int idx = i * NT + tid, row = idx >> 3, ch = idx & 7;
        kr[i] = *(const u32x4*)(Kp + (size_t)row * 1536 + ch * 8); vr[i] = *(const u32x4*)(Vp + (size_t)row * 1536 + ch * 8); }
#pragma unroll
    for (int i = 0; i < 2; ++i) { const int idx = i * NT + tid, row = idx >> 3, ch = idx & 7;
        *(LAS u32x4*)(KT + row * A_PK + ch * 16) = kr[i]; *(LAS u32x4*)(VT + row * A_PV + ch * 16) = vr[i]; }
    __syncthreads();
#define A_QK(Xv, kb, CI) do { Xv = MFMA32(lds_b128(kt + klane + 32 * (kb) * A_PK), qf[0], CI); Xv = MFMA32(lds_b128(kt + klane + 32 * (kb) * A_PK + 32), qf[1], Xv); \
        Xv = MFMA32(lds_b128(kt + klane + 32 * (kb) * A_PK + 64), qf[2], Xv); Xv = MFMA32(lds_b128(kt + klane + 32 * (kb) * A_PK + 96), qf[3], Xv); } while (0)
#define A_PVM(Xv, kb) do { const bf16x8 xb0_ = pack_step(Xv, 0), xb1_ = pack_step(Xv, 1); _Pragma("unroll") for (int d = 0; d < 2; ++d) { \
        const bf16x8 a0_ = tr_frag(vt + vlane, A_PV, 32 * (kb), 32 * (kb) + 8, 32 * d), a1_ = tr_frag(vt + vlane, A_PV, 32 * (kb) + 16, 32 * (kb) + 24, 32 * d); \
        O[d] = MFMA32(a0_, xb0_, O[d]); O[d] = MFMA32(a1_, xb1_, O[d]); } } while (0)
    for (int st = 0; st < nst; ++st) {
        const unsigned kt = KT + (st & 1) * A_SK, vt = VT + (st & 1) * A_SV;
        const bool more = st + 1 < nst;
        if (more) {
#pragma unroll
            for (int i = 0; i < 2; ++i) { const int idx = i * NT + tid, row = 128 * (st + 1) + (idx >> 3), ch = idx & 7;
                kr[i] = *(const u32x4*)(Kp + (size_t)row * 1536 + ch * 8); vr[i] = *(const u32x4*)(Vp + (size_t)row * 1536 + ch * 8); }
            mnxt = mrow[st + 1];
        }
        if (VAR != 3) {
        if (tq_lo - (128 * st + 127) >= 113) {
            f32x16 X, Y;
            A_QK(X, 0, cf16); A_QK(Y, 1, cf16);
            { const unsigned mw_ = mcur.x >> (4 * hh); A_SM16(); } A_PVM(X, 0);
            A_QK(X, 2, cf16);
            { f32x16& Xr = Y; const unsigned mw_ = mcur.y >> (4 * hh);
#define X Xr
              A_SM16();
#undef X
            } A_PVM(Y, 1);
            A_QK(Y, 3, cf16);
            { const unsigned mw_ = mcur.z >> (4 * hh); A_SM16(); } A_PVM(X, 2);
            { f32x16& Xr = Y; const unsigned mw_ = mcur.w >> (4 * hh);
#define X Xr
              A_SM16();
#undef X
            } A_PVM(Y, 3);
        } else {
#pragma unroll
            for (int kb = 0; kb < 4; ++kb) {
                const int key0 = 128 * st + 32 * kb;
                if (key0 > tq_hi) continue;
                f32x16 X, zero;
#pragma unroll
                for (int r = 0; r < 16; ++r) zero[r] = 0.f;
                const unsigned mw_ = (kb == 0 ? mcur.x : kb == 1 ? mcur.y : kb == 2 ? mcur.z : mcur.w) >> (4 * hh);
                if (tq_lo - (key0 + 31) >= 113) { A_QK(X, kb, cf16); }
                else { A_QK(X, kb, zero);
#pragma unroll
                    for (int r = 0; r < 16; ++r) { int di = tq - (key0 + crow(r, hh)); di = di < 0 ? 0 : (di > 127 ? 127 : di); X[r] += BT[di]; } }
                A_SM16();
                A_PVM(X, kb);
            }
        }
        }
        if (more) {
            const unsigned kn = KT + ((st + 1) & 1) * A_SK, vn = VT + ((st + 1) & 1) * A_SV;
#pragma unroll
            for (int i = 0; i < 2; ++i) { const int idx = i * NT + tid, row = idx >> 3, ch = idx & 7;
                *(LAS u32x4*)(kn + row * A_PK + ch * 16) = kr[i]; *(LAS u32x4*)(vn + row * A_PV + ch * 16) = vr[i]; }
            mcur = mnxt;
        }
        __syncthreads();
    }
#undef A_QK
#undef A_PVM
    lsum += __shfl_xor(lsum, 32);
    const float inv = fast_rcp(lsum);
    bf16* orow = DQ + (rowq + 32 * w + (l & 31)) * 1536 + h * 64;
#pragma unroll
    for (int d = 0; d < 2; ++d)
#pragma unroll
        for (int g = 0; g < 4; ++g) { u32x2 o; o.x = pk2(O[d][4 * g] * inv, O[d][4 * g + 1] * inv); o.y = pk2(O[d][4 * g + 2] * inv, O[d][4 * g + 3] * inv);
            if (do_store) *(u32x2*)(orow + 32 * d + 8 * g + 4 * hh) = o; }
}
DI void cross_att_unit(Frame& F, int u) {
    const int b = u >> 7, h = (u >> 5) & 3, qb = u & 31;
    const bf16* QC = (const bf16*)(F.ws + WS_QC); const bf16* KVM = (const bf16*)(F.ws + WS_KVM); bf16* OX = (bf16*)(F.ws + WS_OX);
    const size_t rowq = (size_t)b * T + qb * 256;
    __syncthreads();
    attn_unit<128, false>(F, QC + rowq * 512 + h * 128, 512, KVM + (size_t)b * MEML * 1024 + h * 128, KVM + (size_t)b * MEML * 1024 + 512 + h * 128, 1024, MEML / 64,
                          OX + rowq * 512 + h * 128, 512, 0.08838834764831845f * LOG2E, nullptr, 0, nullptr, 0.f);
}

constexpr int N_PHASES = 19;
#ifndef MK_ONE_LAUNCH
#define MK_ONE_LAUNCH 1
#endif
__global__ void __launch_bounds__(NT, 2) mega_fwd(Args args) {
    extern __shared__ __attribute__((aligned(16))) unsigned char lds_raw[];
    Frame F;
    F.lds = (LAS unsigned char*)lds_raw; F.ws = args.ws;
    F.tid = threadIdx.x; F.lane = F.tid & 63; F.wave = __builtin_amdgcn_readfirstlane(F.tid >> 6);
    F.G = gridDim.x; F.c = blockIdx.x;
    volatile LAS unsigned* MISC = (volatile LAS unsigned*)(F.lds + MISC_OFF);
    if (F.tid < 64) MISC[F.tid] = 0u;
    __syncthreads();
    unsigned* ctl = (unsigned*)(args.ws + WS_CTL);
    const int lo = args.ph_lo, hi = args.ph_hi;
    XcdBarrier bar; bar.bar = ctl + CW_BAR; bar.x = 0; bar.st = MISC + 8;
    if (hi - lo > 1) bar = xcd_barrier_post(ctl + CW_BAR, MISC + 8);
    const float* const* in = args.in;
    unsigned char* ws = args.ws;
    const int gw = F.c * NWAVES + F.wave, NGW = F.G * NWAVES;
#ifndef PHMASK
#define PHMASK 0x7ffff
#endif
#define IN(k) (((PHMASK >> (k)) & 1) && lo <= (k) && (k) < hi)
#define SEAM(k) do { if ((k) + 1 < hi) xcd_barrier(bar); } while (0)
#ifndef DUP_PHASE
#define DUP_PHASE -1
#endif
#ifndef DUP_N
#define DUP_N 1
#endif
#define REPS(k) ((k) == DUP_PHASE ? 1 + DUP_N : 1)
#define FORREP(k) _Pragma("unroll 1") for (int rep = 0; rep < REPS(k); ++rep)
#define ST(k) (rep == REPS(k) - 1 || hi > 1000)
#define REPBAR(k) do { if (rep + 1 < REPS(k)) xcd_barrier(bar); } while (0)
    bf16* XN = (bf16*)(ws + WS_XN); bf16* HID = (bf16*)(ws + WS_HID); bf16* Y = (bf16*)(ws + WS_Y);
    bf16* W1A = (bf16*)(ws + WS_W1A); bf16* W1B = (bf16*)(ws + WS_W1B);

    if (IN(0)) { FORREP(0) {
        LAS float* scr = (LAS float*)(F.lds + F.wave * 16384);
        constexpr int NITEMS = 10240;
        for (int it0 = gw; it0 < NITEMS; it0 += NGW) { int it = it0;
            if (conv_job(it, in[4], 2 * FF, D, 2 * FF / 32, W1A, D, ColFfn{}, scr, F.lane)) continue;
            if (conv_job(it, in[5], D, FF, D / 32, W1B, FF, ColIdent{0}, scr, F.lane)) continue;
            if (conv_job(it, in[8], 7256, D, NIN / 32, (bf16*)(ws + WS_WIN), D, ColInproj{}, scr, F.lane)) continue;
            if (conv_job(it, in[8], 7256, D, 2048 / 32, (bf16*)(ws + WS_WGT), D, ColIdent{5208}, scr, F.lane)) continue;
            if (conv_job(it, in[12], D, D, D / 32, (bf16*)(ws + WS_WG), D, ColIdent{0}, scr, F.lane)) continue;
            if (conv_job(it, in[13], D, 512, D / 32, (bf16*)(ws + WS_WD), 512, ColIdent{0}, scr, F.lane)) continue;
            if (conv_job(it, in[15], D, D, D / 32, (bf16*)(ws + WS_WO), D, ColIdent{0}, scr, F.lane)) continue;
            if (conv_job(it, in[19], 512, D, 512 / 32, (bf16*)(ws + WS_WCQ), D, ColIdent{0}, scr, F.lane)) continue;
            if (conv_job(it, in[20], D, D, D / 32, (bf16*)(ws + WS_WCKV), D, ColIdent{0}, scr, F.lane)) continue;
            conv_job(it, in[21], D, 512, D / 32, (bf16*)(ws + WS_WCO), 512, ColIdent{0}, scr, F.lane);
        }
        { int m = gw;
          for (; m + 3 * NGW < M; m += 4 * NGW) rms_rows_bf16<4>(in[0] + (size_t)m * D, in[2], XN + (size_t)m * D, F.lane, (size_t)NGW * D);
          for (; m < M; m += NGW) rms_rows_bf16<1>(in[0] + (size_t)m * D, in[2], XN + (size_t)m * D, F.lane, 0); }
        for (int m = gw; m < BATCH * MEML; m += NGW) rms_rows_bf16<1>(in[1] + (size_t)m * D, in[16], (bf16*)(ws + WS_MEMN) + (size_t)m * D, F.lane, 0);
        REPBAR(0); }
        SEAM(0);
    }
    if (IN(1)) {
        pg8::Order1 S; S.init(pg8::GDesc{XN, W1A, D, D, D, M / 256, 2 * FF / 256}, F.G, F.c);
        FORREP(1) { pg8::gemm_phase<true>(F.lds, S, EpiSwiglu{HID}); REPBAR(1); }
        SEAM(1);
    }
    if (IN(2)) {
        pg8::Order1 S; S.init(pg8::GDesc{HID, W1B, FF, FF, FF, M / 256, D / 256}, F.G, F.c);
        FORREP(2) { pg8::gemm_phase<true>(F.lds, S, EpiStore{Y, D}); REPBAR(2); }
        SEAM(2);
    }
    if (IN(3)) { FORREP(3) { resnorm_phase(F, in[0], Y, in[3], 0.5f, args.out, in[6], XN, ST(3)); REPBAR(3); } SEAM(3); }
    if (IN(4)) {
        pg8::Order2 S; S.d0 = pg8::GDesc{XN, (const bf16*)(ws + WS_WIN), D, D, D, M / 256, NIN / 256};
        S.d1 = pg8::GDesc{(const bf16*)(ws + WS_MEMN), (const bf16*)(ws + WS_WCKV), D, D, D, BATCH * MEML / 256, D / 256}; S.G = F.G; S.c = F.c;
        FORREP(4) { pg8::gemm_phase<true>(F.lds, S, EpiInproj{ws}); REPBAR(4); }
        SEAM(4);
    }
    if (IN(5)) {
        FORREP(5) {
#if !defined(DUP_SUB) || DUP_SUB == 0
        for (int u = F.c; u < 256; u += F.G) gla_state_unit(F, in, u);
        __syncthreads();
#else
        if (ST(5)) { for (int u = F.c; u < 256; u += F.G) gla_state_unit(F, in, u); __syncthreads(); }
#endif
#if !defined(DUP_SUB) || DUP_SUB == 1
        for (int k = 0; k * F.G < 2048; ++k) { const int u = k * F.G + ((k & 1) ? F.G - 1 - F.c : F.c); if (u < 2048) idx_unit(F, u, ST(5)); }
#else
        if (ST(5)) for (int k = 0; k * F.G < 2048; ++k) { const int u = k * F.G + ((k & 1) ? F.G - 1 - F.c : F.c); if (u < 2048) idx_unit(F, u, true); }
#endif
        REPBAR(5); }
        SEAM(5);
    }
    if (IN(6)) {
        FORREP(6) {
#if !defined(DUP_SUB) || DUP_SUB == 0
        gla_scan_phase(F, ST(6));
#else
        if (ST(6)) gla_scan_phase(F, true);
#endif
#if !defined(DUP_SUB) || DUP_SUB == 1
#ifdef ATT_VAR
        if (!ST(6)) { for (int p = F.c; p < 256; p += F.G) { const int bh = p >> 4, x = p & 15; dsa_att_unit<ATT_VAR>(F, in, bh, x, false); dsa_att_unit<ATT_VAR>(F, in, bh, 31 - x, false); } } else
#endif
        for (int p = F.c; p < 256; p += F.G) { const int bh = p >> 4, x = p & 15; dsa_att_unit(F, in, bh, x, ST(6)); dsa_att_unit(F, in, bh, 31 - x, ST(6)); }
#else
        if (ST(6)) for (int p = F.c; p < 256; p += F.G) { const int bh = p >> 4, x = p & 15; dsa_att_unit(F, in, bh, x, true); dsa_att_unit(F, in, bh, 31 - x, true); }
#endif
        REPBAR(6); }
        SEAM(6);
    }
    if (IN(7)) {
        FORREP(7) { for (int u = F.c; u < 256; u += F.G) { gla_out_unit(F, in, u, ST(7)); __syncthreads(); } REPBAR(7); }
        SEAM(7);
    }
    if (IN(8)) {
        pg8::Order1 S; S.init(pg8::GDesc{XN, (const bf16*)(ws + WS_WGT), D, D, D, M / 256, 2048 / 256}, F.G, F.c);
        FORREP(8) { pg8::gemm_phase<true>(F.lds, S, EpiGates{(bf16*)(ws + WS_SGA), (bf16*)(ws + WS_SGB)}); REPBAR(8); }
        SEAM(8);
    }
    if (IN(9)) {
        pg8::PairOrder S; S.d0 = pg8::GDesc{(const bf16*)(ws + WS_GR), (const bf16*)(ws + WS_WG), D, D, D, M / 256, D / 256};
        S.d1 = pg8::GDesc{(const bf16*)(ws + WS_DQKV), (const bf16*)(ws + WS_WD), 1536, 512, 512, M / 256, D / 256}; S.G = F.G; S.c = F.c;
        FORREP(9) { pg8::gemm_phase<false>(F.lds, S, EpiMerge{(const bf16*)(ws + WS_SGA), (const bf16*)(ws + WS_SGB), (bf16*)(ws + WS_MRG)}); REPBAR(9); }
        SEAM(9);
    }
    if (IN(10)) {
        pg8::Order1 S; S.init(pg8::GDesc{(const bf16*)(ws + WS_MRG), (const bf16*)(ws + WS_WO), D, D, D, M / 256, D / 256}, F.G, F.c);
        FORREP(10) { pg8::gemm_phase<true>(F.lds, S, EpiStore{(bf16*)(ws + WS_Y2), D}); REPBAR(10); }
        SEAM(10);
    }
    if (IN(11)) {
        FORREP(11) {
        resnorm_phase(F, args.out, (const bf16*)(ws + WS_Y2), in[7], 1.0f, args.out, in[17], XN, ST(11));
        LAS float* scr = (LAS float*)(F.lds + F.wave * 16384);
        constexpr int NITEMS = 2816 + 1408;
        for (int it0 = gw; it0 < NITEMS; it0 += NGW) { int it = it0;
            if (conv_job(it, in[24], 2 * FF, D, 2 * FF / 32, W1A, D, ColFfn{}, scr, F.lane)) continue;
            conv_job(it, in[25], D, FF, D / 32, W1B, FF, ColIdent{0}, scr, F.lane);
        }
        REPBAR(11); }
        SEAM(11);
    }
    if (IN(12)) {
        pg8::Order1 S; S.init(pg8::GDesc{XN, (const bf16*)(ws + WS_WCQ), D, D, D, M / 256, 512 / 256}, F.G, F.c);
        FORREP(12) { pg8::gemm_phase<true>(F.lds, S, EpiStore{(bf16*)(ws + WS_QC), 512}); REPBAR(12); }
        SEAM(12);
    }
    if (IN(13)) {
        FORREP(13) { for (int u = F.c; u < 256; u += F.G) cross_att_unit(F, u); REPBAR(13); }
        SEAM(13);
    }
    if (IN(14)) {
        pg8::Order1 S; S.init(pg8::GDesc{(const bf16*)(ws + WS_OX), (const bf16*)(ws + WS_WCO), 512, 512, 512, M / 256, D / 256}, F.G, F.c);
        FORREP(14) { pg8::gemm_phase<true>(F.lds, S, EpiStore{(bf16*)(ws + WS_Y3), D}); REPBAR(14); }
        SEAM(14);
    }
    if (IN(15)) { FORREP(15) { resnorm_phase(F, args.out, (const bf16*)(ws + WS_Y3), in[18], 1.0f, args.out, in[22], XN, ST(15)); REPBAR(15); } SEAM(15); }
    if (IN(16)) {
        pg8::Order1 S; S.init(pg8::GDesc{XN, W1A, D, D, D, M / 256, 2 * FF / 256}, F.G, F.c);
        FORREP(16) { pg8::gemm_phase<true>(F.lds, S, EpiSwiglu{HID}); REPBAR(16); }
        SEAM(16);
    }
    if (IN(17)) {
        pg8::Order1 S; S.init(pg8::GDesc{HID, W1B, FF, FF, FF, M / 256, D / 256}, F.G, F.c);
        FORREP(17) { pg8::gemm_phase<true>(F.lds, S, EpiStore{Y, D}); REPBAR(17); }
        SEAM(17);
    }
    if (IN(18)) { FORREP(18) { resnorm_phase(F, args.out, Y, in[23], 0.5f, args.out, nullptr, nullptr, ST(18)); REPBAR(18); } }
#undef IN
#undef SEAM
}

extern "C" void kernel_launch(void* const* d_in, const int* in_sizes, int n_in, void* d_out, int out_size, void* d_ws, size_t ws_size, hipStream_t stream) {
    static int grid = 0;
    if (grid == 0) {
        if (n_in != 26 || out_size != M * D || ws_size < WS_END) { fprintf(stderr, "kernel_launch: unexpected problem shape (n_in %d, out %d, ws %zu); nothing launched\n", n_in, out_size, ws_size); grid = -1; return; }
        int dev = 0, cus = 0, per_cu = 0;
        if (hipGetDevice(&dev) != hipSuccess || hipDeviceGetAttribute(&cus, hipDeviceAttributeMultiprocessorCount, dev) != hipSuccess) { grid = -1; return; }
        if (hipFuncSetAttribute((const void*)mega_fwd, hipFuncAttributeMaxDynamicSharedMemorySize, LDS_BYTES) != hipSuccess) { fprintf(stderr, "kernel_launch: hipFuncSetAttribute failed\n"); grid = -1; return; }
        if (hipOccupancyMaxActiveBlocksPerMultiprocessor(&per_cu, (const void*)mega_fwd, NT, LDS_BYTES) != hipSuccess || per_cu < 1) fprintf(stderr, "kernel_launch: occupancy query reports %d workgroups per CU\n", per_cu);
        (void)hipGetLastError();
        grid = cus;
    }
    if (grid < 0) return;
    (void)hipMemsetAsync((char*)d_ws + WS_CTL, 0, 65536, stream);
    Args a{};
    for (int i = 0; i < 26; ++i) a.in[i] = (const float*)d_in[i];
    a.out = (float*)d_out; a.ws = (unsigned char*)d_ws;
#if MK_ONE_LAUNCH
    a.ph_lo = 0; a.ph_hi = N_PHASES;
    hipLaunchKernelGGL(mega_fwd, dim3(grid), dim3(NT), LDS_BYTES, stream, a);
#else
    for (int p = 0; p < N_PHASES; ++p) { a.ph_lo = p; a.ph_hi = p + 1; hipLaunchKernelGGL(mega_fwd, dim3(grid), dim3(NT), LDS_BYTES, stream, a); }
#endif
}
```

```cpp
#define MK_ONE_LAUNCH 1
#pragma clang diagnostic ignored "-Wint-to-pointer-cast"
#include <hip/hip_runtime.h>
#include <cstdio>
#include <cstdint>

#define DI __device__ __forceinline__
#define LAS __attribute__((address_space(3)))
#define GAS __attribute__((address_space(1)))
typedef unsigned short bf16;
typedef short bf16x8 __attribute__((ext_vector_type(8)));
typedef short s16x4 __attribute__((ext_vector_type(4)));
typedef float f32x4 __attribute__((ext_vector_type(4)));
typedef float f32x2 __attribute__((ext_vector_type(2)));
typedef float f32x16 __attribute__((ext_vector_type(16)));
typedef unsigned u32x4 __attribute__((ext_vector_type(4)));
typedef unsigned u32x2 __attribute__((ext_vector_type(2)));
typedef __bf16 bf16x2_t __attribute__((ext_vector_type(2)));

DI unsigned pk2(float lo, float hi) { f32x2 v = {lo, hi}; bf16x2_t b = __builtin_convertvector(v, bf16x2_t); return __builtin_bit_cast(unsigned, b); }
DI float bflo(unsigned w) { return __uint_as_float(w << 16); }
DI float bfhi(unsigned w) { return __uint_as_float(w & 0xffff0000u); }
DI float bf2f(bf16 v) { return __uint_as_float(((unsigned)v) << 16); }
DI float wave_sum(float v) {
#pragma unroll
    for (int o = 1; o < 64; o <<= 1) v += __shfl_xor(v, o);
    return v;
}
DI float fast_exp2(float x) { return __builtin_amdgcn_exp2f(x); }
DI float fast_exp(float x) { return __builtin_amdgcn_exp2f(x * 1.4426950408889634f); }
DI float fast_rcp(float x) { return __builtin_amdgcn_rcpf(x); }
DI float sigmoid_f(float x) { return fast_rcp(1.0f + fast_exp(-x)); }
#define MFMA32(a, b, c) __builtin_amdgcn_mfma_f32_32x32x16_bf16((a), (b), (c), 0, 0, 0)
DI int crow(int r, int hi) { return (r & 3) + 8 * (r >> 2) + 4 * hi; }
DI bf16x8 pack8(float a0, float a1, float a2, float a3, float a4, float a5, float a6, float a7) {
    u32x4 p; p.x = pk2(a0, a1); p.y = pk2(a2, a3); p.z = pk2(a4, a5); p.w = pk2(a6, a7); return __builtin_bit_cast(bf16x8, p);
}
DI bf16x8 pack_step(const f32x16& x, int s) { return pack8(x[8 * s], x[8 * s + 1], x[8 * s + 2], x[8 * s + 3], x[8 * s + 4], x[8 * s + 5], x[8 * s + 6], x[8 * s + 7]); }
typedef short v4i16_t __attribute__((ext_vector_type(4)));
DI s16x4 vtr(unsigned lds_byte_addr) { return __builtin_bit_cast(s16x4, __builtin_amdgcn_ds_read_tr16_b64_v4i16((LAS v4i16_t*)lds_byte_addr)); }
DI bf16x8 cat4(s16x4 lo, s16x4 hi) { return __builtin_shufflevector(lo, hi, 0, 1, 2, 3, 4, 5, 6, 7); }
DI bf16x8 lds_b128(unsigned lds_byte_addr) { return *(const LAS bf16x8*)lds_byte_addr; }

namespace pg8 {
#define PG8_LAS __attribute__((address_space(3)))
typedef unsigned short bf16_t;
constexpr int BM = 256, BK = 64, HALF = 128, HTB = HALF * BK * 2  , STAGE_BYTES = 8 * HTB, NXCD = 8, WGM = 8;

__host__ __device__ __forceinline__ int lds_byte(int r, int c) { const int st = (r >> 4) * 2 + (c >> 5), rr = r & 15, cc = c & 31, ob = rr * 64 + cc * 2; return st * 1024 + (ob ^ (((ob >> 9) & 1) << 5)); }
__host__ __device__ __forceinline__ void stage_rc(int b, int& R, int& C) { const int st = b / 1024, sb = b % 1024, swz = sb ^ (((sb >> 9) & 1) << 5); R = (st >> 1) * 16 + swz / 64; C = (st & 1) * 32 + (swz % 64) / 2; }
__host__ __device__ __forceinline__ int perm32(int rho) { const int n = rho >> 4, i = rho & 15; return 8 * (i >> 2) + 4 * n + (i & 3); }

struct Unit { int pm, pn, g; };
struct GDesc { const bf16_t* A; const bf16_t* Bt; int lda, ldb, K, nM, nN; };

__device__ __forceinline__ void tile_of(int l, int nM, int nN, int& pm, int& pn) {
    const int nwg = nM * nN; int wgid = l;
    { const int q = nwg / NXCD, r = nwg % NXCD, xcd = wgid % NXCD, off = wgid / NXCD; wgid = (xcd < r ? xcd * (q + 1) : r * (q + 1) + (xcd - r) * q) + off; }
    const int nig = WGM * nN, gid = wgid / nig, fm = gid * WGM, gsz = (nM - fm) < WGM ? (nM - fm) : WGM;
    pm = fm + ((wgid % nig) % gsz); pn = (wgid % nig) / gsz;
}
struct Order1 {
    GDesc d0; int G, c;
    __device__ __forceinline__ void init(const GDesc& a, int G_, int c_) { d0 = a; G = G_; c = c_; }
    __device__ __forceinline__ GDesc desc(int) const { return d0; }
    __device__ __forceinline__ bool next(int i, Unit& u) const {
        const long L = (long)i * G + c; if (L >= (long)(d0.nM * d0.nN)) return false;
        tile_of((int)L, d0.nM, d0.nN, u.pm, u.pn); u.g = 0; return true;
    }
};
struct Order2 {
    GDesc d0, d1; int G, c;
    __device__ __forceinline__ GDesc desc(int g) const { GDesc r; r.A = g == 0 ? d0.A : d1.A; r.Bt = g == 0 ? d0.Bt : d1.Bt; r.lda = d0.lda; r.ldb = d0.ldb; r.K = d0.K; r.nM = g == 0 ? d0.nM : d1.nM; r.nN = g == 0 ? d0.nN : d1.nN; return r; }
    __device__ __forceinline__ bool next(int i, Unit& u) const {
        const int n0 = d0.nM * d0.nN, n1 = d1.nM * d1.nN;
        const long L = (long)i * G + c; if (L >= (long)(n0 + n1)) return false;
        int l = (int)L, g = 0; if (l >= n0) { l -= n0; g = 1; }
        tile_of(l, g == 0 ? d0.nM : d1.nM, g == 0 ? d0.nN : d1.nN, u.pm, u.pn); u.g = g; return true;
    }
};
struct PairOrder {
    GDesc d0, d1; int G, c;
    __device__ __forceinline__ GDesc desc(int g) const { GDesc r; r.A = g == 0 ? d0.A : d1.A; r.Bt = g == 0 ? d0.Bt : d1.Bt; r.lda = g == 0 ? d0.lda : d1.lda; r.ldb = g == 0 ? d0.ldb : d1.ldb; r.K = g == 0 ? d0.K : d1.K; r.nM = d0.nM; r.nN = d0.nN; return r; }
    __device__ __forceinline__ bool next(int i, Unit& u) const {
        const long L = (long)(i >> 1) * G + c; if (L >= (long)(d0.nM * d0.nN)) return false;
        tile_of((int)L, d0.nM, d0.nN, u.pm, u.pn); u.g = i & 1; return true;
    }
};

template <bool UNIFORM  , class Epi, class Sched>
__device__ __forceinline__ void gemm_phase(PG8_LAS unsigned char* lds, const Sched& S, const Epi& E) {
    const int tid = threadIdx.x, wid = __builtin_amdgcn_readfirstlane(tid >> 6), lane = tid & 63, wr = wid >> 2, wc = wid & 3, fr = lane & 15, fq = lane >> 4;
    auto voff = [tid](int i, int ld, bool perm) -> unsigned { int R, C; stage_rc(tid * 16 + i * 8192, R, C); if (perm) R = (R & ~31) + perm32(R & 31); return (unsigned)(R * ld + C) * 2u; };
    const size_t kstep = (size_t)(BK * 2);
    const unsigned ldsw = (unsigned)wid * 1024u;
    const int aoff = lds_byte(wr * 64 + fr, fq * 8), boff = lds_byte(wc * 32 + fr, fq * 8);
#define PG8_SA(b, h) (((b) * 2 + (h)) * HTB)
#define PG8_SB(b, h) ((4 + (b) * 2 + (h)) * HTB)
#define PG8_STAGE(bufoff, gbase, v0, v1) do { \
        __builtin_amdgcn_global_load_lds((const unsigned*)((const char*)(gbase) + (v0)), (PG8_LAS unsigned*)(lds + (bufoff) + ldsw), 16, 0, 0); \
        __builtin_amdgcn_global_load_lds((const unsigned*)((const char*)(gbase) + (v1)), (PG8_LAS unsigned*)(lds + (bufoff) + ldsw + 8192), 16, 0, 0); } while (0)
#define PG8_LDA(dst, b, h) do { _Pragma("unroll") for (int m = 0; m < 4; ++m) _Pragma("unroll") for (int k = 0; k < 2; ++k) dst[m][k] = *(const PG8_LAS bf16x8*)(lds + PG8_SA(b, h) + aoff + m * 2048 + k * 1024); } while (0)
#define PG8_LDB(dst, b, h) do { _Pragma("unroll") for (int n = 0; n < 2; ++n) _Pragma("unroll") for (int k = 0; k < 2; ++k) dst[n][k] = *(const PG8_LAS bf16x8*)(lds + PG8_SB(b, h) + boff + n * 2048 + k * 1024); } while (0)
#define PG8_MMA(ai, bj, At, Bt) do { __builtin_amdgcn_s_setprio(1); _Pragma("unroll") for (int m = 0; m < 4; ++m) _Pragma("unroll") for (int n = 0; n < 2; ++n) _Pragma("unroll") for (int k = 0; k < 2; ++k) \
        acc[ai][bj][m][n] = __builtin_amdgcn_mfma_f32_16x16x32_bf16(Bt[n][k], At[m][k], acc[ai][bj][m][n], 0, 0, 0); __builtin_amdgcn_s_setprio(0); } while (0)
#define PG8_WAIT_V(n) asm volatile("s_waitcnt vmcnt(" #n ")" ::: "memory")
#define PG8_WAIT_L(n) asm volatile("s_waitcnt lgkmcnt(" #n ")" ::: "memory")
#define PG8_BAR __builtin_amdgcn_s_barrier()
#define PG8_SCHED __builtin_amdgcn_sched_barrier(0)
    Unit cur, nxt; int ui = 0;
    if (!S.next(0, cur)) return;
    GDesc dc = S.desc(cur.g);
    f32x4 acc[2][2][4][2];
#pragma unroll
    for (int a = 0; a < 2; ++a)
#pragma unroll
        for (int b = 0; b < 2; ++b)
#pragma unroll
            for (int m = 0; m < 4; ++m)
#pragma unroll
                for (int n = 0; n < 2; ++n) acc[a][b][m][n] = (f32x4){0.f, 0.f, 0.f, 0.f};
    bf16x8 At[4][2], B0[2][2], B1[2][2];
    unsigned vA0 = voff(0, dc.lda, false), vA1 = voff(1, dc.lda, false), vB0 = voff(0, dc.ldb, true), vB1 = voff(1, dc.ldb, true);
    size_t hA = (size_t)HALF * dc.lda * 2, hB = (size_t)HALF * dc.ldb * 2;
    const char* cA = (const char*)dc.A + (size_t)cur.pm * 2 * hA; const char* cB = (const char*)dc.Bt + (size_t)cur.pn * 2 * hB;
    PG8_STAGE(PG8_SB(0, 0), cB, vB0, vB1); PG8_STAGE(PG8_SB(0, 1), cB + hB, vB0, vB1); PG8_STAGE(PG8_SA(0, 0), cA, vA0, vA1); PG8_STAGE(PG8_SA(0, 1), cA + hA, vA0, vA1);
    if (wr == 1) PG8_BAR;
    PG8_WAIT_V(2); PG8_BAR;
    PG8_STAGE(PG8_SB(1, 0), cB + kstep, vB0, vB1); PG8_STAGE(PG8_SA(1, 0), cA + kstep, vA0, vA1); PG8_STAGE(PG8_SB(1, 1), cB + hB + kstep, vB0, vB1);
    PG8_WAIT_V(6); PG8_BAR;
    for (;;) {
        const bool has_next = S.next(ui + 1, nxt);
        GDesc dn = dc; if (has_next) dn = S.desc(nxt.g);
        unsigned nvA0 = vA0, nvA1 = vA1, nvB0 = vB0, nvB1 = vB1; size_t nhA = hA, nhB = hB;
        if constexpr (!UNIFORM) { if (has_next) { nvA0 = voff(0, dn.lda, false); nvA1 = voff(1, dn.lda, false); nvB0 = voff(0, dn.ldb, true); nvB1 = voff(1, dn.ldb, true); nhA = (size_t)HALF * dn.lda * 2; nhB = (size_t)HALF * dn.ldb * 2; } }
        const char* nA = has_next ? (const char*)dn.A + (size_t)nxt.pm * 2 * nhA : cA; const char* nB = has_next ? (const char*)dn.Bt + (size_t)nxt.pn * 2 * nhB : cB;
        const int nt = dc.K / BK;
        for (int t = 0; t < nt; t += 2) {
            const bool last = (t == nt - 2);
            const char* a1 = cA + (size_t)(t + 1) * kstep;
            const char* a2 = last ? nA : cA + (size_t)(t + 2) * kstep; const char* b2 = last ? nB : cB + (size_t)(t + 2) * kstep;
            const char* a3 = a2 + kstep; const char* b3 = b2 + kstep;
            unsigned xA0 = vA0, xA1 = vA1, xB0 = vB0, xB1 = vB1; size_t xhA = hA, xhB = hB;
            if constexpr (!UNIFORM) { if (last) { xA0 = nvA0; xA1 = nvA1; xB0 = nvB0; xB1 = nvB1; xhA = nhA; xhB = nhB; } }
            PG8_LDB(B0, 0, 0); PG8_LDB(B1, 0, 1); PG8_SCHED; PG8_LDA(At, 0, 0); PG8_STAGE(PG8_SA(1, 1), a1 + hA, vA0, vA1);
            PG8_WAIT_V(8); PG8_WAIT_L(0); PG8_BAR; PG8_MMA(0, 0, At, B0); PG8_MMA(0, 1, At, B1); PG8_BAR; PG8_SCHED;
            PG8_LDA(At, 0, 1); PG8_STAGE(PG8_SB(0, 0), b2, xB0, xB1); PG8_STAGE(PG8_SB(0, 1), b2 + xhB, xB0, xB1); PG8_STAGE(PG8_SA(0, 0), a2, xA0, xA1);
            PG8_WAIT_V(8); PG8_WAIT_L(0); PG8_BAR; PG8_MMA(1, 0, At, B0); PG8_MMA(1, 1, At, B1); PG8_BAR; PG8_SCHED;
            PG8_LDB(B0, 1, 0); PG8_LDB(B1, 1, 1); PG8_SCHED; PG8_LDA(At, 1, 0); PG8_STAGE(PG8_SA(0, 1), a2 + xhA, xA0, xA1);
            PG8_WAIT_V(8); PG8_WAIT_L(0); PG8_BAR; PG8_MMA(0, 0, At, B0); PG8_MMA(0, 1, At, B1); PG8_BAR; PG8_SCHED;
            PG8_LDA(At, 1, 1); PG8_STAGE(PG8_SB(1, 0), b3, xB0, xB1); PG8_STAGE(PG8_SB(1, 1), b3 + xhB, xB0, xB1); PG8_STAGE(PG8_SA(1, 0), a3, xA0, xA1);
            PG8_WAIT_V(8); PG8_WAIT_L(0); PG8_BAR; PG8_MMA(1, 0, At, B0); PG8_MMA(1, 1, At, B1); PG8_BAR; PG8_SCHED;
        }
        if (wr == 0) PG8_BAR;
        const bool keep = E(acc, cur, wr, wc, fr, fq);
        if (!has_next) break;
        if (!keep) {
#pragma unroll
            for (int a = 0; a < 2; ++a)
#pragma unroll
                for (int b = 0; b < 2; ++b)
#pragma unroll
                    for (int m = 0; m < 4; ++m)
#pragma unroll
                        for (int n = 0; n < 2; ++n) acc[a][b][m][n] = (f32x4){0.f, 0.f, 0.f, 0.f};
        }
        cur = nxt; dc = dn; cA = nA; cB = nB; vA0 = nvA0; vA1 = nvA1; vB0 = nvB0; vB1 = nvB1; hA = nhA; hB = nhB; ++ui;
        if (wr == 1) PG8_BAR;
    }
    PG8_WAIT_V(0);
    PG8_BAR;
#undef PG8_SA
#undef PG8_SB
#undef PG8_STAGE
#undef PG8_LDA
#undef PG8_LDB
#undef PG8_MMA
#undef PG8_WAIT_V
#undef PG8_WAIT_L
#undef PG8_BAR
#undef PG8_SCHED
}
}

constexpr int NWAVES = 8, NT = 512;
constexpr int BATCH = 2, T = 8192, D = 1024, M = BATCH * T, FF = 2816, MEML = 256;
constexpr float EPS = 1e-6f;
constexpr float LOG2E = 1.4426950408889634f;
constexpr int NIN = 5376;
constexpr size_t KiB = 1024, MiB = 1u << 20;
constexpr size_t WS_CTL = 0, CTL_ZERO_BYTES = 1 * MiB;
constexpr size_t WS_XN = 1 * MiB;
constexpr size_t WS_HID = 33 * MiB;
constexpr size_t WS_Y = 121 * MiB;
constexpr size_t WS_QKG = 33 * MiB, WS_GV = 65 * MiB, WS_GR = 97 * MiB, WS_DQKV = 129 * MiB, WS_IQ = 177 * MiB, WS_SM = 193 * MiB, WS_GST = 197 * MiB;
constexpr size_t WS_W1A = 153 * MiB, WS_W1B = 164 * MiB;
constexpr size_t WS_WIN = 229 * MiB, WS_WGT = 229 * MiB + 10752 * KiB, WS_WG = WS_WGT + 4 * MiB, WS_WD = WS_WG + 2 * MiB, WS_WO = WS_WD + 1 * MiB,
                 WS_WCQ = WS_WO + 2 * MiB, WS_WCKV = WS_WCQ + 1 * MiB, WS_WCO = WS_WCKV + 2 * MiB, WS_MEMN = WS_WCO + 1 * MiB, WS_KVM = WS_MEMN + 1 * MiB, WS_DEC = WS_KVM + 1 * MiB;
constexpr size_t WS_SGA = WS_QKG, WS_SGB = WS_GV, WS_MRG = WS_GST, WS_Y2 = WS_QKG;
constexpr size_t WS_QC = 65 * MiB, WS_OX = 81 * MiB, WS_Y3 = 97 * MiB;
constexpr size_t WS_END = 256 * MiB;
static_assert(WS_DEC + 128 * KiB <= WS_END && WS_W1B + (size_t)D * FF * 2 <= WS_IQ && WS_HID + (size_t)M * FF * 2 <= WS_Y, "d_ws map");
constexpr int CW_BAR = 4096;
constexpr int LDS_BYTES = 163840;
constexpr int MISC_OFF = LDS_BYTES - 256;

#define XB_TMO      128
#define XB_XCNT(j)  (256  + 64 * (j))
#define XB_XSUB(j)  (1280 + 64 * (j))
#define XB_XGEN(j)  (2304 + 64 * (j))
#define XB_TOP      3328
#define XB_TOPGEN   3392
#define XCD_BAR_WORDS 3456
#define XB_SPIN_CAP (1u << 18)

__device__ __forceinline__ unsigned xb_ld(unsigned* p)              { return __hip_atomic_load(p, __ATOMIC_RELAXED, __HIP_MEMORY_SCOPE_AGENT); }
__device__ __forceinline__ unsigned xb_add(unsigned* p, unsigned v) { return __hip_atomic_fetch_add(p, v, __ATOMIC_RELAXED, __HIP_MEMORY_SCOPE_AGENT); }
__device__ __forceinline__ unsigned xb_xcc_id() { return (unsigned)__builtin_amdgcn_s_getreg((3 << 11) | 20) & 0xFu; }
#define XB_SPIN(cond, bar) do { unsigned _sp = 0; while (cond) { __builtin_amdgcn_s_sleep(1); \
    if ((++_sp & 255u) == 0u) { if (xb_ld(&(bar)[XB_TMO])) break; if (_sp > XB_SPIN_CAP) { atomicAdd(&(bar)[XB_TMO], 1u); break; } } } } while (0)

struct XcdBarrier {
    unsigned* bar; unsigned x;
    volatile LAS unsigned* st;
};

__device__ __forceinline__ XcdBarrier xcd_barrier_post(unsigned* bar, volatile LAS unsigned* st) {
    XcdBarrier b; b.bar = bar; b.x = xb_xcc_id(); b.st = st;
    if (threadIdx.x == 0) (void)xb_add(&bar[XB_XCNT(b.x)], 1u);
    return b;
}
__device__ __forceinline__ void xcd_barrier_complete(unsigned* bar, unsigned x, unsigned& nloc, unsigned& nx) {
    const unsigned G = gridDim.x * gridDim.y * gridDim.z;
    unsigned sum, cnt, mine, sp = 0u;
    for (;;) {
        sum = 0u; cnt = 0u; mine = 0u;
#pragma unroll
        for (unsigned j = 0; j < 16; ++j) { const unsigned c = xb_ld(&bar[XB_XCNT(j)]); sum += c; cnt += (c > 0u) ? 1u : 0u; mine = (j == x) ? c : mine; }
        if (sum == G) break;
        __builtin_amdgcn_s_sleep(1);
        if ((++sp & 255u) == 0u) { if (xb_ld(&bar[XB_TMO])) break; if (sp > XB_SPIN_CAP) { atomicAdd(&bar[XB_TMO], 1u); break; } }
    }
    nloc = mine > 0u ? mine : 1u; nx = cnt > 0u ? cnt : 1u;
}

__device__ __forceinline__ void xcd_barrier(const XcdBarrier& b) {
    asm volatile("s_waitcnt vmcnt(0)" ::: "memory");
    __syncthreads();
    if (threadIdx.x == 0) {
        unsigned* bar = b.bar;
        __builtin_amdgcn_s_waitcnt(0);
        unsigned nloc = b.st[0], nx = b.st[1];
        if (nloc == 0u) { xcd_barrier_complete(bar, b.x, nloc, nx); b.st[0] = nloc; b.st[1] = nx; }
        const unsigned old = xb_add(&bar[XB_XSUB(b.x)], 1u);
        const unsigned gen = old / nloc;
        if (old + 1u == (gen + 1u) * nloc) {
            __builtin_amdgcn_fence(__ATOMIC_RELEASE, "agent");
            asm volatile("s_waitcnt vmcnt(0)" ::: "memory");
            const unsigned og = xb_add(&bar[XB_TOP], 1u);
            const unsigned tg = og / nx;
            if (og + 1u == (tg + 1u) * nx) xb_add(&bar[XB_TOPGEN], 1u);
            else XB_SPIN(xb_ld(&bar[XB_TOPGEN]) == tg, bar);
            __builtin_amdgcn_fence(__ATOMIC_ACQUIRE, "agent");
            xb_add(&bar[XB_XGEN(b.x)], 1u);
            asm volatile("s_waitcnt vmcnt(0)" ::: "memory");
        } else {
            XB_SPIN(xb_ld(&bar[XB_XGEN(b.x)]) == gen, bar);
            __builtin_amdgcn_fence(__ATOMIC_ACQUIRE, "agent");
            asm volatile("s_waitcnt vmcnt(0)" ::: "memory");
        }
    }
    __syncthreads();
}

struct Args { const float* in[26]; float* out; unsigned char* ws; int ph_lo, ph_hi, nostore, sub; };
struct Frame {
    LAS unsigned char* lds;
    unsigned char* ws;
    int tid, lane, wave, G, c;
};
#define LDS_WAIT() asm volatile("s_waitcnt lgkmcnt(0)" ::: "memory")
#define VM_WAIT() asm volatile("s_waitcnt vmcnt(0)" ::: "memory")

template <class ColFn>
DI void conv_item(const float* W, int ldw, int k0, bf16* WT, int ldt, int dr0, int dk0, ColFn srccol, LAS float* scr, int lane) {
    const int n4 = (lane & 7) * 4; const int sc = srccol(dr0 + n4);
#pragma unroll
    for (int i = 0; i < 8; ++i) { const int kk = 8 * i + (lane >> 3);
        const f32x4 v = sc >= 0 ? *(const f32x4*)(W + (size_t)(k0 + kk) * ldw + sc) : (f32x4){0.f, 0.f, 0.f, 0.f};
        LAS float* s = scr + kk * 33 + n4; s[0] = v.x; s[1] = v.y; s[2] = v.z; s[3] = v.w; }
    LDS_WAIT(); asm volatile("" ::: "memory");
    const int c = lane & 7;
#pragma unroll
    for (int j = 0; j < 4; ++j) { const int n = (lane >> 3) + 8 * j; const LAS float* s = scr + (8 * c) * 33 + n;
        u32x4 o; o.x = pk2(s[0 * 33], s[1 * 33]); o.y = pk2(s[2 * 33], s[3 * 33]); o.z = pk2(s[4 * 33], s[5 * 33]); o.w = pk2(s[6 * 33], s[7 * 33]);
        *(u32x4*)(WT + (size_t)(dr0 + n) * ldt + dk0 + k0 + 8 * c) = o; }
    LDS_WAIT(); asm volatile("" ::: "memory");
}
struct ColIdent { int c0; DI int operator()(int r) const { return c0 + r; } };
struct ColFfn { DI int operator()(int r) const { const int tile = r >> 8, j = r & 255; return j < 128 ? tile * 128 + j : FF + tile * 128 + (j - 128); } };
struct ColInproj { DI int operator()(int r) const { return r < 3072 ? r : (r < 5192 ? r + 16 : (r < 5208 ? 3072 + (r - 5192) : -1)); } };
template <class ColFn>
DI bool conv_job(int& it, const float* W, int ldw, int K, int nb, bf16* WT, int ldt, ColFn f, LAS float* scr, int lane) {
    const int n_items = (K / 64) * nb;
    if (it >= n_items) { it -= n_items; return false; }
    const int kb = it / nb, b = it % nb;
    conv_item(W, ldw, 64 * kb, WT, ldt, 32 * b, 0, f, scr, lane);
    return true;
}
template <int NR>
DI void rms_rows_bf16(const float* xrow, const float* g, bf16* orow, int lane, size_t rstride) {
    f32x4 v[NR][4]; float s[NR];
#pragma unroll
    for (int q = 0; q < NR; ++q) { const f32x4* xr = (const f32x4*)(xrow + q * rstride) + lane; float a = 0.f;
#pragma unroll
        for (int j = 0; j < 4; ++j) { v[q][j] = xr[64 * j]; a += (v[q][j].x * v[q][j].x + v[q][j].y * v[q][j].y) + (v[q][j].z * v[q][j].z + v[q][j].w * v[q][j].w); }
        s[q] = a; }
    const f32x4* gr = (const f32x4*)g + lane; f32x4 gg[4];
#pragma unroll
    for (int j = 0; j < 4; ++j) gg[j] = gr[64 * j];
#pragma unroll
    for (int o = 1; o < 64; o <<= 1)
#pragma unroll
        for (int q = 0; q < NR; ++q) s[q] += __shfl_xor(s[q], o);
#pragma unroll
    for (int q = 0; q < NR; ++q) { const float r = __builtin_amdgcn_rsqf(s[q] * (1.f / D) + EPS); u32x2* o8 = (u32x2*)(orow + q * rstride) + lane;
#pragma unroll
        for (int j = 0; j < 4; ++j) { u32x2 w; w.x = pk2(v[q][j].x * r * gg[j].x, v[q][j].y * r * gg[j].y); w.y = pk2(v[q][j].z * r * gg[j].z, v[q][j].w * r * gg[j].w); o8[64 * j] = w; } }
}
template <int NR>
DI void resnorm_rows(const float* hin, const bf16* yrow, const float* gpost, float coef, float* hout, const float* gpre, bf16* xn, int lane, bool do_store, size_t rstride) {
    f32x4 y[NR][4], h[NR][4]; float s[NR], s2[NR];
#pragma unroll
    for (int q = 0; q < NR; ++q) { const u32x2* yr = (const u32x2*)(yrow + q * rstride) + lane; const f32x4* hr = (const f32x4*)(hin + q * rstride) + lane;
#pragma unroll
        for (int j = 0; j < 4; ++j) { const u32x2 w = yr[64 * j]; y[q][j] = (f32x4){bflo(w.x), bfhi(w.x), bflo(w.y), bfhi(w.y)}; h[q][j] = hr[64 * j]; } }
    const f32x4* gp = (const f32x4*)gpost + lane; f32x4 g[4];
#pragma unroll
    for (int j = 0; j < 4; ++j) g[j] = gp[64 * j];
#pragma unroll
    for (int q = 0; q < NR; ++q) { float a = 0.f;
#pragma unroll
        for (int j = 0; j < 4; ++j) a += (y[q][j].x * y[q][j].x + y[q][j].y * y[q][j].y) + (y[q][j].z * y[q][j].z + y[q][j].w * y[q][j].w);
        s[q] = a; }
#pragma unroll
    for (int o = 1; o < 64; o <<= 1)
#pragma unroll
        for (int q = 0; q < NR; ++q) s[q] += __shfl_xor(s[q], o);
#pragma unroll
    for (int q = 0; q < NR; ++q) { const float r = __builtin_amdgcn_rsqf(s[q] * (1.f / D) + EPS) * coef; float a = 0.f;
#pragma unroll
        for (int j = 0; j < 4; ++j) { h[q][j] = h[q][j] + y[q][j] * r * g[j]; a += (h[q][j].x * h[q][j].x + h[q][j].y * h[q][j].y) + (h[q][j].z * h[q][j].z + h[q][j].w * h[q][j].w); }
        s2[q] = a;
        if (do_store) { f32x4* ho = (f32x4*)(hout + q * rstride) + lane;
#pragma unroll
            for (int j = 0; j < 4; ++j) ho[64 * j] = h[q][j]; } }
    if (xn) {
        const f32x4* gq = (const f32x4*)gpre + lane;
#pragma unroll
        for (int j = 0; j < 4; ++j) g[j] = gq[64 * j];
#pragma unroll
        for (int o = 1; o < 64; o <<= 1)
#pragma unroll
            for (int q = 0; q < NR; ++q) s2[q] += __shfl_xor(s2[q], o);
#pragma unroll
        for (int q = 0; q < NR; ++q) { const float r2 = __builtin_amdgcn_rsqf(s2[q] * (1.f / D) + EPS); u32x2* o8 = (u32x2*)(xn + q * rstride) + lane;
#pragma unroll
            for (int j = 0; j < 4; ++j) { u32x2 w; w.x = pk2(h[q][j].x * r2 * g[j].x, h[q][j].y * r2 * g[j].y); w.y = pk2(h[q][j].z * r2 * g[j].z, h[q][j].w * r2 * g[j].w); o8[64 * j] = w; } }
    }
}
DI void resnorm_phase(Frame& F, const float* hin, const bf16* y, const float* gpost, float coef, float* hout, const float* gpre, bf16* xn, bool do_store = true) {
    const int gw = F.c * NWAVES + F.wave, NGW = F.G * NWAVES;
    int m = gw;
    for (; m + NGW < M; m += 2 * NGW) resnorm_rows<2>(hin + (size_t)m * D, y + (size_t)m * D, gpost, coef, hout + (size_t)m * D, gpre, xn ? xn + (size_t)m * D : nullptr, F.lane, do_store, (size_t)NGW * D);
    for (; m < M; m += NGW) resnorm_rows<1>(hin + (size_t)m * D, y + (size_t)m * D, gpost, coef, hout + (size_t)m * D, gpre, xn ? xn + (size_t)m * D : nullptr, F.lane, do_store, 0);
}

using pg8::Unit;
typedef f32x4 Acc[2][2][4][2];
struct EpiStore {
    bf16* O; int ldo;
    DI bool operator()(Acc& acc, const Unit& u, int wr, int wc, int fr, int fq) const {
        const int row0 = u.pm * 256 + wr * 64 + fr, col0 = u.pn * 256 + wc * 32 + 8 * fq;
#pragma unroll
        for (int ai = 0; ai < 2; ++ai)
#pragma unroll
            for (int m = 0; m < 4; ++m) { bf16* rowp = O + (size_t)(row0 + ai * 128 + m * 16) * ldo + col0;
#pragma unroll
                for (int bj = 0; bj < 2; ++bj) { const f32x4 v0 = acc[ai][bj][m][0], v1 = acc[ai][bj][m][1];
                    u32x4 w; w.x = pk2(v0[0], v0[1]); w.y = pk2(v0[2], v0[3]); w.z = pk2(v1[0], v1[1]); w.w = pk2(v1[2], v1[3]);
                    *(u32x4*)(rowp + bj * 128) = w; } }
        return false;
    }
};
struct EpiGates {
    bf16* SGA; bf16* SGB;
    DI bool operator()(Acc& acc, const Unit& u, int wr, int wc, int fr, int fq) const {
        bf16* O = u.pn < 4 ? SGA : SGB;
        const int row0 = u.pm * 256 + wr * 64 + fr, col0 = (u.pn & 3) * 256 + wc * 32 + 8 * fq;
#pragma unroll
        for (int ai = 0; ai < 2; ++ai)
#pragma unroll
            for (int m = 0; m < 4; ++m) { bf16* rowp = O + (size_t)(row0 + ai * 128 + m * 16) * 1024 + col0;
#pragma unroll
                for (int bj = 0; bj < 2; ++bj) { const f32x4 v0 = acc[ai][bj][m][0], v1 = acc[ai][bj][m][1];
                    u32x4 w; w.x = pk2(sigmoid_f(v0[0]), sigmoid_f(v0[1])); w.y = pk2(sigmoid_f(v0[2]), sigmoid_f(v0[3])); w.z = pk2(sigmoid_f(v1[0]), sigmoid_f(v1[1])); w.w = pk2(sigmoid_f(v1[2]), sigmoid_f(v1[3]));
                    *(u32x4*)(rowp + bj * 128) = w; } }
        return false;
    }
};
struct EpiSwiglu {
    bf16* H;
    DI bool operator()(Acc& acc, const Unit& u, int wr, int wc, int fr, int fq) const {
        const int row0 = u.pm * 256 + wr * 64 + fr, col0 = u.pn * 128 + wc * 32 + 8 * fq;
#pragma unroll
        for (int ai = 0; ai < 2; ++ai)
#pragma unroll
            for (int m = 0; m < 4; ++m) { bf16* rowp = H + (size_t)(row0 + ai * 128 + m * 16) * FF + col0;
                float o[8];
#pragma unroll
                for (int n = 0; n < 2; ++n)
#pragma unroll
                    for (int e = 0; e < 4; ++e) { const float a = acc[ai][0][m][n][e], b = acc[ai][1][m][n][e]; o[4 * n + e] = a * sigmoid_f(a) * b; }
                u32x4 w; w.x = pk2(o[0], o[1]); w.y = pk2(o[2], o[3]); w.z = pk2(o[4], o[5]); w.w = pk2(o[6], o[7]);
                *(u32x4*)rowp = w; }
        return false;
    }
};
struct EpiInproj {
    unsigned char* ws;
    DI bool operator()(Acc& acc, const Unit& u, int wr, int wc, int fr, int fq) const {
        bf16* O; int ldo, ct; bool half_only = false; float sc = 1.f;
        if (u.g == 1) { O = (bf16*)(ws + WS_KVM); ldo = 1024; ct = u.pn; }
        else if (u.pn < 4) { O = (bf16*)(ws + WS_QKG); ldo = 1024; ct = u.pn; }
        else if (u.pn < 8) { O = (bf16*)(ws + WS_GV); ldo = 1024; ct = u.pn - 4; }
        else if (u.pn < 12) { O = (bf16*)(ws + WS_GR); ldo = 1024; ct = u.pn - 8; }
        else if (u.pn < 18) { O = (bf16*)(ws + WS_DQKV); ldo = 1536; ct = u.pn - 12; if (u.pn < 14) sc = 0.125f * LOG2E; }
        else if (u.pn < 20) { O = (bf16*)(ws + WS_IQ); ldo = 512; ct = u.pn - 18; }
        else { O = (bf16*)(ws + WS_SM); ldo = 128; ct = 0; half_only = true; }
        const int row0 = u.pm * 256 + wr * 64 + fr, col0 = ct * 256 + wc * 32 + 8 * fq;
#pragma unroll
        for (int ai = 0; ai < 2; ++ai)
#pragma unroll
            for (int m = 0; m < 4; ++m) { bf16* rowp = O + (size_t)(row0 + ai * 128 + m * 16) * ldo + col0;
#pragma unroll
                for (int bj = 0; bj < 2; ++bj) { const f32x4 v0 = acc[ai][bj][m][0] * sc, v1 = acc[ai][bj][m][1] * sc;
                    u32x4 w; w.x = pk2(v0[0], v0[1]); w.y = pk2(v0[2], v0[3]); w.z = pk2(v1[0], v1[1]); w.w = pk2(v1[2], v1[3]);
                    if (bj == 0 || !half_only) *(u32x4*)(rowp + bj * 128) = w; } }
        return false;
    }
};
struct EpiMerge {
    const bf16* SGA; const bf16* SGB; bf16* O;
    DI bool operator()(Acc& acc, const Unit& u, int wr, int wc, int fr, int fq) const {
        const int row0 = u.pm * 256 + wr * 64 + fr, col0 = u.pn * 256 + wc * 32 + 8 * fq;
#pragma unroll
        for (int ai = 0; ai < 2; ++ai)
#pragma unroll
            for (int m = 0; m < 4; ++m) { const size_t off = (size_t)(row0 + ai * 128 + m * 16) * 1024 + col0;
#pragma unroll
                for (int bj = 0; bj < 2; ++bj) {
                    const u32x4 gb = *(const u32x4*)(SGB + off + bj * 128);
                    const float b[8] = {bflo(gb.x), bfhi(gb.x), bflo(gb.y), bfhi(gb.y), bflo(gb.z), bfhi(gb.z), bflo(gb.w), bfhi(gb.w)};
                    if (u.g == 0) {
                        const u32x4 ga = *(const u32x4*)(SGA + off + bj * 128);
                        const float a[8] = {bflo(ga.x), bfhi(ga.x), bflo(ga.y), bfhi(ga.y), bflo(ga.z), bfhi(ga.z), bflo(ga.w), bfhi(ga.w)};
#pragma unroll
                        for (int n = 0; n < 2; ++n)
#pragma unroll
                            for (int e = 0; e < 4; ++e) acc[ai][bj][m][n][e] *= a[4 * n + e] * fast_rcp(fmaxf(b[4 * n + e], 1e-30f));
                    } else {
                        const f32x4 v0 = acc[ai][bj][m][0], v1 = acc[ai][bj][m][1];
                        u32x4 w; w.x = pk2(v0[0] * b[0], v0[1] * b[1]); w.y = pk2(v0[2] * b[2], v0[3] * b[3]); w.z = pk2(v1[0] * b[4], v1[1] * b[5]); w.w = pk2(v1[2] * b[6], v1[3] * b[7]);
                        *(u32x4*)(O + off + bj * 128) = w;
                    } } }
        return u.g == 0;
    }
};

constexpr int GP = 272;
struct GlaW { float wu0[16], wu1[16], bb0, bb1; };
DI void gla_la(const bf16* SM, size_t row, const GlaW& W, float& l0, float& l1) {
    const u32x4* gp = (const u32x4*)(SM + row * 128 + 72);
    const u32x4 g0 = gp[0], g1 = gp[1];
    const float ga[16] = {bflo(g0.x), bfhi(g0.x), bflo(g0.y), bfhi(g0.y), bflo(g0.z), bfhi(g0.z), bflo(g0.w), bfhi(g0.w), bflo(g1.x), bfhi(g1.x), bflo(g1.y), bfhi(g1.y), bflo(g1.z), bfhi(g1.z), bflo(g1.w), bfhi(g1.w)};
    float x0 = W.bb0, x1 = W.bb1;
#pragma unroll
    for (int r = 0; r < 16; ++r) { x0 = fmaf(ga[r], W.wu0[r], x0); x1 = fmaf(ga[r], W.wu1[r], x1); }
    l0 = (fminf(x0, 0.f) - __logf(1.f + fast_exp(-fabsf(x0)))) * 0.0625f; l1 = (fminf(x1, 0.f) - __logf(1.f + fast_exp(-fabsf(x1)))) * 0.0625f;
}
struct GlaPre { float pre0, pre1, end0, end1; };
DI void gla_totals(Frame& F, const float* const* in, int h, size_t row0, LAS float* tot, GlaW& W, GlaPre& P) {
    const int l = F.lane, w = F.wave;
    const bf16* SM = (const bf16*)(F.ws + WS_SM);
    const float* wup = in[9]; const float* bal = in[10];
#pragma unroll
    for (int r = 0; r < 16; ++r) { W.wu0[r] = wup[r * 512 + h * 128 + l]; W.wu1[r] = wup[r * 512 + h * 128 + 64 + l]; }
    W.bb0 = bal[h * 128 + l]; W.bb1 = bal[h * 128 + 64 + l];
    float run0 = 0.f, run1 = 0.f;
#pragma unroll 2
    for (int tt = 0; tt < 32; ++tt) { float l0, l1; gla_la(SM, row0 + 32 * w + tt, W, l0, l1); run0 += l0; run1 += l1; }
    tot[w * 128 + l] = run0; tot[w * 128 + 64 + l] = run1;
    __syncthreads();
    float p0 = 0.f, p1 = 0.f, e0 = 0.f, e1 = 0.f;
#pragma unroll
    for (int ww = 0; ww < 8; ++ww) { const float a = tot[ww * 128 + l], b = tot[ww * 128 + 64 + l]; e0 += a; e1 += b; if (ww < w) { p0 += a; p1 += b; } }
    P.pre0 = p0; P.pre1 = p1; P.end0 = e0; P.end1 = e1;
}
DI unsigned tr_lane(int pitch, int hmul, int lane) { const int i16 = lane & 15, q = i16 >> 2, p = i16 & 3, blk = (lane >> 4) & 1; return (unsigned)((hmul * (lane >> 5) + q) * pitch + (16 * blk + 4 * p) * 2); }
DI bf16x8 tr_frag(unsigned base_lane, int pitch, int row_lo, int row_hi, int n0) {
    return cat4(vtr(base_lane + (unsigned)(row_lo * pitch + n0 * 2)), vtr(base_lane + (unsigned)(row_hi * pitch + n0 * 2)));
}
DI void gla_load_v_half(Frame& F, unsigned vh, size_t row0, int h, int half) {
    const bf16* GV = (const bf16*)(F.ws + WS_GV);
#pragma unroll
    for (int it = 0; it < 8; ++it) { const int idx = it * NT + F.tid, row = idx >> 4, ch = idx & 15;
        const u32x4 v = *(const u32x4*)(GV + (row0 + row) * 1024 + h * 256 + half * 128 + ch * 8);
        *(LAS u32x4*)(vh + row * GP + ch * 16) = v; }
}
DI void gla_state_unit(Frame& F, const float* const* in, int u) {
    const int l = F.lane, w = F.wave, hh = l >> 5;
    const int bh = u >> 5, b = bh >> 2, h = bh & 3, sc = u & 31; const size_t row0 = (size_t)b * T + sc * 256;
    const unsigned KH = (unsigned)(size_t)F.lds, VH = KH + 256 * GP; LAS float* tot = (LAS float*)(F.lds + 2 * 256 * GP);
    const bf16* QKG = (const bf16*)(F.ws + WS_QKG);
    float* GST = (float*)(F.ws + WS_GST); float* DEC = (float*)(F.ws + WS_DEC);
    GlaW W; GlaPre P; gla_totals(F, in, h, row0, tot, W, P);
    {
        const bf16* SM = (const bf16*)(F.ws + WS_SM);
        float B0 = P.pre0, B1 = P.pre1;
#pragma unroll 2
        for (int tt = 0; tt < 32; ++tt) { const size_t row = row0 + 32 * w + tt;
            float l0, l1; gla_la(SM, row, W, l0, l1); B0 += l0; B1 += l1;
            const float k0 = bf2f(QKG[row * 1024 + 512 + h * 128 + l]), k1 = bf2f(QKG[row * 1024 + 512 + h * 128 + 64 + l]);
            const float f0 = k0 * fast_exp(P.end0 - B0), f1 = k1 * fast_exp(P.end1 - B1);
            *(LAS bf16*)(KH + (32 * w + tt) * GP + l * 2) = (bf16)(pk2(f0, 0.f) & 0xffffu); *(LAS bf16*)(KH + (32 * w + tt) * GP + (64 + l) * 2) = (bf16)(pk2(f1, 0.f) & 0xffffu); }
    }
    if (w == 0) { DEC[u * 128 + l] = fast_exp(P.end0); DEC[u * 128 + 64 + l] = fast_exp(P.end1); }
    const int etile = w >> 1, dt0 = 2 * (w & 1);
    const unsigned vhl = VH + tr_lane(GP, 8, l) + etile * 64, khl = KH + tr_lane(GP, 8, l) + dt0 * 64;
    for (int half = 0; half < 2; ++half) {
        gla_load_v_half(F, VH, row0, h, half);
        __syncthreads();
        f32x16 acc0, acc1;
#pragma unroll
        for (int r = 0; r < 16; ++r) { acc0[r] = 0.f; acc1[r] = 0.f; }
#pragma unroll 4
        for (int s = 0; s < 16; ++s) {
            const bf16x8 a = tr_frag(vhl, GP, 16 * s, 16 * s + 4, 0);
            const bf16x8 b0 = tr_frag(khl, GP, 16 * s, 16 * s + 4, 0), b1 = tr_frag(khl, GP, 16 * s, 16 * s + 4, 32);
            acc0 = MFMA32(a, b0, acc0); acc1 = MFMA32(a, b1, acc1);
        }
#pragma unroll
        for (int r = 0; r < 16; ++r) { const int e = half * 128 + etile * 32 + crow(r, hh); float* o = GST + ((size_t)u * 256 + e) * 128 + dt0 * 32 + (l & 31); o[0] = acc0[r]; o[32] = acc1[r]; }
        __syncthreads();
    }
}
DI void gla_scan_phase(Frame& F, bool do_store = true) {
    float* GST = (float*)(F.ws + WS_GST); const float* DEC = (const float*)(F.ws + WS_DEC);
    for (int idx = F.c * NT + F.tid; idx < 8 * 16384; idx += F.G * NT) {
        const int bh = idx >> 14, rem = idx & 16383, e = rem >> 6, d = (rem & 63) * 2;
        f32x2 st = {0.f, 0.f};
#pragma unroll 4
        for (int sc = 0; sc < 32; ++sc) { const int u = bh * 32 + sc; f32x2* p = (f32x2*)(GST + ((size_t)u * 256 + e) * 128 + d);
            const f32x2 uu = *p; const f32x2 dc = *(const f32x2*)(DEC + u * 128 + d); if (do_store) *p = st; st = dc * st + uu; }
        if (!do_store && st.x == 1.2345e-30f) GST[0] = st.y;
    }
}
DI void gla_out_unit(Frame& F, const float* const* in, int u, bool do_store = true) {
    const int l = F.lane, w = F.wave, hh = l >> 5;
    const int bh = u >> 5, b = bh >> 2, h = bh & 3, sc = u & 31; const size_t row0 = (size_t)b * T + sc * 256;
    const unsigned QS = (unsigned)(size_t)F.lds, KS = QS + 256 * GP; LAS float* tot = (LAS float*)(F.lds + 2 * 256 * GP);
    const bf16* QKG = (const bf16*)(F.ws + WS_QKG); const float* GST = (const float*)(F.ws + WS_GST); bf16* GR = (bf16*)(F.ws + WS_GR);
    {
        GlaW W; GlaPre P; gla_totals(F, in, h, row0, tot, W, P);
        const bf16* SM = (const bf16*)(F.ws + WS_SM);
        const float qs = 0.08838834764831845f;
        float B0 = P.pre0, B1 = P.pre1;
#pragma unroll 2
        for (int tt = 0; tt < 32; ++tt) { const size_t row = row0 + 32 * w + tt;
            float l0, l1; gla_la(SM, row, W, l0, l1); B0 += l0; B1 += l1;
            const float q0 = bf2f(QKG[row * 1024 + h * 128 + l]), q1 = bf2f(QKG[row * 1024 + h * 128 + 64 + l]);
            const float k0 = bf2f(QKG[row * 1024 + 512 + h * 128 + l]), k1 = bf2f(QKG[row * 1024 + 512 + h * 128 + 64 + l]);
            const unsigned a = QS + (32 * w + tt) * GP + l * 2, bb = KS + (32 * w + tt) * GP + l * 2;
            *(LAS bf16*)(a) = (bf16)(pk2(q0 * qs * fast_exp(B0), 0.f) & 0xffffu); *(LAS bf16*)(a + 128) = (bf16)(pk2(q1 * qs * fast_exp(B1), 0.f) & 0xffffu);
            *(LAS bf16*)(bb) = (bf16)(pk2(k0 * fast_exp(-B0), 0.f) & 0xffffu); *(LAS bf16*)(bb + 128) = (bf16)(pk2(k1 * fast_exp(-B1), 0.f) & 0xffffu); }
    }
    __syncthreads();
    bf16x8 qf[8];
#pragma unroll
    for (int s = 0; s < 8; ++s) qf[s] = lds_b128(QS + (32 * w + (l & 31)) * GP + (16 * s + 8 * hh) * 2);
    __syncthreads();
    f32x16 acc[8];
#pragma unroll
    for (int et = 0; et < 8; ++et)
#pragma unroll
        for (int r = 0; r < 16; ++r) acc[et][r] = 0.f;
    const unsigned VH = QS;
#pragma unroll
    for (int half = 0; half < 2; ++half) {
        gla_load_v_half(F, VH, row0, h, half);
        __syncthreads();
        for (int j = 0; j <= w; ++j) {
            f32x16 X;
#pragma unroll
            for (int r = 0; r < 16; ++r) X[r] = 0.f;
            const unsigned ksj = KS + (l & 31) * GP + 16 * hh + 32 * j * GP, vhj = VH + tr_lane(GP, 4, l) + 32 * j * GP;
#pragma unroll
            for (int s = 0; s < 8; ++s) X = MFMA32(lds_b128(ksj + 32 * s), qf[s], X);
            if (j == w) {
#pragma unroll
                for (int r = 0; r < 16; ++r) if (crow(r, hh) > (l & 31)) X[r] = 0.f;
            }
            const bf16x8 xb0 = pack_step(X, 0), xb1 = pack_step(X, 1);
#pragma unroll
            for (int et = 0; et < 4; ++et) {
                const bf16x8 a0 = tr_frag(vhj, GP, 0, 8, et * 32), a1 = tr_frag(vhj, GP, 16, 24, et * 32);
                acc[half * 4 + et] = MFMA32(a0, xb0, acc[half * 4 + et]); acc[half * 4 + et] = MFMA32(a1, xb1, acc[half * 4 + et]);
            }
        }
        __syncthreads();
    }
    {
        const int soff = (l & 31) * 128 + 8 * hh;
#pragma unroll
        for (int et = 0; et < 8; ++et) {
            const float* sp = GST + (size_t)u * 32768 + et * 4096 + soff;
#pragma unroll
            for (int s = 0; s < 8; s += 2) {
                const f32x4 x0 = *(const f32x4*)(sp + 16 * s), x1 = *(const f32x4*)(sp + 16 * s + 4), x2 = *(const f32x4*)(sp + 16 * s + 16), x3 = *(const f32x4*)(sp + 16 * s + 20);
                acc[et] = MFMA32(pack8(x0.x, x0.y, x0.z, x0.w, x1.x, x1.y, x1.z, x1.w), qf[s], acc[et]);
                acc[et] = MFMA32(pack8(x2.x, x2.y, x2.z, x2.w, x3.x, x3.y, x3.z, x3.w), qf[s + 1], acc[et]);
                asm volatile("" ::: "memory");
            }
        }
    }
    float ss = 0.f;
#pragma unroll
    for (int et = 0; et < 8; ++et)
#pragma unroll
        for (int r = 0; r < 16; ++r) ss += acc[et][r] * acc[et][r];
    ss += __shfl_xor(ss, 32);
    const float rinv = __builtin_amdgcn_rsqf(ss * (1.f / 256.f) + EPS);
    const float* gn = in[11] + h * 256 + 4 * hh;
    bf16* orow = GR + (row0 + 32 * w + (l & 31)) * 1024 + h * 256 + 4 * hh;
#pragma unroll
    for (int et = 0; et < 8; ++et)
#pragma unroll
        for (int g = 0; g < 4; ++g) { const int e = et * 32 + 8 * g;
            const u32x2 gw = *(const u32x2*)(orow + e); const f32x4 gg = *(const f32x4*)(gn + e);
            const float r0 = bflo(gw.x), r1 = bfhi(gw.x), r2 = bflo(gw.y), r3 = bfhi(gw.y);
            u32x2 o; o.x = pk2(acc[et][4 * g] * rinv * gg.x * r0 * sigmoid_f(r0), acc[et][4 * g + 1] * rinv * gg.y * r1 * sigmoid_f(r1));
            o.y = pk2(acc[et][4 * g + 2] * rinv * gg.z * r2 * sigmoid_f(r2), acc[et][4 * g + 3] * rinv * gg.w * r3 * sigmoid_f(r3));
            if (do_store) *(u32x2*)(orow + e) = o; if (g == 3) __builtin_amdgcn_sched_barrier(0); }
}

DI void hist_find4(const u32x4 c, int lane, unsigned k, unsigned& bin, unsigned& above) {
    const unsigned s = c.x + c.y + c.z + c.w; unsigned suf = s;
#pragma unroll
    for (int o = 1; o < 64; o <<= 1) { const unsigned v = __shfl_down(suf, o); if (lane + o < 64) suf += v; }
    const unsigned excl = suf - s;
    const bool cross = excl < k && suf >= k;
    unsigned a = excl, bn = 0, ab = 0;
    if (a + c.w >= k) { bn = 4 * lane + 3; ab = a; } else { a += c.w;
        if (a + c.z >= k) { bn = 4 * lane + 2; ab = a; } else { a += c.z;
            if (a + c.y >= k) { bn = 4 * lane + 1; ab = a; } else { a += c.y; bn = 4 * lane; ab = a; } } }
    const unsigned long long m = __ballot(cross);
    const int src = m ? __builtin_ctzll(m) : 0;
    bin = __shfl(bn, src); above = __shfl(ab, src);
}
constexpr int IDX_H1 = 131072, IDX_H2 = IDX_H1 + 16384;
DI void idx_unit(Frame& F, int u, bool do_store = true, int mode = 0  ) {
    const int l = F.lane, w = F.wave, hh = l >> 5;
    const int b = u >> 10, t0 = (u & 1023) * 8; const size_t row0 = (size_t)b * T + t0;
    const bf16* IQ = (const bf16*)(F.ws + WS_IQ); const bf16* SM = (const bf16*)(F.ws + WS_SM);
    const unsigned SC = (unsigned)(size_t)F.lds; LAS unsigned* H1 = (LAS unsigned*)(F.lds + IDX_H1); LAS unsigned* H2 = (LAS unsigned*)(F.lds + IDX_H2);
    bf16x8 af[2][4]; float wv[2][16];
    {
        const int rho = l & 31;
#pragma unroll
        for (int tl = 0; tl < 2; ++tl) { const int q = 4 * tl + (rho >> 4) + 2 * ((rho >> 2) & 1), head = (rho & 3) + 4 * ((rho >> 3) & 1);
#pragma unroll
            for (int s = 0; s < 4; ++s) af[tl][s] = *(const bf16x8*)(IQ + (row0 + q) * 512 + head * 64 + 16 * s + 8 * hh);
#pragma unroll
            for (int r = 0; r < 16; ++r) { const int qq = 4 * tl + (r >> 3) + 2 * hh, hd = (r & 3) + 4 * ((r >> 2) & 1); wv[tl][r] = bf2f(SM[(row0 + qq) * 128 + 64 + hd]); } }
    }
#pragma unroll
    for (int i = 0; i < 8; ++i) H1[F.tid + i * NT] = 0u;
    __syncthreads();
    const int ntile = t0 / 32 + 1;
    const bf16* kbase = SM + ((size_t)b * T + (l & 31)) * 128 + 8 * hh;
    const unsigned hrep = (unsigned)(l & 3);
#define IDX_TILE(BF, kt_, EDGE) do { const int key = 32 * (kt_) + (l & 31); \
        f32x16 C0, C1; _Pragma("unroll") for (int r = 0; r < 16; ++r) { C0[r] = 0.f; C1[r] = 0.f; } \
        _Pragma("unroll") for (int s = 0; s < 4; ++s) { C0 = MFMA32(af[0][s], BF[s], C0); C1 = MFMA32(af[1][s], BF[s], C1); } \
        asm volatile("s_nop 15\n\ts_nop 7" : "+v"(C0), "+v"(C1));     \
        _Pragma("unroll") for (int tl = 0; tl < 2; ++tl) _Pragma("unroll") for (int b4 = 0; b4 < 2; ++b4) { \
            float sc = 0.f; \
            _Pragma("unroll") for (int r = 0; r < 8; ++r) { float m_; asm("v_max_f32_e32 %0, 0, %1" : "=v"(m_) : "v"(tl ? C1[8 * b4 + r] : C0[8 * b4 + r])); sc = fmaf(wv[tl][8 * b4 + r], m_, sc); } \
            const int q = 4 * tl + b4 + 2 * hh; \
            const _Float16 hf = (_Float16)sc; unsigned h16 = (unsigned)__builtin_bit_cast(unsigned short, hf); \
            unsigned k16 = (h16 & 0x8000u) ? (~h16 & 0xffffu) : (h16 | 0x8000u); \
            if (EDGE) { const bool valid = key <= t0 + q; if (!valid) k16 = 0u; \
                if (mode != 3) *(LAS unsigned short*)(SC + q * 16384 + key * 2) = (unsigned short)k16; \
                if (valid && mode != 3 && mode != 6) __hip_atomic_fetch_add(H1 + (q * 256 + (k16 >> 8)) * 2 + (hrep >> 1), 1u << (16 * (hrep & 1)), __ATOMIC_RELAXED, __HIP_MEMORY_SCOPE_WORKGROUP); } \
            else { if (mode != 3) *(LAS unsigned short*)(SC + q * 16384 + key * 2) = (unsigned short)k16; \
                if (mode != 3 && mode != 6) __hip_atomic_fetch_add(H1 + (q * 256 + (k16 >> 8)) * 2 + (hrep >> 1), 1u << (16 * (hrep & 1)), __ATOMIC_RELAXED, __HIP_MEMORY_SCOPE_WORKGROUP); } } } while (0)
#define IDX_LOAD(BF, kt_) do { _Pragma("unroll") for (int s = 0; s < 4; ++s) BF[s] = *(const bf16x8*)(kbase + (size_t)(32 * (kt_)) * 128 + 16 * s); } while (0)
    bf16x8 bA[4], bB[4];
    const int klast = ntile - 1;
    IDX_LOAD(bA, w < ntile ? w : klast);
    if (mode != 2)
    for (int kt = w; kt < ntile; kt += 16) {
        if (mode != 4) IDX_LOAD(bB, kt + 8 < ntile ? kt + 8 : klast);
        if (kt == klast) IDX_TILE(bA, kt, true); else IDX_TILE(bA, kt, false);
        if (mode != 4) IDX_LOAD(bA, kt + 16 < ntile ? kt + 16 : klast);
        if (kt + 8 < ntile) { if (kt + 8 == klast) IDX_TILE(bB, kt + 8, true); else IDX_TILE(bB, kt + 8, false); }
    }
#undef IDX_TILE
#undef IDX_LOAD
    __syncthreads();
    if (mode == 0 || mode == 2)
    {
        const int t = t0 + w, n = t + 1, nit = (n + 511) >> 9;
        unsigned char* mrow = (unsigned char*)(F.ws + WS_IQ) + (row0 + w) * 1024;
        const unsigned scq = SC + w * 16384 + l * 16;
        LAS unsigned* H = H2 + w * 256;
        unsigned thr = 0u, rneed = 0u;
        if (n > 256) {
            unsigned B, above, L, above2;
            {
                const u32x4 a = *(const LAS u32x4*)(H1 + (w * 256 + 4 * l) * 2), bq = *(const LAS u32x4*)(H1 + (w * 256 + 4 * l) * 2 + 4);
                u32x4 cnt; cnt.x = (a.x & 0xffffu) + (a.x >> 16) + (a.y & 0xffffu) + (a.y >> 16); cnt.y = (a.z & 0xffffu) + (a.z >> 16) + (a.w & 0xffffu) + (a.w >> 16);
                cnt.z = (bq.x & 0xffffu) + (bq.x >> 16) + (bq.y & 0xffffu) + (bq.y >> 16); cnt.w = (bq.z & 0xffffu) + (bq.z >> 16) + (bq.w & 0xffffu) + (bq.w >> 16);
                hist_find4(cnt, l, 256u, B, above);
            }
            H[l] = 0u; H[l + 64] = 0u; H[l + 128] = 0u; H[l + 192] = 0u; LDS_WAIT();
            for (int it = 0; it < nit; ++it) { const u32x4 kk = *(const LAS u32x4*)(scq + it * 1024); const int i0 = 512 * it + 8 * l;
                const unsigned ks[8] = {kk.x & 0xffffu, kk.x >> 16, kk.y & 0xffffu, kk.y >> 16, kk.z & 0xffffu, kk.z >> 16, kk.w & 0xffffu, kk.w >> 16};
                bool m[8], any = false;
#pragma unroll
                for (int j = 0; j < 8; ++j) { m[j] = (i0 + j < n) && (ks[j] >> 8) == B; any = any || m[j]; }
                if (__ballot(any) == 0ull) continue;
#pragma unroll
                for (int j = 0; j < 8; ++j) if (m[j]) __hip_atomic_fetch_add(H + (ks[j] & 255u), 1u, __ATOMIC_RELAXED, __HIP_MEMORY_SCOPE_WORKGROUP); }
            LDS_WAIT(); hist_find4(*(const LAS u32x4*)(H + 4 * l), l, 256u - above, L, above2);
            thr = (B << 8) | L; rneed = 256u - above - above2;
        }
        unsigned running = 0u;
        for (int it = 0; it < nit; ++it) {
            const u32x4 kk = *(const LAS u32x4*)(scq + it * 1024); const int i0 = 512 * it + 8 * l;
            const unsigned ks[8] = {kk.x & 0xffffu, kk.x >> 16, kk.y & 0xffffu, kk.y >> 16, kk.z & 0xffffu, kk.z >> 16, kk.w & 0xffffu, kk.w >> 16};
            unsigned byte = 0u;
            if (n <= 256) {
#pragma unroll
                for (int j = 0; j < 8; ++j) byte |= (i0 + j < n) ? (1u << j) : 0u;
            } else {
                bool eq[8]; bool anyeq = false;
#pragma unroll
                for (int j = 0; j < 8; ++j) { eq[j] = (i0 + j < n) && ks[j] == thr; anyeq = anyeq || eq[j]; byte |= ((i0 + j < n) && ks[j] > thr) ? (1u << j) : 0u; }
                const unsigned long long anym = __ballot(anyeq);
                if (anym != 0ull) {
                    unsigned mine = 0u;
#pragma unroll
                    for (int j = 0; j < 8; ++j) mine += eq[j] ? 1u : 0u;
                    unsigned before = 0u; unsigned long long mm = anym;
                    while (mm) { const int src = __builtin_ctzll(mm); mm &= mm - 1; const unsigned v = (unsigned)__shfl((int)mine, src); if (src < l) before += v; }
                    unsigned cum = running + before; unsigned tot = 0u; mm = anym;
                    while (mm) { const int src = __builtin_ctzll(mm); mm &= mm - 1; tot += (unsigned)__shfl((int)mine, src); }
#pragma unroll
                    for (int j = 0; j < 8; ++j) { if (eq[j]) { if (cum < rneed) byte |= (1u << j); ++cum; } }
                    running += tot;
                }
            }
            if (do_store) mrow[it * 64 + l] = (unsigned char)byte;
        }
    }
    __syncthreads();
}

template <int DH, bool DSA, int VAR = 0>
DI void attn_unit(Frame& F, const bf16* Qp, int ldq, const bf16* Kp, const bf16* Vp, int ldkv, int nst, bf16* Op, int ldo, float c1,
                  const unsigned* mask0  , int tq0, const LAS float* BT, float cfar, bool do_store = true) {
    constexpr int PK = DH * 2 + 16  , PV = DH == 64 ? 192 : 320  ;
    constexpr int SBK = 64 * PK, SBV = 64 * PV, NS = DH / 16, ND = DH / 32, CH = DH / 8  , NLD = 64 * CH / NT;
    const int l = F.lane, w = F.wave, hh = l >> 5, tid = F.tid;
    const unsigned KT = (unsigned)(size_t)F.lds, VT = KT + 2 * SBK;
    const unsigned klane = (unsigned)((l & 31) * PK + 16 * hh), vlane = tr_lane(PV, 4, l);
    bf16x8 qf[NS];
#pragma unroll
    for (int s = 0; s < NS; ++s) qf[s] = *(const bf16x8*)(Qp + (size_t)(32 * w + (l & 31)) * ldq + 16 * s + 8 * hh);
    f32x16 O[ND];
#pragma unroll
    for (int d = 0; d < ND; ++d)
#pragma unroll
        for (int r = 0; r < 16; ++r) O[d][r] = 0.f;
    float lsum = 0.f;
    const int tq = tq0 + 32 * w + (l & 31), tq_hi = tq0 + 32 * w + 31, tq_lo = tq0 + 32 * w;
    const unsigned* mrow = DSA ? mask0 + (size_t)(32 * w + (l & 31)) * 256 : nullptr;
    u32x4 kr[NLD], vr[NLD];
    u32x2 mcur = {0u, 0u}, mnxt = {0u, 0u};
    if (DSA) mcur = *(const u32x2*)mrow;
#pragma unroll
    for (int i = 0; i < NLD; ++i) { const int idx = i * NT + tid, row = idx / CH, ch = idx % CH;
        kr[i] = *(const u32x4*)(Kp + (size_t)row * ldkv + ch * 8); vr[i] = *(const u32x4*)(Vp + (size_t)row * ldkv + ch * 8); }
#pragma unroll
    for (int i = 0; i < NLD; ++i) { const int idx = i * NT + tid, row = idx / CH, ch = idx % CH;
        *(LAS u32x4*)(KT + row * PK + ch * 16) = kr[i]; *(LAS u32x4*)(VT + row * PV + ch * 16) = vr[i]; }
    __syncthreads();
    __builtin_amdgcn_s_waitcnt(0x0F70);
    for (int st = 0; st < nst; ++st) {
        const unsigned kt = KT + (st & 1) * SBK, vt = VT + (st & 1) * SBV;
        const bool more = st + 1 < nst;
        if (more) {
#pragma unroll
            for (int i = 0; i < NLD; ++i) { const int idx = i * NT + tid, row = 64 * (st + 1) + idx / CH, ch = idx % CH;
                kr[i] = *(const u32x4*)(Kp + (size_t)row * ldkv + ch * 8); vr[i] = *(const u32x4*)(Vp + (size_t)row * ldkv + ch * 8); }
            if (DSA) mnxt = *(const u32x2*)(mrow + 2 * (st + 1));
        }
#pragma unroll
        for (int kb = 0; kb < 2; ++kb) {
            const int key0 = 64 * st + 32 * kb;
            if (VAR == 3) continue;
            if (DSA && key0 > tq_hi) continue;
            f32x16 X;
#pragma unroll
            for (int r = 0; r < 16; ++r) X[r] = 0.f;
#pragma unroll
            for (int s = 0; s < NS; ++s) X = MFMA32(lds_b128(kt + klane + 32 * kb * PK + 32 * s), qf[s], X);
            if (VAR == 2) { lsum += X[0]; }
            else if (DSA) {
                const unsigned mw = (kb ? mcur.y : mcur.x) >> (4 * hh);
                if (tq_lo - (key0 + 31) >= 113) {
#pragma unroll
                    for (int r = 0; r < 16; ++r) { const float p = fast_exp2(fmaf(X[r], c1, cfar)); const int bits = __builtin_amdgcn_sbfe((int)mw, (r & 3) + 8 * (r >> 2), 1);
                        const float pm = __uint_as_float(__float_as_uint(p) & (unsigned)bits); lsum += pm; X[r] = pm; }
                } else {
#pragma unroll
                    for (int r = 0; r < 16; ++r) { int di = tq - (key0 + crow(r, hh)); di = di < 0 ? 0 : (di > 127 ? 127 : di);
                        const float p = fast_exp2(fmaf(X[r], c1, BT[di])); const int bits = __builtin_amdgcn_sbfe((int)mw, (r & 3) + 8 * (r >> 2), 1);
                        const float pm = __uint_as_float(__float_as_uint(p) & (unsigned)bits); lsum += pm; X[r] = pm; }
                }
            } else {
#pragma unroll
                for (int r = 0; r < 16; ++r) { const float p = fast_exp2(X[r] * c1); lsum += p; X[r] = p; }
            }
            const bf16x8 xb0 = pack_step(X, 0), xb1 = pack_step(X, 1);
            if (VAR == 1) { asm volatile("" :: "v"(xb0), "v"(xb1)); }
            else {
#pragma unroll
            for (int d = 0; d < ND; ++d) {
                const bf16x8 a0 = tr_frag(vt + vlane, PV, 32 * kb, 32 * kb + 8, 32 * d), a1 = tr_frag(vt + vlane, PV, 32 * kb + 16, 32 * kb + 24, 32 * d);
                O[d] = MFMA32(a0, xb0, O[d]); O[d] = MFMA32(a1, xb1, O[d]);
            } }
        }
        asm volatile("" ::: "memory"); __builtin_amdgcn_sched_barrier(0);
        if (more) {
            const unsigned kn = KT + ((st + 1) & 1) * SBK, vn = VT + ((st + 1) & 1) * SBV;
#pragma unroll
            for (int i = 0; i < NLD; ++i) { const int idx = i * NT + tid, row = idx / CH, ch = idx % CH;
                *(LAS u32x4*)(kn + row * PK + ch * 16) = kr[i]; *(LAS u32x4*)(vn + row * PV + ch * 16) = vr[i]; }
            mcur = mnxt;
        }
        __syncthreads();
    }
    lsum += __shfl_xor(lsum, 32);
    const float inv = fast_rcp(lsum);
    bf16* orow = Op + (size_t)(32 * w + (l & 31)) * ldo;
#pragma unroll
    for (int d = 0; d < ND; ++d)
#pragma unroll
        for (int g = 0; g < 4; ++g) { u32x2 o; o.x = pk2(O[d][4 * g] * inv, O[d][4 * g + 1] * inv); o.y = pk2(O[d][4 * g + 2] * inv, O[d][4 * g + 3] * inv);
            if (do_store) *(u32x2*)(orow + 32 * d + 8 * g + 4 * hh) = o; }
}
DI int t5_bucket(int rel) {
    if (rel < 16) return rel;
    const float v = logf((float)rel * (1.f / 16.f)) / 2.0794415416798357f * 16.f;
    int lg = 16 + (int)v; return lg > 31 ? 31 : lg;
}
constexpr int A_PK = 144, A_PV = 192, A_SK = 128 * A_PK, A_SV = 128 * A_PV, A_BT = 2 * A_SK + 2 * A_SV;
#define A_SMR(r, pos) { const float p_ = (VAR == 4) ? X[r] : fast_exp2(X[r]); int t_ = -1; if (VAR != 5) asm("v_bfe_i32 %0, %1, %2, 1" : "=v"(t_) : "v"(mw_), "i"(pos)); const float pm_ = (VAR == 5) ? p_ : __uint_as_float(__float_as_uint(p_) & (unsigned)t_); if (VAR != 6) lsum += pm_; X[r] = pm_; }
#define A_SM16() do { A_SMR(0, 0) A_SMR(1, 1) A_SMR(2, 2) A_SMR(3, 3) A_SMR(4, 8) A_SMR(5, 9) A_SMR(6, 10) A_SMR(7, 11) A_SMR(8, 16) A_SMR(9, 17) A_SMR(10, 18) A_SMR(11, 19) A_SMR(12, 24) A_SMR(13, 25) A_SMR(14, 26) A_SMR(15, 27) } while (0)
template <int VAR = 0>
DI void dsa_att_unit(Frame& F, const float* const* in, int bh, int qb, bool do_store = true) {
    const int b = bh >> 3, h = bh & 7, l = F.lane, w = F.wave, hh = l >> 5, tid = F.tid;
    LAS float* BT = (LAS float*)(F.lds + A_BT);
    const float* tab = in[14];
    __syncthreads();
    if (tid < 128) BT[tid] = tab[t5_bucket(tid) * 8 + h] * LOG2E;
    const float cfar = tab[31 * 8 + h] * LOG2E;
    bf16* DQ = (bf16*)(F.ws + WS_DQKV);
    const size_t rowq = (size_t)b * T + qb * 256, rowk = (size_t)b * T;
    const bf16* Kp = DQ + rowk * 1536 + 512 + h * 64; const bf16* Vp = DQ + rowk * 1536 + 1024 + h * 64;
    const unsigned KT = (unsigned)(size_t)F.lds, VT = KT + 2 * A_SK;
    const unsigned klane = (unsigned)((l & 31) * A_PK + 16 * hh), vlane = tr_lane(A_PV, 4, l);
    bf16x8 qf[4];
#pragma unroll
    for (int s = 0; s < 4; ++s) qf[s] = *(const bf16x8*)(DQ + (rowq + 32 * w + (l & 31)) * 1536 + h * 64 + 16 * s + 8 * hh);
    f32x16 O[2], cf16;
#pragma unroll
    for (int r = 0; r < 16; ++r) { O[0][r] = 0.f; O[1][r] = 0.f; cf16[r] = cfar; }
    float lsum = 0.f;
    const int tq = qb * 256 + 32 * w + (l & 31), tq_lo = qb * 256 + 32 * w, tq_hi = tq_lo + 31, nst = 2 * (qb + 1);
    const u32x4* mrow = (const u32x4*)((const unsigned*)(F.ws + WS_IQ) + (rowq + 32 * w + (l & 31)) * 256);
    u32x4 kr[2], vr[2], mcur = mrow[0], mnxt = mcur;
#pragma unroll
    for (int i = 0; i < 2; ++i) { const int idx = i * NT + tid, row = idx >> 3, ch = idx & 7;
        kr[i] = *(const u32x4*)(Kp + (size_t)row * 1536 + ch * 8); vr[i] = *(const u32x4*)(Vp + (size_t)row * 1536 + ch * 8); }
#pragma unroll
    for (int i = 0; i < 2; ++i) { const int idx = i * NT + tid, row = idx >> 3, ch = idx & 7;
        *(LAS u32x4*)(KT + row * A_PK + ch * 16) = kr[i]; *(LAS u32x4*)(VT + row * A_PV + ch * 16) = vr[i]; }
    __syncthreads();
#define A_QK(Xv, kb, CI) do { Xv = MFMA32(lds_b128(kt + klane + 32 * (kb) * A_PK), qf[0], CI); Xv = MFMA32(lds_b128(kt + klane + 32 * (kb) * A_PK + 32), qf[1], Xv); \
        Xv = MFMA32(lds_b128(kt + klane + 32 * (kb) * A_PK + 64), qf[2], Xv); Xv = MFMA32(lds_b128(kt + klane + 32 * (kb) * A_PK + 96), qf[3], Xv); } while (0)
#define A_PVM(Xv, kb) do { const bf16x8 xb0_ = pack_step(Xv, 0), xb1_ = pack_step(Xv, 1); _Pragma("unroll") for (int d = 0; d < 2; ++d) { \
        const bf16x8 a0_ = tr_frag(vt + vlane, A_PV, 32 * (kb), 32 * (kb) + 8, 32 * d), a1_ = tr_frag(vt + vlane, A_PV, 32 * (kb) + 16, 32 * (kb) + 24, 32 * d); \
        O[d] = MFMA32(a0_, xb0_, O[d]); O[d] = MFMA32(a1_, xb1_, O[d]); } } while (0)
    __builtin_amdgcn_s_waitcnt(0x0F70);
    for (int st = 0; st < nst; ++st) {
        const unsigned kt = KT + (st & 1) * A_SK, vt = VT + (st & 1) * A_SV;
        const bool more = st + 1 < nst;
        if (more) {
#pragma unroll
            for (int i = 0; i < 2; ++i) { const int idx = i * NT + tid, row = 128 * (st + 1) + (idx >> 3), ch = idx & 7;
                kr[i] = *(const u32x4*)(Kp + (size_t)row * 1536 + ch * 8); vr[i] = *(const u32x4*)(Vp + (size_t)row * 1536 + ch * 8); }
            mnxt = mrow[st + 1];
        }
        asm volatile("" ::: "memory"); __builtin_amdgcn_sched_barrier(0);
        if (VAR != 3) {
        if (tq_lo - (128 * st + 127) >= 113) {
            f32x16 X, Y;
            A_QK(X, 0, cf16); A_QK(Y, 1, cf16);
            { const unsigned mw_ = mcur.x >> (4 * hh); A_SM16(); } A_PVM(X, 0);
            A_QK(X, 2, cf16);
            { f32x16& Xr = Y; const unsigned mw_ = mcur.y >> (4 * hh);
#define X Xr
              A_SM16();
#undef X
            } A_PVM(Y, 1);
            A_QK(Y, 3, cf16);
            { const unsigned mw_ = mcur.z >> (4 * hh); A_SM16(); } A_PVM(X, 2);
            { f32x16& Xr = Y; const unsigned mw_ = mcur.w >> (4 * hh);
#define X Xr
              A_SM16();
#undef X
            } A_PVM(Y, 3);
        } else {
#pragma unroll
            for (int kb = 0; kb < 4; ++kb) {
                const int key0 = 128 * st + 32 * kb;
                if (key0 > tq_hi) continue;
                f32x16 X, zero;
#pragma unroll
                for (int r = 0; r < 16; ++r) zero[r] = 0.f;
                const unsigned mw_ = (kb == 0 ? mcur.x : kb == 1 ? mcur.y : kb == 2 ? mcur.z : mcur.w) >> (4 * hh);
                if (tq_lo - (key0 + 31) >= 113) { A_QK(X, kb, cf16); }
                else { A_QK(X, kb, zero);
#pragma unroll
                    for (int r = 0; r < 16; ++r) { int di = tq - (key0 + crow(r, hh)); di = di < 0 ? 0 : (di > 127 ? 127 : di); X[r] += BT[di]; } }
                A_SM16();
                A_PVM(X, kb);
            }
        }
        }
        asm volatile("" ::: "memory"); __builtin_amdgcn_sched_barrier(0);
        if (more) {
            const unsigned kn = KT + ((st + 1) & 1) * A_SK, vn = VT + ((st + 1) & 1) * A_SV;
#pragma unroll
            for (int i = 0; i < 2; ++i) { const int idx = i * NT + tid, row = idx >> 3, ch = idx & 7;
                *(LAS u32x4*)(kn + row * A_PK + ch * 16) = kr[i]; *(LAS u32x4*)(vn + row * A_PV + ch * 16) = vr[i]; }
            mcur = mnxt;
        }
        __syncthreads();
    }
#undef A_QK
#undef A_PVM
    lsum += __shfl_xor(lsum, 32);
    const float inv = fast_rcp(lsum);
    bf16* orow = DQ + (rowq + 32 * w + (l & 31)) * 1536 + h * 64;
#pragma unroll
    for (int d = 0; d < 2; ++d)
#pragma unroll
        for (int g = 0; g < 4; ++g) { u32x2 o; o.x = pk2(O[d][4 * g] * inv, O[d][4 * g + 1] * inv); o.y = pk2(O[d][4 * g + 2] * inv, O[d][4 * g + 3] * inv);
            if (do_store) *(u32x2*)(orow + 32 * d + 8 * g + 4 * hh) = o; }
}
DI void cross_att_unit(Frame& F, int u) {
    const int b = u >> 7, h = (u >> 5) & 3, qb = u & 31;
    const bf16* QC = (const bf16*)(F.ws + WS_QC); const bf16* KVM = (const bf16*)(F.ws + WS_KVM); bf16* OX = (bf16*)(F.ws + WS_OX);
    const size_t rowq = (size_t)b * T + qb * 256;
    __syncthreads();
    attn_unit<128, false>(F, QC + rowq * 512 + h * 128, 512, KVM + (size_t)b * MEML * 1024 + h * 128, KVM + (size_t)b * MEML * 1024 + 512 + h * 128, 1024, MEML / 64,
                          OX + rowq * 512 + h * 128, 512, 0.08838834764831845f * LOG2E, nullptr, 0, nullptr, 0.f);
}

constexpr int N_PHASES = 19;
#ifndef MK_ONE_LAUNCH
#define MK_ONE_LAUNCH 1
#endif
__global__ void __launch_bounds__(NT, 2) mega_fwd(Args args) {
    extern __shared__ __attribute__((aligned(16))) unsigned char lds_raw[];
    Frame F;
    F.lds = (LAS unsigned char*)lds_raw; F.ws = args.ws;
    F.tid = threadIdx.x; F.lane = F.tid & 63; F.wave = __builtin_amdgcn_readfirstlane(F.tid >> 6);
    F.G = gridDim.x; F.c = blockIdx.x;
    volatile LAS unsigned* MISC = (volatile LAS unsigned*)(F.lds + MISC_OFF);
    if (F.tid < 64) MISC[F.tid] = 0u;
    __syncthreads();
    unsigned* ctl = (unsigned*)(args.ws + WS_CTL);
    const int lo = args.ph_lo, hi = args.ph_hi;
    XcdBarrier bar; bar.bar = ctl + CW_BAR; bar.x = 0; bar.st = MISC + 8;
    if (hi - lo > 1) bar = xcd_barrier_post(ctl + CW_BAR, MISC + 8);
    const float* const* in = args.in;
    const bool st_ok = args.nostore == 0; const int sub = args.sub;
    unsigned char* ws = args.ws;
    const int gw = F.c * NWAVES + F.wave, NGW = F.G * NWAVES;
#ifndef PHMASK
#define PHMASK 0x7ffff
#endif
#define IN(k) (((PHMASK >> (k)) & 1) && lo <= (k) && (k) < hi)
#define SEAM(k) do { if ((k) + 1 < hi) xcd_barrier(bar); } while (0)
#ifndef DUP_PHASE
#define DUP_PHASE -1
#endif
#ifndef DUP_N
#define DUP_N 1
#endif
#define REPS(k) ((k) == DUP_PHASE ? 1 + DUP_N : 1)
#define FORREP(k) _Pragma("unroll 1") for (int rep = 0; rep < REPS(k); ++rep)
#define ST(k) (st_ok)
#define REPBAR(k) do { if (rep + 1 < REPS(k)) xcd_barrier(bar); } while (0)
    bf16* XN = (bf16*)(ws + WS_XN); bf16* HID = (bf16*)(ws + WS_HID); bf16* Y = (bf16*)(ws + WS_Y);
    bf16* W1A = (bf16*)(ws + WS_W1A); bf16* W1B = (bf16*)(ws + WS_W1B);

    if (IN(0)) { FORREP(0) {
        LAS float* scr = (LAS float*)(F.lds + F.wave * 16384);
        constexpr int NITEMS = 10240;
        for (int it0 = gw; it0 < NITEMS; it0 += NGW) { int it = it0;
            if (conv_job(it, in[4], 2 * FF, D, 2 * FF / 32, W1A, D, ColFfn{}, scr, F.lane)) continue;
            if (conv_job(it, in[5], D, FF, D / 32, W1B, FF, ColIdent{0}, scr, F.lane)) continue;
            if (conv_job(it, in[8], 7256, D, NIN / 32, (bf16*)(ws + WS_WIN), D, ColInproj{}, scr, F.lane)) continue;
            if (conv_job(it, in[8], 7256, D, 2048 / 32, (bf16*)(ws + WS_WGT), D, ColIdent{5208}, scr, F.lane)) continue;
            if (conv_job(it, in[12], D, D, D / 32, (bf16*)(ws + WS_WG), D, ColIdent{0}, scr, F.lane)) continue;
            if (conv_job(it, in[13], D, 512, D / 32, (bf16*)(ws + WS_WD), 512, ColIdent{0}, scr, F.lane)) continue;
            if (conv_job(it, in[15], D, D, D / 32, (bf16*)(ws + WS_WO), D, ColIdent{0}, scr, F.lane)) continue;
            if (conv_job(it, in[19], 512, D, 512 / 32, (bf16*)(ws + WS_WCQ), D, ColIdent{0}, scr, F.lane)) continue;
            if (conv_job(it, in[20], D, D, D / 32, (bf16*)(ws + WS_WCKV), D, ColIdent{0}, scr, F.lane)) continue;
            conv_job(it, in[21], D, 512, D / 32, (bf16*)(ws + WS_WCO), 512, ColIdent{0}, scr, F.lane);
        }
        { int m = gw;
          for (; m + 3 * NGW < M; m += 4 * NGW) rms_rows_bf16<4>(in[0] + (size_t)m * D, in[2], XN + (size_t)m * D, F.lane, (size_t)NGW * D);
          for (; m < M; m += NGW) rms_rows_bf16<1>(in[0] + (size_t)m * D, in[2], XN + (size_t)m * D, F.lane, 0); }
        for (int m = gw; m < BATCH * MEML; m += NGW) rms_rows_bf16<1>(in[1] + (size_t)m * D, in[16], (bf16*)(ws + WS_MEMN) + (size_t)m * D, F.lane, 0);
        REPBAR(0); }
        SEAM(0);
    }
    if (IN(1)) {
        pg8::Order1 S; S.init(pg8::GDesc{XN, W1A, D, D, D, M / 256, 2 * FF / 256}, F.G, F.c);
        FORREP(1) { pg8::gemm_phase<true>(F.lds, S, EpiSwiglu{HID}); REPBAR(1); }
        SEAM(1);
    }
    if (IN(2)) {
        pg8::Order1 S; S.init(pg8::GDesc{HID, W1B, FF, FF, FF, M / 256, D / 256}, F.G, F.c);
        FORREP(2) { pg8::gemm_phase<true>(F.lds, S, EpiStore{Y, D}); REPBAR(2); }
        SEAM(2);
    }
    if (IN(3)) { FORREP(3) { resnorm_phase(F, in[0], Y, in[3], 0.5f, args.out, in[6], XN, ST(3)); REPBAR(3); } SEAM(3); }
    if (IN(4)) {
        pg8::Order2 S; S.d0 = pg8::GDesc{XN, (const bf16*)(ws + WS_WIN), D, D, D, M / 256, NIN / 256};
        S.d1 = pg8::GDesc{(const bf16*)(ws + WS_MEMN), (const bf16*)(ws + WS_WCKV), D, D, D, BATCH * MEML / 256, D / 256}; S.G = F.G; S.c = F.c;
        FORREP(4) { pg8::gemm_phase<true>(F.lds, S, EpiInproj{ws}); REPBAR(4); }
        SEAM(4);
    }
    if (IN(5)) {
        FORREP(5) {
        if (sub <= 0) { for (int u = F.c; u < 256; u += F.G) gla_state_unit(F, in, u); __syncthreads(); }
        if (sub != 0) for (int k = 0; k * F.G < 2048; ++k) { const int u = k * F.G + ((k & 1) ? F.G - 1 - F.c : F.c); if (u < 2048) idx_unit(F, u, ST(5), sub >= 2 ? sub - 1 : 0); }
        REPBAR(5); }
        SEAM(5);
    }
    if (IN(6)) {
        FORREP(6) {
        if (sub != 1) gla_scan_phase(F, ST(6));
#ifdef PROBE_EXTRA_PHASE
        if (sub >= 2) { for (int p = F.c; p < 256; p += F.G) { const int bh = p >> 4, x = p & 15;
            if (sub == 2) { dsa_att_unit<1>(F, in, bh, x, false); dsa_att_unit<1>(F, in, bh, 31 - x, false); }
            if (sub == 3) { dsa_att_unit<3>(F, in, bh, x, false); dsa_att_unit<3>(F, in, bh, 31 - x, false); }
            if (sub == 4) { dsa_att_unit<4>(F, in, bh, x, false); dsa_att_unit<4>(F, in, bh, 31 - x, false); }
            if (sub == 5) { dsa_att_unit<5>(F, in, bh, x, false); dsa_att_unit<5>(F, in, bh, 31 - x, false); }
            if (sub == 6) { dsa_att_unit<6>(F, in, bh, x, false); dsa_att_unit<6>(F, in, bh, 31 - x, false); } } } else
#endif
        if (sub != 0) for (int p = F.c; p < 256; p += F.G) { const int bh = p >> 4, x = p & 15; dsa_att_unit(F, in, bh, x, ST(6)); dsa_att_unit(F, in, bh, 31 - x, ST(6)); }
        REPBAR(6); }
        SEAM(6);
    }
    if (IN(7)) {
        FORREP(7) { for (int u = F.c; u < 256; u += F.G) { gla_out_unit(F, in, u, ST(7)); __syncthreads(); } REPBAR(7); }
        SEAM(7);
    }
    if (IN(8)) {
        pg8::Order1 S; S.init(pg8::GDesc{XN, (const bf16*)(ws + WS_WGT), D, D, D, M / 256, 2048 / 256}, F.G, F.c);
        FORREP(8) { pg8::gemm_phase<true>(F.lds, S, EpiGates{(bf16*)(ws + WS_SGA), (bf16*)(ws + WS_SGB)}); REPBAR(8); }
        SEAM(8);
    }
    if (IN(9)) {
        pg8::PairOrder S; S.d0 = pg8::GDesc{(const bf16*)(ws + WS_GR), (const bf16*)(ws + WS_WG), D, D, D, M / 256, D / 256};
        S.d1 = pg8::GDesc{(const bf16*)(ws + WS_DQKV), (const bf16*)(ws + WS_WD), 1536, 512, 512, M / 256, D / 256}; S.G = F.G; S.c = F.c;
        FORREP(9) { pg8::gemm_phase<false>(F.lds, S, EpiMerge{(const bf16*)(ws + WS_SGA), (const bf16*)(ws + WS_SGB), (bf16*)(ws + WS_MRG)}); REPBAR(9); }
        SEAM(9);
    }
    if (IN(10)) {
        pg8::Order1 S; S.init(pg8::GDesc{(const bf16*)(ws + WS_MRG), (const bf16*)(ws + WS_WO), D, D, D, M / 256, D / 256}, F.G, F.c);
        FORREP(10) { pg8::gemm_phase<true>(F.lds, S, EpiStore{(bf16*)(ws + WS_Y2), D}); REPBAR(10); }
        SEAM(10);
    }
    if (IN(11)) {
        FORREP(11) {
        resnorm_phase(F, args.out, (const bf16*)(ws + WS_Y2), in[7], 1.0f, args.out, in[17], XN, ST(11));
        LAS float* scr = (LAS float*)(F.lds + F.wave * 16384);
        constexpr int NITEMS = 2816 + 1408;
        for (int it0 = gw; it0 < NITEMS; it0 += NGW) { int it = it0;
            if (conv_job(it, in[24], 2 * FF, D, 2 * FF / 32, W1A, D, ColFfn{}, scr, F.lane)) continue;
            conv_job(it, in[25], D, FF, D / 32, W1B, FF, ColIdent{0}, scr, F.lane);
        }
        REPBAR(11); }
        SEAM(11);
    }
    if (IN(12)) {
        pg8::Order1 S; S.init(pg8::GDesc{XN, (const bf16*)(ws + WS_WCQ), D, D, D, M / 256, 512 / 256}, F.G, F.c);
        FORREP(12) { pg8::gemm_phase<true>(F.lds, S, EpiStore{(bf16*)(ws + WS_QC), 512}); REPBAR(12); }
        SEAM(12);
    }
    if (IN(13)) {
        FORREP(13) { for (int u = F.c; u < 256; u += F.G) cross_att_unit(F, u); REPBAR(13); }
        SEAM(13);
    }
    if (IN(14)) {
        pg8::Order1 S; S.init(pg8::GDesc{(const bf16*)(ws + WS_OX), (const bf16*)(ws + WS_WCO), 512, 512, 512, M / 256, D / 256}, F.G, F.c);
        FORREP(14) { pg8::gemm_phase<true>(F.lds, S, EpiStore{(bf16*)(ws + WS_Y3), D}); REPBAR(14); }
        SEAM(14);
    }
    if (IN(15)) { FORREP(15) { resnorm_phase(F, args.out, (const bf16*)(ws + WS_Y3), in[18], 1.0f, args.out, in[22], XN, ST(15)); REPBAR(15); } SEAM(15); }
    if (IN(16)) {
        pg8::Order1 S; S.init(pg8::GDesc{XN, W1A, D, D, D, M / 256, 2 * FF / 256}, F.G, F.c);
        FORREP(16) { pg8::gemm_phase<true>(F.lds, S, EpiSwiglu{HID}); REPBAR(16); }
        SEAM(16);
    }
    if (IN(17)) {
        pg8::Order1 S; S.init(pg8::GDesc{HID, W1B, FF, FF, FF, M / 256, D / 256}, F.G, F.c);
        FORREP(17) { pg8::gemm_phase<true>(F.lds, S, EpiStore{Y, D}); REPBAR(17); }
        SEAM(17);
    }
    if (IN(18)) { FORREP(18) { resnorm_phase(F, args.out, Y, in[23], 0.5f, args.out, nullptr, nullptr, ST(18)); REPBAR(18); } }
#undef IN
#undef SEAM
}

extern "C" void kernel_launch(void* const* d_in, const int* in_sizes, int n_in, void* d_out, int out_size, void* d_ws, size_t ws_size, hipStream_t stream) {
    static int grid = 0;
    if (grid == 0) {
        if (n_in != 26 || out_size != M * D || ws_size < WS_END) { fprintf(stderr, "kernel_launch: unexpected problem shape (n_in %d, out %d, ws %zu); nothing launched\n", n_in, out_size, ws_size); grid = -1; return; }
        int dev = 0, cus = 0, per_cu = 0;
        if (hipGetDevice(&dev) != hipSuccess || hipDeviceGetAttribute(&cus, hipDeviceAttributeMultiprocessorCount, dev) != hipSuccess) { grid = -1; return; }
        if (hipFuncSetAttribute((const void*)mega_fwd, hipFuncAttributeMaxDynamicSharedMemorySize, LDS_BYTES) != hipSuccess) { fprintf(stderr, "kernel_launch: hipFuncSetAttribute failed\n"); grid = -1; return; }
        if (hipOccupancyMaxActiveBlocksPerMultiprocessor(&per_cu, (const void*)mega_fwd, NT, LDS_BYTES) != hipSuccess || per_cu < 1) fprintf(stderr, "kernel_launch: occupancy query reports %d workgroups per CU\n", per_cu);
        (void)hipGetLastError();
        grid = cus;
    }
    if (grid < 0) return;
    (void)hipMemsetAsync((char*)d_ws + WS_CTL, 0, 65536, stream);
    Args a{};
    for (int i = 0; i < 26; ++i) a.in[i] = (const float*)d_in[i];
    a.out = (float*)d_out; a.ws = (unsigned char*)d_ws;
    a.nostore = 0; a.sub = -1;
#if MK_ONE_LAUNCH
    a.ph_lo = 0; a.ph_hi = N_PHASES;
    hipLaunchKernelGGL(mega_fwd, dim3(grid), dim3(NT), LDS_BYTES, stream, a);
#ifdef PROBE_EXTRA_PHASE
    for (int r = 0; r < PROBE_EXTRA_N; ++r) { a.ph_lo = PROBE_EXTRA_PHASE; a.ph_hi = PROBE_EXTRA_PHASE + 1; a.nostore = 1; a.sub = PROBE_EXTRA_SUB;
    hipLaunchKernelGGL(mega_fwd, dim3(grid), dim3(NT), LDS_BYTES, stream, a); }
#endif
#else
    for (int p = 0; p < N_PHASES; ++p) { a.ph_lo = p; a.ph_hi = p + 1; hipLaunchKernelGGL(mega_fwd, dim3(grid), dim3(NT), LDS_BYTES, stream, a); }
#endif
}
```

```cpp
#define MK_ONE_LAUNCH 1
#pragma clang diagnostic ignored "-Wint-to-pointer-cast"
#include <hip/hip_runtime.h>
#include <cstdio>
#include <cstdint>

#define DI __device__ __forceinline__
#define LAS __attribute__((address_space(3)))
#define GAS __attribute__((address_space(1)))
typedef unsigned short bf16;
typedef short bf16x8 __attribute__((ext_vector_type(8)));
typedef short s16x4 __attribute__((ext_vector_type(4)));
typedef float f32x4 __attribute__((ext_vector_type(4)));
typedef float f32x2 __attribute__((ext_vector_type(2)));
typedef float f32x16 __attribute__((ext_vector_type(16)));
typedef unsigned u32x4 __attribute__((ext_vector_type(4)));
typedef unsigned u32x2 __attribute__((ext_vector_type(2)));
typedef __bf16 bf16x2_t __attribute__((ext_vector_type(2)));

DI unsigned pk2(float lo, float hi) { f32x2 v = {lo, hi}; bf16x2_t b = __builtin_convertvector(v, bf16x2_t); return __builtin_bit_cast(unsigned, b); }
DI float bflo(unsigned w) { return __uint_as_float(w << 16); }
DI float bfhi(unsigned w) { return __uint_as_float(w & 0xffff0000u); }
DI float bf2f(bf16 v) { return __uint_as_float(((unsigned)v) << 16); }
DI float wave_sum(float v) {
#pragma unroll
    for (int o = 1; o < 64; o <<= 1) v += __shfl_xor(v, o);
    return v;
}
DI float fast_exp2(float x) { return __builtin_amdgcn_exp2f(x); }
DI float fast_exp(float x) { return __builtin_amdgcn_exp2f(x * 1.4426950408889634f); }
DI float fast_rcp(float x) { return __builtin_amdgcn_rcpf(x); }
DI float sigmoid_f(float x) { return fast_rcp(1.0f + fast_exp(-x)); }
#define MFMA32(a, b, c) __builtin_amdgcn_mfma_f32_32x32x16_bf16((a), (b), (c), 0, 0, 0)
DI int crow(int r, int hi) { return (r & 3) + 8 * (r >> 2) + 4 * hi; }
DI bf16x8 pack8(float a0, float a1, float a2, float a3, float a4, float a5, float a6, float a7) {
    u32x4 p; p.x = pk2(a0, a1); p.y = pk2(a2, a3); p.z = pk2(a4, a5); p.w = pk2(a6, a7); return __builtin_bit_cast(bf16x8, p);
}
DI bf16x8 pack_step(const f32x16& x, int s) { return pack8(x[8 * s], x[8 * s + 1], x[8 * s + 2], x[8 * s + 3], x[8 * s + 4], x[8 * s + 5], x[8 * s + 6], x[8 * s + 7]); }
typedef short v4i16_t __attribute__((ext_vector_type(4)));
DI s16x4 vtr(unsigned lds_byte_addr) { return __builtin_bit_cast(s16x4, __builtin_amdgcn_ds_read_tr16_b64_v4i16((LAS v4i16_t*)lds_byte_addr)); }
DI bf16x8 cat4(s16x4 lo, s16x4 hi) { return __builtin_shufflevector(lo, hi, 0, 1, 2, 3, 4, 5, 6, 7); }
DI bf16x8 lds_b128(unsigned lds_byte_addr) { return *(const LAS bf16x8*)lds_byte_addr; }

namespace pg8 {
#define PG8_LAS __attribute__((address_space(3)))
typedef unsigned short bf16_t;
constexpr int BM = 256, BK = 64, HALF = 128, HTB = HALF * BK * 2  , STAGE_BYTES = 8 * HTB, NXCD = 8, WGM = 8;

__host__ __device__ __forceinline__ int lds_byte(int r, int c) { const int st = (r >> 4) * 2 + (c >> 5), rr = r & 15, cc = c & 31, ob = rr * 64 + cc * 2; return st * 1024 + (ob ^ (((ob >> 9) & 1) << 5)); }
__host__ __device__ __forceinline__ void stage_rc(int b, int& R, int& C) { const int st = b / 1024, sb = b % 1024, swz = sb ^ (((sb >> 9) & 1) << 5); R = (st >> 1) * 16 + swz / 64; C = (st & 1) * 32 + (swz % 64) / 2; }
__host__ __device__ __forceinline__ int perm32(int rho) { const int n = rho >> 4, i = rho & 15; return 8 * (i >> 2) + 4 * n + (i & 3); }

struct Unit { int pm, pn, g; };
struct GDesc { const bf16_t* A; const bf16_t* Bt; int lda, ldb, K, nM, nN; };

__device__ __forceinline__ void tile_of(int l, int nM, int nN, int& pm, int& pn) {
    const int nwg = nM * nN; int wgid = l;
    { const int q = nwg / NXCD, r = nwg % NXCD, xcd = wgid % NXCD, off = wgid / NXCD; wgid = (xcd < r ? xcd * (q + 1) : r * (q + 1) + (xcd - r) * q) + off; }
    const int nig = WGM * nN, gid = wgid / nig, fm = gid * WGM, gsz = (nM - fm) < WGM ? (nM - fm) : WGM;
    pm = fm + ((wgid % nig) % gsz); pn = (wgid % nig) / gsz;
}
struct Order1 {
    GDesc d0; int G, c;
    __device__ __forceinline__ void init(const GDesc& a, int G_, int c_) { d0 = a; G = G_; c = c_; }
    __device__ __forceinline__ GDesc desc(int) const { return d0; }
    __device__ __forceinline__ bool next(int i, Unit& u) const {
        const long L = (long)i * G + c; if (L >= (long)(d0.nM * d0.nN)) return false;
        tile_of((int)L, d0.nM, d0.nN, u.pm, u.pn); u.g = 0; return true;
    }
};
struct Order2 {
    GDesc d0, d1; int G, c;
    __device__ __forceinline__ GDesc desc(int g) const { GDesc r; r.A = g == 0 ? d0.A : d1.A; r.Bt = g == 0 ? d0.Bt : d1.Bt; r.lda = d0.lda; r.ldb = d0.ldb; r.K = d0.K; r.nM = g == 0 ? d0.nM : d1.nM; r.nN = g == 0 ? d0.nN : d1.nN; return r; }
    __device__ __forceinline__ bool next(int i, Unit& u) const {
        const int n0 = d0.nM * d0.nN, n1 = d1.nM * d1.nN;
        const long L = (long)i * G + c; if (L >= (long)(n0 + n1)) return false;
        int l = (int)L, g = 0; if (l >= n0) { l -= n0; g = 1; }
        tile_of(l, g == 0 ? d0.nM : d1.nM, g == 0 ? d0.nN : d1.nN, u.pm, u.pn); u.g = g; return true;
    }
};
struct PairOrder {
    GDesc d0, d1; int G, c;
    __device__ __forceinline__ GDesc desc(int g) const { GDesc r; r.A = g == 0 ? d0.A : d1.A; r.Bt = g == 0 ? d0.Bt : d1.Bt; r.lda = g == 0 ? d0.lda : d1.lda; r.ldb = g == 0 ? d0.ldb : d1.ldb; r.K = g == 0 ? d0.K : d1.K; r.nM = d0.nM; r.nN = d0.nN; return r; }
    __device__ __forceinline__ bool next(int i, Unit& u) const {
        const long L = (long)(i >> 1) * G + c; if (L >= (long)(d0.nM * d0.nN)) return false;
        tile_of((int)L, d0.nM, d0.nN, u.pm, u.pn); u.g = i & 1; return true;
    }
};

template <bool UNIFORM  , class Epi, class Sched>
__device__ __forceinline__ void gemm_phase(PG8_LAS unsigned char* lds, const Sched& S, const Epi& E) {
    const int tid = threadIdx.x, wid = __builtin_amdgcn_readfirstlane(tid >> 6), lane = tid & 63, wr = wid >> 2, wc = wid & 3, fr = lane & 15, fq = lane >> 4;
    auto voff = [tid](int i, int ld, bool perm) -> unsigned { int R, C; stage_rc(tid * 16 + i * 8192, R, C); if (perm) R = (R & ~31) + perm32(R & 31); return (unsigned)(R * ld + C) * 2u; };
    const size_t kstep = (size_t)(BK * 2);
    const unsigned ldsw = (unsigned)wid * 1024u;
    const int aoff = lds_byte(wr * 64 + fr, fq * 8), boff = lds_byte(wc * 32 + fr, fq * 8);
#define PG8_SA(b, h) (((b) * 2 + (h)) * HTB)
#define PG8_SB(b, h) ((4 + (b) * 2 + (h)) * HTB)
#define PG8_STAGE(bufoff, gbase, v0, v1) do { \
        __builtin_amdgcn_global_load_lds((const unsigned*)((const char*)(gbase) + (v0)), (PG8_LAS unsigned*)(lds + (bufoff) + ldsw), 16, 0, 0); \
        __builtin_amdgcn_global_load_lds((const unsigned*)((const char*)(gbase) + (v1)), (PG8_LAS unsigned*)(lds + (bufoff) + ldsw + 8192), 16, 0, 0); } while (0)
#define PG8_LDA(dst, b, h) do { _Pragma("unroll") for (int m = 0; m < 4; ++m) _Pragma("unroll") for (int k = 0; k < 2; ++k) dst[m][k] = *(const PG8_LAS bf16x8*)(lds + PG8_SA(b, h) + aoff + m * 2048 + k * 1024); } while (0)
#define PG8_LDB(dst, b, h) do { _Pragma("unroll") for (int n = 0; n < 2; ++n) _Pragma("unroll") for (int k = 0; k < 2; ++k) dst[n][k] = *(const PG8_LAS bf16x8*)(lds + PG8_SB(b, h) + boff + n * 2048 + k * 1024); } while (0)
#define PG8_MMA(ai, bj, At, Bt) do { __builtin_amdgcn_s_setprio(1); _Pragma("unroll") for (int m = 0; m < 4; ++m) _Pragma("unroll") for (int n = 0; n < 2; ++n) _Pragma("unroll") for (int k = 0; k < 2; ++k) \
        acc[ai][bj][m][n] = __builtin_amdgcn_mfma_f32_16x16x32_bf16(Bt[n][k], At[m][k], acc[ai][bj][m][n], 0, 0, 0); __builtin_amdgcn_s_setprio(0); } while (0)
#define PG8_WAIT_V(n) asm volatile("s_waitcnt vmcnt(" #n ")" ::: "memory")
#define PG8_WAIT_L(n) asm volatile("s_waitcnt lgkmcnt(" #n ")" ::: "memory")
#define PG8_BAR __builtin_amdgcn_s_barrier()
#define PG8_SCHED __builtin_amdgcn_sched_barrier(0)
    Unit cur, nxt; int ui = 0;
    if (!S.next(0, cur)) return;
    GDesc dc = S.desc(cur.g);
    f32x4 acc[2][2][4][2];
#pragma unroll
    for (int a = 0; a < 2; ++a)
#pragma unroll
        for (int b = 0; b < 2; ++b)
#pragma unroll
            for (int m = 0; m < 4; ++m)
#pragma unroll
                for (int n = 0; n < 2; ++n) acc[a][b][m][n] = (f32x4){0.f, 0.f, 0.f, 0.f};
    bf16x8 At[4][2], B0[2][2], B1[2][2];
    unsigned vA0 = voff(0, dc.lda, false), vA1 = voff(1, dc.lda, false), vB0 = voff(0, dc.ldb, true), vB1 = voff(1, dc.ldb, true);
    size_t hA = (size_t)HALF * dc.lda * 2, hB = (size_t)HALF * dc.ldb * 2;
    const char* cA = (const char*)dc.A + (size_t)cur.pm * 2 * hA; const char* cB = (const char*)dc.Bt + (size_t)cur.pn * 2 * hB;
    PG8_STAGE(PG8_SB(0, 0), cB, vB0, vB1); PG8_STAGE(PG8_SB(0, 1), cB + hB, vB0, vB1); PG8_STAGE(PG8_SA(0, 0), cA, vA0, vA1); PG8_STAGE(PG8_SA(0, 1), cA + hA, vA0, vA1);
    if (wr == 1) PG8_BAR;
    PG8_WAIT_V(2); PG8_BAR;
    PG8_STAGE(PG8_SB(1, 0), cB + kstep, vB0, vB1); PG8_STAGE(PG8_SA(1, 0), cA + kstep, vA0, vA1); PG8_STAGE(PG8_SB(1, 1), cB + hB + kstep, vB0, vB1);
    PG8_WAIT_V(6); PG8_BAR;
    for (;;) {
        const bool has_next = S.next(ui + 1, nxt);
        GDesc dn = dc; if (has_next) dn = S.desc(nxt.g);
        unsigned nvA0 = vA0, nvA1 = vA1, nvB0 = vB0, nvB1 = vB1; size_t nhA = hA, nhB = hB;
        if constexpr (!UNIFORM) { if (has_next) { nvA0 = voff(0, dn.lda, false); nvA1 = voff(1, dn.lda, false); nvB0 = voff(0, dn.ldb, true); nvB1 = voff(1, dn.ldb, true); nhA = (size_t)HALF * dn.lda * 2; nhB = (size_t)HALF * dn.ldb * 2; } }
        const char* nA = has_next ? (const char*)dn.A + (size_t)nxt.pm * 2 * nhA : cA; const char* nB = has_next ? (const char*)dn.Bt + (size_t)nxt.pn * 2 * nhB : cB;
        const int nt = dc.K / BK;
        for (int t = 0; t < nt; t += 2) {
            const bool last = (t == nt - 2);
            const char* a1 = cA + (size_t)(t + 1) * kstep;
            const char* a2 = last ? nA : cA + (size_t)(t + 2) * kstep; const char* b2 = last ? nB : cB + (size_t)(t + 2) * kstep;
            const char* a3 = a2 + kstep; const char* b3 = b2 + kstep;
            unsigned xA0 = vA0, xA1 = vA1, xB0 = vB0, xB1 = vB1; size_t xhA = hA, xhB = hB;
            if constexpr (!UNIFORM) { if (last) { xA0 = nvA0; xA1 = nvA1; xB0 = nvB0; xB1 = nvB1; xhA = nhA; xhB = nhB; } }
            PG8_LDB(B0, 0, 0); PG8_LDB(B1, 0, 1); PG8_SCHED; PG8_LDA(At, 0, 0); PG8_STAGE(PG8_SA(1, 1), a1 + hA, vA0, vA1);
            PG8_WAIT_V(8); PG8_WAIT_L(0); PG8_BAR; PG8_MMA(0, 0, At, B0); PG8_MMA(0, 1, At, B1); PG8_BAR; PG8_SCHED;
            PG8_LDA(At, 0, 1); PG8_STAGE(PG8_SB(0, 0), b2, xB0, xB1); PG8_STAGE(PG8_SB(0, 1), b2 + xhB, xB0, xB1); PG8_STAGE(PG8_SA(0, 0), a2, xA0, xA1);
            PG8_WAIT_V(8); PG8_WAIT_L(0); PG8_BAR; PG8_MMA(1, 0, At, B0); PG8_MMA(1, 1, At, B1); PG8_BAR; PG8_SCHED;
            PG8_LDB(B0, 1, 0); PG8_LDB(B1, 1, 1); PG8_SCHED; PG8_LDA(At, 1, 0); PG8_STAGE(PG8_SA(0, 1), a2 + xhA, xA0, xA1);
            PG8_WAIT_V(8); PG8_WAIT_L(0); PG8_BAR; PG8_MMA(0, 0, At, B0); PG8_MMA(0, 1, At, B1); PG8_BAR; PG8_SCHED;
            PG8_LDA(At, 1, 1); PG8_STAGE(PG8_SB(1, 0), b3, xB0, xB1); PG8_STAGE(PG8_SB(1, 1), b3 + xhB, xB0, xB1); PG8_STAGE(PG8_SA(1, 0), a3, xA0, xA1);
            PG8_WAIT_V(8); PG8_WAIT_L(0); PG8_BAR; PG8_MMA(1, 0, At, B0); PG8_MMA(1, 1, At, B1); PG8_BAR; PG8_SCHED;
        }
        if (wr == 0) PG8_BAR;
        const bool keep = E(acc, cur, wr, wc, fr, fq);
        if (!has_next) break;
        if (!keep) {
#pragma unroll
            for (int a = 0; a < 2; ++a)
#pragma unroll
                for (int b = 0; b < 2; ++b)
#pragma unroll
                    for (int m = 0; m < 4; ++m)
#pragma unroll
                        for (int n = 0; n < 2; ++n) acc[a][b][m][n] = (f32x4){0.f, 0.f, 0.f, 0.f};
        }
        cur = nxt; dc = dn; cA = nA; cB = nB; vA0 = nvA0; vA1 = nvA1; vB0 = nvB0; vB1 = nvB1; hA = nhA; hB = nhB; ++ui;
        if (wr == 1) PG8_BAR;
    }
    PG8_WAIT_V(0);
    PG8_BAR;
#undef PG8_SA
#undef PG8_SB
#undef PG8_STAGE
#undef PG8_LDA
#undef PG8_LDB
#undef PG8_MMA
#undef PG8_WAIT_V
#undef PG8_WAIT_L
#undef PG8_BAR
#undef PG8_SCHED
}
}

constexpr int NWAVES = 8, NT = 512;
constexpr int BATCH = 2, T = 8192, D = 1024, M = BATCH * T, FF = 2816, MEML = 256;
constexpr float EPS = 1e-6f;
constexpr float LOG2E = 1.4426950408889634f;
constexpr int NIN = 5376;
constexpr size_t KiB = 1024, MiB = 1u << 20;
constexpr size_t WS_CTL = 0, CTL_ZERO_BYTES = 1 * MiB;
constexpr size_t WS_XN = 1 * MiB;
constexpr size_t WS_HID = 33 * MiB;
constexpr size_t WS_Y = 121 * MiB;
constexpr size_t WS_QKG = 33 * MiB, WS_GV = 65 * MiB, WS_GR = 97 * MiB, WS_DQKV = 129 * MiB, WS_IQ = 177 * MiB, WS_SM = 193 * MiB, WS_GST = 197 * MiB;
constexpr size_t WS_W1A = 153 * MiB, WS_W1B = 164 * MiB;
constexpr size_t WS_WIN = 229 * MiB, WS_WGT = 229 * MiB + 10752 * KiB, WS_WG = WS_WGT + 4 * MiB, WS_WD = WS_WG + 2 * MiB, WS_WO = WS_WD + 1 * MiB,
                 WS_WCQ = WS_WO + 2 * MiB, WS_WCKV = WS_WCQ + 1 * MiB, WS_WCO = WS_WCKV + 2 * MiB, WS_MEMN = WS_WCO + 1 * MiB, WS_KVM = WS_MEMN + 1 * MiB, WS_DEC = WS_KVM + 1 * MiB;
constexpr size_t WS_SGA = WS_QKG, WS_SGB = WS_GV, WS_MRG = WS_GST, WS_Y2 = WS_QKG;
constexpr size_t WS_QC = 65 * MiB, WS_OX = 81 * MiB, WS_Y3 = 97 * MiB;
constexpr size_t WS_END = 256 * MiB;
static_assert(WS_DEC + 128 * KiB <= WS_END && WS_W1B + (size_t)D * FF * 2 <= WS_IQ && WS_HID + (size_t)M * FF * 2 <= WS_Y, "d_ws map");
constexpr int CW_BAR = 4096;
constexpr int LDS_BYTES = 163840;
constexpr int MISC_OFF = LDS_BYTES - 256;

#define XB_TMO      128
#define XB_XCNT(j)  (256  + 64 * (j))
#define XB_XSUB(j)  (1280 + 64 * (j))
#define XB_XGEN(j)  (2304 + 64 * (j))
#define XB_TOP      3328
#define XB_TOPGEN   3392
#define XCD_BAR_WORDS 3456
#define XB_SPIN_CAP (1u << 18)

__device__ __forceinline__ unsigned xb_ld(unsigned* p)              { return __hip_atomic_load(p, __ATOMIC_RELAXED, __HIP_MEMORY_SCOPE_AGENT); }
__device__ __forceinline__ unsigned xb_add(unsigned* p, unsigned v) { return __hip_atomic_fetch_add(p, v, __ATOMIC_RELAXED, __HIP_MEMORY_SCOPE_AGENT); }
__device__ __forceinline__ unsigned xb_xcc_id() { return (unsigned)__builtin_amdgcn_s_getreg((3 << 11) | 20) & 0xFu; }
#define XB_SPIN(cond, bar) do { unsigned _sp = 0; while (cond) { __builtin_amdgcn_s_sleep(1); \
    if ((++_sp & 255u) == 0u) { if (xb_ld(&(bar)[XB_TMO])) break; if (_sp > XB_SPIN_CAP) { atomicAdd(&(bar)[XB_TMO], 1u); break; } } } } while (0)

struct XcdBarrier {
    unsigned* bar; unsigned x;
    volatile LAS unsigned* st;
};

__device__ __forceinline__ XcdBarrier xcd_barrier_post(unsigned* bar, volatile LAS unsigned* st) {
    XcdBarrier b; b.bar = bar; b.x = xb_xcc_id(); b.st = st;
    if (threadIdx.x == 0) (void)xb_add(&bar[XB_XCNT(b.x)], 1u);
    return b;
}
__device__ __forceinline__ void xcd_barrier_complete(unsigned* bar, unsigned x, unsigned& nloc, unsigned& nx) {
    const unsigned G = gridDim.x * gridDim.y * gridDim.z;
    unsigned sum, cnt, mine, sp = 0u;
    for (;;) {
        sum = 0u; cnt = 0u; mine = 0u;
#pragma unroll
        for (unsigned j = 0; j < 16; ++j) { const unsigned c = xb_ld(&bar[XB_XCNT(j)]); sum += c; cnt += (c > 0u) ? 1u : 0u; mine = (j == x) ? c : mine; }
        if (sum == G) break;
        __builtin_amdgcn_s_sleep(1);
        if ((++sp & 255u) == 0u) { if (xb_ld(&bar[XB_TMO])) break; if (sp > XB_SPIN_CAP) { atomicAdd(&bar[XB_TMO], 1u); break; } }
    }
    nloc = mine > 0u ? mine : 1u; nx = cnt > 0u ? cnt : 1u;
}

__device__ __forceinline__ void xcd_barrier(const XcdBarrier& b) {
    asm volatile("s_waitcnt vmcnt(0)" ::: "memory");
    __syncthreads();
    if (threadIdx.x == 0) {
        unsigned* bar = b.bar;
        __builtin_amdgcn_s_waitcnt(0);
        unsigned nloc = b.st[0], nx = b.st[1];
        if (nloc == 0u) { xcd_barrier_complete(bar, b.x, nloc, nx); b.st[0] = nloc; b.st[1] = nx; }
        const unsigned old = xb_add(&bar[XB_XSUB(b.x)], 1u);
        const unsigned gen = old / nloc;
        if (old + 1u == (gen + 1u) * nloc) {
            __builtin_amdgcn_fence(__ATOMIC_RELEASE, "agent");
            asm volatile("s_waitcnt vmcnt(0)" ::: "memory");
            const unsigned og = xb_add(&bar[XB_TOP], 1u);
            const unsigned tg = og / nx;
            if (og + 1u == (tg + 1u) * nx) xb_add(&bar[XB_TOPGEN], 1u);
            else XB_SPIN(xb_ld(&bar[XB_TOPGEN]) == tg, bar);
            __builtin_amdgcn_fence(__ATOMIC_ACQUIRE, "agent");
            xb_add(&bar[XB_XGEN(b.x)], 1u);
            asm volatile("s_waitcnt vmcnt(0)" ::: "memory");
        } else {
            XB_SPIN(xb_ld(&bar[XB_XGEN(b.x)]) == gen, bar);
            __builtin_amdgcn_fence(__ATOMIC_ACQUIRE, "agent");
            asm volatile("s_waitcnt vmcnt(0)" ::: "memory");
        }
    }
    __syncthreads();
}

struct Args { const float* in[26]; float* out; unsigned char* ws; int ph_lo, ph_hi, nostore, sub; };
struct Frame {
    LAS unsigned char* lds;
    unsigned char* ws;
    int tid, lane, wave, G, c;
};
#define LDS_WAIT() asm volatile("s_waitcnt lgkmcnt(0)" ::: "memory")
#define VM_WAIT() asm volatile("s_waitcnt vmcnt(0)" ::: "memory")

template <class ColFn>
DI void conv_item(const float* W, int ldw, int k0, bf16* WT, int ldt, int dr0, int dk0, ColFn srccol, LAS float* scr, int lane) {
    const int n4 = (lane & 7) * 4; const int sc = srccol(dr0 + n4);
#pragma unroll
    for (int i = 0; i < 8; ++i) { const int kk = 8 * i + (lane >> 3);
        const f32x4 v = sc >= 0 ? *(const f32x4*)(W + (size_t)(k0 + kk) * ldw + sc) : (f32x4){0.f, 0.f, 0.f, 0.f};
        LAS float* s = scr + kk * 33 + n4; s[0] = v.x; s[1] = v.y; s[2] = v.z; s[3] = v.w; }
    LDS_WAIT(); asm volatile("" ::: "memory");
    const int c = lane & 7;
#pragma unroll
    for (int j = 0; j < 4; ++j) { const int n = (lane >> 3) + 8 * j; const LAS float* s = scr + (8 * c) * 33 + n;
        u32x4 o; o.x = pk2(s[0 * 33], s[1 * 33]); o.y = pk2(s[2 * 33], s[3 * 33]); o.z = pk2(s[4 * 33], s[5 * 33]); o.w = pk2(s[6 * 33], s[7 * 33]);
        *(u32x4*)(WT + (size_t)(dr0 + n) * ldt + dk0 + k0 + 8 * c) = o; }
    LDS_WAIT(); asm volatile("" ::: "memory");
}
struct ColIdent { int c0; DI int operator()(int r) const { return c0 + r; } };
struct ColFfn { DI int operator()(int r) const { const int tile = r >> 8, j = r & 255; return j < 128 ? tile * 128 + j : FF + tile * 128 + (j - 128); } };
struct ColInproj { DI int operator()(int r) const { return r < 3072 ? r : (r < 5192 ? r + 16 : (r < 5208 ? 3072 + (r - 5192) : -1)); } };
template <class ColFn>
DI bool conv_job(int& it, const float* W, int ldw, int K, int nb, bf16* WT, int ldt, ColFn f, LAS float* scr, int lane) {
    const int n_items = (K / 64) * nb;
    if (it >= n_items) { it -= n_items; return false; }
    const int kb = it / nb, b = it % nb;
    conv_item(W, ldw, 64 * kb, WT, ldt, 32 * b, 0, f, scr, lane);
    return true;
}
template <int NR>
DI void rms_rows_bf16(const float* xrow, const float* g, bf16* orow, int lane, size_t rstride) {
    f32x4 v[NR][4]; float s[NR];
#pragma unroll
    for (int q = 0; q < NR; ++q) { const f32x4* xr = (const f32x4*)(xrow + q * rstride) + lane; float a = 0.f;
#pragma unroll
        for (int j = 0; j < 4; ++j) { v[q][j] = xr[64 * j]; a += (v[q][j].x * v[q][j].x + v[q][j].y * v[q][j].y) + (v[q][j].z * v[q][j].z + v[q][j].w * v[q][j].w); }
        s[q] = a; }
    const f32x4* gr = (const f32x4*)g + lane; f32x4 gg[4];
#pragma unroll
    for (int j = 0; j < 4; ++j) gg[j] = gr[64 * j];
#pragma unroll
    for (int o = 1; o < 64; o <<= 1)
#pragma unroll
        for (int q = 0; q < NR; ++q) s[q] += __shfl_xor(s[q], o);
#pragma unroll
    for (int q = 0; q < NR; ++q) { const float r = __builtin_amdgcn_rsqf(s[q] * (1.f / D) + EPS); u32x2* o8 = (u32x2*)(orow + q * rstride) + lane;
#pragma unroll
        for (int j = 0; j < 4; ++j) { u32x2 w; w.x = pk2(v[q][j].x * r * gg[j].x, v[q][j].y * r * gg[j].y); w.y = pk2(v[q][j].z * r * gg[j].z, v[q][j].w * r * gg[j].w); o8[64 * j] = w; } }
}
template <int NR>
DI void resnorm_rows(const float* hin, const bf16* yrow, const float* gpost, float coef, float* hout, const float* gpre, bf16* xn, int lane, bool do_store, size_t rstride) {
    f32x4 y[NR][4], h[NR][4]; float s[NR], s2[NR];
#pragma unroll
    for (int q = 0; q < NR; ++q) { const u32x2* yr = (const u32x2*)(yrow + q * rstride) + lane; const f32x4* hr = (const f32x4*)(hin + q * rstride) + lane;
#pragma unroll
        for (int j = 0; j < 4; ++j) { const u32x2 w = yr[64 * j]; y[q][j] = (f32x4){bflo(w.x), bfhi(w.x), bflo(w.y), bfhi(w.y)}; h[q][j] = hr[64 * j]; } }
    const f32x4* gp = (const f32x4*)gpost + lane; f32x4 g[4];
#pragma unroll
    for (int j = 0; j < 4; ++j) g[j] = gp[64 * j];
#pragma unroll
    for (int q = 0; q < NR; ++q) { float a = 0.f;
#pragma unroll
        for (int j = 0; j < 4; ++j) a += (y[q][j].x * y[q][j].x + y[q][j].y * y[q][j].y) + (y[q][j].z * y[q][j].z + y[q][j].w * y[q][j].w);
        s[q] = a; }
#pragma unroll
    for (int o = 1; o < 64; o <<= 1)
#pragma unroll
        for (int q = 0; q < NR; ++q) s[q] += __shfl_xor(s[q], o);
#pragma unroll
    for (int q = 0; q < NR; ++q) { const float r = __builtin_amdgcn_rsqf(s[q] * (1.f / D) + EPS) * coef; float a = 0.f;
#pragma unroll
        for (int j = 0; j < 4; ++j) { h[q][j] = h[q][j] + y[q][j] * r * g[j]; a += (h[q][j].x * h[q][j].x + h[q][j].y * h[q][j].y) + (h[q][j].z * h[q][j].z + h[q][j].w * h[q][j].w); }
        s2[q] = a;
        if (do_store) { f32x4* ho = (f32x4*)(hout + q * rstride) + lane;
#pragma unroll
            for (int j = 0; j < 4; ++j) ho[64 * j] = h[q][j]; } }
    if (xn) {
        const f32x4* gq = (const f32x4*)gpre + lane;
#pragma unroll
        for (int j = 0; j < 4; ++j) g[j] = gq[64 * j];
#pragma unroll
        for (int o = 1; o < 64; o <<= 1)
#pragma unroll
            for (int q = 0; q < NR; ++q) s2[q] += __shfl_xor(s2[q], o);
#pragma unroll
        for (int q = 0; q < NR; ++q) { const float r2 = __builtin_amdgcn_rsqf(s2[q] * (1.f / D) + EPS); u32x2* o8 = (u32x2*)(xn + q * rstride) + lane;
#pragma unroll
            for (int j = 0; j < 4; ++j) { u32x2 w; w.x = pk2(h[q][j].x * r2 * g[j].x, h[q][j].y * r2 * g[j].y); w.y = pk2(h[q][j].z * r2 * g[j].z, h[q][j].w * r2 * g[j].w); o8[64 * j] = w; } }
    }
}
DI void resnorm_phase(Frame& F, const float* hin, const bf16* y, const float* gpost, float coef, float* hout, const float* gpre, bf16* xn, bool do_store = true) {
    const int gw = F.c * NWAVES + F.wave, NGW = F.G * NWAVES;
    int m = gw;
    for (; m + NGW < M; m += 2 * NGW) resnorm_rows<2>(hin + (size_t)m * D, y + (size_t)m * D, gpost, coef, hout + (size_t)m * D, gpre, xn ? xn + (size_t)m * D : nullptr, F.lane, do_store, (size_t)NGW * D);
    for (; m < M; m += NGW) resnorm_rows<1>(hin + (size_t)m * D, y + (size_t)m * D, gpost, coef, hout + (size_t)m * D, gpre, xn ? xn + (size_t)m * D : nullptr, F.lane, do_store, 0);
}

using pg8::Unit;
typedef f32x4 Acc[2][2][4][2];
struct EpiStore {
    bf16* O; int ldo;
    DI bool operator()(Acc& acc, const Unit& u, int wr, int wc, int fr, int fq) const {
        const int row0 = u.pm * 256 + wr * 64 + fr, col0 = u.pn * 256 + wc * 32 + 8 * fq;
#pragma unroll
        for (int ai = 0; ai < 2; ++ai)
#pragma unroll
            for (int m = 0; m < 4; ++m) { bf16* rowp = O + (size_t)(row0 + ai * 128 + m * 16) * ldo + col0;
#pragma unroll
                for (int bj = 0; bj < 2; ++bj) { const f32x4 v0 = acc[ai][bj][m][0], v1 = acc[ai][bj][m][1];
                    u32x4 w; w.x = pk2(v0[0], v0[1]); w.y = pk2(v0[2], v0[3]); w.z = pk2(v1[0], v1[1]); w.w = pk2(v1[2], v1[3]);
                    *(u32x4*)(rowp + bj * 128) = w; } }
        return false;
    }
};
struct EpiGates {
    bf16* SGA; bf16* SGB;
    DI bool operator()(Acc& acc, const Unit& u, int wr, int wc, int fr, int fq) const {
        bf16* O = u.pn < 4 ? SGA : SGB;
        const int row0 = u.pm * 256 + wr * 64 + fr, col0 = (u.pn & 3) * 256 + wc * 32 + 8 * fq;
#pragma unroll
        for (int ai = 0; ai < 2; ++ai)
#pragma unroll
            for (int m = 0; m < 4; ++m) { bf16* rowp = O + (size_t)(row0 + ai * 128 + m * 16) * 1024 + col0;
#pragma unroll
                for (int bj = 0; bj < 2; ++bj) { const f32x4 v0 = acc[ai][bj][m][0], v1 = acc[ai][bj][m][1];
                    u32x4 w; w.x = pk2(sigmoid_f(v0[0]), sigmoid_f(v0[1])); w.y = pk2(sigmoid_f(v0[2]), sigmoid_f(v0[3])); w.z = pk2(sigmoid_f(v1[0]), sigmoid_f(v1[1])); w.w = pk2(sigmoid_f(v1[2]), sigmoid_f(v1[3]));
                    *(u32x4*)(rowp + bj * 128) = w; } }
        return false;
    }
};
struct EpiSwiglu {
    bf16* H;
    DI bool operator()(Acc& acc, const Unit& u, int wr, int wc, int fr, int fq) const {
        const int row0 = u.pm * 256 + wr * 64 + fr, col0 = u.pn * 128 + wc * 32 + 8 * fq;
#pragma unroll
        for (int ai = 0; ai < 2; ++ai)
#pragma unroll
            for (int m = 0; m < 4; ++m) { bf16* rowp = H + (size_t)(row0 + ai * 128 + m * 16) * FF + col0;
                float o[8];
#pragma unroll
                for (int n = 0; n < 2; ++n)
#pragma unroll
                    for (int e = 0; e < 4; ++e) { const float a = acc[ai][0][m][n][e], b = acc[ai][1][m][n][e]; o[4 * n + e] = a * sigmoid_f(a) * b; }
                u32x4 w; w.x = pk2(o[0], o[1]); w.y = pk2(o[2], o[3]); w.z = pk2(o[4], o[5]); w.w = pk2(o[6], o[7]);
                *(u32x4*)rowp = w; }
        return false;
    }
};
struct EpiInproj {
    unsigned char* ws;
    DI bool operator()(Acc& acc, const Unit& u, int wr, int wc, int fr, int fq) const {
        bf16* O; int ldo, ct; bool half_only = false; float sc = 1.f;
        if (u.g == 1) { O = (bf16*)(ws + WS_KVM); ldo = 1024; ct = u.pn; }
        else if (u.pn < 4) { O = (bf16*)(ws + WS_QKG); ldo = 1024; ct = u.pn; }
        else if (u.pn < 8) { O = (bf16*)(ws + WS_GV); ldo = 1024; ct = u.pn - 4; }
        else if (u.pn < 12) { O = (bf16*)(ws + WS_GR); ldo = 1024; ct = u.pn - 8; }
        else if (u.pn < 18) { O = (bf16*)(ws + WS_DQKV); ldo = 1536; ct = u.pn - 12; if (u.pn < 14) sc = 0.125f * LOG2E; }
        else if (u.pn < 20) { O = (bf16*)(ws + WS_IQ); ldo = 512; ct = u.pn - 18; }
        else { O = (bf16*)(ws + WS_SM); ldo = 128; ct = 0; half_only = true; }
        const int row0 = u.pm * 256 + wr * 64 + fr, col0 = ct * 256 + wc * 32 + 8 * fq;
#pragma unroll
        for (int ai = 0; ai < 2; ++ai)
#pragma unroll
            for (int m = 0; m < 4; ++m) { bf16* rowp = O + (size_t)(row0 + ai * 128 + m * 16) * ldo + col0;
#pragma unroll
                for (int bj = 0; bj < 2; ++bj) { const f32x4 v0 = acc[ai][bj][m][0] * sc, v1 = acc[ai][bj][m][1] * sc;
                    u32x4 w; w.x = pk2(v0[0], v0[1]); w.y = pk2(v0[2], v0[3]); w.z = pk2(v1[0], v1[1]); w.w = pk2(v1[2], v1[3]);
                    if (bj == 0 || !half_only) *(u32x4*)(rowp + bj * 128) = w; } }
        return false;
    }
};
struct EpiMerge {
    const bf16* SGA; const bf16* SGB; bf16* O;
    DI bool operator()(Acc& acc, const Unit& u, int wr, int wc, int fr, int fq) const {
        const int row0 = u.pm * 256 + wr * 64 + fr, col0 = u.pn * 256 + wc * 32 + 8 * fq;
#pragma unroll
        for (int ai = 0; ai < 2; ++ai)
#pragma unroll
            for (int m = 0; m < 4; ++m) { const size_t off = (size_t)(row0 + ai * 128 + m * 16) * 1024 + col0;
#pragma unroll
                for (int bj = 0; bj < 2; ++bj) {
                    const u32x4 gb = *(const u32x4*)(SGB + off + bj * 128);
                    const float b[8] = {bflo(gb.x), bfhi(gb.x), bflo(gb.y), bfhi(gb.y), bflo(gb.z), bfhi(gb.z), bflo(gb.w), bfhi(gb.w)};
                    if (u.g == 0) {
                        const u32x4 ga = *(const u32x4*)(SGA + off + bj * 128);
                        const float a[8] = {bflo(ga.x), bfhi(ga.x), bflo(ga.y), bfhi(ga.y), bflo(ga.z), bfhi(ga.z), bflo(ga.w), bfhi(ga.w)};
#pragma unroll
                        for (int n = 0; n < 2; ++n)
#pragma unroll
                            for (int e = 0; e < 4; ++e) acc[ai][bj][m][n][e] *= a[4 * n + e] * fast_rcp(fmaxf(b[4 * n + e], 1e-30f));
                    } else {
                        const f32x4 v0 = acc[ai][bj][m][0], v1 = acc[ai][bj][m][1];
                        u32x4 w; w.x = pk2(v0[0] * b[0], v0[1] * b[1]); w.y = pk2(v0[2] * b[2], v0[3] * b[3]); w.z = pk2(v1[0] * b[4], v1[1] * b[5]); w.w = pk2(v1[2] * b[6], v1[3] * b[7]);
                        *(u32x4*)(O + off + bj * 128) = w;
                    } } }
        return u.g == 0;
    }
};

constexpr int GP = 272;
constexpr int LAP = 528;
template <bool GC_MODE>
DI void gla_prep(Frame& F, const float* const* in, int h, size_t row0, unsigned R0, unsigned R1, LAS float* bend, float* dec_out) {
    const int l = F.lane, w = F.wave, hh = l >> 5, c31 = l & 31;
    const bf16* SM = (const bf16*)(F.ws + WS_SM); const bf16* QKG = (const bf16*)(F.ws + WS_QKG);
    const float* wup = in[9]; const float* bal = in[10];
    const unsigned LA = R1;
    {
        const bf16x8 ga = *(const bf16x8*)(SM + (row0 + 32 * w + c31) * 128 + 72 + 8 * hh);
        f32x16 zero;
#pragma unroll
        for (int r = 0; r < 16; ++r) zero[r] = 0.f;
#pragma unroll
        for (int dt = 0; dt < 4; ++dt) { const int d = 32 * dt + c31;
            float wf[8];
#pragma unroll
            for (int j = 0; j < 8; ++j) wf[j] = wup[(8 * hh + j) * 512 + h * 128 + d];
            const f32x16 C = MFMA32(ga, pack8(wf[0], wf[1], wf[2], wf[3], wf[4], wf[5], wf[6], wf[7]), zero);
            const float bias = bal[h * 128 + d];
#pragma unroll
            for (int g = 0; g < 4; ++g) { float la[4];
#pragma unroll
                for (int i = 0; i < 4; ++i) { const float x = C[4 * g + i] + bias; la[i] = (fminf(x, 0.f) - __logf(1.f + fast_exp(-fabsf(x)))) * 0.0625f; }
                u32x2 o; o.x = pk2(la[0], la[1]); o.y = pk2(la[2], la[3]);
                *(LAS u32x2*)(LA + d * LAP + (32 * w + 8 * g + 4 * hh) * 2) = o; }
        }
    }
    __syncthreads();
    f32x16 Bc[4];
    {
#pragma unroll
        for (int dt = 0; dt < 4; ++dt)
#pragma unroll
            for (int r = 0; r < 16; ++r) Bc[dt][r] = 0.f;
        const unsigned la_lane = LA + c31 * LAP + 16 * hh;
        const bf16x8 ones = __builtin_bit_cast(bf16x8, (u32x4){0x3F803F80u, 0x3F803F80u, 0x3F803F80u, 0x3F803F80u});
        for (int s = 0; s < 2 * w; ++s) {
#pragma unroll
            for (int dt = 0; dt < 4; ++dt) Bc[dt] = MFMA32(lds_b128(la_lane + 32 * dt * LAP + 32 * s), ones, Bc[dt]);
        }
#pragma unroll
        for (int s2 = 0; s2 < 2; ++s2) {
            unsigned short v[8];
#pragma unroll
            for (int j = 0; j < 8; ++j) v[j] = (16 * s2 + 8 * hh + j <= c31) ? (unsigned short)0x3F80 : (unsigned short)0;
            u32x4 p; p.x = v[0] | ((unsigned)v[1] << 16); p.y = v[2] | ((unsigned)v[3] << 16); p.z = v[4] | ((unsigned)v[5] << 16); p.w = v[6] | ((unsigned)v[7] << 16);
            const bf16x8 tri = __builtin_bit_cast(bf16x8, p);
#pragma unroll
            for (int dt = 0; dt < 4; ++dt) Bc[dt] = MFMA32(lds_b128(la_lane + 32 * dt * LAP + 32 * (2 * w + s2)), tri, Bc[dt]);
        }
        if (w == 7 && c31 == 31) {
#pragma unroll
            for (int dt = 0; dt < 4; ++dt)
#pragma unroll
                for (int r = 0; r < 16; ++r) bend[32 * dt + crow(r, hh)] = Bc[dt][r];
        }
    }
    __syncthreads();
    {
        const size_t row = row0 + 32 * w + c31;
        const float qs = 0.08838834764831845f;
#pragma unroll
        for (int dt = 0; dt < 4; ++dt)
#pragma unroll
            for (int g = 0; g < 4; ++g) { const int d0 = 32 * dt + 8 * g + 4 * hh;
                const u32x2 kk = *(const u32x2*)(QKG + row * 1024 + 512 + h * 128 + d0);
                const float k0 = bflo(kk.x), k1 = bfhi(kk.x), k2 = bflo(kk.y), k3 = bfhi(kk.y);
                const float b0 = Bc[dt][4 * g], b1 = Bc[dt][4 * g + 1], b2 = Bc[dt][4 * g + 2], b3 = Bc[dt][4 * g + 3];
                if (GC_MODE) {
                    const u32x2 qq = *(const u32x2*)(QKG + row * 1024 + h * 128 + d0);
                    u32x2 o; o.x = pk2(bflo(qq.x) * qs * fast_exp(b0), bfhi(qq.x) * qs * fast_exp(b1)); o.y = pk2(bflo(qq.y) * qs * fast_exp(b2), bfhi(qq.y) * qs * fast_exp(b3));
                    *(LAS u32x2*)(R0 + (32 * w + c31) * GP + d0 * 2) = o;
                    u32x2 p; p.x = pk2(k0 * fast_exp(-b0), k1 * fast_exp(-b1)); p.y = pk2(k2 * fast_exp(-b2), k3 * fast_exp(-b3));
                    *(LAS u32x2*)(R1 + (32 * w + c31) * GP + d0 * 2) = p;
                } else {
                    const f32x4 be = *(const LAS f32x4*)(bend + d0);
                    u32x2 p; p.x = pk2(k0 * fast_exp(be.x - b0), k1 * fast_exp(be.y - b1)); p.y = pk2(k2 * fast_exp(be.z - b2), k3 * fast_exp(be.w - b3));
                    *(LAS u32x2*)(R0 + (32 * w + c31) * GP + d0 * 2) = p;
                } }
        if (!GC_MODE && w == 0) { dec_out[l] = fast_exp(bend[l]); dec_out[64 + l] = fast_exp(bend[64 + l]); }
    }
}
DI unsigned tr_lane(int pitch, int hmul, int lane) { const int i16 = lane & 15, q = i16 >> 2, p = i16 & 3, blk = (lane >> 4) & 1; return (unsigned)((hmul * (lane >> 5) + q) * pitch + (16 * blk + 4 * p) * 2); }
DI bf16x8 tr_frag(unsigned base_lane, int pitch, int row_lo, int row_hi, int n0) {
    return cat4(vtr(base_lane + (unsigned)(row_lo * pitch + n0 * 2)), vtr(base_lane + (unsigned)(row_hi * pitch + n0 * 2)));
}
DI void gla_load_v_half(Frame& F, unsigned vh, size_t row0, int h, int half) {
    const bf16* GV = (const bf16*)(F.ws + WS_GV);
#pragma unroll
    for (int it = 0; it < 8; ++it) { const int idx = it * NT + F.tid, row = idx >> 4, ch = idx & 15;
        const u32x4 v = *(const u32x4*)(GV + (row0 + row) * 1024 + h * 256 + half * 128 + ch * 8);
        *(LAS u32x4*)(vh + row * GP + ch * 16) = v; }
}
DI void gla_state_unit(Frame& F, const float* const* in, int u) {
    const int l = F.lane, w = F.wave, hh = l >> 5;
    const int bh = u >> 5, b = bh >> 2, h = bh & 3, sc = u & 31; const size_t row0 = (size_t)b * T + sc * 256;
    const unsigned KH = (unsigned)(size_t)F.lds, VH = KH + 256 * GP; LAS float* tot = (LAS float*)(F.lds + 2 * 256 * GP);
    const bf16* QKG = (const bf16*)(F.ws + WS_QKG);
    float* GST = (float*)(F.ws + WS_GST); float* DEC = (float*)(F.ws + WS_DEC);
    gla_prep<false>(F, in, h, row0, KH, VH, tot, DEC + (size_t)u * 128);
    const int etile = w >> 1, dt0 = 2 * (w & 1);
    const unsigned vhl = VH + tr_lane(GP, 8, l) + etile * 64, khl = KH + tr_lane(GP, 8, l) + dt0 * 64;
    for (int half = 0; half < 2; ++half) {
        gla_load_v_half(F, VH, row0, h, half);
        __syncthreads();
        f32x16 acc0, acc1;
#pragma unroll
        for (int r = 0; r < 16; ++r) { acc0[r] = 0.f; acc1[r] = 0.f; }
#pragma unroll 4
        for (int s = 0; s < 16; ++s) {
            const bf16x8 a = tr_frag(vhl, GP, 16 * s, 16 * s + 4, 0);
            const bf16x8 b0 = tr_frag(khl, GP, 16 * s, 16 * s + 4, 0), b1 = tr_frag(khl, GP, 16 * s, 16 * s + 4, 32);
            acc0 = MFMA32(a, b0, acc0); acc1 = MFMA32(a, b1, acc1);
        }
#pragma unroll
        for (int r = 0; r < 16; ++r) { const int e = half * 128 + etile * 32 + crow(r, hh); float* o = GST + ((size_t)u * 256 + e) * 128 + dt0 * 32 + (l & 31); o[0] = acc0[r]; o[32] = acc1[r]; }
        __syncthreads();
    }
}
DI void gla_scan_phase(Frame& F, bool do_store = true) {
    float* GST = (float*)(F.ws + WS_GST); const float* DEC = (const float*)(F.ws + WS_DEC);
    for (int idx = F.c * NT + F.tid; idx < 8 * 16384; idx += F.G * NT) {
        const int bh = idx >> 14, rem = idx & 16383, e = rem >> 6, d = (rem & 63) * 2;
        f32x2 st = {0.f, 0.f};
#pragma unroll 4
        for (int sc = 0; sc < 32; ++sc) { const int u = bh * 32 + sc; f32x2* p = (f32x2*)(GST + ((size_t)u * 256 + e) * 128 + d);
            const f32x2 uu = *p; const f32x2 dc = *(const f32x2*)(DEC + u * 128 + d); if (do_store) *p = st; st = dc * st + uu; }
        if (!do_store && st.x == 1.2345e-30f) GST[0] = st.y;
    }
}
DI void gla_out_unit(Frame& F, const float* const* in, int u, bool do_store = true) {
    const int l = F.lane, w = F.wave, hh = l >> 5;
    const int bh = u >> 5, b = bh >> 2, h = bh & 3, sc = u & 31; const size_t row0 = (size_t)b * T + sc * 256;
    const unsigned QS = (unsigned)(size_t)F.lds, KS = QS + 256 * GP; LAS float* tot = (LAS float*)(F.lds + 2 * 256 * GP);
    const bf16* QKG = (const bf16*)(F.ws + WS_QKG); const float* GST = (const float*)(F.ws + WS_GST); bf16* GR = (bf16*)(F.ws + WS_GR);
    gla_prep<true>(F, in, h, row0, QS, KS, tot, nullptr);
    __syncthreads();
    bf16x8 qf[8];
#pragma unroll
    for (int s = 0; s < 8; ++s) qf[s] = lds_b128(QS + (32 * w + (l & 31)) * GP + (16 * s + 8 * hh) * 2);
    __syncthreads();
    f32x16 acc[8];
#pragma unroll
    for (int et = 0; et < 8; ++et)
#pragma unroll
        for (int r = 0; r < 16; ++r) acc[et][r] = 0.f;
    const unsigned VH = QS;
#pragma unroll
    for (int half = 0; half < 2; ++half) {
        gla_load_v_half(F, VH, row0, h, half);
        __syncthreads();
        for (int j = 0; j <= w; ++j) {
            f32x16 X;
#pragma unroll
            for (int r = 0; r < 16; ++r) X[r] = 0.f;
            const unsigned ksj = KS + (l & 31) * GP + 16 * hh + 32 * j * GP, vhj = VH + tr_lane(GP, 4, l) + 32 * j * GP;
#pragma unroll
            for (int s = 0; s < 8; ++s) X = MFMA32(lds_b128(ksj + 32 * s), qf[s], X);
            if (j == w) {
#pragma unroll
                for (int r = 0; r < 16; ++r) if (crow(r, hh) > (l & 31)) X[r] = 0.f;
            }
            const bf16x8 xb0 = pack_step(X, 0), xb1 = pack_step(X, 1);
#pragma unroll
            for (int et = 0; et < 4; ++et) {
                const bf16x8 a0 = tr_frag(vhj, GP, 0, 8, et * 32), a1 = tr_frag(vhj, GP, 16, 24, et * 32);
                acc[half * 4 + et] = MFMA32(a0, xb0, acc[half * 4 + et]); acc[half * 4 + et] = MFMA32(a1, xb1, acc[half * 4 + et]);
            }
        }
        __syncthreads();
    }
    {
        const float* sg = GST + (size_t)u * 32768;
        int tv = F.tid; asm volatile("" : "+v"(tv));
        const float* sgl = sg + tv * 4; const unsigned dl = QS + (tv >> 5) * GP + (tv & 31) * 8;
#pragma unroll
        for (int i = 0; i < 16; i += 2) {
            const f32x4 v0 = *(const f32x4*)(sgl + i * 2048), v1 = *(const f32x4*)(sgl + (i + 1) * 2048);
            u32x2 o0, o1; o0.x = pk2(v0.x, v0.y); o0.y = pk2(v0.z, v0.w); o1.x = pk2(v1.x, v1.y); o1.y = pk2(v1.z, v1.w);
            *(LAS u32x2*)(dl + 16 * i * GP) = o0; *(LAS u32x2*)(dl + 16 * (i + 1) * GP) = o1;
        }
        __syncthreads();
        const unsigned sl = QS + (l & 31) * GP + 16 * hh;
#pragma unroll
        for (int et = 0; et < 8; ++et)
#pragma unroll
            for (int s = 0; s < 8; ++s) { acc[et] = MFMA32(lds_b128(sl + 32 * et * GP + 32 * s), qf[s], acc[et]); if ((s & 3) == 3) asm volatile("" ::: "memory"); }
    }
    float ss = 0.f;
#pragma unroll
    for (int et = 0; et < 8; ++et)
#pragma unroll
        for (int r = 0; r < 16; ++r) ss += acc[et][r] * acc[et][r];
    ss += __shfl_xor(ss, 32);
    const float rinv = __builtin_amdgcn_rsqf(ss * (1.f / 256.f) + EPS);
    const float* gn = in[11] + h * 256 + 4 * hh;
    bf16* orow = GR + (row0 + 32 * w + (l & 31)) * 1024 + h * 256 + 4 * hh;
#pragma unroll
    for (int et = 0; et < 8; ++et)
#pragma unroll
        for (int g = 0; g < 4; ++g) { const int e = et * 32 + 8 * g;
            const u32x2 gw = *(const u32x2*)(orow + e); const f32x4 gg = *(const f32x4*)(gn + e);
            const float r0 = bflo(gw.x), r1 = bfhi(gw.x), r2 = bflo(gw.y), r3 = bfhi(gw.y);
            u32x2 o; o.x = pk2(acc[et][4 * g] * rinv * gg.x * r0 * sigmoid_f(r0), acc[et][4 * g + 1] * rinv * gg.y * r1 * sigmoid_f(r1));
            o.y = pk2(acc[et][4 * g + 2] * rinv * gg.z * r2 * sigmoid_f(r2), acc[et][4 * g + 3] * rinv * gg.w * r3 * sigmoid_f(r3));
            if (do_store) *(u32x2*)(orow + e) = o; if (g == 3) __builtin_amdgcn_sched_barrier(0); }
}

DI void hist_find4(const u32x4 c, int lane, unsigned k, unsigned& bin, unsigned& above) {
    const unsigned s = c.x + c.y + c.z + c.w; unsigned suf = s;
#pragma unroll
    for (int o = 1; o < 64; o <<= 1) { const unsigned v = __shfl_down(suf, o); if (lane + o < 64) suf += v; }
    const unsigned excl = suf - s;
    const bool cross = excl < k && suf >= k;
    unsigned a = excl, bn = 0, ab = 0;
    if (a + c.w >= k) { bn = 4 * lane + 3; ab = a; } else { a += c.w;
        if (a + c.z >= k) { bn = 4 * lane + 2; ab = a; } else { a += c.z;
            if (a + c.y >= k) { bn = 4 * lane + 1; ab = a; } else { a += c.y; bn = 4 * lane; ab = a; } } }
    const unsigned long long m = __ballot(cross);
    const int src = m ? __builtin_ctzll(m) : 0;
    bin = __shfl(bn, src); above = __shfl(ab, src);
}
constexpr int IDX_H1 = 131072, IDX_H2 = IDX_H1 + 16384;
DI void idx_unit(Frame& F, int u, bool do_store = true, int mode = 0  ) {
    const int l = F.lane, w = F.wave, hh = l >> 5;
    const int b = u >> 10, t0 = (u & 1023) * 8; const size_t row0 = (size_t)b * T + t0;
    const bf16* IQ = (const bf16*)(F.ws + WS_IQ); const bf16* SM = (const bf16*)(F.ws + WS_SM);
    const unsigned SC = (unsigned)(size_t)F.lds; LAS unsigned* H1 = (LAS unsigned*)(F.lds + IDX_H1); LAS unsigned* H2 = (LAS unsigned*)(F.lds + IDX_H2);
    bf16x8 af[2][4]; float wv[2][16];
    {
        const int rho = l & 31;
#pragma unroll
        for (int tl = 0; tl < 2; ++tl) { const int q = 4 * tl + (rho >> 4) + 2 * ((rho >> 2) & 1), head = (rho & 3) + 4 * ((rho >> 3) & 1);
#pragma unroll
            for (int s = 0; s < 4; ++s) af[tl][s] = *(const bf16x8*)(IQ + (row0 + q) * 512 + head * 64 + 16 * s + 8 * hh);
#pragma unroll
            for (int r = 0; r < 16; ++r) { const int qq = 4 * tl + (r >> 3) + 2 * hh, hd = (r & 3) + 4 * ((r >> 2) & 1); wv[tl][r] = bf2f(SM[(row0 + qq) * 128 + 64 + hd]); } }
    }
#pragma unroll
    for (int i = 0; i < 8; ++i) H1[F.tid + i * NT] = 0u;
    __syncthreads();
    const int ntile = t0 / 32 + 1;
    const bf16* kbase = SM + ((size_t)b * T + (l & 31)) * 128 + 8 * hh;
    const unsigned hrep = (unsigned)(l & 3);
#define IDX_TILE(BF, kt_, EDGE) do { const int key = 32 * (kt_) + (l & 31); \
        f32x16 C0, C1; _Pragma("unroll") for (int r = 0; r < 16; ++r) { C0[r] = 0.f; C1[r] = 0.f; } \
        _Pragma("unroll") for (int s = 0; s < 4; ++s) { C0 = MFMA32(af[0][s], BF[s], C0); C1 = MFMA32(af[1][s], BF[s], C1); } \
        asm volatile("s_nop 15\n\ts_nop 7" : "+v"(C0), "+v"(C1));     \
        _Pragma("unroll") for (int tl = 0; tl < 2; ++tl) _Pragma("unroll") for (int b4 = 0; b4 < 2; ++b4) { \
            float sc = 0.f; \
            _Pragma("unroll") for (int r = 0; r < 8; ++r) { float m_; asm("v_max_f32_e32 %0, 0, %1" : "=v"(m_) : "v"(tl ? C1[8 * b4 + r] : C0[8 * b4 + r])); sc = fmaf(wv[tl][8 * b4 + r], m_, sc); } \
            const int q = 4 * tl + b4 + 2 * hh; \
            const _Float16 hf = (_Float16)sc; unsigned h16 = (unsigned)__builtin_bit_cast(unsigned short, hf); \
            unsigned k16 = (h16 & 0x8000u) ? (~h16 & 0xffffu) : (h16 | 0x8000u); \
            if (EDGE) { const bool valid = key <= t0 + q; if (!valid) k16 = 0u; \
                if (mode != 3) *(LAS unsigned short*)(SC + q * 16384 + key * 2) = (unsigned short)k16; \
                if (valid && mode != 3 && mode != 6) __hip_atomic_fetch_add(H1 + (q * 256 + (k16 >> 8)) * 2 + (hrep >> 1), 1u << (16 * (hrep & 1)), __ATOMIC_RELAXED, __HIP_MEMORY_SCOPE_WORKGROUP); } \
            else { if (mode != 3) *(LAS unsigned short*)(SC + q * 16384 + key * 2) = (unsigned short)k16; \
                if (mode != 3 && mode != 6) __hip_atomic_fetch_add(H1 + (q * 256 + (k16 >> 8)) * 2 + (hrep >> 1), 1u << (16 * (hrep & 1)), __ATOMIC_RELAXED, __HIP_MEMORY_SCOPE_WORKGROUP); } } } while (0)
#define IDX_LOAD(BF, kt_) do { _Pragma("unroll") for (int s = 0; s < 4; ++s) BF[s] = *(const bf16x8*)(kbase + (size_t)(32 * (kt_)) * 128 + 16 * s); } while (0)
    bf16x8 bA[4], bB[4];
    const int klast = ntile - 1;
    IDX_LOAD(bA, w < ntile ? w : klast);
    if (mode != 2)
    for (int kt = w; kt < ntile; kt += 16) {
        if (mode != 4) IDX_LOAD(bB, kt + 8 < ntile ? kt + 8 : klast);
        if (kt == klast) IDX_TILE(bA, kt, true); else IDX_TILE(bA, kt, false);
        if (mode != 4) IDX_LOAD(bA, kt + 16 < ntile ? kt + 16 : klast);
        if (kt + 8 < ntile) { if (kt + 8 == klast) IDX_TILE(bB, kt + 8, true); else IDX_TILE(bB, kt + 8, false); }
    }
#undef IDX_TILE
#undef IDX_LOAD
    __syncthreads();
    if (mode == 0 || mode == 2)
    {
        const int t = t0 + w, n = t + 1, nit = (n + 511) >> 9;
        unsigned char* mrow = (unsigned char*)(F.ws + WS_IQ) + (row0 + w) * 1024;
        const unsigned scq = SC + w * 16384 + l * 16;
        LAS unsigned* H = H2 + w * 256;
        unsigned thr = 0u, rneed = 0u;
        if (n > 256) {
            unsigned B, above, L, above2;
            {
                const u32x4 a = *(const LAS u32x4*)(H1 + (w * 256 + 4 * l) * 2), bq = *(const LAS u32x4*)(H1 + (w * 256 + 4 * l) * 2 + 4);
                u32x4 cnt; cnt.x = (a.x & 0xffffu) + (a.x >> 16) + (a.y & 0xffffu) + (a.y >> 16); cnt.y = (a.z & 0xffffu) + (a.z >> 16) + (a.w & 0xffffu) + (a.w >> 16);
                cnt.z = (bq.x & 0xffffu) + (bq.x >> 16) + (bq.y & 0xffffu) + (bq.y >> 16); cnt.w = (bq.z & 0xffffu) + (bq.z >> 16) + (bq.w & 0xffffu) + (bq.w >> 16);
                hist_find4(cnt, l, 256u, B, above);
            }
            H[l] = 0u; H[l + 64] = 0u; H[l + 128] = 0u; H[l + 192] = 0u; LDS_WAIT();
            for (int it = 0; it < nit; ++it) { const u32x4 kk = *(const LAS u32x4*)(scq + it * 1024); const int i0 = 512 * it + 8 * l;
                const unsigned ks[8] = {kk.x & 0xffffu, kk.x >> 16, kk.y & 0xffffu, kk.y >> 16, kk.z & 0xffffu, kk.z >> 16, kk.w & 0xffffu, kk.w >> 16};
                bool m[8], any = false;
#pragma unroll
                for (int j = 0; j < 8; ++j) { m[j] = (i0 + j < n) && (ks[j] >> 8) == B; any = any || m[j]; }
                if (__ballot(any) == 0ull) continue;
#pragma unroll
                for (int j = 0; j < 8; ++j) if (m[j]) __hip_atomic_fetch_add(H + (ks[j] & 255u), 1u, __ATOMIC_RELAXED, __HIP_MEMORY_SCOPE_WORKGROUP); }
            LDS_WAIT(); hist_find4(*(const LAS u32x4*)(H + 4 * l), l, 256u - above, L, above2);
            thr = (B << 8) | L; rneed = 256u - above - above2;
        }
        unsigned running = 0u;
        for (int it = 0; it < nit; ++it) {
            const u32x4 kk = *(const LAS u32x4*)(scq + it * 1024); const int i0 = 512 * it + 8 * l;
            const unsigned ks[8] = {kk.x & 0xffffu, kk.x >> 16, kk.y & 0xffffu, kk.y >> 16, kk.z & 0xffffu, kk.z >> 16, kk.w & 0xffffu, kk.w >> 16};
            unsigned byte = 0u;
            if (n <= 256) {
#pragma unroll
                for (int j = 0; j < 8; ++j) byte |= (i0 + j < n) ? (1u << j) : 0u;
            } else {
                bool eq[8]; bool anyeq = false;
#pragma unroll
                for (int j = 0; j < 8; ++j) { eq[j] = (i0 + j < n) && ks[j] == thr; anyeq = anyeq || eq[j]; byte |= ((i0 + j < n) && ks[j] > thr) ? (1u << j) : 0u; }
                const unsigned long long anym = __ballot(anyeq);
                if (anym != 0ull) {
                    unsigned mine = 0u;
#pragma unroll
                    for (int j = 0; j < 8; ++j) mine += eq[j] ? 1u : 0u;
                    unsigned before = 0u; unsigned long long mm = anym;
                    while (mm) { const int src = __builtin_ctzll(mm); mm &= mm - 1; const unsigned v = (unsigned)__shfl((int)mine, src); if (src < l) before += v; }
                    unsigned cum = running + before; unsigned tot = 0u; mm = anym;
                    while (mm) { const int src = __builtin_ctzll(mm); mm &= mm - 1; tot += (unsigned)__shfl((int)mine, src); }
#pragma unroll
                    for (int j = 0; j < 8; ++j) { if (eq[j]) { if (cum < rneed) byte |= (1u << j); ++cum; } }
                    running += tot;
                }
            }
            if (do_store) mrow[it * 64 + l] = (unsigned char)byte;
        }
    }
    __syncthreads();
}

template <int DH, bool DSA, int VAR = 0>
DI void attn_unit(Frame& F, const bf16* Qp, int ldq, const bf16* Kp, const bf16* Vp, int ldkv, int nst, bf16* Op, int ldo, float c1,
                  const unsigned* mask0  , int tq0, const LAS float* BT, float cfar, bool do_store = true) {
    constexpr int PK = DH * 2 + 16  , PV = DH == 64 ? 192 : 320  ;
    constexpr int SBK = 64 * PK, SBV = 64 * PV, NS = DH / 16, ND = DH / 32, CH = DH / 8  , NLD = 64 * CH / NT;
    const int l = F.lane, w = F.wave, hh = l >> 5, tid = F.tid;
    const unsigned KT = (unsigned)(size_t)F.lds, VT = KT + 2 * SBK;
    const unsigned klane = (unsigned)((l & 31) * PK + 16 * hh), vlane = tr_lane(PV, 4, l);
    bf16x8 qf[NS];
#pragma unroll
    for (int s = 0; s < NS; ++s) qf[s] = *(const bf16x8*)(Qp + (size_t)(32 * w + (l & 31)) * ldq + 16 * s + 8 * hh);
    f32x16 O[ND];
#pragma unroll
    for (int d = 0; d < ND; ++d)
#pragma unroll
        for (int r = 0; r < 16; ++r) O[d][r] = 0.f;
    float lsum = 0.f;
    const int tq = tq0 + 32 * w + (l & 31), tq_hi = tq0 + 32 * w + 31, tq_lo = tq0 + 32 * w;
    const unsigned* mrow = DSA ? mask0 + (size_t)(32 * w + (l & 31)) * 256 : nullptr;
    u32x4 kr[NLD], vr[NLD];
    u32x2 mcur = {0u, 0u}, mnxt = {0u, 0u};
    if (DSA) mcur = *(const u32x2*)mrow;
#pragma unroll
    for (int i = 0; i < NLD; ++i) { const int idx = i * NT + tid, row = idx / CH, ch = idx % CH;
        kr[i] = *(const u32x4*)(Kp + (size_t)row * ldkv + ch * 8); vr[i] = *(const u32x4*)(Vp + (size_t)row * ldkv + ch * 8); }
#pragma unroll
    for (int i = 0; i < NLD; ++i) { const int idx = i * NT + tid, row = idx / CH, ch = idx % CH;
        *(LAS u32x4*)(KT + row * PK + ch * 16) = kr[i]; *(LAS u32x4*)(VT + row * PV + ch * 16) = vr[i]; }
    __syncthreads();
    __builtin_amdgcn_s_waitcnt(0x0F70);
    for (int st = 0; st < nst; ++st) {
        const unsigned kt = KT + (st & 1) * SBK, vt = VT + (st & 1) * SBV;
        const bool more = st + 1 < nst;
        if (more) {
#pragma unroll
            for (int i = 0; i < NLD; ++i) { const int idx = i * NT + tid, row = 64 * (st + 1) + idx / CH, ch = idx % CH;
                kr[i] = *(const u32x4*)(Kp + (size_t)row * ldkv + ch * 8); vr[i] = *(const u32x4*)(Vp + (size_t)row * ldkv + ch * 8); }
            if (DSA) mnxt = *(const u32x2*)(mrow + 2 * (st + 1));
        }
#pragma unroll
        for (int kb = 0; kb < 2; ++kb) {
            const int key0 = 64 * st + 32 * kb;
            if (VAR == 3) continue;
            if (DSA && key0 > tq_hi) continue;
            f32x16 X;
#pragma unroll
            for (int r = 0; r < 16; ++r) X[r] = 0.f;
#pragma unroll
            for (int s = 0; s < NS; ++s) X = MFMA32(lds_b128(kt + klane + 32 * kb * PK + 32 * s), qf[s], X);
            if (VAR == 2) { lsum += X[0]; }
            else if (DSA) {
                const unsigned mw = (kb ? mcur.y : mcur.x) >> (4 * hh);
                if (tq_lo - (key0 + 31) >= 113) {
#pragma unroll
                    for (int r = 0; r < 16; ++r) { const float p = fast_exp2(fmaf(X[r], c1, cfar)); const int bits = __builtin_amdgcn_sbfe((int)mw, (r & 3) + 8 * (r >> 2), 1);
                        const float pm = __uint_as_float(__float_as_uint(p) & (unsigned)bits); lsum += pm; X[r] = pm; }
                } else {
#pragma unroll
                    for (int r = 0; r < 16; ++r) { int di = tq - (key0 + crow(r, hh)); di = di < 0 ? 0 : (di > 127 ? 127 : di);
                        const float p = fast_exp2(fmaf(X[r], c1, BT[di])); const int bits = __builtin_amdgcn_sbfe((int)mw, (r & 3) + 8 * (r >> 2), 1);
                        const float pm = __uint_as_float(__float_as_uint(p) & (unsigned)bits); lsum += pm; X[r] = pm; }
                }
            } else {
#pragma unroll
                for (int r = 0; r < 16; ++r) { const float p = fast_exp2(X[r] * c1); lsum += p; X[r] = p; }
            }
            const bf16x8 xb0 = pack_step(X, 0), xb1 = pack_step(X, 1);
            if (VAR == 1) { asm volatile("" :: "v"(xb0), "v"(xb1)); }
            else {
#pragma unroll
            for (int d = 0; d < ND; ++d) {
                const bf16x8 a0 = tr_frag(vt + vlane, PV, 32 * kb, 32 * kb + 8, 32 * d), a1 = tr_frag(vt + vlane, PV, 32 * kb + 16, 32 * kb + 24, 32 * d);
                O[d] = MFMA32(a0, xb0, O[d]); O[d] = MFMA32(a1, xb1, O[d]);
            } }
        }
        asm volatile("" ::: "memory"); __builtin_amdgcn_sched_barrier(0);
        if (more) {
            const unsigned kn = KT + ((st + 1) & 1) * SBK, vn = VT + ((st + 1) & 1) * SBV;
#pragma unroll
            for (int i = 0; i < NLD; ++i) { const int idx = i * NT + tid, row = idx / CH, ch = idx % CH;
                *(LAS u32x4*)(kn + row * PK + ch * 16) = kr[i]; *(LAS u32x4*)(vn + row * PV + ch * 16) = vr[i]; }
            mcur = mnxt;
        }
        __syncthreads();
    }
    lsum += __shfl_xor(lsum, 32);
    const float inv = fast_rcp(lsum);
    bf16* orow = Op + (size_t)(32 * w + (l & 31)) * ldo;
#pragma unroll
    for (int d = 0; d < ND; ++d)
#pragma unroll
        for (int g = 0; g < 4; ++g) { u32x2 o; o.x = pk2(O[d][4 * g] * inv, O[d][4 * g + 1] * inv); o.y = pk2(O[d][4 * g + 2] * inv, O[d][4 * g + 3] * inv);
            if (do_store) *(u32x2*)(orow + 32 * d + 8 * g + 4 * hh) = o; }
}
DI int t5_bucket(int rel) {
    if (rel < 16) return rel;
    const float v = logf((float)rel * (1.f / 16.f)) / 2.0794415416798357f * 16.f;
    int lg = 16 + (int)v; return lg > 31 ? 31 : lg;
}
constexpr int A_PK = 144, A_PV = 192, A_SK = 128 * A_PK, A_SV = 128 * A_PV, A_BT = 2 * A_SK + 2 * A_SV;
#define A_SMR(r, pos) { const float p_ = (VAR == 4) ? X[r] : fast_exp2(X[r]); int t_ = -1; if (VAR != 5) asm("v_bfe_i32 %0, %1, %2, 1" : "=v"(t_) : "v"(mw_), "i"(pos)); const float pm_ = (VAR == 5) ? p_ : __uint_as_float(__float_as_uint(p_) & (unsigned)t_); if (VAR != 6) lsum += pm_; X[r] = pm_; }
#define A_SM16() do { A_SMR(0, 0) A_SMR(1, 1) A_SMR(2, 2) A_SMR(3, 3) A_SMR(4, 8) A_SMR(5, 9) A_SMR(6, 10) A_SMR(7, 11) A_SMR(8, 16) A_SMR(9, 17) A_SMR(10, 18) A_SMR(11, 19) A_SMR(12, 24) A_SMR(13, 25) A_SMR(14, 26) A_SMR(15, 27) } while (0)
template <int VAR = 0>
DI void dsa_att_unit(Frame& F, const float* const* in, int bh, int qb, bool do_store = true) {
    const int b = bh >> 3, h = bh & 7, l = F.lane, w = F.wave, hh = l >> 5, tid = F.tid;
    LAS float* BT = (LAS float*)(F.lds + A_BT);
    const float* tab = in[14];
    __syncthreads();
    if (tid < 128) BT[tid] = tab[t5_bucket(tid) * 8 + h] * LOG2E;
    const float cfar = tab[31 * 8 + h] * LOG2E;
    bf16* DQ = (bf16*)(F.ws + WS_DQKV);
    const size_t rowq = (size_t)b * T + qb * 256, rowk = (size_t)b * T;
    const bf16* Kp = DQ + rowk * 1536 + 512 + h * 64; const bf16* Vp = DQ + rowk * 1536 + 1024 + h * 64;
    const unsigned KT = (unsigned)(size_t)F.lds, VT = KT + 2 * A_SK;
    const unsigned klane = (unsigned)((l & 31) * A_PK + 16 * hh), vlane = tr_lane(A_PV, 4, l);
    bf16x8 qf[4];
#pragma unroll
    for (int s = 0; s < 4; ++s) qf[s] = *(const bf16x8*)(DQ + (rowq + 32 * w + (l & 31)) * 1536 + h * 64 + 16 * s + 8 * hh);
    f32x16 O[2], cf16;
#pragma unroll
    for (int r = 0; r < 16; ++r) { O[0][r] = 0.f; O[1][r] = 0.f; cf16[r] = cfar; }
    float lsum = 0.f;
    const int tq = qb * 256 + 32 * w + (l & 31), tq_lo = qb * 256 + 32 * w, tq_hi = tq_lo + 31, nst = 2 * (qb + 1);
    const u32x4* mrow = (const u32x4*)((const unsigned*)(F.ws + WS_IQ) + (rowq + 32 * w + (l & 31)) * 256);
    u32x4 kr[2], vr[2], mcur = mrow[0], mnxt = mcur;
#pragma unroll
    for (int i = 0; i < 2; ++i) { const int idx = i * NT + tid, row = idx >> 3, ch = idx & 7;
        kr[i] = *(const u32x4*)(Kp + (size_t)row * 1536 + ch * 8); vr[i] = *(const u32x4*)(Vp + (size_t)row * 1536 + ch * 8); }
#pragma unroll
    for (int i = 0; i < 2; ++i) { const int idx = i * NT + tid, row = idx >> 3, ch = idx & 7;
        *(LAS u32x4*)(KT + row * A_PK + ch * 16) = kr[i]; *(LAS u32x4*)(VT + row * A_PV + ch * 16) = vr[i]; }
    __syncthreads();
#define A_QK(Xv, kb, CI) do { Xv = MFMA32(lds_b128(kt + klane + 32 * (kb) * A_PK), qf[0], CI); Xv = MFMA32(lds_b128(kt + klane + 32 * (kb) * A_PK + 32), qf[1], Xv); \
        Xv = MFMA32(lds_b128(kt + klane + 32 * (kb) * A_PK + 64), qf[2], Xv); Xv = MFMA32(lds_b128(kt + klane + 32 * (kb) * A_PK + 96), qf[3], Xv); } while (0)
#define A_PVM(Xv, kb) do { const bf16x8 xb0_ = pack_step(Xv, 0), xb1_ = pack_step(Xv, 1); _Pragma("unroll") for (int d = 0; d < 2; ++d) { \
        const bf16x8 a0_ = tr_frag(vt + vlane, A_PV, 32 * (kb), 32 * (kb) + 8, 32 * d), a1_ = tr_frag(vt + vlane, A_PV, 32 * (kb) + 16, 32 * (kb) + 24, 32 * d); \
        O[d] = MFMA32(a0_, xb0_, O[d]); O[d] = MFMA32(a1_, xb1_, O[d]); } } while (0)
    __builtin_amdgcn_s_waitcnt(0x0F70);
    for (int st = 0; st < nst; ++st) {
        const unsigned kt = KT + (st & 1) * A_SK, vt = VT + (st & 1) * A_SV;
        const bool more = st + 1 < nst;
        if (more) {
#pragma unroll
            for (int i = 0; i < 2; ++i) { const int idx = i * NT + tid, row = 128 * (st + 1) + (idx >> 3), ch = idx & 7;
                kr[i] = *(const u32x4*)(Kp + (size_t)row * 1536 + ch * 8); vr[i] = *(const u32x4*)(Vp + (size_t)row * 1536 + ch * 8); }
            mnxt = mrow[st + 1];
        }
        asm volatile("" ::: "memory"); __builtin_amdgcn_sched_barrier(0);
        if (VAR != 3) {
        if (tq_lo - (128 * st + 127) >= 113) {
            f32x16 X, Y;
            A_QK(X, 0, cf16); A_QK(Y, 1, cf16);
            { const unsigned mw_ = mcur.x >> (4 * hh); A_SM16(); } A_PVM(X, 0);
            A_QK(X, 2, cf16);
            { f32x16& Xr = Y; const unsigned mw_ = mcur.y >> (4 * hh);
#define X Xr
              A_SM16();
#undef X
            } A_PVM(Y, 1);
            A_QK(Y, 3, cf16);
            { const unsigned mw_ = mcur.z >> (4 * hh); A_SM16(); } A_PVM(X, 2);
            { f32x16& Xr = Y; const unsigned mw_ = mcur.w >> (4 * hh);
#define X Xr
              A_SM16();
#undef X
            } A_PVM(Y, 3);
        } else {
#pragma unroll
            for (int kb = 0; kb < 4; ++kb) {
                const int key0 = 128 * st + 32 * kb;
                if (key0 > tq_hi) continue;
                f32x16 X, zero;
#pragma unroll
                for (int r = 0; r < 16; ++r) zero[r] = 0.f;
                const unsigned mw_ = (kb == 0 ? mcur.x : kb == 1 ? mcur.y : kb == 2 ? mcur.z : mcur.w) >> (4 * hh);
                if (tq_lo - (key0 + 31) >= 113) { A_QK(X, kb, cf16); }
                else { A_QK(X, kb, zero);
#pragma unroll
                    for (int r = 0; r < 16; ++r) { int di = tq - (key0 + crow(r, hh)); di = di < 0 ? 0 : (di > 127 ? 127 : di); X[r] += BT[di]; } }
                A_SM16();
                A_PVM(X, kb);
            }
        }
        }
        asm volatile("" ::: "memory"); __builtin_amdgcn_sched_barrier(0);
        if (more) {
            const unsigned kn = KT + ((st + 1) & 1) * A_SK, vn = VT + ((st + 1) & 1) * A_SV;
#pragma unroll
            for (int i = 0; i < 2; ++i) { const int idx = i * NT + tid, row = idx >> 3, ch = idx & 7;
                *(LAS u32x4*)(kn + row * A_PK + ch * 16) = kr[i]; *(LAS u32x4*)(vn + row * A_PV + ch * 16) = vr[i]; }
            mcur = mnxt;
        }
        __syncthreads();
    }
#undef A_QK
#undef A_PVM
    lsum += __shfl_xor(lsum, 32);
    const float inv = fast_rcp(lsum);
    bf16* orow = DQ + (rowq + 32 * w + (l & 31)) * 1536 + h * 64;
#pragma unroll
    for (int d = 0; d < 2; ++d)
#pragma unroll
        for (int g = 0; g < 4; ++g) { u32x2 o; o.x = pk2(O[d][4 * g] * inv, O[d][4 * g + 1] * inv); o.y = pk2(O[d][4 * g + 2] * inv, O[d][4 * g + 3] * inv);
            if (do_store) *(u32x2*)(orow + 32 * d + 8 * g + 4 * hh) = o; }
}
DI void cross_att_unit(Frame& F, int u) {
    const int b = u >> 7, h = (u >> 5) & 3, qb = u & 31;
    const bf16* QC = (const bf16*)(F.ws + WS_QC); const bf16* KVM = (const bf16*)(F.ws + WS_KVM); bf16* OX = (bf16*)(F.ws + WS_OX);
    const size_t rowq = (size_t)b * T + qb * 256;
    __syncthreads();
    attn_unit<128, false>(F, QC + rowq * 512 + h * 128, 512, KVM + (size_t)b * MEML * 1024 + h * 128, KVM + (size_t)b * MEML * 1024 + 512 + h * 128, 1024, MEML / 64,
                          OX + rowq * 512 + h * 128, 512, 0.08838834764831845f * LOG2E, nullptr, 0, nullptr, 0.f);
}

constexpr int N_PHASES = 19;
#ifndef MK_ONE_LAUNCH
#define MK_ONE_LAUNCH 1
#endif
__global__ void __launch_bounds__(NT, 2) mega_fwd(Args args) {
    extern __shared__ __attribute__((aligned(16))) unsigned char lds_raw[];
    Frame F;
    F.lds = (LAS unsigned char*)lds_raw; F.ws = args.ws;
    F.tid = threadIdx.x; F.lane = F.tid & 63; F.wave = __builtin_amdgcn_readfirstlane(F.tid >> 6);
    F.G = gridDim.x; F.c = blockIdx.x;
    volatile LAS unsigned* MISC = (volatile LAS unsigned*)(F.lds + MISC_OFF);
    if (F.tid < 64) MISC[F.tid] = 0u;
    __syncthreads();
    unsigned* ctl = (unsigned*)(args.ws + WS_CTL);
    const int lo = args.ph_lo, hi = args.ph_hi;
    XcdBarrier bar; bar.bar = ctl + CW_BAR; bar.x = 0; bar.st = MISC + 8;
    if (hi - lo > 1) bar = xcd_barrier_post(ctl + CW_BAR, MISC + 8);
    const float* const* in = args.in;
    const bool st_ok = args.nostore == 0; const int sub = args.sub;
    unsigned char* ws = args.ws;
    const int gw = F.c * NWAVES + F.wave, NGW = F.G * NWAVES;
#ifndef PHMASK
#define PHMASK 0x7ffff
#endif
#define IN(k) (((PHMASK >> (k)) & 1) && lo <= (k) && (k) < hi)
#define SEAM(k) do { if ((k) + 1 < hi) xcd_barrier(bar); } while (0)
#ifndef DUP_PHASE
#define DUP_PHASE -1
#endif
#ifndef DUP_N
#define DUP_N 1
#endif
#define REPS(k) ((k) == DUP_PHASE ? 1 + DUP_N : 1)
#define FORREP(k) _Pragma("unroll 1") for (int rep = 0; rep < REPS(k); ++rep)
#define ST(k) (st_ok)
#define REPBAR(k) do { if (rep + 1 < REPS(k)) xcd_barrier(bar); } while (0)
    bf16* XN = (bf16*)(ws + WS_XN); bf16* HID = (bf16*)(ws + WS_HID); bf16* Y = (bf16*)(ws + WS_Y);
    bf16* W1A = (bf16*)(ws + WS_W1A); bf16* W1B = (bf16*)(ws + WS_W1B);

    if (IN(0)) { FORREP(0) {
        LAS float* scr = (LAS float*)(F.lds + F.wave * 16384);
        constexpr int NITEMS = 10240;
        for (int it0 = gw; it0 < NITEMS; it0 += NGW) { int it = it0;
            if (conv_job(it, in[4], 2 * FF, D, 2 * FF / 32, W1A, D, ColFfn{}, scr, F.lane)) continue;
            if (conv_job(it, in[5], D, FF, D / 32, W1B, FF, ColIdent{0}, scr, F.lane)) continue;
            if (conv_job(it, in[8], 7256, D, NIN / 32, (bf16*)(ws + WS_WIN), D, ColInproj{}, scr, F.lane)) continue;
            if (conv_job(it, in[8], 7256, D, 2048 / 32, (bf16*)(ws + WS_WGT), D, ColIdent{5208}, scr, F.lane)) continue;
            if (conv_job(it, in[12], D, D, D / 32, (bf16*)(ws + WS_WG), D, ColIdent{0}, scr, F.lane)) continue;
            if (conv_job(it, in[13], D, 512, D / 32, (bf16*)(ws + WS_WD), 512, ColIdent{0}, scr, F.lane)) continue;
            if (conv_job(it, in[15], D, D, D / 32, (bf16*)(ws + WS_WO), D, ColIdent{0}, scr, F.lane)) continue;
            if (conv_job(it, in[19], 512, D, 512 / 32, (bf16*)(ws + WS_WCQ), D, ColIdent{0}, scr, F.lane)) continue;
            if (conv_job(it, in[20], D, D, D / 32, (bf16*)(ws + WS_WCKV), D, ColIdent{0}, scr, F.lane)) continue;
            conv_job(it, in[21], D, 512, D / 32, (bf16*)(ws + WS_WCO), 512, ColIdent{0}, scr, F.lane);
        }
        { int m = gw;
          for (; m + 3 * NGW < M; m += 4 * NGW) rms_rows_bf16<4>(in[0] + (size_t)m * D, in[2], XN + (size_t)m * D, F.lane, (size_t)NGW * D);
          for (; m < M; m += NGW) rms_rows_bf16<1>(in[0] + (size_t)m * D, in[2], XN + (size_t)m * D, F.lane, 0); }
        for (int m = gw; m < BATCH * MEML; m += NGW) rms_rows_bf16<1>(in[1] + (size_t)m * D, in[16], (bf16*)(ws + WS_MEMN) + (size_t)m * D, F.lane, 0);
        REPBAR(0); }
        SEAM(0);
    }
    if (IN(1)) {
        pg8::Order1 S; S.init(pg8::GDesc{XN, W1A, D, D, D, M / 256, 2 * FF / 256}, F.G, F.c);
        FORREP(1) { pg8::gemm_phase<true>(F.lds, S, EpiSwiglu{HID}); REPBAR(1); }
        SEAM(1);
    }
    if (IN(2)) {
        pg8::Order1 S; S.init(pg8::GDesc{HID, W1B, FF, FF, FF, M / 256, D / 256}, F.G, F.c);
        FORREP(2) { pg8::gemm_phase<true>(F.lds, S, EpiStore{Y, D}); REPBAR(2); }
        SEAM(2);
    }
    if (IN(3)) { FORREP(3) { resnorm_phase(F, in[0], Y, in[3], 0.5f, args.out, in[6], XN, ST(3)); REPBAR(3); } SEAM(3); }
    if (IN(4)) {
        pg8::Order2 S; S.d0 = pg8::GDesc{XN, (const bf16*)(ws + WS_WIN), D, D, D, M / 256, NIN / 256};
        S.d1 = pg8::GDesc{(const bf16*)(ws + WS_MEMN), (const bf16*)(ws + WS_WCKV), D, D, D, BATCH * MEML / 256, D / 256}; S.G = F.G; S.c = F.c;
        FORREP(4) { pg8::gemm_phase<true>(F.lds, S, EpiInproj{ws}); REPBAR(4); }
        SEAM(4);
    }
    if (IN(5)) {
        FORREP(5) {
        if (sub <= 0) { for (int u = F.c; u < 256; u += F.G) gla_state_unit(F, in, u); __syncthreads(); }
        if (sub != 0) for (int k = 0; k * F.G < 2048; ++k) { const int u = k * F.G + ((k & 1) ? F.G - 1 - F.c : F.c); if (u < 2048) idx_unit(F, u, ST(5), sub >= 2 ? sub - 1 : 0); }
        REPBAR(5); }
        SEAM(5);
    }
    if (IN(6)) {
        FORREP(6) {
        if (sub != 1) gla_scan_phase(F, ST(6));
#ifdef PROBE_EXTRA_PHASE
        if (sub >= 2) { for (int p = F.c; p < 256; p += F.G) { const int bh = p >> 4, x = p & 15;
            if (sub == 2) { dsa_att_unit<1>(F, in, bh, x, false); dsa_att_unit<1>(F, in, bh, 31 - x, false); }
            if (sub == 3) { dsa_att_unit<3>(F, in, bh, x, false); dsa_att_unit<3>(F, in, bh, 31 - x, false); }
            if (sub == 4) { dsa_att_unit<4>(F, in, bh, x, false); dsa_att_unit<4>(F, in, bh, 31 - x, false); }
            if (sub == 5) { dsa_att_unit<5>(F, in, bh, x, false); dsa_att_unit<5>(F, in, bh, 31 - x, false); }
            if (sub == 6) { dsa_att_unit<6>(F, in, bh, x, false); dsa_att_unit<6>(F, in, bh, 31 - x, false); } } } else
#endif
        if (sub != 0) for (int p = F.c; p < 256; p += F.G) { const int bh = p >> 4, x = p & 15; dsa_att_unit(F, in, bh, x, ST(6)); dsa_att_unit(F, in, bh, 31 - x, ST(6)); }
        REPBAR(6); }
        SEAM(6);
    }
    if (IN(7)) {
        FORREP(7) { for (int u = F.c; u < 256; u += F.G) { gla_out_unit(F, in, u, ST(7)); __syncthreads(); } REPBAR(7); }
        SEAM(7);
    }
    if (IN(8)) {
        pg8::Order1 S; S.init(pg8::GDesc{XN, (const bf16*)(ws + WS_WGT), D, D, D, M / 256, 2048 / 256}, F.G, F.c);
        FORREP(8) { pg8::gemm_phase<true>(F.lds, S, EpiGates{(bf16*)(ws + WS_SGA), (bf16*)(ws + WS_SGB)}); REPBAR(8); }
        SEAM(8);
    }
    if (IN(9)) {
        pg8::PairOrder S; S.d0 = pg8::GDesc{(const bf16*)(ws + WS_GR), (const bf16*)(ws + WS_WG), D, D, D, M / 256, D / 256};
        S.d1 = pg8::GDesc{(const bf16*)(ws + WS_DQKV), (const bf16*)(ws + WS_WD), 1536, 512, 512, M / 256, D / 256}; S.G = F.G; S.c = F.c;
        FORREP(9) { pg8::gemm_phase<false>(F.lds, S, EpiMerge{(const bf16*)(ws + WS_SGA), (const bf16*)(ws + WS_SGB), (bf16*)(ws + WS_MRG)}); REPBAR(9); }
        SEAM(9);
    }
    if (IN(10)) {
        pg8::Order1 S; S.init(pg8::GDesc{(const bf16*)(ws + WS_MRG), (const bf16*)(ws + WS_WO), D, D, D, M / 256, D / 256}, F.G, F.c);
        FORREP(10) { pg8::gemm_phase<true>(F.lds, S, EpiStore{(bf16*)(ws + WS_Y2), D}); REPBAR(10); }
        SEAM(10);
    }
    if (IN(11)) {
        FORREP(11) {
        resnorm_phase(F, args.out, (const bf16*)(ws + WS_Y2), in[7], 1.0f, args.out, in[17], XN, ST(11));
        LAS float* scr = (LAS float*)(F.lds + F.wave * 16384);
        constexpr int NITEMS = 2816 + 1408;
        for (int it0 = gw; it0 < NITEMS; it0 += NGW) { int it = it0;
            if (conv_job(it, in[24], 2 * FF, D, 2 * FF / 32, W1A, D, ColFfn{}, scr, F.lane)) continue;
            conv_job(it, in[25], D, FF, D / 32, W1B, FF, ColIdent{0}, scr, F.lane);
        }
        REPBAR(11); }
        SEAM(11);
    }
    if (IN(12)) {
        pg8::Order1 S; S.init(pg8::GDesc{XN, (const bf16*)(ws + WS_WCQ), D, D, D, M / 256, 512 / 256}, F.G, F.c);
        FORREP(12) { pg8::gemm_phase<true>(F.lds, S, EpiStore{(bf16*)(ws + WS_QC), 512}); REPBAR(12); }
        SEAM(12);
    }
    if (IN(13)) {
        FORREP(13) { for (int u = F.c; u < 256; u += F.G) cross_att_unit(F, u); REPBAR(13); }
        SEAM(13);
    }
    if (IN(14)) {
        pg8::Order1 S; S.init(pg8::GDesc{(const bf16*)(ws + WS_OX), (const bf16*)(ws + WS_WCO), 512, 512, 512, M / 256, D / 256}, F.G, F.c);
        FORREP(14) { pg8::gemm_phase<true>(F.lds, S, EpiStore{(bf16*)(ws + WS_Y3), D}); REPBAR(14); }
        SEAM(14);
    }
    if (IN(15)) { FORREP(15) { resnorm_phase(F, args.out, (const bf16*)(ws + WS_Y3), in[18], 1.0f, args.out, in[22], XN, ST(15)); REPBAR(15); } SEAM(15); }
    if (IN(16)) {
        pg8::Order1 S; S.init(pg8::GDesc{XN, W1A, D, D, D, M / 256, 2 * FF / 256}, F.G, F.c);
        FORREP(16) { pg8::gemm_phase<true>(F.lds, S, EpiSwiglu{HID}); REPBAR(16); }
        SEAM(16);
    }
    if (IN(17)) {
        pg8::Order1 S; S.init(pg8::GDesc{HID, W1B, FF, FF, FF, M / 256, D / 256}, F.G, F.c);
        FORREP(17) { pg8::gemm_phase<true>(F.lds, S, EpiStore{Y, D}); REPBAR(17); }
        SEAM(17);
    }
    if (IN(18)) { FORREP(18) { resnorm_phase(F, args.out, Y, in[23], 0.5f, args.out, nullptr, nullptr, ST(18)); REPBAR(18); } }
#ifdef PROBE_EXTRA_PHASE
    if (lo == 20) { f32x16 a0, a1, a2, a3; for (int r = 0; r < 16; ++r) { a0[r] = 0.f; a1[r] = 1.f; a2[r] = 2.f; a3[r] = 3.f; }
        bf16x8 x = pack8(1.f, 2.f, 3.f, 4.f, 5.f, 6.f, 7.f, (float)F.lane), y = pack8(.5f, .25f, .125f, 1.f, 2.f, 3.f, 4.f, (float)F.wave);
        for (int i = 0; i < 2048; ++i) { a0 = MFMA32(x, y, a0); a1 = MFMA32(x, y, a1); a2 = MFMA32(x, y, a2); a3 = MFMA32(x, y, a3); }
        if (a0[0] + a1[1] + a2[2] + a3[3] == 1.2345f) ctl[32] = 1u; }
    if (lo == 21) { float v0 = (float)F.lane, v1 = 1.f, v2 = 2.f, v3 = 3.f, v4 = 4.f, v5 = 5.f, v6 = 6.f, v7 = 7.f; const float m = 1.0000001f, c = 1e-9f;
        for (int i = 0; i < 8192; ++i) { v0 = fmaf(v0, m, c); v1 = fmaf(v1, m, c); v2 = fmaf(v2, m, c); v3 = fmaf(v3, m, c); v4 = fmaf(v4, m, c); v5 = fmaf(v5, m, c); v6 = fmaf(v6, m, c); v7 = fmaf(v7, m, c); }
        if (v0 + v1 + v2 + v3 + v4 + v5 + v6 + v7 == 1.2345f) ctl[32] = 1u; }
    if (lo == 22) { f32x4 a0 = {0, 0, 0, 0}, a1 = {1, 1, 1, 1}, a2 = {2, 2, 2, 2}, a3 = {3, 3, 3, 3};
        bf16x8 x = pack8(1.f, 2.f, 3.f, 4.f, 5.f, 6.f, 7.f, (float)F.lane), y = pack8(.5f, .25f, .125f, 1.f, 2.f, 3.f, 4.f, (float)F.wave);
        for (int i = 0; i < 4096; ++i) { a0 = __builtin_amdgcn_mfma_f32_16x16x32_bf16(x, y, a0, 0, 0, 0); a1 = __builtin_amdgcn_mfma_f32_16x16x32_bf16(x, y, a1, 0, 0, 0); a2 = __builtin_amdgcn_mfma_f32_16x16x32_bf16(x, y, a2, 0, 0, 0); a3 = __builtin_amdgcn_mfma_f32_16x16x32_bf16(x, y, a3, 0, 0, 0); }
        if (a0[0] + a1[1] + a2[2] + a3[3] == 1.2345f) ctl[32] = 1u; }
    if (lo == 23) { float v0 = (float)F.lane * 1e-3f, v1 = .1f, v2 = .2f, v3 = .3f;
        for (int i = 0; i < 8192; ++i) { v0 = fast_exp2(v0) - 1.f; v1 = fast_exp2(v1) - 1.f; v2 = fast_exp2(v2) - 1.f; v3 = fast_exp2(v3) - 1.f; }
        if (v0 + v1 + v2 + v3 == 1.2345f) ctl[32] = 1u; }
#endif
#undef IN
#undef SEAM
}

extern "C" void kernel_launch(void* const* d_in, const int* in_sizes, int n_in, void* d_out, int out_size, void* d_ws, size_t ws_size, hipStream_t stream) {
    static int grid = 0;
    if (grid == 0) {
        if (n_in != 26 || out_size != M * D || ws_size < WS_END) { fprintf(stderr, "kernel_launch: unexpected problem shape (n_in %d, out %d, ws %zu); nothing launched\n", n_in, out_size, ws_size); grid = -1; return; }
        int dev = 0, cus = 0, per_cu = 0;
        if (hipGetDevice(&dev) != hipSuccess || hipDeviceGetAttribute(&cus, hipDeviceAttributeMultiprocessorCount, dev) != hipSuccess) { grid = -1; return; }
        if (hipFuncSetAttribute((const void*)mega_fwd, hipFuncAttributeMaxDynamicSharedMemorySize, LDS_BYTES) != hipSuccess) { fprintf(stderr, "kernel_launch: hipFuncSetAttribute failed\n"); grid = -1; return; }
        if (hipOccupancyMaxActiveBlocksPerMultiprocessor(&per_cu, (const void*)mega_fwd, NT, LDS_BYTES) != hipSuccess || per_cu < 1) fprintf(stderr, "kernel_launch: occupancy query reports %d workgroups per CU\n", per_cu);
        (void)hipGetLastError();
        grid = cus;
    }
    if (grid < 0) return;
    (void)hipMemsetAsync((char*)d_ws + WS_CTL, 0, 65536, stream);
    Args a{};
    for (int i = 0; i < 26; ++i) a.in[i] = (const float*)d_in[i];
    a.out = (float*)d_out; a.ws = (unsigned char*)d_ws;
    a.nostore = 0; a.sub = -1;
#if MK_ONE_LAUNCH
    a.ph_lo = 0; a.ph_hi = N_PHASES;
    hipLaunchKernelGGL(mega_fwd, dim3(grid), dim3(NT), LDS_BYTES, stream, a);
#ifdef PROBE_EXTRA_PHASE
    for (int r = 0; r < PROBE_EXTRA_N; ++r) { a.ph_lo = PROBE_EXTRA_PHASE; a.ph_hi = PROBE_EXTRA_PHASE + 1; a.nostore = 1; a.sub = PROBE_EXTRA_SUB;
    hipLaunchKernelGGL(mega_fwd, dim3(grid), dim3(NT), LDS_BYTES, stream, a); }
#endif
#else
    for (int p = 0; p < N_PHASES; ++p) { a.ph_lo = p; a.ph_hi = p + 1; hipLaunchKernelGGL(mega_fwd, dim3(grid), dim3(NT), LDS_BYTES, stream, a); }
#endif
}
```

```cpp
#define MK_ONE_LAUNCH 1
#pragma clang diagnostic ignored "-Wint-to-pointer-cast"
#include <hip/hip_runtime.h>
#include <cstdio>
#include <cstdint>

#define DI __device__ __forceinline__
#define LAS __attribute__((address_space(3)))
#define GAS __attribute__((address_space(1)))
typedef unsigned short bf16;
typedef short bf16x8 __attribute__((ext_vector_type(8)));
typedef short s16x4 __attribute__((ext_vector_type(4)));
typedef float f32x4 __attribute__((ext_vector_type(4)));
typedef float f32x2 __attribute__((ext_vector_type(2)));
typedef float f32x16 __attribute__((ext_vector_type(16)));
typedef unsigned u32x4 __attribute__((ext_vector_type(4)));
typedef unsigned u32x2 __attribute__((ext_vector_type(2)));
typedef __bf16 bf16x2_t __attribute__((ext_vector_type(2)));

DI unsigned pk2(float lo, float hi) { f32x2 v = {lo, hi}; bf16x2_t b = __builtin_convertvector(v, bf16x2_t); return __builtin_bit_cast(unsigned, b); }
DI float bflo(unsigned w) { return __uint_as_float(w << 16); }
DI float bfhi(unsigned w) { return __uint_as_float(w & 0xffff0000u); }
DI float bf2f(bf16 v) { return __uint_as_float(((unsigned)v) << 16); }
DI float wave_sum(float v) {
#pragma unroll
    for (int o = 1; o < 64; o <<= 1) v += __shfl_xor(v, o);
    return v;
}
DI float fast_exp2(float x) { return __builtin_amdgcn_exp2f(x); }
DI float fast_exp(float x) { return __builtin_amdgcn_exp2f(x * 1.4426950408889634f); }
DI float fast_rcp(float x) { return __builtin_amdgcn_rcpf(x); }
DI float sigmoid_f(float x) { return fast_rcp(1.0f + fast_exp(-x)); }
#define MFMA32(a, b, c) __builtin_amdgcn_mfma_f32_32x32x16_bf16((a), (b), (c), 0, 0, 0)
DI int crow(int r, int hi) { return (r & 3) + 8 * (r >> 2) + 4 * hi; }
DI bf16x8 pack8(float a0, float a1, float a2, float a3, float a4, float a5, float a6, float a7) {
    u32x4 p; p.x = pk2(a0, a1); p.y = pk2(a2, a3); p.z = pk2(a4, a5); p.w = pk2(a6, a7); return __builtin_bit_cast(bf16x8, p);
}
DI bf16x8 pack_step(const f32x16& x, int s) { return pack8(x[8 * s], x[8 * s + 1], x[8 * s + 2], x[8 * s + 3], x[8 * s + 4], x[8 * s + 5], x[8 * s + 6], x[8 * s + 7]); }
typedef short v4i16_t __attribute__((ext_vector_type(4)));
DI s16x4 vtr(unsigned lds_byte_addr) { return __builtin_bit_cast(s16x4, __builtin_amdgcn_ds_read_tr16_b64_v4i16((LAS v4i16_t*)lds_byte_addr)); }
DI bf16x8 cat4(s16x4 lo, s16x4 hi) { return __builtin_shufflevector(lo, hi, 0, 1, 2, 3, 4, 5, 6, 7); }
DI bf16x8 lds_b128(unsigned lds_byte_addr) { return *(const LAS bf16x8*)lds_byte_addr; }

namespace pg8 {
#define PG8_LAS __attribute__((address_space(3)))
typedef unsigned short bf16_t;
constexpr int BM = 256, BK = 64, HALF = 128, HTB = HALF * BK * 2  , STAGE_BYTES = 8 * HTB, NXCD = 8, WGM = 8;

__host__ __device__ __forceinline__ int lds_byte(int r, int c) { const int st = (r >> 4) * 2 + (c >> 5), rr = r & 15, cc = c & 31, ob = rr * 64 + cc * 2; return st * 1024 + (ob ^ (((ob >> 9) & 1) << 5)); }
__host__ __device__ __forceinline__ void stage_rc(int b, int& R, int& C) { const int st = b / 1024, sb = b % 1024, swz = sb ^ (((sb >> 9) & 1) << 5); R = (st >> 1) * 16 + swz / 64; C = (st & 1) * 32 + (swz % 64) / 2; }
__host__ __device__ __forceinline__ int perm32(int rho) { const int n = rho >> 4, i = rho & 15; return 8 * (i >> 2) + 4 * n + (i & 3); }

struct Unit { int pm, pn, g; };
struct GDesc { const bf16_t* A; const bf16_t* Bt; int lda, ldb, K, nM, nN; };

__device__ __forceinline__ void tile_of(int l, int nM, int nN, int& pm, int& pn) {
    const int nwg = nM * nN; int wgid = l;
    { const int q = nwg / NXCD, r = nwg % NXCD, xcd = wgid % NXCD, off = wgid / NXCD; wgid = (xcd < r ? xcd * (q + 1) : r * (q + 1) + (xcd - r) * q) + off; }
    const int nig = WGM * nN, gid = wgid / nig, fm = gid * WGM, gsz = (nM - fm) < WGM ? (nM - fm) : WGM;
    pm = fm + ((wgid % nig) % gsz); pn = (wgid % nig) / gsz;
}
struct Order1 {
    GDesc d0; int G, c;
    __device__ __forceinline__ void init(const GDesc& a, int G_, int c_) { d0 = a; G = G_; c = c_; }
    __device__ __forceinline__ GDesc desc(int) const { return d0; }
    __device__ __forceinline__ bool next(int i, Unit& u) const {
        const long L = (long)i * G + c; if (L >= (long)(d0.nM * d0.nN)) return false;
        tile_of((int)L, d0.nM, d0.nN, u.pm, u.pn); u.g = 0; return true;
    }
};
struct Order2 {
    GDesc d0, d1; int G, c;
    __device__ __forceinline__ GDesc desc(int g) const { GDesc r; r.A = g == 0 ? d0.A : d1.A; r.Bt = g == 0 ? d0.Bt : d1.Bt; r.lda = d0.lda; r.ldb = d0.ldb; r.K = d0.K; r.nM = g == 0 ? d0.nM : d1.nM; r.nN = g == 0 ? d0.nN : d1.nN; return r; }
    __device__ __forceinline__ bool next(int i, Unit& u) const {
        const int n0 = d0.nM * d0.nN, n1 = d1.nM * d1.nN;
        const long L = (long)i * G + c; if (L >= (long)(n0 + n1)) return false;
        int l = (int)L, g = 0; if (l >= n0) { l -= n0; g = 1; }
        tile_of(l, g == 0 ? d0.nM : d1.nM, g == 0 ? d0.nN : d1.nN, u.pm, u.pn); u.g = g; return true;
    }
};
struct PairOrder {
    GDesc d0, d1; int G, c;
    __device__ __forceinline__ GDesc desc(int g) const { GDesc r; r.A = g == 0 ? d0.A : d1.A; r.Bt = g == 0 ? d0.Bt : d1.Bt; r.lda = g == 0 ? d0.lda : d1.lda; r.ldb = g == 0 ? d0.ldb : d1.ldb; r.K = g == 0 ? d0.K : d1.K; r.nM = d0.nM; r.nN = d0.nN; return r; }
    __device__ __forceinline__ bool next(int i, Unit& u) const {
        const long L = (long)(i >> 1) * G + c; if (L >= (long)(d0.nM * d0.nN)) return false;
        tile_of((int)L, d0.nM, d0.nN, u.pm, u.pn); u.g = i & 1; return true;
    }
};

template <bool UNIFORM  , class Epi, class Sched>
__device__ __forceinline__ void gemm_phase(PG8_LAS unsigned char* lds, const Sched& S, const Epi& E) {
    const int tid = threadIdx.x, wid = __builtin_amdgcn_readfirstlane(tid >> 6), lane = tid & 63, wr = wid >> 2, wc = wid & 3, fr = lane & 15, fq = lane >> 4;
    auto voff = [tid](int i, int ld, bool perm) -> unsigned { int R, C; stage_rc(tid * 16 + i * 8192, R, C); if (perm) R = (R & ~31) + perm32(R & 31); return (unsigned)(R * ld + C) * 2u; };
    const size_t kstep = (size_t)(BK * 2);
    const unsigned ldsw = (unsigned)wid * 1024u;
    const int aoff = lds_byte(wr * 64 + fr, fq * 8), boff = lds_byte(wc * 32 + fr, fq * 8);
#define PG8_SA(b, h) (((b) * 2 + (h)) * HTB)
#define PG8_SB(b, h) ((4 + (b) * 2 + (h)) * HTB)
#define PG8_STAGE(bufoff, gbase, v0, v1) do { \
        __builtin_amdgcn_global_load_lds((const unsigned*)((const char*)(gbase) + (v0)), (PG8_LAS unsigned*)(lds + (bufoff) + ldsw), 16, 0, 0); \
        __builtin_amdgcn_global_load_lds((const unsigned*)((const char*)(gbase) + (v1)), (PG8_LAS unsigned*)(lds + (bufoff) + ldsw + 8192), 16, 0, 0); } while (0)
#define PG8_LDA(dst, b, h) do { _Pragma("unroll") for (int m = 0; m < 4; ++m) _Pragma("unroll") for (int k = 0; k < 2; ++k) dst[m][k] = *(const PG8_LAS bf16x8*)(lds + PG8_SA(b, h) + aoff + m * 2048 + k * 1024); } while (0)
#define PG8_LDB(dst, b, h) do { _Pragma("unroll") for (int n = 0; n < 2; ++n) _Pragma("unroll") for (int k = 0; k < 2; ++k) dst[n][k] = *(const PG8_LAS bf16x8*)(lds + PG8_SB(b, h) + boff + n * 2048 + k * 1024); } while (0)
#define PG8_MMA(ai, bj, At, Bt) do { __builtin_amdgcn_s_setprio(1); _Pragma("unroll") for (int m = 0; m < 4; ++m) _Pragma("unroll") for (int n = 0; n < 2; ++n) _Pragma("unroll") for (int k = 0; k < 2; ++k) \
        acc[ai][bj][m][n] = __builtin_amdgcn_mfma_f32_16x16x32_bf16(Bt[n][k], At[m][k], acc[ai][bj][m][n], 0, 0, 0); __builtin_amdgcn_s_setprio(0); } while (0)
#define PG8_WAIT_V(n) asm volatile("s_waitcnt vmcnt(" #n ")" ::: "memory")
#define PG8_WAIT_L(n) asm volatile("s_waitcnt lgkmcnt(" #n ")" ::: "memory")
#define PG8_BAR __builtin_amdgcn_s_barrier()
#define PG8_SCHED __builtin_amdgcn_sched_barrier(0)
    Unit cur, nxt; int ui = 0;
    if (!S.next(0, cur)) return;
    GDesc dc = S.desc(cur.g);
    f32x4 acc[2][2][4][2];
#pragma unroll
    for (int a = 0; a < 2; ++a)
#pragma unroll
        for (int b = 0; b < 2; ++b)
#pragma unroll
            for (int m = 0; m < 4; ++m)
#pragma unroll
                for (int n = 0; n < 2; ++n) acc[a][b][m][n] = (f32x4){0.f, 0.f, 0.f, 0.f};
    bf16x8 At[4][2], B0[2][2], B1[2][2];
    unsigned vA0 = voff(0, dc.lda, false), vA1 = voff(1, dc.lda, false), vB0 = voff(0, dc.ldb, true), vB1 = voff(1, dc.ldb, true);
    size_t hA = (size_t)HALF * dc.lda * 2, hB = (size_t)HALF * dc.ldb * 2;
    const char* cA = (const char*)dc.A + (size_t)cur.pm * 2 * hA; const char* cB = (const char*)dc.Bt + (size_t)cur.pn * 2 * hB;
    PG8_STAGE(PG8_SB(0, 0), cB, vB0, vB1); PG8_STAGE(PG8_SB(0, 1), cB + hB, vB0, vB1); PG8_STAGE(PG8_SA(0, 0), cA, vA0, vA1); PG8_STAGE(PG8_SA(0, 1), cA + hA, vA0, vA1);
    if (wr == 1) PG8_BAR;
    PG8_WAIT_V(2); PG8_BAR;
    PG8_STAGE(PG8_SB(1, 0), cB + kstep, vB0, vB1); PG8_STAGE(PG8_SA(1, 0), cA + kstep, vA0, vA1); PG8_STAGE(PG8_SB(1, 1), cB + hB + kstep, vB0, vB1);
    PG8_WAIT_V(6); PG8_BAR;
    for (;;) {
        const bool has_next = S.next(ui + 1, nxt);
        GDesc dn = dc; if (has_next) dn = S.desc(nxt.g);
        unsigned nvA0 = vA0, nvA1 = vA1, nvB0 = vB0, nvB1 = vB1; size_t nhA = hA, nhB = hB;
        if constexpr (!UNIFORM) { if (has_next) { nvA0 = voff(0, dn.lda, false); nvA1 = voff(1, dn.lda, false); nvB0 = voff(0, dn.ldb, true); nvB1 = voff(1, dn.ldb, true); nhA = (size_t)HALF * dn.lda * 2; nhB = (size_t)HALF * dn.ldb * 2; } }
        const char* nA = has_next ? (const char*)dn.A + (size_t)nxt.pm * 2 * nhA : cA; const char* nB = has_next ? (const char*)dn.Bt + (size_t)nxt.pn * 2 * nhB : cB;
        const int nt = dc.K / BK;
        for (int t = 0; t < nt; t += 2) {
            const bool last = (t == nt - 2);
            const char* a1 = cA + (size_t)(t + 1) * kstep;
            const char* a2 = last ? nA : cA + (size_t)(t + 2) * kstep; const char* b2 = last ? nB : cB + (size_t)(t + 2) * kstep;
            const char* a3 = a2 + kstep; const char* b3 = b2 + kstep;
            unsigned xA0 = vA0, xA1 = vA1, xB0 = vB0, xB1 = vB1; size_t xhA = hA, xhB = hB;
            if constexpr (!UNIFORM) { if (last) { xA0 = nvA0; xA1 = nvA1; xB0 = nvB0; xB1 = nvB1; xhA = nhA; xhB = nhB; } }
            PG8_LDB(B0, 0, 0); PG8_LDB(B1, 0, 1); PG8_SCHED; PG8_LDA(At, 0, 0); PG8_STAGE(PG8_SA(1, 1), a1 + hA, vA0, vA1);
            PG8_WAIT_V(8); PG8_WAIT_L(0); PG8_BAR; PG8_MMA(0, 0, At, B0); PG8_MMA(0, 1, At, B1); PG8_BAR; PG8_SCHED;
            PG8_LDA(At, 0, 1); PG8_STAGE(PG8_SB(0, 0), b2, xB0, xB1); PG8_STAGE(PG8_SB(0, 1), b2 + xhB, xB0, xB1); PG8_STAGE(PG8_SA(0, 0), a2, xA0, xA1);
            PG8_WAIT_V(8); PG8_WAIT_L(0); PG8_BAR; PG8_MMA(1, 0, At, B0); PG8_MMA(1, 1, At, B1); PG8_BAR; PG8_SCHED;
            PG8_LDB(B0, 1, 0); PG8_LDB(B1, 1, 1); PG8_SCHED; PG8_LDA(At, 1, 0); PG8_STAGE(PG8_SA(0, 1), a2 + xhA, xA0, xA1);
            PG8_WAIT_V(8); PG8_WAIT_L(0); PG8_BAR; PG8_MMA(0, 0, At, B0); PG8_MMA(0, 1, At, B1); PG8_BAR; PG8_SCHED;
            PG8_LDA(At, 1, 1); PG8_STAGE(PG8_SB(1, 0), b3, xB0, xB1); PG8_STAGE(PG8_SB(1, 1), b3 + xhB, xB0, xB1); PG8_STAGE(PG8_SA(1, 0), a3, xA0, xA1);
            PG8_WAIT_V(8); PG8_WAIT_L(0); PG8_BAR; PG8_MMA(1, 0, At, B0); PG8_MMA(1, 1, At, B1); PG8_BAR; PG8_SCHED;
        }
        if (wr == 0) PG8_BAR;
        const bool keep = E(acc, cur, wr, wc, fr, fq);
        if (!has_next) break;
        if (!keep) {
#pragma unroll
            for (int a = 0; a < 2; ++a)
#pragma unroll
                for (int b = 0; b < 2; ++b)
#pragma unroll
                    for (int m = 0; m < 4; ++m)
#pragma unroll
                        for (int n = 0; n < 2; ++n) acc[a][b][m][n] = (f32x4){0.f, 0.f, 0.f, 0.f};
        }
        cur = nxt; dc = dn; cA = nA; cB = nB; vA0 = nvA0; vA1 = nvA1; vB0 = nvB0; vB1 = nvB1; hA = nhA; hB = nhB; ++ui;
        if (wr == 1) PG8_BAR;
    }
    PG8_WAIT_V(0);
    PG8_BAR;
#undef PG8_SA
#undef PG8_SB
#undef PG8_STAGE
#undef PG8_LDA
#undef PG8_LDB
#undef PG8_MMA
#undef PG8_WAIT_V
#undef PG8_WAIT_L
#undef PG8_BAR
#undef PG8_SCHED
}
template <bool UNIFORM, class Epi, class Sched>
__device__ __forceinline__ void gemm_phase8(PG8_LAS unsigned char* lds, const Sched& S, const Epi& E) {
    const int tid = threadIdx.x, wid = __builtin_amdgcn_readfirstlane(tid >> 6), lane = tid & 63, wr = wid >> 2, wc = wid & 3, fr = lane & 15, fq = lane >> 4;
    auto voff = [tid](int i, int ld, bool perm) -> unsigned { int R, C; stage_rc(tid * 16 + i * 8192, R, C); if (perm) R = (R & ~31) + perm32(R & 31); return (unsigned)(R * ld + 2 * C); };
    const size_t kstep = (size_t)(BK * 2);
    const unsigned ldsw = (unsigned)wid * 1024u;
    const int aoff0 = lds_byte(wr * 64 + fr, fq * 16), boff0 = lds_byte(wc * 32 + fr, fq * 16);
    constexpr int aoff1d = 16, boff1d = 16;
    typedef int v8i __attribute__((ext_vector_type(8))); typedef int v4i __attribute__((ext_vector_type(4)));
    const int unit_scale = 0x7f7f7f7f;
#define PG8_SA(b, h) (((b) * 2 + (h)) * HTB)
#define PG8_SB(b, h) ((4 + (b) * 2 + (h)) * HTB)
#define PG8_STAGE(bufoff, gbase, v0, v1) do { \
        __builtin_amdgcn_global_load_lds((const unsigned*)((const char*)(gbase) + (v0)), (PG8_LAS unsigned*)(lds + (bufoff) + ldsw), 16, 0, 0); \
        __builtin_amdgcn_global_load_lds((const unsigned*)((const char*)(gbase) + (v1)), (PG8_LAS unsigned*)(lds + (bufoff) + ldsw + 8192), 16, 0, 0); } while (0)
#define PG8_LDA(dst, b, h) do { _Pragma("unroll") for (int m = 0; m < 4; ++m) { const v4i lo_ = *(const PG8_LAS v4i*)(lds + PG8_SA(b, h) + aoff0 + m * 2048), hi_ = *(const PG8_LAS v4i*)(lds + PG8_SA(b, h) + aoff0 + aoff1d + m * 2048); dst[m] = __builtin_shufflevector(lo_, hi_, 0, 1, 2, 3, 4, 5, 6, 7); } } while (0)
#define PG8_LDB(dst, b, h) do { _Pragma("unroll") for (int n = 0; n < 2; ++n) { const v4i lo_ = *(const PG8_LAS v4i*)(lds + PG8_SB(b, h) + boff0 + n * 2048), hi_ = *(const PG8_LAS v4i*)(lds + PG8_SB(b, h) + boff0 + boff1d + n * 2048); dst[n] = __builtin_shufflevector(lo_, hi_, 0, 1, 2, 3, 4, 5, 6, 7); } } while (0)
#define PG8_MMA(ai, bj, At, Bt) do { __builtin_amdgcn_s_setprio(1); _Pragma("unroll") for (int m = 0; m < 4; ++m) _Pragma("unroll") for (int n = 0; n < 2; ++n) \
        asm volatile("v_mfma_scale_f32_16x16x128_f8f6f4 %0, %1, %2, %0, %3, %3 op_sel_hi:[0,0,0]" : "+v"(acc[ai][bj][m][n]) : "v"(Bt[n]), "v"(At[m]), "v"(unit_scale)); __builtin_amdgcn_s_setprio(0); } while (0)
#define PG8_WAIT_V(n) asm volatile("s_waitcnt vmcnt(" #n ")" ::: "memory")
#define PG8_WAIT_L(n) asm volatile("s_waitcnt lgkmcnt(" #n ")" ::: "memory")
#define PG8_BAR __builtin_amdgcn_s_barrier()
#define PG8_SCHED __builtin_amdgcn_sched_barrier(0)
    Unit cur, nxt; int ui = 0;
    if (!S.next(0, cur)) return;
    GDesc dc = S.desc(cur.g);
    f32x4 acc[2][2][4][2];
#pragma unroll
    for (int a = 0; a < 2; ++a)
#pragma unroll
        for (int b = 0; b < 2; ++b)
#pragma unroll
            for (int m = 0; m < 4; ++m)
#pragma unroll
                for (int n = 0; n < 2; ++n) acc[a][b][m][n] = (f32x4){0.f, 0.f, 0.f, 0.f};
    v8i At[4], B0[2], B1[2];
    unsigned vA0 = voff(0, dc.lda, false), vA1 = voff(1, dc.lda, false), vB0 = voff(0, dc.ldb, true), vB1 = voff(1, dc.ldb, true);
    size_t hA = (size_t)HALF * dc.lda, hB = (size_t)HALF * dc.ldb;
    const char* cA = (const char*)dc.A + (size_t)cur.pm * 2 * hA; const char* cB = (const char*)dc.Bt + (size_t)cur.pn * 2 * hB;
    PG8_STAGE(PG8_SB(0, 0), cB, vB0, vB1); PG8_STAGE(PG8_SB(0, 1), cB + hB, vB0, vB1); PG8_STAGE(PG8_SA(0, 0), cA, vA0, vA1); PG8_STAGE(PG8_SA(0, 1), cA + hA, vA0, vA1);
    if (wr == 1) PG8_BAR;
    PG8_WAIT_V(2); PG8_BAR;
    PG8_STAGE(PG8_SB(1, 0), cB + kstep, vB0, vB1); PG8_STAGE(PG8_SA(1, 0), cA + kstep, vA0, vA1); PG8_STAGE(PG8_SB(1, 1), cB + hB + kstep, vB0, vB1);
    PG8_WAIT_V(6); PG8_BAR;
    for (;;) {
        const bool has_next = S.next(ui + 1, nxt);
        GDesc dn = dc; if (has_next) dn = S.desc(nxt.g);
        unsigned nvA0 = vA0, nvA1 = vA1, nvB0 = vB0, nvB1 = vB1; size_t nhA = hA, nhB = hB;
        if constexpr (!UNIFORM) { if (has_next) { nvA0 = voff(0, dn.lda, false); nvA1 = voff(1, dn.lda, false); nvB0 = voff(0, dn.ldb, true); nvB1 = voff(1, dn.ldb, true); nhA = (size_t)HALF * dn.lda; nhB = (size_t)HALF * dn.ldb; } }
        const char* nA = has_next ? (const char*)dn.A + (size_t)nxt.pm * 2 * nhA : cA; const char* nB = has_next ? (const char*)dn.Bt + (size_t)nxt.pn * 2 * nhB : cB;
        const int nt = dc.K / 128;
        for (int t = 0; t < nt; t += 2) {
            const bool last = (t == nt - 2);
            const char* a1 = cA + (size_t)(t + 1) * kstep;
            const char* a2 = last ? nA : cA + (size_t)(t + 2) * kstep; const char* b2 = last ? nB : cB + (size_t)(t + 2) * kstep;
            const char* a3 = a2 + kstep; const char* b3 = b2 + kstep;
            unsigned xA0 = vA0, xA1 = vA1, xB0 = vB0, xB1 = vB1; size_t xhA = hA, xhB = hB;
            if constexpr (!UNIFORM) { if (last) { xA0 = nvA0; xA1 = nvA1; xB0 = nvB0; xB1 = nvB1; xhA = nhA; xhB = nhB; } }
            PG8_LDB(B0, 0, 0); PG8_LDB(B1, 0, 1); PG8_SCHED; PG8_LDA(At, 0, 0); PG8_STAGE(PG8_SA(1, 1), a1 + hA, vA0, vA1);
            PG8_WAIT_V(8); PG8_WAIT_L(0); PG8_BAR; PG8_MMA(0, 0, At, B0); PG8_MMA(0, 1, At, B1); PG8_BAR; PG8_SCHED;
            PG8_LDA(At, 0, 1); PG8_STAGE(PG8_SB(0, 0), b2, xB0, xB1); PG8_STAGE(PG8_SB(0, 1), b2 + xhB, xB0, xB1); PG8_STAGE(PG8_SA(0, 0), a2, xA0, xA1);
            PG8_WAIT_V(8); PG8_WAIT_L(0); PG8_BAR; PG8_MMA(1, 0, At, B0); PG8_MMA(1, 1, At, B1); PG8_BAR; PG8_SCHED;
            PG8_LDB(B0, 1, 0); PG8_LDB(B1, 1, 1); PG8_SCHED; PG8_LDA(At, 1, 0); PG8_STAGE(PG8_SA(0, 1), a2 + xhA, xA0, xA1);
            PG8_WAIT_V(8); PG8_WAIT_L(0); PG8_BAR; PG8_MMA(0, 0, At, B0); PG8_MMA(0, 1, At, B1); PG8_BAR; PG8_SCHED;
            PG8_LDA(At, 1, 1); PG8_STAGE(PG8_SB(1, 0), b3, xB0, xB1); PG8_STAGE(PG8_SB(1, 1), b3 + xhB, xB0, xB1); PG8_STAGE(PG8_SA(1, 0), a3, xA0, xA1);
            PG8_WAIT_V(8); PG8_WAIT_L(0); PG8_BAR; PG8_MMA(1, 0, At, B0); PG8_MMA(1, 1, At, B1); PG8_BAR; PG8_SCHED;
        }
        if (wr == 0) PG8_BAR;
#define PG8_PAD16(a_) asm volatile("s_nop 15\n\ts_nop 15" : "+v"(acc[a_][0][0][0]), "+v"(acc[a_][0][0][1]), "+v"(acc[a_][0][1][0]), "+v"(acc[a_][0][1][1]), "+v"(acc[a_][0][2][0]), "+v"(acc[a_][0][2][1]), "+v"(acc[a_][0][3][0]), "+v"(acc[a_][0][3][1]), \
            "+v"(acc[a_][1][0][0]), "+v"(acc[a_][1][0][1]), "+v"(acc[a_][1][1][0]), "+v"(acc[a_][1][1][1]), "+v"(acc[a_][1][2][0]), "+v"(acc[a_][1][2][1]), "+v"(acc[a_][1][3][0]), "+v"(acc[a_][1][3][1]))
        PG8_PAD16(0); PG8_PAD16(1);
#undef PG8_PAD16
        const bool keep = E(acc, cur, wr, wc, fr, fq);
        if (!has_next) break;
        if (!keep) {
#pragma unroll
            for (int a = 0; a < 2; ++a)
#pragma unroll
                for (int b = 0; b < 2; ++b)
#pragma unroll
                    for (int m = 0; m < 4; ++m)
#pragma unroll
                        for (int n = 0; n < 2; ++n) acc[a][b][m][n] = (f32x4){0.f, 0.f, 0.f, 0.f};
        }
        cur = nxt; dc = dn; cA = nA; cB = nB; vA0 = nvA0; vA1 = nvA1; vB0 = nvB0; vB1 = nvB1; hA = nhA; hB = nhB; ++ui;
        if (wr == 1) PG8_BAR;
    }
    PG8_WAIT_V(0);
    PG8_BAR;
#undef PG8_SA
#undef PG8_SB
#undef PG8_STAGE
#undef PG8_LDA
#undef PG8_LDB
#undef PG8_MMA
#undef PG8_WAIT_V
#undef PG8_WAIT_L
#undef PG8_BAR
#undef PG8_SCHED
}
}

constexpr int NWAVES = 8, NT = 512;
constexpr int BATCH = 2, T = 8192, D = 1024, M = BATCH * T, FF = 2816, MEML = 256;
constexpr float EPS = 1e-6f;
constexpr float LOG2E = 1.4426950408889634f;
constexpr int NIN = 5376;
constexpr size_t KiB = 1024, MiB = 1u << 20;
constexpr size_t WS_CTL = 0, CTL_ZERO_BYTES = 1 * MiB;
constexpr size_t WS_XN = 1 * MiB;
constexpr size_t WS_HID = 33 * MiB;
constexpr size_t WS_Y = 121 * MiB;
constexpr size_t WS_QKG = 33 * MiB, WS_GV = 65 * MiB, WS_GR = 97 * MiB, WS_DQKV = 129 * MiB, WS_IQ = 177 * MiB, WS_SM = 193 * MiB, WS_GST = 197 * MiB;
constexpr size_t WS_W1A = 153 * MiB, WS_W1B = 164 * MiB;
constexpr size_t WS_WIN = 229 * MiB, WS_WGT = 229 * MiB + 10752 * KiB, WS_WG = WS_WGT + 4 * MiB, WS_WD = WS_WG + 2 * MiB, WS_WO = WS_WD + 1 * MiB,
                 WS_WCQ = WS_WO + 2 * MiB, WS_WCKV = WS_WCQ + 1 * MiB, WS_WCO = WS_WCKV + 2 * MiB, WS_MEMN = WS_WCO + 1 * MiB, WS_KVM = WS_MEMN + 1 * MiB, WS_DEC = WS_KVM + 1 * MiB;
constexpr size_t WS_SGA = WS_QKG, WS_SGB = WS_GV, WS_MRG = WS_GST, WS_Y2 = WS_QKG;
constexpr size_t WS_QC = 65 * MiB, WS_OX = 81 * MiB, WS_Y3 = 97 * MiB;
constexpr size_t WS_END = 256 * MiB;
static_assert(WS_DEC + 128 * KiB <= WS_END && WS_W1B + (size_t)D * FF * 2 <= WS_IQ && WS_HID + (size_t)M * FF * 2 <= WS_Y, "d_ws map");
constexpr int CW_BAR = 4096;
constexpr int LDS_BYTES = 163840;
constexpr int MISC_OFF = LDS_BYTES - 256;

#define XB_TMO      128
#define XB_XCNT(j)  (256  + 64 * (j))
#define XB_XSUB(j)  (1280 + 64 * (j))
#define XB_XGEN(j)  (2304 + 64 * (j))
#define XB_TOP      3328
#define XB_TOPGEN   3392
#define XCD_BAR_WORDS 3456
#define XB_SPIN_CAP (1u << 18)

__device__ __forceinline__ unsigned xb_ld(unsigned* p)              { return __hip_atomic_load(p, __ATOMIC_RELAXED, __HIP_MEMORY_SCOPE_AGENT); }
__device__ __forceinline__ unsigned xb_add(unsigned* p, unsigned v) { return __hip_atomic_fetch_add(p, v, __ATOMIC_RELAXED, __HIP_MEMORY_SCOPE_AGENT); }
__device__ __forceinline__ unsigned xb_xcc_id() { return (unsigned)__builtin_amdgcn_s_getreg((3 << 11) | 20) & 0xFu; }
#define XB_SPIN(cond, bar) do { unsigned _sp = 0; while (cond) { __builtin_amdgcn_s_sleep(1); \
    if ((++_sp & 255u) == 0u) { if (xb_ld(&(bar)[XB_TMO])) break; if (_sp > XB_SPIN_CAP) { atomicAdd(&(bar)[XB_TMO], 1u); break; } } } } while (0)

struct XcdBarrier {
    unsigned* bar; unsigned x;
    volatile LAS unsigned* st;
};

__device__ __forceinline__ XcdBarrier xcd_barrier_post(unsigned* bar, volatile LAS unsigned* st) {
    XcdBarrier b; b.bar = bar; b.x = xb_xcc_id(); b.st = st;
    if (threadIdx.x == 0) (void)xb_add(&bar[XB_XCNT(b.x)], 1u);
    return b;
}
__device__ __forceinline__ void xcd_barrier_complete(unsigned* bar, unsigned x, unsigned& nloc, unsigned& nx) {
    const unsigned G = gridDim.x * gridDim.y * gridDim.z;
    unsigned sum, cnt, mine, sp = 0u;
    for (;;) {
        sum = 0u; cnt = 0u; mine = 0u;
#pragma unroll
        for (unsigned j = 0; j < 16; ++j) { const unsigned c = xb_ld(&bar[XB_XCNT(j)]); sum += c; cnt += (c > 0u) ? 1u : 0u; mine = (j == x) ? c : mine; }
        if (sum == G) break;
        __builtin_amdgcn_s_sleep(1);
        if ((++sp & 255u) == 0u) { if (xb_ld(&bar[XB_TMO])) break; if (sp > XB_SPIN_CAP) { atomicAdd(&bar[XB_TMO], 1u); break; } }
    }
    nloc = mine > 0u ? mine : 1u; nx = cnt > 0u ? cnt : 1u;
}

__device__ __forceinline__ void xcd_barrier(const XcdBarrier& b) {
    asm volatile("s_waitcnt vmcnt(0)" ::: "memory");
    __syncthreads();
    if (threadIdx.x == 0) {
        unsigned* bar = b.bar;
        __builtin_amdgcn_s_waitcnt(0);
        unsigned nloc = b.st[0], nx = b.st[1];
        if (nloc == 0u) { xcd_barrier_complete(bar, b.x, nloc, nx); b.st[0] = nloc; b.st[1] = nx; }
        const unsigned old = xb_add(&bar[XB_XSUB(b.x)], 1u);
        const unsigned gen = old / nloc;
        if (old + 1u == (gen + 1u) * nloc) {
            __builtin_amdgcn_fence(__ATOMIC_RELEASE, "agent");
            asm volatile("s_waitcnt vmcnt(0)" ::: "memory");
            const unsigned og = xb_add(&bar[XB_TOP], 1u);
            const unsigned tg = og / nx;
            if (og + 1u == (tg + 1u) * nx) xb_add(&bar[XB_TOPGEN], 1u);
            else XB_SPIN(xb_ld(&bar[XB_TOPGEN]) == tg, bar);
            __builtin_amdgcn_fence(__ATOMIC_ACQUIRE, "agent");
            xb_add(&bar[XB_XGEN(b.x)], 1u);
            asm volatile("s_waitcnt vmcnt(0)" ::: "memory");
        } else {
            XB_SPIN(xb_ld(&bar[XB_XGEN(b.x)]) == gen, bar);
            __builtin_amdgcn_fence(__ATOMIC_ACQUIRE, "agent");
            asm volatile("s_waitcnt vmcnt(0)" ::: "memory");
        }
    }
    __syncthreads();
}

struct Args { const float* in[26]; float* out; unsigned char* ws; int ph_lo, ph_hi, nostore, sub; };
struct Frame {
    LAS unsigned char* lds;
    unsigned char* ws;
    int tid, lane, wave, G, c;
};
#define LDS_WAIT() asm volatile("s_waitcnt lgkmcnt(0)" ::: "memory")
#define VM_WAIT() asm volatile("s_waitcnt vmcnt(0)" ::: "memory")

template <class ColFn>
DI void conv_item(const float* W, int ldw, int k0, bf16* WT, int ldt, int dr0, int dk0, ColFn srccol, LAS float* scr, int lane) {
    const int n4 = (lane & 7) * 4; const int sc = srccol(dr0 + n4);
#pragma unroll
    for (int i = 0; i < 8; ++i) { const int kk = 8 * i + (lane >> 3);
        const f32x4 v = sc >= 0 ? *(const f32x4*)(W + (size_t)(k0 + kk) * ldw + sc) : (f32x4){0.f, 0.f, 0.f, 0.f};
        LAS float* s = scr + kk * 33 + n4; s[0] = v.x; s[1] = v.y; s[2] = v.z; s[3] = v.w; }
    LDS_WAIT(); asm volatile("" ::: "memory");
    const int c = lane & 7;
#pragma unroll
    for (int j = 0; j < 4; ++j) { const int n = (lane >> 3) + 8 * j; const LAS float* s = scr + (8 * c) * 33 + n;
        u32x4 o; o.x = pk2(s[0 * 33], s[1 * 33]); o.y = pk2(s[2 * 33], s[3 * 33]); o.z = pk2(s[4 * 33], s[5 * 33]); o.w = pk2(s[6 * 33], s[7 * 33]);
        *(u32x4*)(WT + (size_t)(dr0 + n) * ldt + dk0 + k0 + 8 * c) = o; }
    LDS_WAIT(); asm volatile("" ::: "memory");
}
DI unsigned pk4_fp8(float a, float b, float c_, float d) {
    a = __builtin_amdgcn_fmed3f(a, -448.f, 448.f); b = __builtin_amdgcn_fmed3f(b, -448.f, 448.f); c_ = __builtin_amdgcn_fmed3f(c_, -448.f, 448.f); d = __builtin_amdgcn_fmed3f(d, -448.f, 448.f);
    int w = __builtin_amdgcn_cvt_pk_fp8_f32(a, b, 0, false); w = __builtin_amdgcn_cvt_pk_fp8_f32(c_, d, w, true); return (unsigned)w;
}
template <class ColFn>
DI void conv_item8(const float* W, int ldw, int k0, unsigned char* WT, int ldt, int dr0, float scale, ColFn srccol, LAS float* scr, int lane) {
    const int n4 = (lane & 7) * 4; const int sc = srccol(dr0 + n4);
#pragma unroll
    for (int i = 0; i < 8; ++i) { const int kk = 8 * i + (lane >> 3);
        const f32x4 v = sc >= 0 ? *(const f32x4*)(W + (size_t)(k0 + kk) * ldw + sc) : (f32x4){0.f, 0.f, 0.f, 0.f};
        LAS float* s = scr + kk * 33 + n4; s[0] = v.x; s[1] = v.y; s[2] = v.z; s[3] = v.w; }
    LDS_WAIT(); asm volatile("" ::: "memory");
    const int c = lane & 7;
#pragma unroll
    for (int j = 0; j < 4; ++j) { const int n = (lane >> 3) + 8 * j; const LAS float* s = scr + (8 * c) * 33 + n;
        u32x2 o; o.x = pk4_fp8(s[0 * 33] * scale, s[1 * 33] * scale, s[2 * 33] * scale, s[3 * 33] * scale); o.y = pk4_fp8(s[4 * 33] * scale, s[5 * 33] * scale, s[6 * 33] * scale, s[7 * 33] * scale);
        *(u32x2*)(WT + (size_t)(dr0 + n) * ldt + k0 + 8 * c) = o; }
    LDS_WAIT(); asm volatile("" ::: "memory");
}
template <class ColFn>
DI bool conv_job8(int& it, const float* W, int ldw, int K, int nb, unsigned char* WT, int ldt, float scale, ColFn f, LAS float* scr, int lane) {
    const int n_items = (K / 64) * nb;
    if (it >= n_items) { it -= n_items; return false; }
    const int kb = it / nb, b = it % nb;
    conv_item8(W, ldw, 64 * kb, WT, ldt, 32 * b, scale, f, scr, lane);
    return true;
}
struct ColIdent { int c0; DI int operator()(int r) const { return c0 + r; } };
struct ColFfn { DI int operator()(int r) const { const int tile = r >> 8, j = r & 255; return j < 128 ? tile * 128 + j : FF + tile * 128 + (j - 128); } };
struct ColInproj { DI int operator()(int r) const { return r < 3072 ? r : (r < 5192 ? r + 16 : (r < 5208 ? 3072 + (r - 5192) : -1)); } };
template <class ColFn>
DI bool conv_job(int& it, const float* W, int ldw, int K, int nb, bf16* WT, int ldt, ColFn f, LAS float* scr, int lane) {
    const int n_items = (K / 64) * nb;
    if (it >= n_items) { it -= n_items; return false; }
    const int kb = it / nb, b = it % nb;
    conv_item(W, ldw, 64 * kb, WT, ldt, 32 * b, 0, f, scr, lane);
    return true;
}
template <int NR>
DI void rms_rows_bf16(const float* xrow, const float* g, bf16* orow, int lane, size_t rstride) {
    f32x4 v[NR][4]; float s[NR];
#pragma unroll
    for (int q = 0; q < NR; ++q) { const f32x4* xr = (const f32x4*)(xrow + q * rstride) + lane; float a = 0.f;
#pragma unroll
        for (int j = 0; j < 4; ++j) { v[q][j] = xr[64 * j]; a += (v[q][j].x * v[q][j].x + v[q][j].y * v[q][j].y) + (v[q][j].z * v[q][j].z + v[q][j].w * v[q][j].w); }
        s[q] = a; }
    const f32x4* gr = (const f32x4*)g + lane; f32x4 gg[4];
#pragma unroll
    for (int j = 0; j < 4; ++j) gg[j] = gr[64 * j];
#pragma unroll
    for (int o = 1; o < 64; o <<= 1)
#pragma unroll
        for (int q = 0; q < NR; ++q) s[q] += __shfl_xor(s[q], o);
#pragma unroll
    for (int q = 0; q < NR; ++q) { const float r = __builtin_amdgcn_rsqf(s[q] * (1.f / D) + EPS); u32x2* o8 = (u32x2*)(orow + q * rstride) + lane;
#pragma unroll
        for (int j = 0; j < 4; ++j) { u32x2 w; w.x = pk2(v[q][j].x * r * gg[j].x, v[q][j].y * r * gg[j].y); w.y = pk2(v[q][j].z * r * gg[j].z, v[q][j].w * r * gg[j].w); o8[64 * j] = w; } }
}
template <int NR, bool XN8 = false  >
DI void resnorm_rows(const float* hin, const bf16* yrow, const float* gpost, float coef, float* hout, const float* gpre, bf16* xn, int lane, bool do_store, size_t rstride) {
    f32x4 y[NR][4], h[NR][4]; float s[NR], s2[NR];
#pragma unroll
    for (int q = 0; q < NR; ++q) { const u32x2* yr = (const u32x2*)(yrow + q * rstride) + lane; const f32x4* hr = (const f32x4*)(hin + q * rstride) + lane;
#pragma unroll
        for (int j = 0; j < 4; ++j) { const u32x2 w = yr[64 * j]; y[q][j] = (f32x4){bflo(w.x), bfhi(w.x), bflo(w.y), bfhi(w.y)}; h[q][j] = hr[64 * j]; } }
    const f32x4* gp = (const f32x4*)gpost + lane; f32x4 g[4];
#pragma unroll
    for (int j = 0; j < 4; ++j) g[j] = gp[64 * j];
#pragma unroll
    for (int q = 0; q < NR; ++q) { float a = 0.f;
#pragma unroll
        for (int j = 0; j < 4; ++j) a += (y[q][j].x * y[q][j].x + y[q][j].y * y[q][j].y) + (y[q][j].z * y[q][j].z + y[q][j].w * y[q][j].w);
        s[q] = a; }
#pragma unroll
    for (int o = 1; o < 64; o <<= 1)
#pragma unroll
        for (int q = 0; q < NR; ++q) s[q] += __shfl_xor(s[q], o);
#pragma unroll
    for (int q = 0; q < NR; ++q) { const float r = __builtin_amdgcn_rsqf(s[q] * (1.f / D) + EPS) * coef; float a = 0.f;
#pragma unroll
        for (int j = 0; j < 4; ++j) { h[q][j] = h[q][j] + y[q][j] * r * g[j]; a += (h[q][j].x * h[q][j].x + h[q][j].y * h[q][j].y) + (h[q][j].z * h[q][j].z + h[q][j].w * h[q][j].w); }
        s2[q] = a;
        if (do_store) { f32x4* ho = (f32x4*)(hout + q * rstride) + lane;
#pragma unroll
            for (int j = 0; j < 4; ++j) ho[64 * j] = h[q][j]; } }
    if (xn) {
        const f32x4* gq = (const f32x4*)gpre + lane;
#pragma unroll
        for (int j = 0; j < 4; ++j) g[j] = gq[64 * j];
#pragma unroll
        for (int o = 1; o < 64; o <<= 1)
#pragma unroll
            for (int q = 0; q < NR; ++q) s2[q] += __shfl_xor(s2[q], o);
#pragma unroll
        for (int q = 0; q < NR; ++q) { const float r2 = __builtin_amdgcn_rsqf(s2[q] * (1.f / D) + EPS);
            if (XN8) { const float r16 = r2 * 16.f; unsigned* o4 = (unsigned*)((unsigned char*)xn + q * rstride) + lane;
#pragma unroll
                for (int j = 0; j < 4; ++j) o4[64 * j] = pk4_fp8(h[q][j].x * r16 * g[j].x, h[q][j].y * r16 * g[j].y, h[q][j].z * r16 * g[j].z, h[q][j].w * r16 * g[j].w);
            } else { u32x2* o8 = (u32x2*)(xn + q * rstride) + lane;
#pragma unroll
            for (int j = 0; j < 4; ++j) { u32x2 w; w.x = pk2(h[q][j].x * r2 * g[j].x, h[q][j].y * r2 * g[j].y); w.y = pk2(h[q][j].z * r2 * g[j].z, h[q][j].w * r2 * g[j].w); o8[64 * j] = w; } } }
    }
}
template <bool XN8 = false>
DI void resnorm_phase(Frame& F, const float* hin, const bf16* y, const float* gpost, float coef, float* hout, const float* gpre, bf16* xn, bool do_store = true) {
    const int gw = F.c * NWAVES + F.wave, NGW = F.G * NWAVES;
    int m = gw;
    for (; m + NGW < M; m += 2 * NGW) { bf16* xp = xn ? (XN8 ? (bf16*)((unsigned char*)xn + (size_t)m * D) : xn + (size_t)m * D) : nullptr;
        resnorm_rows<2, XN8>(hin + (size_t)m * D, y + (size_t)m * D, gpost, coef, hout + (size_t)m * D, gpre, xp, F.lane, do_store, (size_t)NGW * D); }
    for (; m < M; m += NGW) { bf16* xp = xn ? (XN8 ? (bf16*)((unsigned char*)xn + (size_t)m * D) : xn + (size_t)m * D) : nullptr;
        resnorm_rows<1, XN8>(hin + (size_t)m * D, y + (size_t)m * D, gpost, coef, hout + (size_t)m * D, gpre, xp, F.lane, do_store, 0); }
}

using pg8::Unit;
typedef f32x4 Acc[2][2][4][2];
struct EpiStore {
    bf16* O; int ldo; float sc = 1.f;
    DI bool operator()(Acc& acc, const Unit& u, int wr, int wc, int fr, int fq) const {
        const int row0 = u.pm * 256 + wr * 64 + fr, col0 = u.pn * 256 + wc * 32 + 8 * fq;
#pragma unroll
        for (int ai = 0; ai < 2; ++ai)
#pragma unroll
            for (int m = 0; m < 4; ++m) { bf16* rowp = O + (size_t)(row0 + ai * 128 + m * 16) * ldo + col0;
#pragma unroll
                for (int bj = 0; bj < 2; ++bj) { const f32x4 v0 = acc[ai][bj][m][0] * sc, v1 = acc[ai][bj][m][1] * sc;
                    u32x4 w; w.x = pk2(v0[0], v0[1]); w.y = pk2(v0[2], v0[3]); w.z = pk2(v1[0], v1[1]); w.w = pk2(v1[2], v1[3]);
                    *(u32x4*)(rowp + bj * 128) = w; } }
        return false;
    }
};
struct EpiGates {
    bf16* SGA; bf16* SGB;
    DI bool operator()(Acc& acc, const Unit& u, int wr, int wc, int fr, int fq) const {
        bf16* O = u.pn < 4 ? SGA : SGB;
        const int row0 = u.pm * 256 + wr * 64 + fr, col0 = (u.pn & 3) * 256 + wc * 32 + 8 * fq;
#pragma unroll
        for (int ai = 0; ai < 2; ++ai)
#pragma unroll
            for (int m = 0; m < 4; ++m) { bf16* rowp = O + (size_t)(row0 + ai * 128 + m * 16) * 1024 + col0;
#pragma unroll
                for (int bj = 0; bj < 2; ++bj) { const f32x4 v0 = acc[ai][bj][m][0], v1 = acc[ai][bj][m][1];
                    u32x4 w; w.x = pk2(sigmoid_f(v0[0]), sigmoid_f(v0[1])); w.y = pk2(sigmoid_f(v0[2]), sigmoid_f(v0[3])); w.z = pk2(sigmoid_f(v1[0]), sigmoid_f(v1[1])); w.w = pk2(sigmoid_f(v1[2]), sigmoid_f(v1[3]));
                    *(u32x4*)(rowp + bj * 128) = w; } }
        return false;
    }
};
struct EpiSwiglu {
    bf16* H;
    DI bool operator()(Acc& acc, const Unit& u, int wr, int wc, int fr, int fq) const {
        const int row0 = u.pm * 256 + wr * 64 + fr, col0 = u.pn * 128 + wc * 32 + 8 * fq;
#pragma unroll
        for (int ai = 0; ai < 2; ++ai)
#pragma unroll
            for (int m = 0; m < 4; ++m) { bf16* rowp = H + (size_t)(row0 + ai * 128 + m * 16) * FF + col0;
                float o[8];
#pragma unroll
                for (int n = 0; n < 2; ++n)
#pragma unroll
                    for (int e = 0; e < 4; ++e) { const float a = acc[ai][0][m][n][e], b = acc[ai][1][m][n][e]; o[4 * n + e] = a * sigmoid_f(a) * b; }
                u32x4 w; w.x = pk2(o[0], o[1]); w.y = pk2(o[2], o[3]); w.z = pk2(o[4], o[5]); w.w = pk2(o[6], o[7]);
                *(u32x4*)rowp = w; }
        return false;
    }
};
struct EpiSwiglu8 {
    unsigned char* H;
    DI bool operator()(Acc& acc, const Unit& u, int wr, int wc, int fr, int fq) const {
        const int row0 = u.pm * 256 + wr * 64 + fr, col0 = u.pn * 128 + wc * 32 + 8 * fq;
        const float si = 1.f / 1024.f;
#pragma unroll
        for (int ai = 0; ai < 2; ++ai)
#pragma unroll
            for (int m = 0; m < 4; ++m) { unsigned char* rowp = H + (size_t)(row0 + ai * 128 + m * 16) * FF + col0;
                float o[8];
#pragma unroll
                for (int n = 0; n < 2; ++n)
#pragma unroll
                    for (int e = 0; e < 4; ++e) { const float a = acc[ai][0][m][n][e] * si, b = acc[ai][1][m][n][e] * si; o[4 * n + e] = a * sigmoid_f(a) * b * 8.f; }
                u32x2 w; w.x = pk4_fp8(o[0], o[1], o[2], o[3]); w.y = pk4_fp8(o[4], o[5], o[6], o[7]);
                *(u32x2*)rowp = w; }
        return false;
    }
};
struct EpiInproj {
    unsigned char* ws;
    DI bool operator()(Acc& acc, const Unit& u, int wr, int wc, int fr, int fq) const {
        bf16* O; int ldo, ct; bool half_only = false; float sc = 1.f;
        if (u.g == 1) { O = (bf16*)(ws + WS_KVM); ldo = 1024; ct = u.pn; }
        else if (u.pn < 4) { O = (bf16*)(ws + WS_QKG); ldo = 1024; ct = u.pn; }
        else if (u.pn < 8) { O = (bf16*)(ws + WS_GV); ldo = 1024; ct = u.pn - 4; }
        else if (u.pn < 12) { O = (bf16*)(ws + WS_GR); ldo = 1024; ct = u.pn - 8; }
        else if (u.pn < 18) { O = (bf16*)(ws + WS_DQKV); ldo = 1536; ct = u.pn - 12; if (u.pn < 14) sc = 0.125f * LOG2E; }
        else if (u.pn < 20) { O = (bf16*)(ws + WS_IQ); ldo = 512; ct = u.pn - 18; }
        else { O = (bf16*)(ws + WS_SM); ldo = 128; ct = 0; half_only = true; }
        const int row0 = u.pm * 256 + wr * 64 + fr, col0 = ct * 256 + wc * 32 + 8 * fq;
#pragma unroll
        for (int ai = 0; ai < 2; ++ai)
#pragma unroll
            for (int m = 0; m < 4; ++m) { bf16* rowp = O + (size_t)(row0 + ai * 128 + m * 16) * ldo + col0;
#pragma unroll
                for (int bj = 0; bj < 2; ++bj) { const f32x4 v0 = acc[ai][bj][m][0] * sc, v1 = acc[ai][bj][m][1] * sc;
                    u32x4 w; w.x = pk2(v0[0], v0[1]); w.y = pk2(v0[2], v0[3]); w.z = pk2(v1[0], v1[1]); w.w = pk2(v1[2], v1[3]);
                    if (bj == 0 || !half_only) *(u32x4*)(rowp + bj * 128) = w; } }
        return false;
    }
};
struct EpiMerge {
    const bf16* SGA; const bf16* SGB; bf16* O;
    DI bool operator()(Acc& acc, const Unit& u, int wr, int wc, int fr, int fq) const {
        const int row0 = u.pm * 256 + wr * 64 + fr, col0 = u.pn * 256 + wc * 32 + 8 * fq;
#pragma unroll
        for (int ai = 0; ai < 2; ++ai)
#pragma unroll
            for (int m = 0; m < 4; ++m) { const size_t off = (size_t)(row0 + ai * 128 + m * 16) * 1024 + col0;
#pragma unroll
                for (int bj = 0; bj < 2; ++bj) {
                    const u32x4 gb = *(const u32x4*)(SGB + off + bj * 128);
                    const float b[8] = {bflo(gb.x), bfhi(gb.x), bflo(gb.y), bfhi(gb.y), bflo(gb.z), bfhi(gb.z), bflo(gb.w), bfhi(gb.w)};
                    if (u.g == 0) {
                        const u32x4 ga = *(const u32x4*)(SGA + off + bj * 128);
                        const float a[8] = {bflo(ga.x), bfhi(ga.x), bflo(ga.y), bfhi(ga.y), bflo(ga.z), bfhi(ga.z), bflo(ga.w), bfhi(ga.w)};
#pragma unroll
                        for (int n = 0; n < 2; ++n)
#pragma unroll
                            for (int e = 0; e < 4; ++e) acc[ai][bj][m][n][e] *= a[4 * n + e] * fast_rcp(fmaxf(b[4 * n + e], 1e-30f));
                    } else {
                        const f32x4 v0 = acc[ai][bj][m][0], v1 = acc[ai][bj][m][1];
                        u32x4 w; w.x = pk2(v0[0] * b[0], v0[1] * b[1]); w.y = pk2(v0[2] * b[2], v0[3] * b[3]); w.z = pk2(v1[0] * b[4], v1[1] * b[5]); w.w = pk2(v1[2] * b[6], v1[3] * b[7]);
                        *(u32x4*)(O + off + bj * 128) = w;
                    } } }
        return u.g == 0;
    }
};

constexpr int GP = 272;
constexpr int LAP = 528;
template <bool GC_MODE>
DI void gla_prep(Frame& F, const float* const* in, int h, size_t row0, unsigned R0, unsigned R1, LAS float* bend, float* dec_out) {
    const int l = F.lane, w = F.wave, hh = l >> 5, c31 = l & 31;
    const bf16* SM = (const bf16*)(F.ws + WS_SM); const bf16* QKG = (const bf16*)(F.ws + WS_QKG);
    const float* wup = in[9]; const float* bal = in[10];
    const unsigned LA = R1;
    {
        const bf16x8 ga = *(const bf16x8*)(SM + (row0 + 32 * w + c31) * 128 + 72 + 8 * hh);
        f32x16 zero;
#pragma unroll
        for (int r = 0; r < 16; ++r) zero[r] = 0.f;
#pragma unroll
        for (int dt = 0; dt < 4; ++dt) { const int d = 32 * dt + c31;
            float wf[8];
#pragma unroll
            for (int j = 0; j < 8; ++j) wf[j] = wup[(8 * hh + j) * 512 + h * 128 + d];
            const f32x16 C = MFMA32(ga, pack8(wf[0], wf[1], wf[2], wf[3], wf[4], wf[5], wf[6], wf[7]), zero);
            const float bias = bal[h * 128 + d];
#pragma unroll
            for (int g = 0; g < 4; ++g) { float la[4];
#pragma unroll
                for (int i = 0; i < 4; ++i) { const float x = C[4 * g + i] + bias; la[i] = (fminf(x, 0.f) - __logf(1.f + fast_exp(-fabsf(x)))) * 0.0625f; }
                u32x2 o; o.x = pk2(la[0], la[1]); o.y = pk2(la[2], la[3]);
                *(LAS u32x2*)(LA + d * LAP + (32 * w + 8 * g + 4 * hh) * 2) = o; }
        }
    }
    __syncthreads();
    f32x16 Bc[4];
    {
#pragma unroll
        for (int dt = 0; dt < 4; ++dt)
#pragma unroll
            for (int r = 0; r < 16; ++r) Bc[dt][r] = 0.f;
        const unsigned la_lane = LA + c31 * LAP + 16 * hh;
        const bf16x8 ones = __builtin_bit_cast(bf16x8, (u32x4){0x3F803F80u, 0x3F803F80u, 0x3F803F80u, 0x3F803F80u});
        for (int s = 0; s < 2 * w; ++s) {
#pragma unroll
            for (int dt = 0; dt < 4; ++dt) Bc[dt] = MFMA32(lds_b128(la_lane + 32 * dt * LAP + 32 * s), ones, Bc[dt]);
        }
#pragma unroll
        for (int s2 = 0; s2 < 2; ++s2) {
            unsigned short v[8];
#pragma unroll
            for (int j = 0; j < 8; ++j) v[j] = (16 * s2 + 8 * hh + j <= c31) ? (unsigned short)0x3F80 : (unsigned short)0;
            u32x4 p; p.x = v[0] | ((unsigned)v[1] << 16); p.y = v[2] | ((unsigned)v[3] << 16); p.z = v[4] | ((unsigned)v[5] << 16); p.w = v[6] | ((unsigned)v[7] << 16);
            const bf16x8 tri = __builtin_bit_cast(bf16x8, p);
#pragma unroll
            for (int dt = 0; dt < 4; ++dt) Bc[dt] = MFMA32(lds_b128(la_lane + 32 * dt * LAP + 32 * (2 * w + s2)), tri, Bc[dt]);
        }
        if (w == 7 && c31 == 31) {
#pragma unroll
            for (int dt = 0; dt < 4; ++dt)
#pragma unroll
                for (int r = 0; r < 16; ++r) bend[32 * dt + crow(r, hh)] = Bc[dt][r];
        }
    }
    __syncthreads();
    {
        const size_t row = row0 + 32 * w + c31;
        const float qs = 0.08838834764831845f;
#pragma unroll
        for (int dt = 0; dt < 4; ++dt)
#pragma unroll
            for (int g = 0; g < 4; ++g) { const int d0 = 32 * dt + 8 * g + 4 * hh;
                const u32x2 kk = *(const u32x2*)(QKG + row * 1024 + 512 + h * 128 + d0);
                const float k0 = bflo(kk.x), k1 = bfhi(kk.x), k2 = bflo(kk.y), k3 = bfhi(kk.y);
                const float b0 = Bc[dt][4 * g], b1 = Bc[dt][4 * g + 1], b2 = Bc[dt][4 * g + 2], b3 = Bc[dt][4 * g + 3];
                if (GC_MODE) {
                    const u32x2 qq = *(const u32x2*)(QKG + row * 1024 + h * 128 + d0);
                    u32x2 o; o.x = pk2(bflo(qq.x) * qs * fast_exp(b0), bfhi(qq.x) * qs * fast_exp(b1)); o.y = pk2(bflo(qq.y) * qs * fast_exp(b2), bfhi(qq.y) * qs * fast_exp(b3));
                    *(LAS u32x2*)(R0 + (32 * w + c31) * GP + d0 * 2) = o;
                    u32x2 p; p.x = pk2(k0 * fast_exp(-b0), k1 * fast_exp(-b1)); p.y = pk2(k2 * fast_exp(-b2), k3 * fast_exp(-b3));
                    *(LAS u32x2*)(R1 + (32 * w + c31) * GP + d0 * 2) = p;
                } else {
                    const f32x4 be = *(const LAS f32x4*)(bend + d0);
                    u32x2 p; p.x = pk2(k0 * fast_exp(be.x - b0), k1 * fast_exp(be.y - b1)); p.y = pk2(k2 * fast_exp(be.z - b2), k3 * fast_exp(be.w - b3));
                    *(LAS u32x2*)(R0 + (32 * w + c31) * GP + d0 * 2) = p;
                } }
        if (!GC_MODE && w == 0) { dec_out[l] = fast_exp(bend[l]); dec_out[64 + l] = fast_exp(bend[64 + l]); }
    }
}
DI unsigned tr_lane(int pitch, int hmul, int lane) { const int i16 = lane & 15, q = i16 >> 2, p = i16 & 3, blk = (lane >> 4) & 1; return (unsigned)((hmul * (lane >> 5) + q) * pitch + (16 * blk + 4 * p) * 2); }
DI bf16x8 tr_frag(unsigned base_lane, int pitch, int row_lo, int row_hi, int n0) {
    return cat4(vtr(base_lane + (unsigned)(row_lo * pitch + n0 * 2)), vtr(base_lane + (unsigned)(row_hi * pitch + n0 * 2)));
}
DI void gla_load_v_half(Frame& F, unsigned vh, size_t row0, int h, int half) {
    const bf16* GV = (const bf16*)(F.ws + WS_GV);
#pragma unroll
    for (int it = 0; it < 8; ++it) { const int idx = it * NT + F.tid, row = idx >> 4, ch = idx & 15;
        const u32x4 v = *(const u32x4*)(GV + (row0 + row) * 1024 + h * 256 + half * 128 + ch * 8);
        *(LAS u32x4*)(vh + row * GP + ch * 16) = v; }
}
DI void gla_state_unit(Frame& F, const float* const* in, int u) {
    const int l = F.lane, w = F.wave, hh = l >> 5;
    const int bh = u >> 5, b = bh >> 2, h = bh & 3, sc = u & 31; const size_t row0 = (size_t)b * T + sc * 256;
    const unsigned KH = (unsigned)(size_t)F.lds, VH = KH + 256 * GP; LAS float* tot = (LAS float*)(F.lds + 2 * 256 * GP);
    const bf16* QKG = (const bf16*)(F.ws + WS_QKG);
    float* GST = (float*)(F.ws + WS_GST); float* DEC = (float*)(F.ws + WS_DEC);
    gla_prep<false>(F, in, h, row0, KH, VH, tot, DEC + (size_t)u * 128);
    const int etile = w >> 1, dt0 = 2 * (w & 1);
    const unsigned vhl = VH + tr_lane(GP, 8, l) + etile * 64, khl = KH + tr_lane(GP, 8, l) + dt0 * 64;
    for (int half = 0; half < 2; ++half) {
        gla_load_v_half(F, VH, row0, h, half);
        __syncthreads();
        f32x16 acc0, acc1;
#pragma unroll
        for (int r = 0; r < 16; ++r) { acc0[r] = 0.f; acc1[r] = 0.f; }
#pragma unroll 4
        for (int s = 0; s < 16; ++s) {
            const bf16x8 a = tr_frag(vhl, GP, 16 * s, 16 * s + 4, 0);
            const bf16x8 b0 = tr_frag(khl, GP, 16 * s, 16 * s + 4, 0), b1 = tr_frag(khl, GP, 16 * s, 16 * s + 4, 32);
            acc0 = MFMA32(a, b0, acc0); acc1 = MFMA32(a, b1, acc1);
        }
#pragma unroll
        for (int r = 0; r < 16; ++r) { const int e = half * 128 + etile * 32 + crow(r, hh); float* o = GST + ((size_t)u * 256 + e) * 128 + dt0 * 32 + (l & 31); o[0] = acc0[r]; o[32] = acc1[r]; }
        __syncthreads();
    }
}
DI void gla_scan_phase(Frame& F, bool do_store = true) {
    float* GST = (float*)(F.ws + WS_GST); const float* DEC = (const float*)(F.ws + WS_DEC);
    for (int idx = F.c * NT + F.tid; idx < 8 * 16384; idx += F.G * NT) {
        const int bh = idx >> 14, rem = idx & 16383, e = rem >> 6, d = (rem & 63) * 2;
        f32x2 st = {0.f, 0.f};
#pragma unroll 4
        for (int sc = 0; sc < 32; ++sc) { const int u = bh * 32 + sc; f32x2* p = (f32x2*)(GST + ((size_t)u * 256 + e) * 128 + d);
            const f32x2 uu = *p; const f32x2 dc = *(const f32x2*)(DEC + u * 128 + d); if (do_store) *p = st; st = dc * st + uu; }
        if (!do_store && st.x == 1.2345e-30f) GST[0] = st.y;
    }
}
DI void gla_out_unit(Frame& F, const float* const* in, int u, bool do_store = true) {
    const int l = F.lane, w = F.wave, hh = l >> 5;
    const int bh = u >> 5, b = bh >> 2, h = bh & 3, sc = u & 31; const size_t row0 = (size_t)b * T + sc * 256;
    const unsigned QS = (unsigned)(size_t)F.lds, KS = QS + 256 * GP; LAS float* tot = (LAS float*)(F.lds + 2 * 256 * GP);
    const bf16* QKG = (const bf16*)(F.ws + WS_QKG); const float* GST = (const float*)(F.ws + WS_GST); bf16* GR = (bf16*)(F.ws + WS_GR);
    gla_prep<true>(F, in, h, row0, QS, KS, tot, nullptr);
    __syncthreads();
    bf16x8 qf[8];
#pragma unroll
    for (int s = 0; s < 8; ++s) qf[s] = lds_b128(QS + (32 * w + (l & 31)) * GP + (16 * s + 8 * hh) * 2);
    __syncthreads();
    f32x16 acc[8];
#pragma unroll
    for (int et = 0; et < 8; ++et)
#pragma unroll
        for (int r = 0; r < 16; ++r) acc[et][r] = 0.f;
    const unsigned VH = QS;
#pragma unroll
    for (int half = 0; half < 2; ++half) {
        gla_load_v_half(F, VH, row0, h, half);
        __syncthreads();
        for (int j = 0; j <= w; ++j) {
            f32x16 X;
#pragma unroll
            for (int r = 0; r < 16; ++r) X[r] = 0.f;
            const unsigned ksj = KS + (l & 31) * GP + 16 * hh + 32 * j * GP, vhj = VH + tr_lane(GP, 4, l) + 32 * j * GP;
#pragma unroll
            for (int s = 0; s < 8; ++s) X = MFMA32(lds_b128(ksj + 32 * s), qf[s], X);
            if (j == w) {
#pragma unroll
                for (int r = 0; r < 16; ++r) if (crow(r, hh) > (l & 31)) X[r] = 0.f;
            }
            const bf16x8 xb0 = pack_step(X, 0), xb1 = pack_step(X, 1);
#pragma unroll
            for (int et = 0; et < 4; ++et) {
                const bf16x8 a0 = tr_frag(vhj, GP, 0, 8, et * 32), a1 = tr_frag(vhj, GP, 16, 24, et * 32);
                acc[half * 4 + et] = MFMA32(a0, xb0, acc[half * 4 + et]); acc[half * 4 + et] = MFMA32(a1, xb1, acc[half * 4 + et]);
            }
        }
        __syncthreads();
    }
    {
        const float* sg = GST + (size_t)u * 32768;
        int tv = F.tid; asm volatile("" : "+v"(tv));
        const float* sgl = sg + tv * 4; const unsigned dl = QS + (tv >> 5) * GP + (tv & 31) * 8;
#pragma unroll
        for (int i = 0; i < 16; i += 2) {
            const f32x4 v0 = *(const f32x4*)(sgl + i * 2048), v1 = *(const f32x4*)(sgl + (i + 1) * 2048);
            u32x2 o0, o1; o0.x = pk2(v0.x, v0.y); o0.y = pk2(v0.z, v0.w); o1.x = pk2(v1.x, v1.y); o1.y = pk2(v1.z, v1.w);
            *(LAS u32x2*)(dl + 16 * i * GP) = o0; *(LAS u32x2*)(dl + 16 * (i + 1) * GP) = o1;
        }
        __syncthreads();
        const unsigned sl = QS + (l & 31) * GP + 16 * hh;
#pragma unroll
        for (int et = 0; et < 8; ++et)
#pragma unroll
            for (int s = 0; s < 8; ++s) { acc[et] = MFMA32(lds_b128(sl + 32 * et * GP + 32 * s), qf[s], acc[et]); if ((s & 3) == 3) asm volatile("" ::: "memory"); }
    }
    float ss = 0.f;
#pragma unroll
    for (int et = 0; et < 8; ++et)
#pragma unroll
        for (int r = 0; r < 16; ++r) ss += acc[et][r] * acc[et][r];
    ss += __shfl_xor(ss, 32);
    const float rinv = __builtin_amdgcn_rsqf(ss * (1.f / 256.f) + EPS);
    const float* gn = in[11] + h * 256 + 4 * hh;
    bf16* orow = GR + (row0 + 32 * w + (l & 31)) * 1024 + h * 256 + 4 * hh;
#pragma unroll
    for (int et = 0; et < 8; ++et)
#pragma unroll
        for (int g = 0; g < 4; ++g) { const int e = et * 32 + 8 * g;
            const u32x2 gw = *(const u32x2*)(orow + e); const f32x4 gg = *(const f32x4*)(gn + e);
            const float r0 = bflo(gw.x), r1 = bfhi(gw.x), r2 = bflo(gw.y), r3 = bfhi(gw.y);
            u32x2 o; o.x = pk2(acc[et][4 * g] * rinv * gg.x * r0 * sigmoid_f(r0), acc[et][4 * g + 1] * rinv * gg.y * r1 * sigmoid_f(r1));
            o.y = pk2(acc[et][4 * g + 2] * rinv * gg.z * r2 * sigmoid_f(r2), acc[et][4 * g + 3] * rinv * gg.w * r3 * sigmoid_f(r3));
            if (do_store) *(u32x2*)(orow + e) = o; if (g == 3) __builtin_amdgcn_sched_barrier(0); }
}

DI void hist_find4(const u32x4 c, int lane, unsigned k, unsigned& bin, unsigned& above) {
    const unsigned s = c.x + c.y + c.z + c.w; unsigned suf = s;
#pragma unroll
    for (int o = 1; o < 64; o <<= 1) { const unsigned v = __shfl_down(suf, o); if (lane + o < 64) suf += v; }
    const unsigned excl = suf - s;
    const bool cross = excl < k && suf >= k;
    unsigned a = excl, bn = 0, ab = 0;
    if (a + c.w >= k) { bn = 4 * lane + 3; ab = a; } else { a += c.w;
        if (a + c.z >= k) { bn = 4 * lane + 2; ab = a; } else { a += c.z;
            if (a + c.y >= k) { bn = 4 * lane + 1; ab = a; } else { a += c.y; bn = 4 * lane; ab = a; } } }
    const unsigned long long m = __ballot(cross);
    const int src = m ? __builtin_ctzll(m) : 0;
    bin = __shfl(bn, src); above = __shfl(ab, src);
}
constexpr int IDX_H1 = 131072, IDX_H2 = IDX_H1 + 16384;
DI void idx_unit(Frame& F, int u, bool do_store = true, int mode = 0  ) {
    const int l = F.lane, w = F.wave, hh = l >> 5;
    const int b = u >> 10, t0 = (u & 1023) * 8; const size_t row0 = (size_t)b * T + t0;
    const bf16* IQ = (const bf16*)(F.ws + WS_IQ); const bf16* SM = (const bf16*)(F.ws + WS_SM);
    const unsigned SC = (unsigned)(size_t)F.lds; LAS unsigned* H1 = (LAS unsigned*)(F.lds + IDX_H1); LAS unsigned* H2 = (LAS unsigned*)(F.lds + IDX_H2);
    bf16x8 af[2][4]; float wv[2][16];
    {
        const int rho = l & 31;
#pragma unroll
        for (int tl = 0; tl < 2; ++tl) { const int q = 4 * tl + (rho >> 4) + 2 * ((rho >> 2) & 1), head = (rho & 3) + 4 * ((rho >> 3) & 1);
#pragma unroll
            for (int s = 0; s < 4; ++s) af[tl][s] = *(const bf16x8*)(IQ + (row0 + q) * 512 + head * 64 + 16 * s + 8 * hh);
#pragma unroll
            for (int r = 0; r < 16; ++r) { const int qq = 4 * tl + (r >> 3) + 2 * hh, hd = (r & 3) + 4 * ((r >> 2) & 1); wv[tl][r] = bf2f(SM[(row0 + qq) * 128 + 64 + hd]); } }
    }
#pragma unroll
    for (int i = 0; i < 8; ++i) H1[F.tid + i * NT] = 0u;
    __syncthreads();
    const int ntile = t0 / 32 + 1;
    const bf16* kbase = SM + ((size_t)b * T + (l & 31)) * 128 + 8 * hh;
    const unsigned hrep = (unsigned)(l & 3);
#define IDX_TILE(BF, kt_, EDGE) do { const int key = 32 * (kt_) + (l & 31); \
        f32x16 C0, C1; _Pragma("unroll") for (int r = 0; r < 16; ++r) { C0[r] = 0.f; C1[r] = 0.f; } \
        _Pragma("unroll") for (int s = 0; s < 4; ++s) { C0 = MFMA32(af[0][s], BF[s], C0); C1 = MFMA32(af[1][s], BF[s], C1); } \
        asm volatile("s_nop 15\n\ts_nop 7" : "+v"(C0), "+v"(C1));     \
        _Pragma("unroll") for (int tl = 0; tl < 2; ++tl) _Pragma("unroll") for (int b4 = 0; b4 < 2; ++b4) { \
            float sc = 0.f; \
            _Pragma("unroll") for (int r = 0; r < 8; ++r) { float m_; asm("v_max_f32_e32 %0, 0, %1" : "=v"(m_) : "v"(tl ? C1[8 * b4 + r] : C0[8 * b4 + r])); sc = fmaf(wv[tl][8 * b4 + r], m_, sc); } \
            const int q = 4 * tl + b4 + 2 * hh; \
            const _Float16 hf = (_Float16)sc; unsigned h16 = (unsigned)__builtin_bit_cast(unsigned short, hf); \
            unsigned k16 = (h16 & 0x8000u) ? (~h16 & 0xffffu) : (h16 | 0x8000u); \
            if (EDGE) { const bool valid = key <= t0 + q; if (!valid) k16 = 0u; \
                if (mode != 3) *(LAS unsigned short*)(SC + q * 16384 + key * 2) = (unsigned short)k16; \
                if (valid && mode != 3 && mode != 6) __hip_atomic_fetch_add(H1 + (q * 256 + (k16 >> 8)) * 2 + (hrep >> 1), 1u << (16 * (hrep & 1)), __ATOMIC_RELAXED, __HIP_MEMORY_SCOPE_WORKGROUP); } \
            else { if (mode != 3) *(LAS unsigned short*)(SC + q * 16384 + key * 2) = (unsigned short)k16; \
                if (mode != 3 && mode != 6) __hip_atomic_fetch_add(H1 + (q * 256 + (k16 >> 8)) * 2 + (hrep >> 1), 1u << (16 * (hrep & 1)), __ATOMIC_RELAXED, __HIP_MEMORY_SCOPE_WORKGROUP); } } } while (0)
#define IDX_LOAD(BF, kt_) do { _Pragma("unroll") for (int s = 0; s < 4; ++s) BF[s] = *(const bf16x8*)(kbase + (size_t)(32 * (kt_)) * 128 + 16 * s); } while (0)
    bf16x8 bA[4], bB[4];
    const int klast = ntile - 1;
    IDX_LOAD(bA, w < ntile ? w : klast);
    if (mode != 2)
    for (int kt = w; kt < ntile; kt += 16) {
        if (mode != 4) IDX_LOAD(bB, kt + 8 < ntile ? kt + 8 : klast);
        if (kt == klast) IDX_TILE(bA, kt, true); else IDX_TILE(bA, kt, false);
        if (mode != 4) IDX_LOAD(bA, kt + 16 < ntile ? kt + 16 : klast);
        if (kt + 8 < ntile) { if (kt + 8 == klast) IDX_TILE(bB, kt + 8, true); else IDX_TILE(bB, kt + 8, false); }
    }
#undef IDX_TILE
#undef IDX_LOAD
    __syncthreads();
    if (mode == 0 || mode == 2)
    {
        const int t = t0 + w, n = t + 1, nit = (n + 511) >> 9;
        unsigned char* mrow = (unsigned char*)(F.ws + WS_IQ) + (row0 + w) * 1024;
        const unsigned scq = SC + w * 16384 + l * 16;
        LAS unsigned* H = H2 + w * 256;
        unsigned thr = 0u, rneed = 0u;
        if (n > 256) {
            unsigned B, above, L, above2;
            {
                const u32x4 a = *(const LAS u32x4*)(H1 + (w * 256 + 4 * l) * 2), bq = *(const LAS u32x4*)(H1 + (w * 256 + 4 * l) * 2 + 4);
                u32x4 cnt; cnt.x = (a.x & 0xffffu) + (a.x >> 16) + (a.y & 0xffffu) + (a.y >> 16); cnt.y = (a.z & 0xffffu) + (a.z >> 16) + (a.w & 0xffffu) + (a.w >> 16);
                cnt.z = (bq.x & 0xffffu) + (bq.x >> 16) + (bq.y & 0xffffu) + (bq.y >> 16); cnt.w = (bq.z & 0xffffu) + (bq.z >> 16) + (bq.w & 0xffffu) + (bq.w >> 16);
                hist_find4(cnt, l, 256u, B, above);
            }
            H[l] = 0u; H[l + 64] = 0u; H[l + 128] = 0u; H[l + 192] = 0u; LDS_WAIT();
            for (int it = 0; it < nit; ++it) { const u32x4 kk = *(const LAS u32x4*)(scq + it * 1024); const int i0 = 512 * it + 8 * l;
                const unsigned ks[8] = {kk.x & 0xffffu, kk.x >> 16, kk.y & 0xffffu, kk.y >> 16, kk.z & 0xffffu, kk.z >> 16, kk.w & 0xffffu, kk.w >> 16};
                bool m[8], any = false;
#pragma unroll
                for (int j = 0; j < 8; ++j) { m[j] = (i0 + j < n) && (ks[j] >> 8) == B; any = any || m[j]; }
                if (__ballot(any) == 0ull) continue;
#pragma unroll
                for (int j = 0; j < 8; ++j) if (m[j]) __hip_atomic_fetch_add(H + (ks[j] & 255u), 1u, __ATOMIC_RELAXED, __HIP_MEMORY_SCOPE_WORKGROUP); }
            LDS_WAIT(); hist_find4(*(const LAS u32x4*)(H + 4 * l), l, 256u - above, L, above2);
            thr = (B << 8) | L; rneed = 256u - above - above2;
        }
        unsigned running = 0u;
        for (int it = 0; it < nit; ++it) {
            const u32x4 kk = *(const LAS u32x4*)(scq + it * 1024); const int i0 = 512 * it + 8 * l;
            const unsigned ks[8] = {kk.x & 0xffffu, kk.x >> 16, kk.y & 0xffffu, kk.y >> 16, kk.z & 0xffffu, kk.z >> 16, kk.w & 0xffffu, kk.w >> 16};
            unsigned byte = 0u;
            if (n <= 256) {
#pragma unroll
                for (int j = 0; j < 8; ++j) byte |= (i0 + j < n) ? (1u << j) : 0u;
            } else {
                bool eq[8]; bool anyeq = false;
#pragma unroll
                for (int j = 0; j < 8; ++j) { eq[j] = (i0 + j < n) && ks[j] == thr; anyeq = anyeq || eq[j]; byte |= ((i0 + j < n) && ks[j] > thr) ? (1u << j) : 0u; }
                const unsigned long long anym = __ballot(anyeq);
                if (anym != 0ull) {
                    unsigned mine = 0u;
#pragma unroll
                    for (int j = 0; j < 8; ++j) mine += eq[j] ? 1u : 0u;
                    unsigned before = 0u; unsigned long long mm = anym;
                    while (mm) { const int src = __builtin_ctzll(mm); mm &= mm - 1; const unsigned v = (unsigned)__shfl((int)mine, src); if (src < l) before += v; }
                    unsigned cum = running + before; unsigned tot = 0u; mm = anym;
                    while (mm) { const int src = __builtin_ctzll(mm); mm &= mm - 1; tot += (unsigned)__shfl((int)mine, src); }
#pragma unroll
                    for (int j = 0; j < 8; ++j) { if (eq[j]) { if (cum < rneed) byte |= (1u << j); ++cum; } }
                    running += tot;
                }
            }
            if (do_store) mrow[it * 64 + l] = (unsigned char)byte;
        }
    }
    __syncthreads();
}

template <int DH, bool DSA, int VAR = 0>
DI void attn_unit(Frame& F, const bf16* Qp, int ldq, const bf16* Kp, const bf16* Vp, int ldkv, int nst, bf16* Op, int ldo, float c1,
                  const unsigned* mask0  , int tq0, const LAS float* BT, float cfar, bool do_store = true) {
    constexpr int PK = DH * 2 + 16  , PV = DH == 64 ? 192 : 320  ;
    constexpr int SBK = 64 * PK, SBV = 64 * PV, NS = DH / 16, ND = DH / 32, CH = DH / 8  , NLD = 64 * CH / NT;
    const int l = F.lane, w = F.wave, hh = l >> 5, tid = F.tid;
    const unsigned KT = (unsigned)(size_t)F.lds, VT = KT + 2 * SBK;
    const unsigned klane = (unsigned)((l & 31) * PK + 16 * hh), vlane = tr_lane(PV, 4, l);
    bf16x8 qf[NS];
#pragma unroll
    for (int s = 0; s < NS; ++s) qf[s] = *(const bf16x8*)(Qp + (size_t)(32 * w + (l & 31)) * ldq + 16 * s + 8 * hh);
    f32x16 O[ND];
#pragma unroll
    for (int d = 0; d < ND; ++d)
#pragma unroll
        for (int r = 0; r < 16; ++r) O[d][r] = 0.f;
    float lsum = 0.f;
    const int tq = tq0 + 32 * w + (l & 31), tq_hi = tq0 + 32 * w + 31, tq_lo = tq0 + 32 * w;
    const unsigned* mrow = DSA ? mask0 + (size_t)(32 * w + (l & 31)) * 256 : nullptr;
    u32x4 kr[NLD], vr[NLD];
    u32x2 mcur = {0u, 0u}, mnxt = {0u, 0u};
    if (DSA) mcur = *(const u32x2*)mrow;
#pragma unroll
    for (int i = 0; i < NLD; ++i) { const int idx = i * NT + tid, row = idx / CH, ch = idx % CH;
        kr[i] = *(const u32x4*)(Kp + (size_t)row * ldkv + ch * 8); vr[i] = *(const u32x4*)(Vp + (size_t)row * ldkv + ch * 8); }
#pragma unroll
    for (int i = 0; i < NLD; ++i) { const int idx = i * NT + tid, row = idx / CH, ch = idx % CH;
        *(LAS u32x4*)(KT + row * PK + ch * 16) = kr[i]; *(LAS u32x4*)(VT + row * PV + ch * 16) = vr[i]; }
    __syncthreads();
    __builtin_amdgcn_s_waitcnt(0x0F70);
    for (int st = 0; st < nst; ++st) {
        const unsigned kt = KT + (st & 1) * SBK, vt = VT + (st & 1) * SBV;
        const bool more = st + 1 < nst;
        if (more) {
#pragma unroll
            for (int i = 0; i < NLD; ++i) { const int idx = i * NT + tid, row = 64 * (st + 1) + idx / CH, ch = idx % CH;
                kr[i] = *(const u32x4*)(Kp + (size_t)row * ldkv + ch * 8); vr[i] = *(const u32x4*)(Vp + (size_t)row * ldkv + ch * 8); }
            if (DSA) mnxt = *(const u32x2*)(mrow + 2 * (st + 1));
        }
#pragma unroll
        for (int kb = 0; kb < 2; ++kb) {
            const int key0 = 64 * st + 32 * kb;
            if (VAR == 3) continue;
            if (DSA && key0 > tq_hi) continue;
            f32x16 X;
#pragma unroll
            for (int r = 0; r < 16; ++r) X[r] = 0.f;
#pragma unroll
            for (int s = 0; s < NS; ++s) X = MFMA32(lds_b128(kt + klane + 32 * kb * PK + 32 * s), qf[s], X);
            if (VAR == 2) { lsum += X[0]; }
            else if (DSA) {
                const unsigned mw = (kb ? mcur.y : mcur.x) >> (4 * hh);
                if (tq_lo - (key0 + 31) >= 113) {
#pragma unroll
                    for (int r = 0; r < 16; ++r) { const float p = fast_exp2(fmaf(X[r], c1, cfar)); const int bits = __builtin_amdgcn_sbfe((int)mw, (r & 3) + 8 * (r >> 2), 1);
                        const float pm = __uint_as_float(__float_as_uint(p) & (unsigned)bits); lsum += pm; X[r] = pm; }
                } else {
#pragma unroll
                    for (int r = 0; r < 16; ++r) { int di = tq - (key0 + crow(r, hh)); di = di < 0 ? 0 : (di > 127 ? 127 : di);
                        const float p = fast_exp2(fmaf(X[r], c1, BT[di])); const int bits = __builtin_amdgcn_sbfe((int)mw, (r & 3) + 8 * (r >> 2), 1);
                        const float pm = __uint_as_float(__float_as_uint(p) & (unsigned)bits); lsum += pm; X[r] = pm; }
                }
            } else {
#pragma unroll
                for (int r = 0; r < 16; ++r) { const float p = fast_exp2(X[r] * c1); lsum += p; X[r] = p; }
            }
            const bf16x8 xb0 = pack_step(X, 0), xb1 = pack_step(X, 1);
            if (VAR == 1) { asm volatile("" :: "v"(xb0), "v"(xb1)); }
            else {
#pragma unroll
            for (int d = 0; d < ND; ++d) {
                const bf16x8 a0 = tr_frag(vt + vlane, PV, 32 * kb, 32 * kb + 8, 32 * d), a1 = tr_frag(vt + vlane, PV, 32 * kb + 16, 32 * kb + 24, 32 * d);
                O[d] = MFMA32(a0, xb0, O[d]); O[d] = MFMA32(a1, xb1, O[d]);
            } }
        }
        asm volatile("" ::: "memory"); __builtin_amdgcn_sched_barrier(0);
        if (more) {
            const unsigned kn = KT + ((st + 1) & 1) * SBK, vn = VT + ((st + 1) & 1) * SBV;
#pragma unroll
            for (int i = 0; i < NLD; ++i) { const int idx = i * NT + tid, row = idx / CH, ch = idx % CH;
                *(LAS u32x4*)(kn + row * PK + ch * 16) = kr[i]; *(LAS u32x4*)(vn + row * PV + ch * 16) = vr[i]; }
            mcur = mnxt;
        }
        __syncthreads();
    }
    lsum += __shfl_xor(lsum, 32);
    const float inv = fast_rcp(lsum);
    bf16* orow = Op + (size_t)(32 * w + (l & 31)) * ldo;
#pragma unroll
    for (int d = 0; d < ND; ++d)
#pragma unroll
        for (int g = 0; g < 4; ++g) { u32x2 o; o.x = pk2(O[d][4 * g] * inv, O[d][4 * g + 1] * inv); o.y = pk2(O[d][4 * g + 2] * inv, O[d][4 * g + 3] * inv);
            if (do_store) *(u32x2*)(orow + 32 * d + 8 * g + 4 * hh) = o; }
}
DI int t5_bucket(int rel) {
    if (rel < 16) return rel;
    const float v = logf((float)rel * (1.f / 16.f)) / 2.0794415416798357f * 16.f;
    int lg = 16 + (int)v; return lg > 31 ? 31 : lg;
}
constexpr int A_PK = 144, A_PV = 192, A_SK = 128 * A_PK, A_SV = 128 * A_PV, A_BT = 2 * A_SK + 2 * A_SV;
#define A_SMR(r, pos) { const float p_ = (VAR == 4) ? X[r] : fast_exp2(X[r]); int t_ = -1; if (VAR != 5) asm("v_bfe_i32 %0, %1, %2, 1" : "=v"(t_) : "v"(mw_), "i"(pos)); const float pm_ = (VAR == 5) ? p_ : __uint_as_float(__float_as_uint(p_) & (unsigned)t_); if (VAR != 6) lsum += pm_; X[r] = pm_; }
#define A_SM16() do { A_SMR(0, 0) A_SMR(1, 1) A_SMR(2, 2) A_SMR(3, 3) A_SMR(4, 8) A_SMR(5, 9) A_SMR(6, 10) A_SMR(7, 11) A_SMR(8, 16) A_SMR(9, 17) A_SMR(10, 18) A_SMR(11, 19) A_SMR(12, 24) A_SMR(13, 25) A_SMR(14, 26) A_SMR(15, 27) } while (0)
template <int VAR = 0>
DI void dsa_att_unit(Frame& F, const float* const* in, int bh, int qb, bool do_store = true) {
    const int b = bh >> 3, h = bh & 7, l = F.lane, w = F.wave, hh = l >> 5, tid = F.tid;
    LAS float* BT = (LAS float*)(F.lds + A_BT);
    const float* tab = in[14];
    __syncthreads();
    if (tid < 128) BT[tid] = tab[t5_bucket(tid) * 8 + h] * LOG2E;
    const float cfar = tab[31 * 8 + h] * LOG2E;
    bf16* DQ = (bf16*)(F.ws + WS_DQKV);
    const size_t rowq = (size_t)b * T + qb * 256, rowk = (size_t)b * T;
    const bf16* Kp = DQ + rowk * 1536 + 512 + h * 64; const bf16* Vp = DQ + rowk * 1536 + 1024 + h * 64;
    const unsigned KT = (unsigned)(size_t)F.lds, VT = KT + 2 * A_SK;
    const unsigned klane = (unsigned)((l & 31) * A_PK + 16 * hh), vlane = tr_lane(A_PV, 4, l);
    bf16x8 qf[4];
#pragma unroll
    for (int s = 0; s < 4; ++s) qf[s] = *(const bf16x8*)(DQ + (rowq + 32 * w + (l & 31)) * 1536 + h * 64 + 16 * s + 8 * hh);
    f32x16 O[2], cf16;
#pragma unroll
    for (int r = 0; r < 16; ++r) { O[0][r] = 0.f; O[1][r] = 0.f; cf16[r] = cfar; }
    float lsum = 0.f;
    const int tq = qb * 256 + 32 * w + (l & 31), tq_lo = qb * 256 + 32 * w, tq_hi = tq_lo + 31, nst = 2 * (qb + 1);
    const u32x4* mrow = (const u32x4*)((const unsigned*)(F.ws + WS_IQ) + (rowq + 32 * w + (l & 31)) * 256);
    u32x4 kr[2], vr[2], mcur = mrow[0], mnxt = mcur;
#pragma unroll
    for (int i = 0; i < 2; ++i) { const int idx = i * NT + tid, row = idx >> 3, ch = idx & 7;
        kr[i] = *(const u32x4*)(Kp + (size_t)row * 1536 + ch * 8); vr[i] = *(const u32x4*)(Vp + (size_t)row * 1536 + ch * 8); }
#pragma unroll
    for (int i = 0; i < 2; ++i) { const int idx = i * NT + tid, row = idx >> 3, ch = idx & 7;
        *(LAS u32x4*)(KT + row * A_PK + ch * 16) = kr[i]; *(LAS u32x4*)(VT + row * A_PV + ch * 16) = vr[i]; }
    __syncthreads();
#define A_QK(Xv, kb, CI) do { Xv = MFMA32(lds_b128(kt + klane + 32 * (kb) * A_PK), qf[0], CI); Xv = MFMA32(lds_b128(kt + klane + 32 * (kb) * A_PK + 32), qf[1], Xv); \
        Xv = MFMA32(lds_b128(kt + klane + 32 * (kb) * A_PK + 64), qf[2], Xv); Xv = MFMA32(lds_b128(kt + klane + 32 * (kb) * A_PK + 96), qf[3], Xv); } while (0)
#define A_PVM(Xv, kb) do { const bf16x8 xb0_ = pack_step(Xv, 0), xb1_ = pack_step(Xv, 1); _Pragma("unroll") for (int d = 0; d < 2; ++d) { \
        const bf16x8 a0_ = tr_frag(vt + vlane, A_PV, 32 * (kb), 32 * (kb) + 8, 32 * d), a1_ = tr_frag(vt + vlane, A_PV, 32 * (kb) + 16, 32 * (kb) + 24, 32 * d); \
        O[d] = MFMA32(a0_, xb0_, O[d]); O[d] = MFMA32(a1_, xb1_, O[d]); } } while (0)
    __builtin_amdgcn_s_waitcnt(0x0F70);
    for (int st = 0; st < nst; ++st) {
        const unsigned kt = KT + (st & 1) * A_SK, vt = VT + (st & 1) * A_SV;
        const bool more = st + 1 < nst;
        if (more) {
#pragma unroll
            for (int i = 0; i < 2; ++i) { const int idx = i * NT + tid, row = 128 * (st + 1) + (idx >> 3), ch = idx & 7;
                kr[i] = *(const u32x4*)(Kp + (size_t)row * 1536 + ch * 8); vr[i] = *(const u32x4*)(Vp + (size_t)row * 1536 + ch * 8); }
            mnxt = mrow[st + 1];
        }
        asm volatile("" ::: "memory"); __builtin_amdgcn_sched_barrier(0);
        if (VAR != 3) {
        if (tq_lo - (128 * st + 127) >= 113) {
            f32x16 X, Y;
            A_QK(X, 0, cf16); A_QK(Y, 1, cf16);
            { const unsigned mw_ = mcur.x >> (4 * hh); A_SM16(); } A_PVM(X, 0);
            A_QK(X, 2, cf16);
            { f32x16& Xr = Y; const unsigned mw_ = mcur.y >> (4 * hh);
#define X Xr
              A_SM16();
#undef X
            } A_PVM(Y, 1);
            A_QK(Y, 3, cf16);
            { const unsigned mw_ = mcur.z >> (4 * hh); A_SM16(); } A_PVM(X, 2);
            { f32x16& Xr = Y; const unsigned mw_ = mcur.w >> (4 * hh);
#define X Xr
              A_SM16();
#undef X
            } A_PVM(Y, 3);
        } else {
#pragma unroll
            for (int kb = 0; kb < 4; ++kb) {
                const int key0 = 128 * st + 32 * kb;
                if (key0 > tq_hi) continue;
                f32x16 X, zero;
#pragma unroll
                for (int r = 0; r < 16; ++r) zero[r] = 0.f;
                const unsigned mw_ = (kb == 0 ? mcur.x : kb == 1 ? mcur.y : kb == 2 ? mcur.z : mcur.w) >> (4 * hh);
                if (tq_lo - (key0 + 31) >= 113) { A_QK(X, kb, cf16); }
                else { A_QK(X, kb, zero);
#pragma unroll
                    for (int r = 0; r < 16; ++r) { int di = tq - (key0 + crow(r, hh)); di = di < 0 ? 0 : (di > 127 ? 127 : di); X[r] += BT[di]; } }
                A_SM16();
                A_PVM(X, kb);
            }
        }
        }
        asm volatile("" ::: "memory"); __builtin_amdgcn_sched_barrier(0);
        if (more) {
            const unsigned kn = KT + ((st + 1) & 1) * A_SK, vn = VT + ((st + 1) & 1) * A_SV;
#pragma unroll
            for (int i = 0; i < 2; ++i) { const int idx = i * NT + tid, row = idx >> 3, ch = idx & 7;
                *(LAS u32x4*)(kn + row * A_PK + ch * 16) = kr[i]; *(LAS u32x4*)(vn + row * A_PV + ch * 16) = vr[i]; }
            mcur = mnxt;
        }
        __syncthreads();
    }
#undef A_QK
#undef A_PVM
    lsum += __shfl_xor(lsum, 32);
    const float inv = fast_rcp(lsum);
    bf16* orow = DQ + (rowq + 32 * w + (l & 31)) * 1536 + h * 64;
#pragma unroll
    for (int d = 0; d < 2; ++d)
#pragma unroll
        for (int g = 0; g < 4; ++g) { u32x2 o; o.x = pk2(O[d][4 * g] * inv, O[d][4 * g + 1] * inv); o.y = pk2(O[d][4 * g + 2] * inv, O[d][4 * g + 3] * inv);
            if (do_store) *(u32x2*)(orow + 32 * d + 8 * g + 4 * hh) = o; }
}
DI void cross_att_unit(Frame& F, int u) {
    const int b = u >> 7, h = (u >> 5) & 3, qb = u & 31;
    const bf16* QC = (const bf16*)(F.ws + WS_QC); const bf16* KVM = (const bf16*)(F.ws + WS_KVM); bf16* OX = (bf16*)(F.ws + WS_OX);
    const size_t rowq = (size_t)b * T + qb * 256;
    __syncthreads();
    attn_unit<128, false>(F, QC + rowq * 512 + h * 128, 512, KVM + (size_t)b * MEML * 1024 + h * 128, KVM + (size_t)b * MEML * 1024 + 512 + h * 128, 1024, MEML / 64,
                          OX + rowq * 512 + h * 128, 512, 0.08838834764831845f * LOG2E, nullptr, 0, nullptr, 0.f);
}

constexpr int N_PHASES = 19;
#ifndef MK_ONE_LAUNCH
#define MK_ONE_LAUNCH 1
#endif
__global__ void __launch_bounds__(NT, 2) mega_fwd(Args args) {
    extern __shared__ __attribute__((aligned(16))) unsigned char lds_raw[];
    Frame F;
    F.lds = (LAS unsigned char*)lds_raw; F.ws = args.ws;
    F.tid = threadIdx.x; F.lane = F.tid & 63; F.wave = __builtin_amdgcn_readfirstlane(F.tid >> 6);
    F.G = gridDim.x; F.c = blockIdx.x;
    volatile LAS unsigned* MISC = (volatile LAS unsigned*)(F.lds + MISC_OFF);
    if (F.tid < 64) MISC[F.tid] = 0u;
    __syncthreads();
    unsigned* ctl = (unsigned*)(args.ws + WS_CTL);
    const int lo = args.ph_lo, hi = args.ph_hi;
    XcdBarrier bar; bar.bar = ctl + CW_BAR; bar.x = 0; bar.st = MISC + 8;
    if (hi - lo > 1) bar = xcd_barrier_post(ctl + CW_BAR, MISC + 8);
    const float* const* in = args.in;
    const bool st_ok = args.nostore == 0; const int sub = args.sub;
    unsigned char* ws = args.ws;
    const int gw = F.c * NWAVES + F.wave, NGW = F.G * NWAVES;
#ifndef PHMASK
#define PHMASK 0x7ffff
#endif
#define IN(k) (((PHMASK >> (k)) & 1) && lo <= (k) && (k) < hi)
#define SEAM(k) do { if ((k) + 1 < hi) xcd_barrier(bar); } while (0)
#ifndef DUP_PHASE
#define DUP_PHASE -1
#endif
#ifndef DUP_N
#define DUP_N 1
#endif
#define REPS(k) ((k) == DUP_PHASE ? 1 + DUP_N : 1)
#define FORREP(k) _Pragma("unroll 1") for (int rep = 0; rep < REPS(k); ++rep)
#define ST(k) (st_ok)
#define REPBAR(k) do { if (rep + 1 < REPS(k)) xcd_barrier(bar); } while (0)
    bf16* XN = (bf16*)(ws + WS_XN); bf16* HID = (bf16*)(ws + WS_HID); bf16* Y = (bf16*)(ws + WS_Y);
    bf16* W1A = (bf16*)(ws + WS_W1A); bf16* W1B = (bf16*)(ws + WS_W1B);

    if (IN(0)) { FORREP(0) {
        LAS float* scr = (LAS float*)(F.lds + F.wave * 16384);
        constexpr int NITEMS = 10240;
        for (int it0 = gw; it0 < NITEMS; it0 += NGW) { int it = it0;
            if (conv_job(it, in[4], 2 * FF, D, 2 * FF / 32, W1A, D, ColFfn{}, scr, F.lane)) continue;
            if (conv_job(it, in[5], D, FF, D / 32, W1B, FF, ColIdent{0}, scr, F.lane)) continue;
            if (conv_job(it, in[8], 7256, D, NIN / 32, (bf16*)(ws + WS_WIN), D, ColInproj{}, scr, F.lane)) continue;
            if (conv_job(it, in[8], 7256, D, 2048 / 32, (bf16*)(ws + WS_WGT), D, ColIdent{5208}, scr, F.lane)) continue;
            if (conv_job(it, in[12], D, D, D / 32, (bf16*)(ws + WS_WG), D, ColIdent{0}, scr, F.lane)) continue;
            if (conv_job(it, in[13], D, 512, D / 32, (bf16*)(ws + WS_WD), 512, ColIdent{0}, scr, F.lane)) continue;
            if (conv_job(it, in[15], D, D, D / 32, (bf16*)(ws + WS_WO), D, ColIdent{0}, scr, F.lane)) continue;
            if (conv_job(it, in[19], 512, D, 512 / 32, (bf16*)(ws + WS_WCQ), D, ColIdent{0}, scr, F.lane)) continue;
            if (conv_job(it, in[20], D, D, D / 32, (bf16*)(ws + WS_WCKV), D, ColIdent{0}, scr, F.lane)) continue;
            conv_job(it, in[21], D, 512, D / 32, (bf16*)(ws + WS_WCO), 512, ColIdent{0}, scr, F.lane);
        }
        { int m = gw;
          for (; m + 3 * NGW < M; m += 4 * NGW) rms_rows_bf16<4>(in[0] + (size_t)m * D, in[2], XN + (size_t)m * D, F.lane, (size_t)NGW * D);
          for (; m < M; m += NGW) rms_rows_bf16<1>(in[0] + (size_t)m * D, in[2], XN + (size_t)m * D, F.lane, 0); }
        for (int m = gw; m < BATCH * MEML; m += NGW) rms_rows_bf16<1>(in[1] + (size_t)m * D, in[16], (bf16*)(ws + WS_MEMN) + (size_t)m * D, F.lane, 0);
        REPBAR(0); }
        SEAM(0);
    }
    if (IN(1)) {
        pg8::Order1 S; S.init(pg8::GDesc{XN, W1A, D, D, D, M / 256, 2 * FF / 256}, F.G, F.c);
        FORREP(1) { pg8::gemm_phase<true>(F.lds, S, EpiSwiglu{HID}); REPBAR(1); }
        SEAM(1);
    }
    if (IN(2)) {
        pg8::Order1 S; S.init(pg8::GDesc{HID, W1B, FF, FF, FF, M / 256, D / 256}, F.G, F.c);
        FORREP(2) { pg8::gemm_phase<true>(F.lds, S, EpiStore{Y, D}); REPBAR(2); }
        SEAM(2);
    }
    if (IN(3)) { FORREP(3) { resnorm_phase(F, in[0], Y, in[3], 0.5f, args.out, in[6], XN, ST(3)); REPBAR(3); } SEAM(3); }
    if (IN(4)) {
        pg8::Order2 S; S.d0 = pg8::GDesc{XN, (const bf16*)(ws + WS_WIN), D, D, D, M / 256, NIN / 256};
        S.d1 = pg8::GDesc{(const bf16*)(ws + WS_MEMN), (const bf16*)(ws + WS_WCKV), D, D, D, BATCH * MEML / 256, D / 256}; S.G = F.G; S.c = F.c;
        FORREP(4) { pg8::gemm_phase<true>(F.lds, S, EpiInproj{ws}); REPBAR(4); }
        SEAM(4);
    }
    if (IN(5)) {
        FORREP(5) {
        if (sub <= 0) { for (int u = F.c; u < 256; u += F.G) gla_state_unit(F, in, u); __syncthreads(); }
        if (sub != 0) for (int k = 0; k * F.G < 2048; ++k) { const int u = k * F.G + ((k & 1) ? F.G - 1 - F.c : F.c); if (u < 2048) idx_unit(F, u, ST(5), sub >= 2 ? sub - 1 : 0); }
        REPBAR(5); }
        SEAM(5);
    }
    if (IN(6)) {
        FORREP(6) {
        if (sub != 1) gla_scan_phase(F, ST(6));
#ifdef PROBE_EXTRA_PHASE
        if (sub >= 2) { for (int p = F.c; p < 256; p += F.G) { const int bh = p >> 4, x = p & 15;
            if (sub == 2) { dsa_att_unit<1>(F, in, bh, x, false); dsa_att_unit<1>(F, in, bh, 31 - x, false); }
            if (sub == 3) { dsa_att_unit<3>(F, in, bh, x, false); dsa_att_unit<3>(F, in, bh, 31 - x, false); }
            if (sub == 4) { dsa_att_unit<4>(F, in, bh, x, false); dsa_att_unit<4>(F, in, bh, 31 - x, false); }
            if (sub == 5) { dsa_att_unit<5>(F, in, bh, x, false); dsa_att_unit<5>(F, in, bh, 31 - x, false); }
            if (sub == 6) { dsa_att_unit<6>(F, in, bh, x, false); dsa_att_unit<6>(F, in, bh, 31 - x, false); } } } else
#endif
        if (sub != 0) for (int p = F.c; p < 256; p += F.G) { const int bh = p >> 4, x = p & 15; dsa_att_unit(F, in, bh, x, ST(6)); dsa_att_unit(F, in, bh, 31 - x, ST(6)); }
        REPBAR(6); }
        SEAM(6);
    }
    if (IN(7)) {
        FORREP(7) { for (int u = F.c; u < 256; u += F.G) { gla_out_unit(F, in, u, ST(7)); __syncthreads(); } REPBAR(7); }
        SEAM(7);
    }
    if (IN(8)) {
        pg8::Order1 S; S.init(pg8::GDesc{XN, (const bf16*)(ws + WS_WGT), D, D, D, M / 256, 2048 / 256}, F.G, F.c);
        FORREP(8) { pg8::gemm_phase<true>(F.lds, S, EpiGates{(bf16*)(ws + WS_SGA), (bf16*)(ws + WS_SGB)}); REPBAR(8); }
        SEAM(8);
    }
    if (IN(9)) {
        pg8::PairOrder S; S.d0 = pg8::GDesc{(const bf16*)(ws + WS_GR), (const bf16*)(ws + WS_WG), D, D, D, M / 256, D / 256};
        S.d1 = pg8::GDesc{(const bf16*)(ws + WS_DQKV), (const bf16*)(ws + WS_WD), 1536, 512, 512, M / 256, D / 256}; S.G = F.G; S.c = F.c;
        FORREP(9) { pg8::gemm_phase<false>(F.lds, S, EpiMerge{(const bf16*)(ws + WS_SGA), (const bf16*)(ws + WS_SGB), (bf16*)(ws + WS_MRG)}); REPBAR(9); }
        SEAM(9);
    }
    if (IN(10)) {
        pg8::Order1 S; S.init(pg8::GDesc{(const bf16*)(ws + WS_MRG), (const bf16*)(ws + WS_WO), D, D, D, M / 256, D / 256}, F.G, F.c);
        FORREP(10) { pg8::gemm_phase<true>(F.lds, S, EpiStore{(bf16*)(ws + WS_Y2), D}); REPBAR(10); }
        SEAM(10);
    }
    if (IN(11)) {
        FORREP(11) {
        resnorm_phase(F, args.out, (const bf16*)(ws + WS_Y2), in[7], 1.0f, args.out, in[17], XN, ST(11));
        LAS float* scr = (LAS float*)(F.lds + F.wave * 16384);
        constexpr int NITEMS = 2816 + 1408;
        for (int it0 = gw; it0 < NITEMS; it0 += NGW) { int it = it0;
            if (conv_job8(it, in[24], 2 * FF, D, 2 * FF / 32, (unsigned char*)W1A, D, 64.f, ColFfn{}, scr, F.lane)) continue;
            conv_job8(it, in[25], D, FF, D / 32, (unsigned char*)W1B, FF, 64.f, ColIdent{0}, scr, F.lane);
        }
        REPBAR(11); }
        SEAM(11);
    }
    if (IN(12)) {
        pg8::Order1 S; S.init(pg8::GDesc{XN, (const bf16*)(ws + WS_WCQ), D, D, D, M / 256, 512 / 256}, F.G, F.c);
        FORREP(12) { pg8::gemm_phase<true>(F.lds, S, EpiStore{(bf16*)(ws + WS_QC), 512}); REPBAR(12); }
        SEAM(12);
    }
    if (IN(13)) {
        FORREP(13) { for (int u = F.c; u < 256; u += F.G) cross_att_unit(F, u); REPBAR(13); }
        SEAM(13);
    }
    if (IN(14)) {
        pg8::Order1 S; S.init(pg8::GDesc{(const bf16*)(ws + WS_OX), (const bf16*)(ws + WS_WCO), 512, 512, 512, M / 256, D / 256}, F.G, F.c);
        FORREP(14) { pg8::gemm_phase<true>(F.lds, S, EpiStore{(bf16*)(ws + WS_Y3), D}); REPBAR(14); }
        SEAM(14);
    }
    if (IN(15)) { FORREP(15) { resnorm_phase<true>(F, args.out, (const bf16*)(ws + WS_Y3), in[18], 1.0f, args.out, in[22], XN, ST(15)); REPBAR(15); } SEAM(15); }
    if (IN(16)) {
        pg8::Order1 S; S.init(pg8::GDesc{XN, W1A, D, D, D, M / 256, 2 * FF / 256}, F.G, F.c);
        FORREP(16) { pg8::gemm_phase8<true>(F.lds, S, EpiSwiglu8{(unsigned char*)HID}); REPBAR(16); }
        SEAM(16);
    }
    if (IN(17)) {
        pg8::Order1 S; S.init(pg8::GDesc{HID, W1B, FF, FF, FF, M / 256, D / 256}, F.G, F.c);
        FORREP(17) { pg8::gemm_phase8<true>(F.lds, S, EpiStore{Y, D, 1.f / 512.f}); REPBAR(17); }
        SEAM(17);
    }
    if (IN(18)) { FORREP(18) { resnorm_phase(F, args.out, Y, in[23], 0.5f, args.out, nullptr, nullptr, ST(18)); REPBAR(18); } }
#ifdef PROBE_EXTRA_PHASE
    if (lo == 20) { f32x16 a0, a1, a2, a3; for (int r = 0; r < 16; ++r) { a0[r] = 0.f; a1[r] = 1.f; a2[r] = 2.f; a3[r] = 3.f; }
        bf16x8 x = pack8(1.f, 2.f, 3.f, 4.f, 5.f, 6.f, 7.f, (float)F.lane), y = pack8(.5f, .25f, .125f, 1.f, 2.f, 3.f, 4.f, (float)F.wave);
        for (int i = 0; i < 2048; ++i) { a0 = MFMA32(x, y, a0); a1 = MFMA32(x, y, a1); a2 = MFMA32(x, y, a2); a3 = MFMA32(x, y, a3); }
        if (a0[0] + a1[1] + a2[2] + a3[3] == 1.2345f) ctl[32] = 1u; }
    if (lo == 21) { float v0 = (float)F.lane, v1 = 1.f, v2 = 2.f, v3 = 3.f, v4 = 4.f, v5 = 5.f, v6 = 6.f, v7 = 7.f; const float m = 1.0000001f, c = 1e-9f;
        for (int i = 0; i < 8192; ++i) { v0 = fmaf(v0, m, c); v1 = fmaf(v1, m, c); v2 = fmaf(v2, m, c); v3 = fmaf(v3, m, c); v4 = fmaf(v4, m, c); v5 = fmaf(v5, m, c); v6 = fmaf(v6, m, c); v7 = fmaf(v7, m, c); }
        if (v0 + v1 + v2 + v3 + v4 + v5 + v6 + v7 == 1.2345f) ctl[32] = 1u; }
    if (lo == 22) { f32x4 a0 = {0, 0, 0, 0}, a1 = {1, 1, 1, 1}, a2 = {2, 2, 2, 2}, a3 = {3, 3, 3, 3};
        bf16x8 x = pack8(1.f, 2.f, 3.f, 4.f, 5.f, 6.f, 7.f, (float)F.lane), y = pack8(.5f, .25f, .125f, 1.f, 2.f, 3.f, 4.f, (float)F.wave);
        for (int i = 0; i < 4096; ++i) { a0 = __builtin_amdgcn_mfma_f32_16x16x32_bf16(x, y, a0, 0, 0, 0); a1 = __builtin_amdgcn_mfma_f32_16x16x32_bf16(x, y, a1, 0, 0, 0); a2 = __builtin_amdgcn_mfma_f32_16x16x32_bf16(x, y, a2, 0, 0, 0); a3 = __builtin_amdgcn_mfma_f32_16x16x32_bf16(x, y, a3, 0, 0, 0); }
        if (a0[0] + a1[1] + a2[2] + a3[3] == 1.2345f) ctl[32] = 1u; }
    if (lo == 23) { float v0 = (float)F.lane * 1e-3f, v1 = .1f, v2 = .2f, v3 = .3f;
        for (int i = 0; i < 8192; ++i) { v0 = fast_exp2(v0) - 1.f; v1 = fast_exp2(v1) - 1.f; v2 = fast_exp2(v2) - 1.f; v3 = fast_exp2(v3) - 1.f; }
        if (v0 + v1 + v2 + v3 == 1.2345f) ctl[32] = 1u; }
#endif
#undef IN
#undef SEAM
}

extern "C" void kernel_launch(void* const* d_in, const int* in_sizes, int n_in, void* d_out, int out_size, void* d_ws, size_t ws_size, hipStream_t stream) {
    static int grid = 0;
    if (grid == 0) {
        if (n_in != 26 || out_size != M * D || ws_size < WS_END) { fprintf(stderr, "kernel_launch: unexpected problem shape (n_in %d, out %d, ws %zu); nothing launched\n", n_in, out_size, ws_size); grid = -1; return; }
        int dev = 0, cus = 0, per_cu = 0;
        if (hipGetDevice(&dev) != hipSuccess || hipDeviceGetAttribute(&cus, hipDeviceAttributeMultiprocessorCount, dev) != hipSuccess) { grid = -1; return; }
        if (hipFuncSetAttribute((const void*)mega_fwd, hipFuncAttributeMaxDynamicSharedMemorySize, LDS_BYTES) != hipSuccess) { fprintf(stderr, "kernel_launch: hipFuncSetAttribute failed\n"); grid = -1; return; }
        if (hipOccupancyMaxActiveBlocksPerMultiprocessor(&per_cu, (const void*)mega_fwd, NT, LDS_BYTES) != hipSuccess || per_cu < 1) fprintf(stderr, "kernel_launch: occupancy query reports %d workgroups per CU\n", per_cu);
        (void)hipGetLastError();
        grid = cus;
    }
    if (grid < 0) return;
    (void)hipMemsetAsync((char*)d_ws + WS_CTL, 0, 65536, stream);
    Args a{};
    for (int i = 0; i < 26; ++i) a.in[i] = (const float*)d_in[i];
    a.out = (float*)d_out; a.ws = (unsigned char*)d_ws;
    a.nostore = 0; a.sub = -1;
#if MK_ONE_LAUNCH
    a.ph_lo = 0; a.ph_hi = N_PHASES;
    hipLaunchKernelGGL(mega_fwd, dim3(grid), dim3(NT), LDS_BYTES, stream, a);
#ifdef PROBE_EXTRA_PHASE
    for (int r = 0; r < PROBE_EXTRA_N; ++r) { a.ph_lo = PROBE_EXTRA_PHASE; a.ph_hi = PROBE_EXTRA_PHASE + 1; a.nostore = 1; a.sub = PROBE_EXTRA_SUB;
    hipLaunchKernelGGL(mega_fwd, dim3(grid), dim3(NT), LDS_BYTES, stream, a); }
#endif
#else
    for (int p = 0; p < N_PHASES; ++p) { a.ph_lo = p; a.ph_hi = p + 1; hipLaunchKernelGGL(mega_fwd, dim3(grid), dim3(NT), LDS_BYTES, stream, a); }
#endif
}
```

```cpp
#define MK_ONE_LAUNCH 1
#pragma clang diagnostic ignored "-Wint-to-pointer-cast"
#include <hip/hip_runtime.h>
#include <cstdio>
#include <cstdint>

#define DI __device__ __forceinline__
#define LAS __attribute__((address_space(3)))
#define GAS __attribute__((address_space(1)))
typedef unsigned short bf16;
typedef short bf16x8 __attribute__((ext_vector_type(8)));
typedef short s16x4 __attribute__((ext_vector_type(4)));
typedef float f32x4 __attribute__((ext_vector_type(4)));
typedef float f32x2 __attribute__((ext_vector_type(2)));
typedef float f32x16 __attribute__((ext_vector_type(16)));
typedef unsigned u32x4 __attribute__((ext_vector_type(4)));
typedef unsigned u32x2 __attribute__((ext_vector_type(2)));
typedef __bf16 bf16x2_t __attribute__((ext_vector_type(2)));

DI unsigned pk2(float lo, float hi) { f32x2 v = {lo, hi}; bf16x2_t b = __builtin_convertvector(v, bf16x2_t); return __builtin_bit_cast(unsigned, b); }
DI float bflo(unsigned w) { return __uint_as_float(w << 16); }
DI float bfhi(unsigned w) { return __uint_as_float(w & 0xffff0000u); }
DI float bf2f(bf16 v) { return __uint_as_float(((unsigned)v) << 16); }
DI float wave_sum(float v) {
#pragma unroll
    for (int o = 1; o < 64; o <<= 1) v += __shfl_xor(v, o);
    return v;
}
DI float fast_exp2(float x) { return __builtin_amdgcn_exp2f(x); }
DI float fast_exp(float x) { return __builtin_amdgcn_exp2f(x * 1.4426950408889634f); }
DI float fast_rcp(float x) { return __builtin_amdgcn_rcpf(x); }
DI float sigmoid_f(float x) { return fast_rcp(1.0f + fast_exp(-x)); }
#define MFMA32(a, b, c) __builtin_amdgcn_mfma_f32_32x32x16_bf16((a), (b), (c), 0, 0, 0)
DI int crow(int r, int hi) { return (r & 3) + 8 * (r >> 2) + 4 * hi; }
DI bf16x8 pack8(float a0, float a1, float a2, float a3, float a4, float a5, float a6, float a7) {
    u32x4 p; p.x = pk2(a0, a1); p.y = pk2(a2, a3); p.z = pk2(a4, a5); p.w = pk2(a6, a7); return __builtin_bit_cast(bf16x8, p);
}
DI bf16x8 pack_step(const f32x16& x, int s) { return pack8(x[8 * s], x[8 * s + 1], x[8 * s + 2], x[8 * s + 3], x[8 * s + 4], x[8 * s + 5], x[8 * s + 6], x[8 * s + 7]); }
typedef short v4i16_t __attribute__((ext_vector_type(4)));
DI s16x4 vtr(unsigned lds_byte_addr) { return __builtin_bit_cast(s16x4, __builtin_amdgcn_ds_read_tr16_b64_v4i16((LAS v4i16_t*)lds_byte_addr)); }
DI bf16x8 cat4(s16x4 lo, s16x4 hi) { return __builtin_shufflevector(lo, hi, 0, 1, 2, 3, 4, 5, 6, 7); }
DI bf16x8 lds_b128(unsigned lds_byte_addr) { return *(const LAS bf16x8*)lds_byte_addr; }

namespace pg8 {
#define PG8_LAS __attribute__((address_space(3)))
typedef unsigned short bf16_t;
constexpr int BM = 256, BK = 64, HALF = 128, HTB = HALF * BK * 2  , STAGE_BYTES = 8 * HTB, NXCD = 8, WGM = 8;

__host__ __device__ __forceinline__ int lds_byte(int r, int c) { const int st = (r >> 4) * 2 + (c >> 5), rr = r & 15, cc = c & 31, ob = rr * 64 + cc * 2; return st * 1024 + (ob ^ (((ob >> 9) & 1) << 5)); }
__host__ __device__ __forceinline__ void stage_rc(int b, int& R, int& C) { const int st = b / 1024, sb = b % 1024, swz = sb ^ (((sb >> 9) & 1) << 5); R = (st >> 1) * 16 + swz / 64; C = (st & 1) * 32 + (swz % 64) / 2; }
__host__ __device__ __forceinline__ int perm32(int rho) { const int n = rho >> 4, i = rho & 15; return 8 * (i >> 2) + 4 * n + (i & 3); }

struct Unit { int pm, pn, g; };
struct GDesc { const bf16_t* A; const bf16_t* Bt; int lda, ldb, K, nM, nN; };

__device__ __forceinline__ void tile_of(int l, int nM, int nN, int& pm, int& pn) {
    const int nwg = nM * nN; int wgid = l;
    { const int q = nwg / NXCD, r = nwg % NXCD, xcd = wgid % NXCD, off = wgid / NXCD; wgid = (xcd < r ? xcd * (q + 1) : r * (q + 1) + (xcd - r) * q) + off; }
    const int nig = WGM * nN, gid = wgid / nig, fm = gid * WGM, gsz = (nM - fm) < WGM ? (nM - fm) : WGM;
    pm = fm + ((wgid % nig) % gsz); pn = (wgid % nig) / gsz;
}
struct Order1 {
    GDesc d0; int G, c;
    __device__ __forceinline__ void init(const GDesc& a, int G_, int c_) { d0 = a; G = G_; c = c_; }
    __device__ __forceinline__ GDesc desc(int) const { return d0; }
    __device__ __forceinline__ bool next(int i, Unit& u) const {
        const long L = (long)i * G + c; if (L >= (long)(d0.nM * d0.nN)) return false;
        tile_of((int)L, d0.nM, d0.nN, u.pm, u.pn); u.g = 0; return true;
    }
};
struct Order2 {
    GDesc d0, d1; int G, c;
    __device__ __forceinline__ GDesc desc(int g) const { GDesc r; r.A = g == 0 ? d0.A : d1.A; r.Bt = g == 0 ? d0.Bt : d1.Bt; r.lda = d0.lda; r.ldb = d0.ldb; r.K = d0.K; r.nM = g == 0 ? d0.nM : d1.nM; r.nN = g == 0 ? d0.nN : d1.nN; return r; }
    __device__ __forceinline__ bool next(int i, Unit& u) const {
        const int n0 = d0.nM * d0.nN, n1 = d1.nM * d1.nN;
        const long L = (long)i * G + c; if (L >= (long)(n0 + n1)) return false;
        int l = (int)L, g = 0; if (l >= n0) { l -= n0; g = 1; }
        tile_of(l, g == 0 ? d0.nM : d1.nM, g == 0 ? d0.nN : d1.nN, u.pm, u.pn); u.g = g; return true;
    }
};
struct PairOrder {
    GDesc d0, d1; int G, c;
    __device__ __forceinline__ GDesc desc(int g) const { GDesc r; r.A = g == 0 ? d0.A : d1.A; r.Bt = g == 0 ? d0.Bt : d1.Bt; r.lda = g == 0 ? d0.lda : d1.lda; r.ldb = g == 0 ? d0.ldb : d1.ldb; r.K = g == 0 ? d0.K : d1.K; r.nM = d0.nM; r.nN = d0.nN; return r; }
    __device__ __forceinline__ bool next(int i, Unit& u) const {
        const long L = (long)(i >> 1) * G + c; if (L >= (long)(d0.nM * d0.nN)) return false;
        tile_of((int)L, d0.nM, d0.nN, u.pm, u.pn); u.g = i & 1; return true;
    }
};

template <bool UNIFORM  , class Epi, class Sched>
__device__ __forceinline__ void gemm_phase(PG8_LAS unsigned char* lds, const Sched& S, const Epi& E) {
    const int tid = threadIdx.x, wid = __builtin_amdgcn_readfirstlane(tid >> 6), lane = tid & 63, wr = wid >> 2, wc = wid & 3, fr = lane & 15, fq = lane >> 4;
    auto voff = [tid](int i, int ld, bool perm) -> unsigned { int R, C; stage_rc(tid * 16 + i * 8192, R, C); if (perm) R = (R & ~31) + perm32(R & 31); return (unsigned)(R * ld + C) * 2u; };
    const size_t kstep = (size_t)(BK * 2);
    const unsigned ldsw = (unsigned)wid * 1024u;
    const int aoff = lds_byte(wr * 64 + fr, fq * 8), boff = lds_byte(wc * 32 + fr, fq * 8);
#define PG8_SA(b, h) (((b) * 2 + (h)) * HTB)
#define PG8_SB(b, h) ((4 + (b) * 2 + (h)) * HTB)
#define PG8_STAGE(bufoff, gbase, v0, v1) do { \
        __builtin_amdgcn_global_load_lds((const unsigned*)((const char*)(gbase) + (v0)), (PG8_LAS unsigned*)(lds + (bufoff) + ldsw), 16, 0, 0); \
        __builtin_amdgcn_global_load_lds((const unsigned*)((const char*)(gbase) + (v1)), (PG8_LAS unsigned*)(lds + (bufoff) + ldsw + 8192), 16, 0, 0); } while (0)
#define PG8_LDA(dst, b, h) do { _Pragma("unroll") for (int m = 0; m < 4; ++m) _Pragma("unroll") for (int k = 0; k < 2; ++k) dst[m][k] = *(const PG8_LAS bf16x8*)(lds + PG8_SA(b, h) + aoff + m * 2048 + k * 1024); } while (0)
#define PG8_LDB(dst, b, h) do { _Pragma("unroll") for (int n = 0; n < 2; ++n) _Pragma("unroll") for (int k = 0; k < 2; ++k) dst[n][k] = *(const PG8_LAS bf16x8*)(lds + PG8_SB(b, h) + boff + n * 2048 + k * 1024); } while (0)
#define PG8_MMA(ai, bj, At, Bt) do { __builtin_amdgcn_s_setprio(1); _Pragma("unroll") for (int m = 0; m < 4; ++m) _Pragma("unroll") for (int n = 0; n < 2; ++n) _Pragma("unroll") for (int k = 0; k < 2; ++k) \
        acc[ai][bj][m][n] = __builtin_amdgcn_mfma_f32_16x16x32_bf16(Bt[n][k], At[m][k], acc[ai][bj][m][n], 0, 0, 0); __builtin_amdgcn_s_setprio(0); } while (0)
#define PG8_WAIT_V(n) asm volatile("s_waitcnt vmcnt(" #n ")" ::: "memory")
#define PG8_WAIT_L(n) asm volatile("s_waitcnt lgkmcnt(" #n ")" ::: "memory")
#define PG8_BAR __builtin_amdgcn_s_barrier()
#define PG8_SCHED __builtin_amdgcn_sched_barrier(0)
    Unit cur, nxt; int ui = 0;
    if (!S.next(0, cur)) return;
    GDesc dc = S.desc(cur.g);
    f32x4 acc[2][2][4][2];
#pragma unroll
    for (int a = 0; a < 2; ++a)
#pragma unroll
        for (int b = 0; b < 2; ++b)
#pragma unroll
            for (int m = 0; m < 4; ++m)
#pragma unroll
                for (int n = 0; n < 2; ++n) acc[a][b][m][n] = (f32x4){0.f, 0.f, 0.f, 0.f};
    bf16x8 At[4][2], B0[2][2], B1[2][2];
    unsigned vA0 = voff(0, dc.lda, false), vA1 = voff(1, dc.lda, false), vB0 = voff(0, dc.ldb, true), vB1 = voff(1, dc.ldb, true);
    size_t hA = (size_t)HALF * dc.lda * 2, hB = (size_t)HALF * dc.ldb * 2;
    const char* cA = (const char*)dc.A + (size_t)cur.pm * 2 * hA; const char* cB = (const char*)dc.Bt + (size_t)cur.pn * 2 * hB;
    PG8_STAGE(PG8_SB(0, 0), cB, vB0, vB1); PG8_STAGE(PG8_SB(0, 1), cB + hB, vB0, vB1); PG8_STAGE(PG8_SA(0, 0), cA, vA0, vA1); PG8_STAGE(PG8_SA(0, 1), cA + hA, vA0, vA1);
    if (wr == 1) PG8_BAR;
    PG8_WAIT_V(2); PG8_BAR;
    PG8_STAGE(PG8_SB(1, 0), cB + kstep, vB0, vB1); PG8_STAGE(PG8_SA(1, 0), cA + kstep, vA0, vA1); PG8_STAGE(PG8_SB(1, 1), cB + hB + kstep, vB0, vB1);
    PG8_WAIT_V(6); PG8_BAR;
    for (;;) {
        const bool has_next = S.next(ui + 1, nxt);
        GDesc dn = dc; if (has_next) dn = S.desc(nxt.g);
        unsigned nvA0 = vA0, nvA1 = vA1, nvB0 = vB0, nvB1 = vB1; size_t nhA = hA, nhB = hB;
        if constexpr (!UNIFORM) { if (has_next) { nvA0 = voff(0, dn.lda, false); nvA1 = voff(1, dn.lda, false); nvB0 = voff(0, dn.ldb, true); nvB1 = voff(1, dn.ldb, true); nhA = (size_t)HALF * dn.lda * 2; nhB = (size_t)HALF * dn.ldb * 2; } }
        const char* nA = has_next ? (const char*)dn.A + (size_t)nxt.pm * 2 * nhA : cA; const char* nB = has_next ? (const char*)dn.Bt + (size_t)nxt.pn * 2 * nhB : cB;
        const int nt = dc.K / BK;
        for (int t = 0; t < nt; t += 2) {
            const bool last = (t == nt - 2);
            const char* a1 = cA + (size_t)(t + 1) * kstep;
            const char* a2 = last ? nA : cA + (size_t)(t + 2) * kstep; const char* b2 = last ? nB : cB + (size_t)(t + 2) * kstep;
            const char* a3 = a2 + kstep; const char* b3 = b2 + kstep;
            unsigned xA0 = vA0, xA1 = vA1, xB0 = vB0, xB1 = vB1; size_t xhA = hA, xhB = hB;
            if constexpr (!UNIFORM) { if (last) { xA0 = nvA0; xA1 = nvA1; xB0 = nvB0; xB1 = nvB1; xhA = nhA; xhB = nhB; } }
            PG8_LDB(B0, 0, 0); PG8_LDB(B1, 0, 1); PG8_SCHED; PG8_LDA(At, 0, 0); PG8_STAGE(PG8_SA(1, 1), a1 + hA, vA0, vA1);
            PG8_WAIT_V(8); PG8_WAIT_L(0); PG8_BAR; PG8_MMA(0, 0, At, B0); PG8_MMA(0, 1, At, B1); PG8_BAR; PG8_SCHED;
            PG8_LDA(At, 0, 1); PG8_STAGE(PG8_SB(0, 0), b2, xB0, xB1); PG8_STAGE(PG8_SB(0, 1), b2 + xhB, xB0, xB1); PG8_STAGE(PG8_SA(0, 0), a2, xA0, xA1);
            PG8_WAIT_V(8); PG8_WAIT_L(0); PG8_BAR; PG8_MMA(1, 0, At, B0); PG8_MMA(1, 1, At, B1); PG8_BAR; PG8_SCHED;
            PG8_LDB(B0, 1, 0); PG8_LDB(B1, 1, 1); PG8_SCHED; PG8_LDA(At, 1, 0); PG8_STAGE(PG8_SA(0, 1), a2 + xhA, xA0, xA1);
            PG8_WAIT_V(8); PG8_WAIT_L(0); PG8_BAR; PG8_MMA(0, 0, At, B0); PG8_MMA(0, 1, At, B1); PG8_BAR; PG8_SCHED;
            PG8_LDA(At, 1, 1); PG8_STAGE(PG8_SB(1, 0), b3, xB0, xB1); PG8_STAGE(PG8_SB(1, 1), b3 + xhB, xB0, xB1); PG8_STAGE(PG8_SA(1, 0), a3, xA0, xA1);
            PG8_WAIT_V(8); PG8_WAIT_L(0); PG8_BAR; PG8_MMA(1, 0, At, B0); PG8_MMA(1, 1, At, B1); PG8_BAR; PG8_SCHED;
        }
        if (wr == 0) PG8_BAR;
        const bool keep = E(acc, cur, wr, wc, fr, fq);
        if (!has_next) break;
        if (!keep) {
#pragma unroll
            for (int a = 0; a < 2; ++a)
#pragma unroll
                for (int b = 0; b < 2; ++b)
#pragma unroll
                    for (int m = 0; m < 4; ++m)
#pragma unroll
                        for (int n = 0; n < 2; ++n) acc[a][b][m][n] = (f32x4){0.f, 0.f, 0.f, 0.f};
        }
        cur = nxt; dc = dn; cA = nA; cB = nB; vA0 = nvA0; vA1 = nvA1; vB0 = nvB0; vB1 = nvB1; hA = nhA; hB = nhB; ++ui;
        if (wr == 1) PG8_BAR;
    }
    PG8_WAIT_V(0);
    PG8_BAR;
#undef PG8_SA
#undef PG8_SB
#undef PG8_STAGE
#undef PG8_LDA
#undef PG8_LDB
#undef PG8_MMA
#undef PG8_WAIT_V
#undef PG8_WAIT_L
#undef PG8_BAR
#undef PG8_SCHED
}
template <bool UNIFORM, class Epi, class Sched>
__device__ __forceinline__ void gemm_phase8(PG8_LAS unsigned char* lds, const Sched& S, const Epi& E) {
    const int tid = threadIdx.x, wid = __builtin_amdgcn_readfirstlane(tid >> 6), lane = tid & 63, wr = wid >> 2, wc = wid & 3, fr = lane & 15, fq = lane >> 4;
    auto voff = [tid](int i, int ld, bool perm) -> unsigned { int R, C; stage_rc(tid * 16 + i * 8192, R, C); if (perm) R = (R & ~31) + perm32(R & 31); return (unsigned)(R * ld + 2 * C); };
    const size_t kstep = (size_t)(BK * 2);
    const unsigned ldsw = (unsigned)wid * 1024u;
    const int aoff0 = lds_byte(wr * 64 + fr, fq * 16), boff0 = lds_byte(wc * 32 + fr, fq * 16);
    constexpr int aoff1d = 16, boff1d = 16;
    typedef int v8i __attribute__((ext_vector_type(8))); typedef int v4i __attribute__((ext_vector_type(4)));
    const int unit_scale = 0x7f7f7f7f;
#define PG8_SA(b, h) (((b) * 2 + (h)) * HTB)
#define PG8_SB(b, h) ((4 + (b) * 2 + (h)) * HTB)
#define PG8_STAGE(bufoff, gbase, v0, v1) do { \
        __builtin_amdgcn_global_load_lds((const unsigned*)((const char*)(gbase) + (v0)), (PG8_LAS unsigned*)(lds + (bufoff) + ldsw), 16, 0, 0); \
        __builtin_amdgcn_global_load_lds((const unsigned*)((const char*)(gbase) + (v1)), (PG8_LAS unsigned*)(lds + (bufoff) + ldsw + 8192), 16, 0, 0); } while (0)
#define PG8_LDA(dst, b, h) do { _Pragma("unroll") for (int m = 0; m < 4; ++m) { const v4i lo_ = *(const PG8_LAS v4i*)(lds + PG8_SA(b, h) + aoff0 + m * 2048), hi_ = *(const PG8_LAS v4i*)(lds + PG8_SA(b, h) + aoff0 + aoff1d + m * 2048); dst[m] = __builtin_shufflevector(lo_, hi_, 0, 1, 2, 3, 4, 5, 6, 7); } } while (0)
#define PG8_LDB(dst, b, h) do { _Pragma("unroll") for (int n = 0; n < 2; ++n) { const v4i lo_ = *(const PG8_LAS v4i*)(lds + PG8_SB(b, h) + boff0 + n * 2048), hi_ = *(const PG8_LAS v4i*)(lds + PG8_SB(b, h) + boff0 + boff1d + n * 2048); dst[n] = __builtin_shufflevector(lo_, hi_, 0, 1, 2, 3, 4, 5, 6, 7); } } while (0)
#define PG8_MMA(ai, bj, At, Bt) do { __builtin_amdgcn_s_setprio(1); _Pragma("unroll") for (int m = 0; m < 4; ++m) _Pragma("unroll") for (int n = 0; n < 2; ++n) \
        asm volatile("v_mfma_scale_f32_16x16x128_f8f6f4 %0, %1, %2, %0, %3, %3 op_sel_hi:[0,0,0]" : "+v"(acc[ai][bj][m][n]) : "v"(Bt[n]), "v"(At[m]), "v"(unit_scale)); __builtin_amdgcn_s_setprio(0); } while (0)
#define PG8_WAIT_V(n) asm volatile("s_waitcnt vmcnt(" #n ")" ::: "memory")
#define PG8_WAIT_L(n) asm volatile("s_waitcnt lgkmcnt(" #n ")" ::: "memory")
#define PG8_BAR __builtin_amdgcn_s_barrier()
#define PG8_SCHED __builtin_amdgcn_sched_barrier(0)
    Unit cur, nxt; int ui = 0;
    if (!S.next(0, cur)) return;
    GDesc dc = S.desc(cur.g);
    f32x4 acc[2][2][4][2];
#pragma unroll
    for (int a = 0; a < 2; ++a)
#pragma unroll
        for (int b = 0; b < 2; ++b)
#pragma unroll
            for (int m = 0; m < 4; ++m)
#pragma unroll
                for (int n = 0; n < 2; ++n) acc[a][b][m][n] = (f32x4){0.f, 0.f, 0.f, 0.f};
    v8i At[4], B0[2], B1[2];
    unsigned vA0 = voff(0, dc.lda, false), vA1 = voff(1, dc.lda, false), vB0 = voff(0, dc.ldb, true), vB1 = voff(1, dc.ldb, true);
    size_t hA = (size_t)HALF * dc.lda, hB = (size_t)HALF * dc.ldb;
    const char* cA = (const char*)dc.A + (size_t)cur.pm * 2 * hA; const char* cB = (const char*)dc.Bt + (size_t)cur.pn * 2 * hB;
    PG8_STAGE(PG8_SB(0, 0), cB, vB0, vB1); PG8_STAGE(PG8_SB(0, 1), cB + hB, vB0, vB1); PG8_STAGE(PG8_SA(0, 0), cA, vA0, vA1); PG8_STAGE(PG8_SA(0, 1), cA + hA, vA0, vA1);
    if (wr == 1) PG8_BAR;
    PG8_WAIT_V(2); PG8_BAR;
    PG8_STAGE(PG8_SB(1, 0), cB + kstep, vB0, vB1); PG8_STAGE(PG8_SA(1, 0), cA + kstep, vA0, vA1); PG8_STAGE(PG8_SB(1, 1), cB + hB + kstep, vB0, vB1);
    PG8_WAIT_V(6); PG8_BAR;
    for (;;) {
        const bool has_next = S.next(ui + 1, nxt);
        GDesc dn = dc; if (has_next) dn = S.desc(nxt.g);
        unsigned nvA0 = vA0, nvA1 = vA1, nvB0 = vB0, nvB1 = vB1; size_t nhA = hA, nhB = hB;
        if constexpr (!UNIFORM) { if (has_next) { nvA0 = voff(0, dn.lda, false); nvA1 = voff(1, dn.lda, false); nvB0 = voff(0, dn.ldb, true); nvB1 = voff(1, dn.ldb, true); nhA = (size_t)HALF * dn.lda; nhB = (size_t)HALF * dn.ldb; } }
        const char* nA = has_next ? (const char*)dn.A + (size_t)nxt.pm * 2 * nhA : cA; const char* nB = has_next ? (const char*)dn.Bt + (size_t)nxt.pn * 2 * nhB : cB;
        const int nt = dc.K / 128;
        for (int t = 0; t < nt; t += 2) {
            const bool last = (t == nt - 2);
            const char* a1 = cA + (size_t)(t + 1) * kstep;
            const char* a2 = last ? nA : cA + (size_t)(t + 2) * kstep; const char* b2 = last ? nB : cB + (size_t)(t + 2) * kstep;
            const char* a3 = a2 + kstep; const char* b3 = b2 + kstep;
            unsigned xA0 = vA0, xA1 = vA1, xB0 = vB0, xB1 = vB1; size_t xhA = hA, xhB = hB;
            if constexpr (!UNIFORM) { if (last) { xA0 = nvA0; xA1 = nvA1; xB0 = nvB0; xB1 = nvB1; xhA = nhA; xhB = nhB; } }
            PG8_LDB(B0, 0, 0); PG8_LDB(B1, 0, 1); PG8_SCHED; PG8_LDA(At, 0, 0); PG8_STAGE(PG8_SA(1, 1), a1 + hA, vA0, vA1);
            PG8_WAIT_V(8); PG8_WAIT_L(0); PG8_BAR; PG8_MMA(0, 0, At, B0); PG8_MMA(0, 1, At, B1); PG8_BAR; PG8_SCHED;
            PG8_LDA(At, 0, 1); PG8_STAGE(PG8_SB(0, 0), b2, xB0, xB1); PG8_STAGE(PG8_SB(0, 1), b2 + xhB, xB0, xB1); PG8_STAGE(PG8_SA(0, 0), a2, xA0, xA1);
            PG8_WAIT_V(8); PG8_WAIT_L(0); PG8_BAR; PG8_MMA(1, 0, At, B0); PG8_MMA(1, 1, At, B1); PG8_BAR; PG8_SCHED;
            PG8_LDB(B0, 1, 0); PG8_LDB(B1, 1, 1); PG8_SCHED; PG8_LDA(At, 1, 0); PG8_STAGE(PG8_SA(0, 1), a2 + xhA, xA0, xA1);
            PG8_WAIT_V(8); PG8_WAIT_L(0); PG8_BAR; PG8_MMA(0, 0, At, B0); PG8_MMA(0, 1, At, B1); PG8_BAR; PG8_SCHED;
            PG8_LDA(At, 1, 1); PG8_STAGE(PG8_SB(1, 0), b3, xB0, xB1); PG8_STAGE(PG8_SB(1, 1), b3 + xhB, xB0, xB1); PG8_STAGE(PG8_SA(1, 0), a3, xA0, xA1);
            PG8_WAIT_V(8); PG8_WAIT_L(0); PG8_BAR; PG8_MMA(1, 0, At, B0); PG8_MMA(1, 1, At, B1); PG8_BAR; PG8_SCHED;
        }
        if (wr == 0) PG8_BAR;
#define PG8_PAD16(a_) asm volatile("s_nop 15\n\ts_nop 15" : "+v"(acc[a_][0][0][0]), "+v"(acc[a_][0][0][1]), "+v"(acc[a_][0][1][0]), "+v"(acc[a_][0][1][1]), "+v"(acc[a_][0][2][0]), "+v"(acc[a_][0][2][1]), "+v"(acc[a_][0][3][0]), "+v"(acc[a_][0][3][1]), \
            "+v"(acc[a_][1][0][0]), "+v"(acc[a_][1][0][1]), "+v"(acc[a_][1][1][0]), "+v"(acc[a_][1][1][1]), "+v"(acc[a_][1][2][0]), "+v"(acc[a_][1][2][1]), "+v"(acc[a_][1][3][0]), "+v"(acc[a_][1][3][1]))
        PG8_PAD16(0); PG8_PAD16(1);
#undef PG8_PAD16
        const bool keep = E(acc, cur, wr, wc, fr, fq);
        if (!has_next) break;
        if (!keep) {
#pragma unroll
            for (int a = 0; a < 2; ++a)
#pragma unroll
                for (int b = 0; b < 2; ++b)
#pragma unroll
                    for (int m = 0; m < 4; ++m)
#pragma unroll
                        for (int n = 0; n < 2; ++n) acc[a][b][m][n] = (f32x4){0.f, 0.f, 0.f, 0.f};
        }
        cur = nxt; dc = dn; cA = nA; cB = nB; vA0 = nvA0; vA1 = nvA1; vB0 = nvB0; vB1 = nvB1; hA = nhA; hB = nhB; ++ui;
        if (wr == 1) PG8_BAR;
    }
    PG8_WAIT_V(0);
    PG8_BAR;
#undef PG8_SA
#undef PG8_SB
#undef PG8_STAGE
#undef PG8_LDA
#undef PG8_LDB
#undef PG8_MMA
#undef PG8_WAIT_V
#undef PG8_WAIT_L
#undef PG8_BAR
#undef PG8_SCHED
}
}

constexpr int NWAVES = 8, NT = 512;
constexpr int BATCH = 2, T = 8192, D = 1024, M = BATCH * T, FF = 2816, MEML = 256;
constexpr float EPS = 1e-6f;
constexpr float LOG2E = 1.4426950408889634f;
constexpr int NIN = 5376;
constexpr size_t KiB = 1024, MiB = 1u << 20;
constexpr size_t WS_CTL = 0, CTL_ZERO_BYTES = 1 * MiB;
constexpr size_t WS_XN = 1 * MiB;
constexpr size_t WS_HID = 33 * MiB;
constexpr size_t WS_Y = 121 * MiB;
constexpr size_t WS_QKG = 33 * MiB, WS_GV = 65 * MiB, WS_GR = 97 * MiB, WS_DQKV = 129 * MiB, WS_IQ = 177 * MiB, WS_SM = 193 * MiB, WS_GST = 197 * MiB;
constexpr size_t WS_W1A = 153 * MiB, WS_W1B = 164 * MiB;
constexpr size_t WS_WIN = 229 * MiB, WS_WGT = 229 * MiB + 10752 * KiB, WS_WG = WS_WGT + 4 * MiB, WS_WD = WS_WG + 2 * MiB, WS_WO = WS_WD + 1 * MiB,
                 WS_WCQ = WS_WO + 2 * MiB, WS_WCKV = WS_WCQ + 1 * MiB, WS_WCO = WS_WCKV + 2 * MiB, WS_MEMN = WS_WCO + 1 * MiB, WS_KVM = WS_MEMN + 1 * MiB, WS_DEC = WS_KVM + 1 * MiB;
constexpr size_t WS_SGA = WS_QKG, WS_SGB = WS_GV, WS_MRG = WS_GST, WS_Y2 = WS_QKG;
constexpr size_t WS_QC = 65 * MiB, WS_OX = 81 * MiB, WS_Y3 = 97 * MiB;
constexpr size_t WS_H3 = 177 * MiB;
constexpr size_t WS_END = 256 * MiB;
static_assert(WS_DEC + 128 * KiB <= WS_END && WS_W1B + (size_t)D * FF * 2 <= WS_IQ && WS_HID + (size_t)M * FF * 2 <= WS_Y, "d_ws map");
constexpr int CW_BAR = 4096;
constexpr int LDS_BYTES = 163840;
constexpr int MISC_OFF = LDS_BYTES - 256;

#define XB_TMO      128
#define XB_XCNT(j)  (256  + 64 * (j))
#define XB_XSUB(j)  (1280 + 64 * (j))
#define XB_XGEN(j)  (2304 + 64 * (j))
#define XB_TOP      3328
#define XB_TOPGEN   3392
#define XCD_BAR_WORDS 3456
#define XB_SPIN_CAP (1u << 18)

__device__ __forceinline__ unsigned xb_ld(unsigned* p)              { return __hip_atomic_load(p, __ATOMIC_RELAXED, __HIP_MEMORY_SCOPE_AGENT); }
__device__ __forceinline__ unsigned xb_add(unsigned* p, unsigned v) { return __hip_atomic_fetch_add(p, v, __ATOMIC_RELAXED, __HIP_MEMORY_SCOPE_AGENT); }
__device__ __forceinline__ unsigned xb_xcc_id() { return (unsigned)__builtin_amdgcn_s_getreg((3 << 11) | 20) & 0xFu; }
#define XB_SPIN(cond, bar) do { unsigned _sp = 0; while (cond) { __builtin_amdgcn_s_sleep(1); \
    if ((++_sp & 255u) == 0u) { if (xb_ld(&(bar)[XB_TMO])) break; if (_sp > XB_SPIN_CAP) { atomicAdd(&(bar)[XB_TMO], 1u); break; } } } } while (0)

struct XcdBarrier {
    unsigned* bar; unsigned x;
    volatile LAS unsigned* st;
};

__device__ __forceinline__ XcdBarrier xcd_barrier_post(unsigned* bar, volatile LAS unsigned* st) {
    XcdBarrier b; b.bar = bar; b.x = xb_xcc_id(); b.st = st;
    if (threadIdx.x == 0) (void)xb_add(&bar[XB_XCNT(b.x)], 1u);
    return b;
}
__device__ __forceinline__ void xcd_barrier_complete(unsigned* bar, unsigned x, unsigned& nloc, unsigned& nx) {
    const unsigned G = gridDim.x * gridDim.y * gridDim.z;
    unsigned sum, cnt, mine, sp = 0u;
    for (;;) {
        sum = 0u; cnt = 0u; mine = 0u;
#pragma unroll
        for (unsigned j = 0; j < 16; ++j) { const unsigned c = xb_ld(&bar[XB_XCNT(j)]); sum += c; cnt += (c > 0u) ? 1u : 0u; mine = (j == x) ? c : mine; }
        if (sum == G) break;
        __builtin_amdgcn_s_sleep(1);
        if ((++sp & 255u) == 0u) { if (xb_ld(&bar[XB_TMO])) break; if (sp > XB_SPIN_CAP) { atomicAdd(&bar[XB_TMO], 1u); break; } }
    }
    nloc = mine > 0u ? mine : 1u; nx = cnt > 0u ? cnt : 1u;
}

__device__ __forceinline__ void xcd_barrier(const XcdBarrier& b) {
    asm volatile("s_waitcnt vmcnt(0)" ::: "memory");
    __syncthreads();
    if (threadIdx.x == 0) {
        unsigned* bar = b.bar;
        __builtin_amdgcn_s_waitcnt(0);
        unsigned nloc = b.st[0], nx = b.st[1];
        if (nloc == 0u) { xcd_barrier_complete(bar, b.x, nloc, nx); b.st[0] = nloc; b.st[1] = nx; }
        const unsigned old = xb_add(&bar[XB_XSUB(b.x)], 1u);
        const unsigned gen = old / nloc;
        if (old + 1u == (gen + 1u) * nloc) {
            __builtin_amdgcn_fence(__ATOMIC_RELEASE, "agent");
            asm volatile("s_waitcnt vmcnt(0)" ::: "memory");
            const unsigned og = xb_add(&bar[XB_TOP], 1u);
            const unsigned tg = og / nx;
            if (og + 1u == (tg + 1u) * nx) xb_add(&bar[XB_TOPGEN], 1u);
            else XB_SPIN(xb_ld(&bar[XB_TOPGEN]) == tg, bar);
            __builtin_amdgcn_fence(__ATOMIC_ACQUIRE, "agent");
            xb_add(&bar[XB_XGEN(b.x)], 1u);
            asm volatile("s_waitcnt vmcnt(0)" ::: "memory");
        } else {
            XB_SPIN(xb_ld(&bar[XB_XGEN(b.x)]) == gen, bar);
            __builtin_amdgcn_fence(__ATOMIC_ACQUIRE, "agent");
            asm volatile("s_waitcnt vmcnt(0)" ::: "memory");
        }
    }
    __syncthreads();
}

struct Args { const float* in[26]; float* out; unsigned char* ws; int ph_lo, ph_hi, nostore, sub; };
struct Frame {
    LAS unsigned char* lds;
    unsigned char* ws;
    int tid, lane, wave, G, c;
};
#define LDS_WAIT() asm volatile("s_waitcnt lgkmcnt(0)" ::: "memory")
#define VM_WAIT() asm volatile("s_waitcnt vmcnt(0)" ::: "memory")

DI unsigned pk4_fp8(float a, float b, float c_, float d) {
    a = __builtin_amdgcn_fmed3f(a, -448.f, 448.f); b = __builtin_amdgcn_fmed3f(b, -448.f, 448.f); c_ = __builtin_amdgcn_fmed3f(c_, -448.f, 448.f); d = __builtin_amdgcn_fmed3f(d, -448.f, 448.f);
    int w = __builtin_amdgcn_cvt_pk_fp8_f32(a, b, 0, false); w = __builtin_amdgcn_cvt_pk_fp8_f32(c_, d, w, true); return (unsigned)w;
}

template <class ColFn>
DI void conv_item(const float* W, int ldw, int k0, bf16* WT, int ldt, int dr0, int dk0, ColFn srccol, LAS float* scr, int lane) {
    const int n4 = (lane & 7) * 4; const int sc = srccol(dr0 + n4);
#pragma unroll
    for (int i = 0; i < 8; ++i) { const int kk = 8 * i + (lane >> 3);
        const f32x4 v = sc >= 0 ? *(const f32x4*)(W + (size_t)(k0 + kk) * ldw + sc) : (f32x4){0.f, 0.f, 0.f, 0.f};
        LAS float* s = scr + kk * 33 + n4; s[0] = v.x; s[1] = v.y; s[2] = v.z; s[3] = v.w; }
    LDS_WAIT(); asm volatile("" ::: "memory");
    const int c = lane & 7;
#pragma unroll
    for (int j = 0; j < 4; ++j) { const int n = (lane >> 3) + 8 * j; const LAS float* s = scr + (8 * c) * 33 + n;
        u32x4 o; o.x = pk2(s[0 * 33], s[1 * 33]); o.y = pk2(s[2 * 33], s[3 * 33]); o.z = pk2(s[4 * 33], s[5 * 33]); o.w = pk2(s[6 * 33], s[7 * 33]);
        *(u32x4*)(WT + (size_t)(dr0 + n) * ldt + dk0 + k0 + 8 * c) = o; }
    LDS_WAIT(); asm volatile("" ::: "memory");
}
template <class ColFn>
DI void conv_item8(const float* W, int ldw, int k0, unsigned char* WT, int ldt, int dr0, float scale, ColFn srccol, LAS float* scr, int lane) {
    const int n4 = (lane & 7) * 4; const int sc = srccol(dr0 + n4);
#pragma unroll
    for (int i = 0; i < 8; ++i) { const int kk = 8 * i + (lane >> 3);
        const f32x4 v = sc >= 0 ? *(const f32x4*)(W + (size_t)(k0 + kk) * ldw + sc) : (f32x4){0.f, 0.f, 0.f, 0.f};
        LAS float* s = scr + kk * 33 + n4; s[0] = v.x; s[1] = v.y; s[2] = v.z; s[3] = v.w; }
    LDS_WAIT(); asm volatile("" ::: "memory");
    const int c = lane & 7;
#pragma unroll
    for (int j = 0; j < 4; ++j) { const int n = (lane >> 3) + 8 * j; const LAS float* s = scr + (8 * c) * 33 + n;
        u32x2 o; o.x = pk4_fp8(s[0 * 33] * scale, s[1 * 33] * scale, s[2 * 33] * scale, s[3 * 33] * scale); o.y = pk4_fp8(s[4 * 33] * scale, s[5 * 33] * scale, s[6 * 33] * scale, s[7 * 33] * scale);
        *(u32x2*)(WT + (size_t)(dr0 + n) * ldt + k0 + 8 * c) = o; }
    LDS_WAIT(); asm volatile("" ::: "memory");
}
template <class ColFn>
DI bool conv_job8(int& it, const float* W, int ldw, int K, int nb, unsigned char* WT, int ldt, float scale, ColFn f, LAS float* scr, int lane) {
    const int n_items = (K / 64) * nb;
    if (it >= n_items) { it -= n_items; return false; }
    const int kb = it / nb, b = it % nb;
    conv_item8(W, ldw, 64 * kb, WT, ldt, 32 * b, scale, f, scr, lane);
    return true;
}
struct ColIdent { int c0; DI int operator()(int r) const { return c0 + r; } };
struct ColFfn { DI int operator()(int r) const { const int tile = r >> 8, j = r & 255; return j < 128 ? tile * 128 + j : FF + tile * 128 + (j - 128); } };
struct ColInproj { DI int operator()(int r) const { return r < 3072 ? r : (r < 5192 ? r + 16 : (r < 5208 ? 3072 + (r - 5192) : -1)); } };
template <class ColFn>
DI bool conv_job(int& it, const float* W, int ldw, int K, int nb, bf16* WT, int ldt, ColFn f, LAS float* scr, int lane) {
    const int n_items = (K / 64) * nb;
    if (it >= n_items) { it -= n_items; return false; }
    const int kb = it / nb, b = it % nb;
    conv_item(W, ldw, 64 * kb, WT, ldt, 32 * b, 0, f, scr, lane);
    return true;
}
template <int NR, bool O8 = false  >
DI void rms_rows_bf16(const float* xrow, const float* g, bf16* orow, int lane, size_t rstride) {
    f32x4 v[NR][4]; float s[NR];
#pragma unroll
    for (int q = 0; q < NR; ++q) { const f32x4* xr = (const f32x4*)(xrow + q * rstride) + lane; float a = 0.f;
#pragma unroll
        for (int j = 0; j < 4; ++j) { v[q][j] = xr[64 * j]; a += (v[q][j].x * v[q][j].x + v[q][j].y * v[q][j].y) + (v[q][j].z * v[q][j].z + v[q][j].w * v[q][j].w); }
        s[q] = a; }
    const f32x4* gr = (const f32x4*)g + lane; f32x4 gg[4];
#pragma unroll
    for (int j = 0; j < 4; ++j) gg[j] = gr[64 * j];
#pragma unroll
    for (int o = 1; o < 64; o <<= 1)
#pragma unroll
        for (int q = 0; q < NR; ++q) s[q] += __shfl_xor(s[q], o);
#pragma unroll
    for (int q = 0; q < NR; ++q) { const float r = __builtin_amdgcn_rsqf(s[q] * (1.f / D) + EPS);
        if (O8) { const float r16 = r * 16.f; unsigned* o4 = (unsigned*)((unsigned char*)orow + q * rstride) + lane;
#pragma unroll
            for (int j = 0; j < 4; ++j) o4[64 * j] = pk4_fp8(v[q][j].x * r16 * gg[j].x, v[q][j].y * r16 * gg[j].y, v[q][j].z * r16 * gg[j].z, v[q][j].w * r16 * gg[j].w);
        } else { u32x2* o8 = (u32x2*)(orow + q * rstride) + lane;
#pragma unroll
        for (int j = 0; j < 4; ++j) { u32x2 w; w.x = pk2(v[q][j].x * r * gg[j].x, v[q][j].y * r * gg[j].y); w.y = pk2(v[q][j].z * r * gg[j].z, v[q][j].w * r * gg[j].w); o8[64 * j] = w; } } }
}
template <int NR, bool XN8, bool HIN16, bool HOUT16>
DI void resnorm_rows(const void* hin, const bf16* yrow, const float* gpost, float coef, void* hout, const float* gpre, void* xn, int lane, bool do_store, size_t rstride  ) {
    f32x4 y[NR][4], h[NR][4]; float s[NR], s2[NR];
#pragma unroll
    for (int q = 0; q < NR; ++q) { const u32x2* yr = (const u32x2*)(yrow + q * rstride) + lane;
#pragma unroll
        for (int j = 0; j < 4; ++j) { const u32x2 w = yr[64 * j]; y[q][j] = (f32x4){bflo(w.x), bfhi(w.x), bflo(w.y), bfhi(w.y)};
            if (HIN16) { const u32x2 hw = ((const u32x2*)((const bf16*)hin + q * rstride) + lane)[64 * j]; h[q][j] = (f32x4){bflo(hw.x), bfhi(hw.x), bflo(hw.y), bfhi(hw.y)}; }
            else h[q][j] = ((const f32x4*)((const float*)hin + q * rstride) + lane)[64 * j]; } }
    const f32x4* gp = (const f32x4*)gpost + lane; f32x4 g[4];
#pragma unroll
    for (int j = 0; j < 4; ++j) g[j] = gp[64 * j];
#pragma unroll
    for (int q = 0; q < NR; ++q) { float a = 0.f;
#pragma unroll
        for (int j = 0; j < 4; ++j) a += (y[q][j].x * y[q][j].x + y[q][j].y * y[q][j].y) + (y[q][j].z * y[q][j].z + y[q][j].w * y[q][j].w);
        s[q] = a; }
#pragma unroll
    for (int o = 1; o < 64; o <<= 1)
#pragma unroll
        for (int q = 0; q < NR; ++q) s[q] += __shfl_xor(s[q], o);
#pragma unroll
    for (int q = 0; q < NR; ++q) { const float r = __builtin_amdgcn_rsqf(s[q] * (1.f / D) + EPS) * coef; float a = 0.f;
#pragma unroll
        for (int j = 0; j < 4; ++j) { h[q][j] = h[q][j] + y[q][j] * r * g[j]; a += (h[q][j].x * h[q][j].x + h[q][j].y * h[q][j].y) + (h[q][j].z * h[q][j].z + h[q][j].w * h[q][j].w); }
        s2[q] = a;
        if (do_store) {
            if (HOUT16) { u32x2* ho = (u32x2*)((bf16*)hout + q * rstride) + lane;
#pragma unroll
                for (int j = 0; j < 4; ++j) { u32x2 w; w.x = pk2(h[q][j].x, h[q][j].y); w.y = pk2(h[q][j].z, h[q][j].w); ho[64 * j] = w; } }
            else { f32x4* ho = (f32x4*)((float*)hout + q * rstride) + lane;
#pragma unroll
                for (int j = 0; j < 4; ++j) ho[64 * j] = h[q][j]; } } }
    if (xn) {
        const f32x4* gq = (const f32x4*)gpre + lane;
#pragma unroll
        for (int j = 0; j < 4; ++j) g[j] = gq[64 * j];
#pragma unroll
        for (int o = 1; o < 64; o <<= 1)
#pragma unroll
            for (int q = 0; q < NR; ++q) s2[q] += __shfl_xor(s2[q], o);
#pragma unroll
        for (int q = 0; q < NR; ++q) { const float r2 = __builtin_amdgcn_rsqf(s2[q] * (1.f / D) + EPS);
            if (XN8) { const float r16 = r2 * 16.f; unsigned* o4 = (unsigned*)((unsigned char*)xn + q * rstride) + lane;
#pragma unroll
                for (int j = 0; j < 4; ++j) o4[64 * j] = pk4_fp8(h[q][j].x * r16 * g[j].x, h[q][j].y * r16 * g[j].y, h[q][j].z * r16 * g[j].z, h[q][j].w * r16 * g[j].w);
            } else { u32x2* o8 = (u32x2*)((bf16*)xn + q * rstride) + lane;
#pragma unroll
            for (int j = 0; j < 4; ++j) { u32x2 w; w.x = pk2(h[q][j].x * r2 * g[j].x, h[q][j].y * r2 * g[j].y); w.y = pk2(h[q][j].z * r2 * g[j].z, h[q][j].w * r2 * g[j].w); o8[64 * j] = w; } } }
    }
}
template <bool XN8, bool HIN16, bool HOUT16>
DI void resnorm_phase(Frame& F, const void* hin, const bf16* y, const float* gpost, float coef, void* hout, const float* gpre, void* xn, bool do_store = true) {
    const int gw = F.c * NWAVES + F.wave, NGW = F.G * NWAVES;
    const size_t hi_b = HIN16 ? 2 : 4, ho_b = HOUT16 ? 2 : 4, xn_b = XN8 ? 1 : 2;
    int m = gw;
    for (; m + NGW < M; m += 2 * NGW)
        resnorm_rows<2, XN8, HIN16, HOUT16>((const char*)hin + (size_t)m * D * hi_b, y + (size_t)m * D, gpost, coef, (char*)hout + (size_t)m * D * ho_b, gpre, xn ? (char*)xn + (size_t)m * D * xn_b : nullptr, F.lane, do_store, (size_t)NGW * D);
    for (; m < M; m += NGW)
        resnorm_rows<1, XN8, HIN16, HOUT16>((const char*)hin + (size_t)m * D * hi_b, y + (size_t)m * D, gpost, coef, (char*)hout + (size_t)m * D * ho_b, gpre, xn ? (char*)xn + (size_t)m * D * xn_b : nullptr, F.lane, do_store, 0);
}

using pg8::Unit;
typedef f32x4 Acc[2][2][4][2];
struct EpiStore {
    bf16* O; int ldo; float sc = 1.f;
    DI bool operator()(Acc& acc, const Unit& u, int wr, int wc, int fr, int fq) const {
        const int row0 = u.pm * 256 + wr * 64 + fr, col0 = u.pn * 256 + wc * 32 + 8 * fq;
#pragma unroll
        for (int ai = 0; ai < 2; ++ai)
#pragma unroll
            for (int m = 0; m < 4; ++m) { bf16* rowp = O + (size_t)(row0 + ai * 128 + m * 16) * ldo + col0;
#pragma unroll
                for (int bj = 0; bj < 2; ++bj) { const f32x4 v0 = acc[ai][bj][m][0] * sc, v1 = acc[ai][bj][m][1] * sc;
                    u32x4 w; w.x = pk2(v0[0], v0[1]); w.y = pk2(v0[2], v0[3]); w.z = pk2(v1[0], v1[1]); w.w = pk2(v1[2], v1[3]);
                    *(u32x4*)(rowp + bj * 128) = w; } }
        return false;
    }
};
struct EpiGates {
    bf16* SGA; bf16* SGB;
    DI bool operator()(Acc& acc, const Unit& u, int wr, int wc, int fr, int fq) const {
        bf16* O = u.pn < 4 ? SGA : SGB;
        const int row0 = u.pm * 256 + wr * 64 + fr, col0 = (u.pn & 3) * 256 + wc * 32 + 8 * fq;
#pragma unroll
        for (int ai = 0; ai < 2; ++ai)
#pragma unroll
            for (int m = 0; m < 4; ++m) { bf16* rowp = O + (size_t)(row0 + ai * 128 + m * 16) * 1024 + col0;
#pragma unroll
                for (int bj = 0; bj < 2; ++bj) { const f32x4 v0 = acc[ai][bj][m][0], v1 = acc[ai][bj][m][1];
                    u32x4 w; w.x = pk2(sigmoid_f(v0[0]), sigmoid_f(v0[1])); w.y = pk2(sigmoid_f(v0[2]), sigmoid_f(v0[3])); w.z = pk2(sigmoid_f(v1[0]), sigmoid_f(v1[1])); w.w = pk2(sigmoid_f(v1[2]), sigmoid_f(v1[3]));
                    *(u32x4*)(rowp + bj * 128) = w; } }
        return false;
    }
};
struct EpiSwiglu {
    bf16* H;
    DI bool operator()(Acc& acc, const Unit& u, int wr, int wc, int fr, int fq) const {
        const int row0 = u.pm * 256 + wr * 64 + fr, col0 = u.pn * 128 + wc * 32 + 8 * fq;
#pragma unroll
        for (int ai = 0; ai < 2; ++ai)
#pragma unroll
            for (int m = 0; m < 4; ++m) { bf16* rowp = H + (size_t)(row0 + ai * 128 + m * 16) * FF + col0;
                float o[8];
#pragma unroll
                for (int n = 0; n < 2; ++n)
#pragma unroll
                    for (int e = 0; e < 4; ++e) { const float a = acc[ai][0][m][n][e], b = acc[ai][1][m][n][e]; o[4 * n + e] = a * sigmoid_f(a) * b; }
                u32x4 w; w.x = pk2(o[0], o[1]); w.y = pk2(o[2], o[3]); w.z = pk2(o[4], o[5]); w.w = pk2(o[6], o[7]);
                *(u32x4*)rowp = w; }
        return false;
    }
};
struct EpiSwiglu8 {
    unsigned char* H;
    DI bool operator()(Acc& acc, const Unit& u, int wr, int wc, int fr, int fq) const {
        const int row0 = u.pm * 256 + wr * 64 + fr, col0 = u.pn * 128 + wc * 32 + 8 * fq;
        const float si = 1.f / 1024.f;
#pragma unroll
        for (int ai = 0; ai < 2; ++ai)
#pragma unroll
            for (int m = 0; m < 4; ++m) { unsigned char* rowp = H + (size_t)(row0 + ai * 128 + m * 16) * FF + col0;
                float o[8];
#pragma unroll
                for (int n = 0; n < 2; ++n)
#pragma unroll
                    for (int e = 0; e < 4; ++e) { const float a = acc[ai][0][m][n][e] * si, b = acc[ai][1][m][n][e] * si; o[4 * n + e] = a * sigmoid_f(a) * b * 8.f; }
                u32x2 w; w.x = pk4_fp8(o[0], o[1], o[2], o[3]); w.y = pk4_fp8(o[4], o[5], o[6], o[7]);
                *(u32x2*)rowp = w; }
        return false;
    }
};
struct EpiInproj {
    unsigned char* ws;
    DI bool operator()(Acc& acc, const Unit& u, int wr, int wc, int fr, int fq) const {
        bf16* O; int ldo, ct; bool half_only = false; float sc = 1.f;
        if (u.g == 1) { O = (bf16*)(ws + WS_KVM); ldo = 1024; ct = u.pn; }
        else if (u.pn < 4) { O = (bf16*)(ws + WS_QKG); ldo = 1024; ct = u.pn; }
        else if (u.pn < 8) { O = (bf16*)(ws + WS_GV); ldo = 1024; ct = u.pn - 4; }
        else if (u.pn < 12) { O = (bf16*)(ws + WS_GR); ldo = 1024; ct = u.pn - 8; }
        else if (u.pn < 18) { O = (bf16*)(ws + WS_DQKV); ldo = 1536; ct = u.pn - 12; if (u.pn < 14) sc = 0.125f * LOG2E; }
        else if (u.pn < 20) { O = (bf16*)(ws + WS_IQ); ldo = 512; ct = u.pn - 18; }
        else { O = (bf16*)(ws + WS_SM); ldo = 128; ct = 0; half_only = true; }
        const int row0 = u.pm * 256 + wr * 64 + fr, col0 = ct * 256 + wc * 32 + 8 * fq;
#pragma unroll
        for (int ai = 0; ai < 2; ++ai)
#pragma unroll
            for (int m = 0; m < 4; ++m) { bf16* rowp = O + (size_t)(row0 + ai * 128 + m * 16) * ldo + col0;
#pragma unroll
                for (int bj = 0; bj < 2; ++bj) { const f32x4 v0 = acc[ai][bj][m][0] * sc, v1 = acc[ai][bj][m][1] * sc;
                    u32x4 w; w.x = pk2(v0[0], v0[1]); w.y = pk2(v0[2], v0[3]); w.z = pk2(v1[0], v1[1]); w.w = pk2(v1[2], v1[3]);
                    if (bj == 0 || !half_only) *(u32x4*)(rowp + bj * 128) = w; } }
        return false;
    }
};
struct EpiMerge {
    const bf16* SGA; const bf16* SGB; bf16* O;
    DI bool operator()(Acc& acc, const Unit& u, int wr, int wc, int fr, int fq) const {
        const int row0 = u.pm * 256 + wr * 64 + fr, col0 = u.pn * 256 + wc * 32 + 8 * fq;
#pragma unroll
        for (int ai = 0; ai < 2; ++ai)
#pragma unroll
            for (int m = 0; m < 4; ++m) { const size_t off = (size_t)(row0 + ai * 128 + m * 16) * 1024 + col0;
#pragma unroll
                for (int bj = 0; bj < 2; ++bj) {
                    const u32x4 gb = *(const u32x4*)(SGB + off + bj * 128);
                    const float b[8] = {bflo(gb.x), bfhi(gb.x), bflo(gb.y), bfhi(gb.y), bflo(gb.z), bfhi(gb.z), bflo(gb.w), bfhi(gb.w)};
                    if (u.g == 0) {
                        const u32x4 ga = *(const u32x4*)(SGA + off + bj * 128);
                        const float a[8] = {bflo(ga.x), bfhi(ga.x), bflo(ga.y), bfhi(ga.y), bflo(ga.z), bfhi(ga.z), bflo(ga.w), bfhi(ga.w)};
#pragma unroll
                        for (int n = 0; n < 2; ++n)
#pragma unroll
                            for (int e = 0; e < 4; ++e) acc[ai][bj][m][n][e] *= a[4 * n + e] * fast_rcp(fmaxf(b[4 * n + e], 1e-30f));
                    } else {
                        const f32x4 v0 = acc[ai][bj][m][0], v1 = acc[ai][bj][m][1];
                        u32x4 w; w.x = pk2(v0[0] * b[0], v0[1] * b[1]); w.y = pk2(v0[2] * b[2], v0[3] * b[3]); w.z = pk2(v1[0] * b[4], v1[1] * b[5]); w.w = pk2(v1[2] * b[6], v1[3] * b[7]);
                        *(u32x4*)(O + off + bj * 128) = w;
                    } } }
        return u.g == 0;
    }
};

constexpr int GP = 272;
constexpr int LAP = 528;
template <bool GC_MODE>
DI void gla_prep(Frame& F, const float* const* in, int h, size_t row0, unsigned R0, unsigned R1, LAS float* bend, float* dec_out) {
    const int l = F.lane, w = F.wave, hh = l >> 5, c31 = l & 31;
    const bf16* SM = (const bf16*)(F.ws + WS_SM); const bf16* QKG = (const bf16*)(F.ws + WS_QKG);
    const float* wup = in[9]; const float* bal = in[10];
    const unsigned LA = R1;
    {
        const bf16x8 ga = *(const bf16x8*)(SM + (row0 + 32 * w + c31) * 128 + 72 + 8 * hh);
        f32x16 zero;
#pragma unroll
        for (int r = 0; r < 16; ++r) zero[r] = 0.f;
#pragma unroll
        for (int dt = 0; dt < 4; ++dt) { const int d = 32 * dt + c31;
            float wf[8];
#pragma unroll
            for (int j = 0; j < 8; ++j) wf[j] = wup[(8 * hh + j) * 512 + h * 128 + d];
            const f32x16 C = MFMA32(ga, pack8(wf[0], wf[1], wf[2], wf[3], wf[4], wf[5], wf[6], wf[7]), zero);
            const float bias = bal[h * 128 + d];
#pragma unroll
            for (int g = 0; g < 4; ++g) { float la[4];
#pragma unroll
                for (int i = 0; i < 4; ++i) { const float x = C[4 * g + i] + bias; la[i] = (fminf(x, 0.f) - __logf(1.f + fast_exp(-fabsf(x)))) * 0.0625f; }
                u32x2 o; o.x = pk2(la[0], la[1]); o.y = pk2(la[2], la[3]);
                *(LAS u32x2*)(LA + d * LAP + (32 * w + 8 * g + 4 * hh) * 2) = o; }
        }
    }
    __syncthreads();
    f32x16 Bc[4];
    {
#pragma unroll
        for (int dt = 0; dt < 4; ++dt)
#pragma unroll
            for (int r = 0; r < 16; ++r) Bc[dt][r] = 0.f;
        const unsigned la_lane = LA + c31 * LAP + 16 * hh;
        const bf16x8 ones = __builtin_bit_cast(bf16x8, (u32x4){0x3F803F80u, 0x3F803F80u, 0x3F803F80u, 0x3F803F80u});
        for (int s = 0; s < 2 * w; ++s) {
#pragma unroll
            for (int dt = 0; dt < 4; ++dt) Bc[dt] = MFMA32(lds_b128(la_lane + 32 * dt * LAP + 32 * s), ones, Bc[dt]);
        }
#pragma unroll
        for (int s2 = 0; s2 < 2; ++s2) {
            unsigned short v[8];
#pragma unroll
            for (int j = 0; j < 8; ++j) v[j] = (16 * s2 + 8 * hh + j <= c31) ? (unsigned short)0x3F80 : (unsigned short)0;
            u32x4 p; p.x = v[0] | ((unsigned)v[1] << 16); p.y = v[2] | ((unsigned)v[3] << 16); p.z = v[4] | ((unsigned)v[5] << 16); p.w = v[6] | ((unsigned)v[7] << 16);
            const bf16x8 tri = __builtin_bit_cast(bf16x8, p);
#pragma unroll
            for (int dt = 0; dt < 4; ++dt) Bc[dt] = MFMA32(lds_b128(la_lane + 32 * dt * LAP + 32 * (2 * w + s2)), tri, Bc[dt]);
        }
        if (w == 7 && c31 == 31) {
#pragma unroll
            for (int dt = 0; dt < 4; ++dt)
#pragma unroll
                for (int r = 0; r < 16; ++r) bend[32 * dt + crow(r, hh)] = Bc[dt][r];
        }
    }
    __syncthreads();
    {
        const size_t row = row0 + 32 * w + c31;
        const float qs = 0.08838834764831845f;
#pragma unroll
        for (int dt = 0; dt < 4; ++dt)
#pragma unroll
            for (int g = 0; g < 4; ++g) { const int d0 = 32 * dt + 8 * g + 4 * hh;
                const u32x2 kk = *(const u32x2*)(QKG + row * 1024 + 512 + h * 128 + d0);
                const float k0 = bflo(kk.x), k1 = bfhi(kk.x), k2 = bflo(kk.y), k3 = bfhi(kk.y);
                const float b0 = Bc[dt][4 * g], b1 = Bc[dt][4 * g + 1], b2 = Bc[dt][4 * g + 2], b3 = Bc[dt][4 * g + 3];
                if (GC_MODE) {
                    const u32x2 qq = *(const u32x2*)(QKG + row * 1024 + h * 128 + d0);
                    u32x2 o; o.x = pk2(bflo(qq.x) * qs * fast_exp(b0), bfhi(qq.x) * qs * fast_exp(b1)); o.y = pk2(bflo(qq.y) * qs * fast_exp(b2), bfhi(qq.y) * qs * fast_exp(b3));
                    *(LAS u32x2*)(R0 + (32 * w + c31) * GP + d0 * 2) = o;
                    u32x2 p; p.x = pk2(k0 * fast_exp(-b0), k1 * fast_exp(-b1)); p.y = pk2(k2 * fast_exp(-b2), k3 * fast_exp(-b3));
                    *(LAS u32x2*)(R1 + (32 * w + c31) * GP + d0 * 2) = p;
                } else {
                    const f32x4 be = *(const LAS f32x4*)(bend + d0);
                    u32x2 p; p.x = pk2(k0 * fast_exp(be.x - b0), k1 * fast_exp(be.y - b1)); p.y = pk2(k2 * fast_exp(be.z - b2), k3 * fast_exp(be.w - b3));
                    *(LAS u32x2*)(R0 + (32 * w + c31) * GP + d0 * 2) = p;
                } }
        if (!GC_MODE && w == 0) { dec_out[l] = fast_exp(bend[l]); dec_out[64 + l] = fast_exp(bend[64 + l]); }
    }
}
DI unsigned tr_lane(int pitch, int hmul, int lane) { const int i16 = lane & 15, q = i16 >> 2, p = i16 & 3, blk = (lane >> 4) & 1; return (unsigned)((hmul * (lane >> 5) + q) * pitch + (16 * blk + 4 * p) * 2); }
DI bf16x8 tr_frag(unsigned base_lane, int pitch, int row_lo, int row_hi, int n0) {
    return cat4(vtr(base_lane + (unsigned)(row_lo * pitch + n0 * 2)), vtr(base_lane + (unsigned)(row_hi * pitch + n0 * 2)));
}
DI void gla_load_v_half(Frame& F, unsigned vh, size_t row0, int h, int half) {
    const bf16* GV = (const bf16*)(F.ws + WS_GV);
#pragma unroll
    for (int it = 0; it < 8; ++it) { const int idx = it * NT + F.tid, row = idx >> 4, ch = idx & 15;
        const u32x4 v = *(const u32x4*)(GV + (row0 + row) * 1024 + h * 256 + half * 128 + ch * 8);
        *(LAS u32x4*)(vh + row * GP + ch * 16) = v; }
}
DI void gla_state_unit(Frame& F, const float* const* in, int u) {
    const int l = F.lane, w = F.wave, hh = l >> 5;
    const int bh = u >> 5, b = bh >> 2, h = bh & 3, sc = u & 31; const size_t row0 = (size_t)b * T + sc * 256;
    const unsigned KH = (unsigned)(size_t)F.lds, VH = KH + 256 * GP; LAS float* tot = (LAS float*)(F.lds + 2 * 256 * GP);
    const bf16* QKG = (const bf16*)(F.ws + WS_QKG);
    float* GST = (float*)(F.ws + WS_GST); float* DEC = (float*)(F.ws + WS_DEC);
    gla_prep<false>(F, in, h, row0, KH, VH, tot, DEC + (size_t)u * 128);
    const int etile = w >> 1, dt0 = 2 * (w & 1);
    const unsigned vhl = VH + tr_lane(GP, 8, l) + etile * 64, khl = KH + tr_lane(GP, 8, l) + dt0 * 64;
    for (int half = 0; half < 2; ++half) {
        gla_load_v_half(F, VH, row0, h, half);
        __syncthreads();
        f32x16 acc0, acc1;
#pragma unroll
        for (int r = 0; r < 16; ++r) { acc0[r] = 0.f; acc1[r] = 0.f; }
#pragma unroll 4
        for (int s = 0; s < 16; ++s) {
            const bf16x8 a = tr_frag(vhl, GP, 16 * s, 16 * s + 4, 0);
            const bf16x8 b0 = tr_frag(khl, GP, 16 * s, 16 * s + 4, 0), b1 = tr_frag(khl, GP, 16 * s, 16 * s + 4, 32);
            acc0 = MFMA32(a, b0, acc0); acc1 = MFMA32(a, b1, acc1);
        }
#pragma unroll
        for (int r = 0; r < 16; ++r) { const int e = half * 128 + etile * 32 + crow(r, hh); float* o = GST + ((size_t)u * 256 + e) * 128 + dt0 * 32 + (l & 31); o[0] = acc0[r]; o[32] = acc1[r]; }
        __syncthreads();
    }
}
DI void gla_scan_phase(Frame& F, bool do_store = true) {
    float* GST = (float*)(F.ws + WS_GST); const float* DEC = (const float*)(F.ws + WS_DEC);
    for (int idx = F.c * NT + F.tid; idx < 8 * 16384; idx += F.G * NT) {
        const int bh = idx >> 14, rem = idx & 16383, e = rem >> 6, d = (rem & 63) * 2;
        f32x2 st = {0.f, 0.f};
#pragma unroll 4
        for (int sc = 0; sc < 32; ++sc) { const int u = bh * 32 + sc; f32x2* p = (f32x2*)(GST + ((size_t)u * 256 + e) * 128 + d);
            const f32x2 uu = *p; const f32x2 dc = *(const f32x2*)(DEC + u * 128 + d); if (do_store) *p = st; st = dc * st + uu; }
        if (!do_store && st.x == 1.2345e-30f) GST[0] = st.y;
    }
}
DI void gla_out_unit(Frame& F, const float* const* in, int u, bool do_store = true) {
    const int l = F.lane, w = F.wave, hh = l >> 5;
    const int bh = u >> 5, b = bh >> 2, h = bh & 3, sc = u & 31; const size_t row0 = (size_t)b * T + sc * 256;
    const unsigned QS = (unsigned)(size_t)F.lds, KS = QS + 256 * GP; LAS float* tot = (LAS float*)(F.lds + 2 * 256 * GP);
    const bf16* QKG = (const bf16*)(F.ws + WS_QKG); const float* GST = (const float*)(F.ws + WS_GST); bf16* GR = (bf16*)(F.ws + WS_GR);
    gla_prep<true>(F, in, h, row0, QS, KS, tot, nullptr);
    __syncthreads();
    bf16x8 qf[8];
#pragma unroll
    for (int s = 0; s < 8; ++s) qf[s] = lds_b128(QS + (32 * w + (l & 31)) * GP + (16 * s + 8 * hh) * 2);
    __syncthreads();
    f32x16 acc[8];
#pragma unroll
    for (int et = 0; et < 8; ++et)
#pragma unroll
        for (int r = 0; r < 16; ++r) acc[et][r] = 0.f;
    const unsigned VH = QS;
#pragma unroll
    for (int half = 0; half < 2; ++half) {
        gla_load_v_half(F, VH, row0, h, half);
        __syncthreads();
        for (int j = 0; j <= w; ++j) {
            f32x16 X;
#pragma unroll
            for (int r = 0; r < 16; ++r) X[r] = 0.f;
            const unsigned ksj = KS + (l & 31) * GP + 16 * hh + 32 * j * GP, vhj = VH + tr_lane(GP, 4, l) + 32 * j * GP;
#pragma unroll
            for (int s = 0; s < 8; ++s) X = MFMA32(lds_b128(ksj + 32 * s), qf[s], X);
            if (j == w) {
#pragma unroll
                for (int r = 0; r < 16; ++r) if (crow(r, hh) > (l & 31)) X[r] = 0.f;
            }
            const bf16x8 xb0 = pack_step(X, 0), xb1 = pack_step(X, 1);
#pragma unroll
            for (int et = 0; et < 4; ++et) {
                const bf16x8 a0 = tr_frag(vhj, GP, 0, 8, et * 32), a1 = tr_frag(vhj, GP, 16, 24, et * 32);
                acc[half * 4 + et] = MFMA32(a0, xb0, acc[half * 4 + et]); acc[half * 4 + et] = MFMA32(a1, xb1, acc[half * 4 + et]);
            }
        }
        __syncthreads();
    }
    {
        const float* sg = GST + (size_t)u * 32768;
        int tv = F.tid; asm volatile("" : "+v"(tv));
        const float* sgl = sg + tv * 4; const unsigned dl = QS + (tv >> 5) * GP + (tv & 31) * 8;
#pragma unroll
        for (int i = 0; i < 16; i += 2) {
            const f32x4 v0 = *(const f32x4*)(sgl + i * 2048), v1 = *(const f32x4*)(sgl + (i + 1) * 2048);
            u32x2 o0, o1; o0.x = pk2(v0.x, v0.y); o0.y = pk2(v0.z, v0.w); o1.x = pk2(v1.x, v1.y); o1.y = pk2(v1.z, v1.w);
            *(LAS u32x2*)(dl + 16 * i * GP) = o0; *(LAS u32x2*)(dl + 16 * (i + 1) * GP) = o1;
        }
        __syncthreads();
        const unsigned sl = QS + (l & 31) * GP + 16 * hh;
#pragma unroll
        for (int et = 0; et < 8; ++et)
#pragma unroll
            for (int s = 0; s < 8; ++s) { acc[et] = MFMA32(lds_b128(sl + 32 * et * GP + 32 * s), qf[s], acc[et]); if ((s & 3) == 3) asm volatile("" ::: "memory"); }
    }
    float ss = 0.f;
#pragma unroll
    for (int et = 0; et < 8; ++et)
#pragma unroll
        for (int r = 0; r < 16; ++r) ss += acc[et][r] * acc[et][r];
    ss += __shfl_xor(ss, 32);
    const float rinv = __builtin_amdgcn_rsqf(ss * (1.f / 256.f) + EPS);
    const float* gn = in[11] + h * 256 + 4 * hh;
    bf16* orow = GR + (row0 + 32 * w + (l & 31)) * 1024 + h * 256 + 4 * hh;
#pragma unroll
    for (int et = 0; et < 8; ++et)
#pragma unroll
        for (int g = 0; g < 4; ++g) { const int e = et * 32 + 8 * g;
            const u32x2 gw = *(const u32x2*)(orow + e); const f32x4 gg = *(const f32x4*)(gn + e);
            const float r0 = bflo(gw.x), r1 = bfhi(gw.x), r2 = bflo(gw.y), r3 = bfhi(gw.y);
            u32x2 o; o.x = pk2(acc[et][4 * g] * rinv * gg.x * r0 * sigmoid_f(r0), acc[et][4 * g + 1] * rinv * gg.y * r1 * sigmoid_f(r1));
            o.y = pk2(acc[et][4 * g + 2] * rinv * gg.z * r2 * sigmoid_f(r2), acc[et][4 * g + 3] * rinv * gg.w * r3 * sigmoid_f(r3));
            if (do_store) *(u32x2*)(orow + e) = o; if (g == 3) __builtin_amdgcn_sched_barrier(0); }
}

DI void hist_find4(const u32x4 c, int lane, unsigned k, unsigned& bin, unsigned& above) {
    const unsigned s = c.x + c.y + c.z + c.w; unsigned suf = s;
#pragma unroll
    for (int o = 1; o < 64; o <<= 1) { const unsigned v = __shfl_down(suf, o); if (lane + o < 64) suf += v; }
    const unsigned excl = suf - s;
    const bool cross = excl < k && suf >= k;
    unsigned a = excl, bn = 0, ab = 0;
    if (a + c.w >= k) { bn = 4 * lane + 3; ab = a; } else { a += c.w;
        if (a + c.z >= k) { bn = 4 * lane + 2; ab = a; } else { a += c.z;
            if (a + c.y >= k) { bn = 4 * lane + 1; ab = a; } else { a += c.y; bn = 4 * lane; ab = a; } } }
    const unsigned long long m = __ballot(cross);
    const int src = m ? __builtin_ctzll(m) : 0;
    bin = __shfl(bn, src); above = __shfl(ab, src);
}
constexpr int IDX_H1 = 131072, IDX_H2 = IDX_H1 + 16384;
DI void idx_unit(Frame& F, int u, bool do_store = true, int mode = 0  ) {
    const int l = F.lane, w = F.wave, hh = l >> 5;
    const int b = u >> 10, t0 = (u & 1023) * 8; const size_t row0 = (size_t)b * T + t0;
    const bf16* IQ = (const bf16*)(F.ws + WS_IQ); const bf16* SM = (const bf16*)(F.ws + WS_SM);
    const unsigned SC = (unsigned)(size_t)F.lds; LAS unsigned* H1 = (LAS unsigned*)(F.lds + IDX_H1); LAS unsigned* H2 = (LAS unsigned*)(F.lds + IDX_H2);
    bf16x8 af[2][4]; float wv[2][16];
    {
        const int rho = l & 31;
#pragma unroll
        for (int tl = 0; tl < 2; ++tl) { const int q = 4 * tl + (rho >> 4) + 2 * ((rho >> 2) & 1), head = (rho & 3) + 4 * ((rho >> 3) & 1);
#pragma unroll
            for (int s = 0; s < 4; ++s) af[tl][s] = *(const bf16x8*)(IQ + (row0 + q) * 512 + head * 64 + 16 * s + 8 * hh);
#pragma unroll
            for (int r = 0; r < 16; ++r) { const int qq = 4 * tl + (r >> 3) + 2 * hh, hd = (r & 3) + 4 * ((r >> 2) & 1); wv[tl][r] = bf2f(SM[(row0 + qq) * 128 + 64 + hd]); } }
    }
#pragma unroll
    for (int i = 0; i < 8; ++i) H1[F.tid + i * NT] = 0u;
    __syncthreads();
    const int ntile = t0 / 32 + 1;
    const bf16* kbase = SM + ((size_t)b * T + (l & 31)) * 128 + 8 * hh;
    const unsigned hrep = (unsigned)(l & 3);
#define IDX_TILE(BF, kt_, EDGE) do { const int key = 32 * (kt_) + (l & 31); \
        f32x16 C0, C1; _Pragma("unroll") for (int r = 0; r < 16; ++r) { C0[r] = 0.f; C1[r] = 0.f; } \
        _Pragma("unroll") for (int s = 0; s < 4; ++s) { C0 = MFMA32(af[0][s], BF[s], C0); C1 = MFMA32(af[1][s], BF[s], C1); } \
        asm volatile("s_nop 15\n\ts_nop 7" : "+v"(C0), "+v"(C1));     \
        _Pragma("unroll") for (int tl = 0; tl < 2; ++tl) _Pragma("unroll") for (int b4 = 0; b4 < 2; ++b4) { \
            float sc = 0.f; \
            _Pragma("unroll") for (int r = 0; r < 8; ++r) { float m_; asm("v_max_f32_e32 %0, 0, %1" : "=v"(m_) : "v"(tl ? C1[8 * b4 + r] : C0[8 * b4 + r])); sc = fmaf(wv[tl][8 * b4 + r], m_, sc); } \
            const int q = 4 * tl + b4 + 2 * hh; \
            const _Float16 hf = (_Float16)sc; unsigned h16 = (unsigned)__builtin_bit_cast(unsigned short, hf); \
            unsigned k16 = (h16 & 0x8000u) ? (~h16 & 0xffffu) : (h16 | 0x8000u); \
            if (EDGE) { const bool valid = key <= t0 + q; if (!valid) k16 = 0u; \
                if (mode != 3) *(LAS unsigned short*)(SC + q * 16384 + key * 2) = (unsigned short)k16; \
                if (valid && mode != 3 && mode != 6) __hip_atomic_fetch_add(H1 + (q * 256 + (k16 >> 8)) * 2 + (hrep >> 1), 1u << (16 * (hrep & 1)), __ATOMIC_RELAXED, __HIP_MEMORY_SCOPE_WORKGROUP); } \
            else { if (mode != 3) *(LAS unsigned short*)(SC + q * 16384 + key * 2) = (unsigned short)k16; \
                if (mode != 3 && mode != 6) __hip_atomic_fetch_add(H1 + (q * 256 + (k16 >> 8)) * 2 + (hrep >> 1), 1u << (16 * (hrep & 1)), __ATOMIC_RELAXED, __HIP_MEMORY_SCOPE_WORKGROUP); } } } while (0)
#define IDX_LOAD(BF, kt_) do { _Pragma("unroll") for (int s = 0; s < 4; ++s) BF[s] = *(const bf16x8*)(kbase + (size_t)(32 * (kt_)) * 128 + 16 * s); } while (0)
    bf16x8 bA[4], bB[4];
    const int klast = ntile - 1;
    IDX_LOAD(bA, w < ntile ? w : klast);
    if (mode != 2)
    for (int kt = w; kt < ntile; kt += 16) {
        if (mode != 4) IDX_LOAD(bB, kt + 8 < ntile ? kt + 8 : klast);
        if (kt == klast) IDX_TILE(bA, kt, true); else IDX_TILE(bA, kt, false);
        if (mode != 4) IDX_LOAD(bA, kt + 16 < ntile ? kt + 16 : klast);
        if (kt + 8 < ntile) { if (kt + 8 == klast) IDX_TILE(bB, kt + 8, true); else IDX_TILE(bB, kt + 8, false); }
    }
#undef IDX_TILE
#undef IDX_LOAD
    __syncthreads();
    if (mode == 0 || mode == 2)
    {
        const int t = t0 + w, n = t + 1, nit = (n + 511) >> 9;
        unsigned char* mrow = (unsigned char*)(F.ws + WS_IQ) + (row0 + w) * 1024;
        const unsigned scq = SC + w * 16384 + l * 16;
        LAS unsigned* H = H2 + w * 256;
        unsigned thr = 0u, rneed = 0u;
        if (n > 256) {
            unsigned B, above, L, above2;
            {
                const u32x4 a = *(const LAS u32x4*)(H1 + (w * 256 + 4 * l) * 2), bq = *(const LAS u32x4*)(H1 + (w * 256 + 4 * l) * 2 + 4);
                u32x4 cnt; cnt.x = (a.x & 0xffffu) + (a.x >> 16) + (a.y & 0xffffu) + (a.y >> 16); cnt.y = (a.z & 0xffffu) + (a.z >> 16) + (a.w & 0xffffu) + (a.w >> 16);
                cnt.z = (bq.x & 0xffffu) + (bq.x >> 16) + (bq.y & 0xffffu) + (bq.y >> 16); cnt.w = (bq.z & 0xffffu) + (bq.z >> 16) + (bq.w & 0xffffu) + (bq.w >> 16);
                hist_find4(cnt, l, 256u, B, above);
            }
            H[l] = 0u; H[l + 64] = 0u; H[l + 128] = 0u; H[l + 192] = 0u; LDS_WAIT();
            for (int it = 0; it < nit; ++it) { const u32x4 kk = *(const LAS u32x4*)(scq + it * 1024); const int i0 = 512 * it + 8 * l;
                const unsigned ks[8] = {kk.x & 0xffffu, kk.x >> 16, kk.y & 0xffffu, kk.y >> 16, kk.z & 0xffffu, kk.z >> 16, kk.w & 0xffffu, kk.w >> 16};
                bool m[8], any = false;
#pragma unroll
                for (int j = 0; j < 8; ++j) { m[j] = (i0 + j < n) && (ks[j] >> 8) == B; any = any || m[j]; }
                if (__ballot(any) == 0ull) continue;
#pragma unroll
                for (int j = 0; j < 8; ++j) if (m[j]) __hip_atomic_fetch_add(H + (ks[j] & 255u), 1u, __ATOMIC_RELAXED, __HIP_MEMORY_SCOPE_WORKGROUP); }
            LDS_WAIT(); hist_find4(*(const LAS u32x4*)(H + 4 * l), l, 256u - above, L, above2);
            thr = (B << 8) | L; rneed = 256u - above - above2;
        }
        unsigned running = 0u;
        for (int it = 0; it < nit; ++it) {
            const u32x4 kk = *(const LAS u32x4*)(scq + it * 1024); const int i0 = 512 * it + 8 * l;
            const unsigned ks[8] = {kk.x & 0xffffu, kk.x >> 16, kk.y & 0xffffu, kk.y >> 16, kk.z & 0xffffu, kk.z >> 16, kk.w & 0xffffu, kk.w >> 16};
            unsigned byte = 0u;
            if (n <= 256) {
#pragma unroll
                for (int j = 0; j < 8; ++j) byte |= (i0 + j < n) ? (1u << j) : 0u;
            } else {
                bool eq[8]; bool anyeq = false;
#pragma unroll
                for (int j = 0; j < 8; ++j) { eq[j] = (i0 + j < n) && ks[j] == thr; anyeq = anyeq || eq[j]; byte |= ((i0 + j < n) && ks[j] > thr) ? (1u << j) : 0u; }
                const unsigned long long anym = __ballot(anyeq);
                if (anym != 0ull) {
                    unsigned mine = 0u;
#pragma unroll
                    for (int j = 0; j < 8; ++j) mine += eq[j] ? 1u : 0u;
                    unsigned before = 0u; unsigned long long mm = anym;
                    while (mm) { const int src = __builtin_ctzll(mm); mm &= mm - 1; const unsigned v = (unsigned)__shfl((int)mine, src); if (src < l) before += v; }
                    unsigned cum = running + before; unsigned tot = 0u; mm = anym;
                    while (mm) { const int src = __builtin_ctzll(mm); mm &= mm - 1; tot += (unsigned)__shfl((int)mine, src); }
#pragma unroll
                    for (int j = 0; j < 8; ++j) { if (eq[j]) { if (cum < rneed) byte |= (1u << j); ++cum; } }
                    running += tot;
                }
            }
            if (do_store) mrow[it * 64 + l] = (unsigned char)byte;
        }
    }
    __syncthreads();
}

template <int DH, bool DSA, int VAR = 0>
DI void attn_unit(Frame& F, const bf16* Qp, int ldq, const bf16* Kp, const bf16* Vp, int ldkv, int nst, bf16* Op, int ldo, float c1,
                  const unsigned* mask0  , int tq0, const LAS float* BT, float cfar, bool do_store = true) {
    constexpr int PK = DH * 2 + 16  , PV = DH == 64 ? 192 : 320  ;
    constexpr int SBK = 64 * PK, SBV = 64 * PV, NS = DH / 16, ND = DH / 32, CH = DH / 8  , NLD = 64 * CH / NT;
    const int l = F.lane, w = F.wave, hh = l >> 5, tid = F.tid;
    const unsigned KT = (unsigned)(size_t)F.lds, VT = KT + 2 * SBK;
    const unsigned klane = (unsigned)((l & 31) * PK + 16 * hh), vlane = tr_lane(PV, 4, l);
    bf16x8 qf[NS];
#pragma unroll
    for (int s = 0; s < NS; ++s) qf[s] = *(const bf16x8*)(Qp + (size_t)(32 * w + (l & 31)) * ldq + 16 * s + 8 * hh);
    f32x16 O[ND];
#pragma unroll
    for (int d = 0; d < ND; ++d)
#pragma unroll
        for (int r = 0; r < 16; ++r) O[d][r] = 0.f;
    float lsum = 0.f;
    const int tq = tq0 + 32 * w + (l & 31), tq_hi = tq0 + 32 * w + 31, tq_lo = tq0 + 32 * w;
    const unsigned* mrow = DSA ? mask0 + (size_t)(32 * w + (l & 31)) * 256 : nullptr;
    u32x4 kr[NLD], vr[NLD];
    u32x2 mcur = {0u, 0u}, mnxt = {0u, 0u};
    if (DSA) mcur = *(const u32x2*)mrow;
#pragma unroll
    for (int i = 0; i < NLD; ++i) { const int idx = i * NT + tid, row = idx / CH, ch = idx % CH;
        kr[i] = *(const u32x4*)(Kp + (size_t)row * ldkv + ch * 8); vr[i] = *(const u32x4*)(Vp + (size_t)row * ldkv + ch * 8); }
#pragma unroll
    for (int i = 0; i < NLD; ++i) { const int idx = i * NT + tid, row = idx / CH, ch = idx % CH;
        *(LAS u32x4*)(KT + row * PK + ch * 16) = kr[i]; *(LAS u32x4*)(VT + row * PV + ch * 16) = vr[i]; }
    __syncthreads();
    __builtin_amdgcn_s_waitcnt(0x0F70);
    for (int st = 0; st < nst; ++st) {
        const unsigned kt = KT + (st & 1) * SBK, vt = VT + (st & 1) * SBV;
        const bool more = st + 1 < nst;
        if (more) {
#pragma unroll
            for (int i = 0; i < NLD; ++i) { const int idx = i * NT + tid, row = 64 * (st + 1) + idx / CH, ch = idx % CH;
                kr[i] = *(const u32x4*)(Kp + (size_t)row * ldkv + ch * 8); vr[i] = *(const u32x4*)(Vp + (size_t)row * ldkv + ch * 8); }
            if (DSA) mnxt = *(const u32x2*)(mrow + 2 * (st + 1));
        }
#pragma unroll
        for (int kb = 0; kb < 2; ++kb) {
            const int key0 = 64 * st + 32 * kb;
            if (VAR == 3) continue;
            if (DSA && key0 > tq_hi) continue;
            f32x16 X;
#pragma unroll
            for (int r = 0; r < 16; ++r) X[r] = 0.f;
#pragma unroll
            for (int s = 0; s < NS; ++s) X = MFMA32(lds_b128(kt + klane + 32 * kb * PK + 32 * s), qf[s], X);
            if (VAR == 2) { lsum += X[0]; }
            else if (DSA) {
                const unsigned mw = (kb ? mcur.y : mcur.x) >> (4 * hh);
                if (tq_lo - (key0 + 31) >= 113) {
#pragma unroll
                    for (int r = 0; r < 16; ++r) { const float p = fast_exp2(fmaf(X[r], c1, cfar)); const int bits = __builtin_amdgcn_sbfe((int)mw, (r & 3) + 8 * (r >> 2), 1);
                        const float pm = __uint_as_float(__float_as_uint(p) & (unsigned)bits); lsum += pm; X[r] = pm; }
                } else {
#pragma unroll
                    for (int r = 0; r < 16; ++r) { int di = tq - (key0 + crow(r, hh)); di = di < 0 ? 0 : (di > 127 ? 127 : di);
                        const float p = fast_exp2(fmaf(X[r], c1, BT[di])); const int bits = __builtin_amdgcn_sbfe((int)mw, (r & 3) + 8 * (r >> 2), 1);
                        const float pm = __uint_as_float(__float_as_uint(p) & (unsigned)bits); lsum += pm; X[r] = pm; }
                }
            } else {
#pragma unroll
                for (int r = 0; r < 16; ++r) { const float p = fast_exp2(X[r] * c1); lsum += p; X[r] = p; }
            }
            const bf16x8 xb0 = pack_step(X, 0), xb1 = pack_step(X, 1);
            if (VAR == 1) { asm volatile("" :: "v"(xb0), "v"(xb1)); }
            else {
#pragma unroll
            for (int d = 0; d < ND; ++d) {
                const bf16x8 a0 = tr_frag(vt + vlane, PV, 32 * kb, 32 * kb + 8, 32 * d), a1 = tr_frag(vt + vlane, PV, 32 * kb + 16, 32 * kb + 24, 32 * d);
                O[d] = MFMA32(a0, xb0, O[d]); O[d] = MFMA32(a1, xb1, O[d]);
            } }
        }
        asm volatile("" ::: "memory"); __builtin_amdgcn_sched_barrier(0);
        if (more) {
            const unsigned kn = KT + ((st + 1) & 1) * SBK, vn = VT + ((st + 1) & 1) * SBV;
#pragma unroll
            for (int i = 0; i < NLD; ++i) { const int idx = i * NT + tid, row = idx / CH, ch = idx % CH;
                *(LAS u32x4*)(kn + row * PK + ch * 16) = kr[i]; *(LAS u32x4*)(vn + row * PV + ch * 16) = vr[i]; }
            mcur = mnxt;
        }
        __syncthreads();
    }
    lsum += __shfl_xor(lsum, 32);
    const float inv = fast_rcp(lsum);
    bf16* orow = Op + (size_t)(32 * w + (l & 31)) * ldo;
#pragma unroll
    for (int d = 0; d < ND; ++d)
#pragma unroll
        for (int g = 0; g < 4; ++g) { u32x2 o; o.x = pk2(O[d][4 * g] * inv, O[d][4 * g + 1] * inv); o.y = pk2(O[d][4 * g + 2] * inv, O[d][4 * g + 3] * inv);
            if (do_store) *(u32x2*)(orow + 32 * d + 8 * g + 4 * hh) = o; }
}
DI int t5_bucket(int rel) {
    if (rel < 16) return rel;
    const float v = logf((float)rel * (1.f / 16.f)) / 2.0794415416798357f * 16.f;
    int lg = 16 + (int)v; return lg > 31 ? 31 : lg;
}
constexpr int A_PK = 144, A_PV = 192, A_SK = 128 * A_PK, A_SV = 128 * A_PV, A_BT = 2 * A_SK + 2 * A_SV;
#define A_SMR(r, pos) { const float p_ = (VAR == 4) ? X[r] : fast_exp2(X[r]); int t_ = -1; if (VAR != 5) asm("v_bfe_i32 %0, %1, %2, 1" : "=v"(t_) : "v"(mw_), "i"(pos)); const float pm_ = (VAR == 5) ? p_ : __uint_as_float(__float_as_uint(p_) & (unsigned)t_); if (VAR != 6) lsum += pm_; X[r] = pm_; }
#define A_SM16() do { A_SMR(0, 0) A_SMR(1, 1) A_SMR(2, 2) A_SMR(3, 3) A_SMR(4, 8) A_SMR(5, 9) A_SMR(6, 10) A_SMR(7, 11) A_SMR(8, 16) A_SMR(9, 17) A_SMR(10, 18) A_SMR(11, 19) A_SMR(12, 24) A_SMR(13, 25) A_SMR(14, 26) A_SMR(15, 27) } while (0)
template <int VAR = 0>
DI void dsa_att_unit(Frame& F, const float* const* in, int bh, int qb, bool do_store = true) {
    const int b = bh >> 3, h = bh & 7, l = F.lane, w = F.wave, hh = l >> 5, tid = F.tid;
    LAS float* BT = (LAS float*)(F.lds + A_BT);
    const float* tab = in[14];
    __syncthreads();
    if (tid < 128) BT[tid] = tab[t5_bucket(tid) * 8 + h] * LOG2E;
    const float cfar = tab[31 * 8 + h] * LOG2E;
    bf16* DQ = (bf16*)(F.ws + WS_DQKV);
    const size_t rowq = (size_t)b * T + qb * 256, rowk = (size_t)b * T;
    const bf16* Kp = DQ + rowk * 1536 + 512 + h * 64; const bf16* Vp = DQ + rowk * 1536 + 1024 + h * 64;
    const unsigned KT = (unsigned)(size_t)F.lds, VT = KT + 2 * A_SK;
    const unsigned klane = (unsigned)((l & 31) * A_PK + 16 * hh), vlane = tr_lane(A_PV, 4, l);
    bf16x8 qf[4];
#pragma unroll
    for (int s = 0; s < 4; ++s) qf[s] = *(const bf16x8*)(DQ + (rowq + 32 * w + (l & 31)) * 1536 + h * 64 + 16 * s + 8 * hh);
    f32x16 O[2], cf16;
#pragma unroll
    for (int r = 0; r < 16; ++r) { O[0][r] = 0.f; O[1][r] = 0.f; cf16[r] = cfar; }
    float lsum = 0.f;
    const int tq = qb * 256 + 32 * w + (l & 31), tq_lo = qb * 256 + 32 * w, tq_hi = tq_lo + 31, nst = 2 * (qb + 1);
    const u32x4* mrow = (const u32x4*)((const unsigned*)(F.ws + WS_IQ) + (rowq + 32 * w + (l & 31)) * 256);
    u32x4 kr[2], vr[2], mcur = mrow[0], mnxt = mcur;
#pragma unroll
    for (int i = 0; i < 2; ++i) { const int idx = i * NT + tid, row = idx >> 3, ch = idx & 7;
        kr[i] = *(const u32x4*)(Kp + (size_t)row * 1536 + ch * 8); vr[i] = *(const u32x4*)(Vp + (size_t)row * 1536 + ch * 8); }
#pragma unroll
    for (int i = 0; i < 2; ++i) { const int idx = i * NT + tid, row = idx >> 3, ch = idx & 7;
        *(LAS u32x4*)(KT + row * A_PK + ch * 16) = kr[i]; *(LAS u32x4*)(VT + row * A_PV + ch * 16) = vr[i]; }
    __syncthreads();
#define A_QK(Xv, kb, CI) do { Xv = MFMA32(lds_b128(kt + klane + 32 * (kb) * A_PK), qf[0], CI); Xv = MFMA32(lds_b128(kt + klane + 32 * (kb) * A_PK + 32), qf[1], Xv); \
        Xv = MFMA32(lds_b128(kt + klane + 32 * (kb) * A_PK + 64), qf[2], Xv); Xv = MFMA32(lds_b128(kt + klane + 32 * (kb) * A_PK + 96), qf[3], Xv); } while (0)
#define A_PVM(Xv, kb) do { const bf16x8 xb0_ = pack_step(Xv, 0), xb1_ = pack_step(Xv, 1); _Pragma("unroll") for (int d = 0; d < 2; ++d) { \
        const bf16x8 a0_ = tr_frag(vt + vlane, A_PV, 32 * (kb), 32 * (kb) + 8, 32 * d), a1_ = tr_frag(vt + vlane, A_PV, 32 * (kb) + 16, 32 * (kb) + 24, 32 * d); \
        O[d] = MFMA32(a0_, xb0_, O[d]); O[d] = MFMA32(a1_, xb1_, O[d]); } } while (0)
    __builtin_amdgcn_s_waitcnt(0x0F70);
    for (int st = 0; st < nst; ++st) {
        const unsigned kt = KT + (st & 1) * A_SK, vt = VT + (st & 1) * A_SV;
        const bool more = st + 1 < nst;
        if (more) {
#pragma unroll
            for (int i = 0; i < 2; ++i) { const int idx = i * NT + tid, row = 128 * (st + 1) + (idx >> 3), ch = idx & 7;
                kr[i] = *(const u32x4*)(Kp + (size_t)row * 1536 + ch * 8); vr[i] = *(const u32x4*)(Vp + (size_t)row * 1536 + ch * 8); }
            mnxt = mrow[st + 1];
        }
        asm volatile("" ::: "memory"); __builtin_amdgcn_sched_barrier(0);
        if (VAR != 3) {
        if (tq_lo - (128 * st + 127) >= 113) {
            f32x16 X, Y;
            A_QK(X, 0, cf16); A_QK(Y, 1, cf16);
            { const unsigned mw_ = mcur.x >> (4 * hh); A_SM16(); } A_PVM(X, 0);
            A_QK(X, 2, cf16);
            { f32x16& Xr = Y; const unsigned mw_ = mcur.y >> (4 * hh);
#define X Xr
              A_SM16();
#undef X
            } A_PVM(Y, 1);
            A_QK(Y, 3, cf16);
            { const unsigned mw_ = mcur.z >> (4 * hh); A_SM16(); } A_PVM(X, 2);
            { f32x16& Xr = Y; const unsigned mw_ = mcur.w >> (4 * hh);
#define X Xr
              A_SM16();
#undef X
            } A_PVM(Y, 3);
        } else {
#pragma unroll
            for (int kb = 0; kb < 4; ++kb) {
                const int key0 = 128 * st + 32 * kb;
                if (key0 > tq_hi) continue;
                f32x16 X, zero;
#pragma unroll
                for (int r = 0; r < 16; ++r) zero[r] = 0.f;
                const unsigned mw_ = (kb == 0 ? mcur.x : kb == 1 ? mcur.y : kb == 2 ? mcur.z : mcur.w) >> (4 * hh);
                if (tq_lo - (key0 + 31) >= 113) { A_QK(X, kb, cf16); }
                else { A_QK(X, kb, zero);
#pragma unroll
                    for (int r = 0; r < 16; ++r) { int di = tq - (key0 + crow(r, hh)); di = di < 0 ? 0 : (di > 127 ? 127 : di); X[r] += BT[di]; } }
                A_SM16();
                A_PVM(X, kb);
            }
        }
        }
        asm volatile("" ::: "memory"); __builtin_amdgcn_sched_barrier(0);
        if (more) {
            const unsigned kn = KT + ((st + 1) & 1) * A_SK, vn = VT + ((st + 1) & 1) * A_SV;
#pragma unroll
            for (int i = 0; i < 2; ++i) { const int idx = i * NT + tid, row = idx >> 3, ch = idx & 7;
                *(LAS u32x4*)(kn + row * A_PK + ch * 16) = kr[i]; *(LAS u32x4*)(vn + row * A_PV + ch * 16) = vr[i]; }
            mcur = mnxt;
        }
        __syncthreads();
    }
#undef A_QK
#undef A_PVM
    lsum += __shfl_xor(lsum, 32);
    const float inv = fast_rcp(lsum);
    bf16* orow = DQ + (rowq + 32 * w + (l & 31)) * 1536 + h * 64;
#pragma unroll
    for (int d = 0; d < 2; ++d)
#pragma unroll
        for (int g = 0; g < 4; ++g) { u32x2 o; o.x = pk2(O[d][4 * g] * inv, O[d][4 * g + 1] * inv); o.y = pk2(O[d][4 * g + 2] * inv, O[d][4 * g + 3] * inv);
            if (do_store) *(u32x2*)(orow + 32 * d + 8 * g + 4 * hh) = o; }
}
DI void cross_att_unit(Frame& F, int u) {
    const int b = u >> 7, h = (u >> 5) & 3, qb = u & 31;
    const bf16* QC = (const bf16*)(F.ws + WS_QC); const bf16* KVM = (const bf16*)(F.ws + WS_KVM); bf16* OX = (bf16*)(F.ws + WS_OX);
    const size_t rowq = (size_t)b * T + qb * 256;
    __syncthreads();
    attn_unit<128, false>(F, QC + rowq * 512 + h * 128, 512, KVM + (size_t)b * MEML * 1024 + h * 128, KVM + (size_t)b * MEML * 1024 + 512 + h * 128, 1024, MEML / 64,
                          OX + rowq * 512 + h * 128, 512, 0.08838834764831845f * LOG2E, nullptr, 0, nullptr, 0.f);
}

constexpr int N_PHASES = 19;
#ifndef FFN1_FP8
#define FFN1_FP8 0
#endif
#ifndef MK_ONE_LAUNCH
#define MK_ONE_LAUNCH 1
#endif
__global__ void __launch_bounds__(NT, 2) mega_fwd(Args args) {
    extern __shared__ __attribute__((aligned(16))) unsigned char lds_raw[];
    Frame F;
    F.lds = (LAS unsigned char*)lds_raw; F.ws = args.ws;
    F.tid = threadIdx.x; F.lane = F.tid & 63; F.wave = __builtin_amdgcn_readfirstlane(F.tid >> 6);
    F.G = gridDim.x; F.c = blockIdx.x;
    volatile LAS unsigned* MISC = (volatile LAS unsigned*)(F.lds + MISC_OFF);
    if (F.tid < 64) MISC[F.tid] = 0u;
    __syncthreads();
    unsigned* ctl = (unsigned*)(args.ws + WS_CTL);
    const int lo = args.ph_lo, hi = args.ph_hi;
    XcdBarrier bar; bar.bar = ctl + CW_BAR; bar.x = 0; bar.st = MISC + 8;
    if (hi - lo > 1) bar = xcd_barrier_post(ctl + CW_BAR, MISC + 8);
    const float* const* in = args.in;
    const bool st_ok = args.nostore == 0; const int sub = args.sub;
    unsigned char* ws = args.ws;
    const int gw = F.c * NWAVES + F.wave, NGW = F.G * NWAVES;
#ifndef PHMASK
#define PHMASK 0x7ffff
#endif
#define IN(k) (((PHMASK >> (k)) & 1) && lo <= (k) && (k) < hi)
#define SEAM(k) do { if ((k) + 1 < hi) xcd_barrier(bar); } while (0)
#ifndef DUP_PHASE
#define DUP_PHASE -1
#endif
#ifndef DUP_N
#define DUP_N 1
#endif
#define REPS(k) ((k) == DUP_PHASE ? 1 + DUP_N : 1)
#define FORREP(k) _Pragma("unroll 1") for (int rep = 0; rep < REPS(k); ++rep)
#define ST(k) (st_ok)
#define REPBAR(k) do { if (rep + 1 < REPS(k)) xcd_barrier(bar); } while (0)
    bf16* XN = (bf16*)(ws + WS_XN); bf16* HID = (bf16*)(ws + WS_HID); bf16* Y = (bf16*)(ws + WS_Y);
    bf16* W1A = (bf16*)(ws + WS_W1A); bf16* W1B = (bf16*)(ws + WS_W1B);

    if (IN(0)) { FORREP(0) {
        LAS float* scr = (LAS float*)(F.lds + F.wave * 16384);
        constexpr int NITEMS = 10240;
        for (int it0 = gw; it0 < NITEMS; it0 += NGW) { int it = it0;
#if FFN1_FP8
            if (conv_job8(it, in[4], 2 * FF, D, 2 * FF / 32, (unsigned char*)W1A, D, 64.f, ColFfn{}, scr, F.lane)) continue;
            if (conv_job8(it, in[5], D, FF, D / 32, (unsigned char*)W1B, FF, 64.f, ColIdent{0}, scr, F.lane)) continue;
#else
            if (conv_job(it, in[4], 2 * FF, D, 2 * FF / 32, W1A, D, ColFfn{}, scr, F.lane)) continue;
            if (conv_job(it, in[5], D, FF, D / 32, W1B, FF, ColIdent{0}, scr, F.lane)) continue;
#endif
            if (conv_job(it, in[8], 7256, D, NIN / 32, (bf16*)(ws + WS_WIN), D, ColInproj{}, scr, F.lane)) continue;
            if (conv_job(it, in[8], 7256, D, 2048 / 32, (bf16*)(ws + WS_WGT), D, ColIdent{5208}, scr, F.lane)) continue;
            if (conv_job(it, in[12], D, D, D / 32, (bf16*)(ws + WS_WG), D, ColIdent{0}, scr, F.lane)) continue;
            if (conv_job(it, in[13], D, 512, D / 32, (bf16*)(ws + WS_WD), 512, ColIdent{0}, scr, F.lane)) continue;
            if (conv_job(it, in[15], D, D, D / 32, (bf16*)(ws + WS_WO), D, ColIdent{0}, scr, F.lane)) continue;
            if (conv_job(it, in[19], 512, D, 512 / 32, (bf16*)(ws + WS_WCQ), D, ColIdent{0}, scr, F.lane)) continue;
            if (conv_job(it, in[20], D, D, D / 32, (bf16*)(ws + WS_WCKV), D, ColIdent{0}, scr, F.lane)) continue;
            conv_job(it, in[21], D, 512, D / 32, (bf16*)(ws + WS_WCO), 512, ColIdent{0}, scr, F.lane);
        }
        { int m = gw;
#if FFN1_FP8
          for (; m + 3 * NGW < M; m += 4 * NGW) rms_rows_bf16<4, true>(in[0] + (size_t)m * D, in[2], (bf16*)((unsigned char*)XN + (size_t)m * D), F.lane, (size_t)NGW * D);
          for (; m < M; m += NGW) rms_rows_bf16<1, true>(in[0] + (size_t)m * D, in[2], (bf16*)((unsigned char*)XN + (size_t)m * D), F.lane, 0); }
#else
          for (; m + 3 * NGW < M; m += 4 * NGW) rms_rows_bf16<4>(in[0] + (size_t)m * D, in[2], XN + (size_t)m * D, F.lane, (size_t)NGW * D);
          for (; m < M; m += NGW) rms_rows_bf16<1>(in[0] + (size_t)m * D, in[2], XN + (size_t)m * D, F.lane, 0); }
#endif
        for (int m = gw; m < BATCH * MEML; m += NGW) rms_rows_bf16<1>(in[1] + (size_t)m * D, in[16], (bf16*)(ws + WS_MEMN) + (size_t)m * D, F.lane, 0);
        REPBAR(0); }
        SEAM(0);
    }
    if (IN(1)) {
        pg8::Order1 S; S.init(pg8::GDesc{XN, W1A, D, D, D, M / 256, 2 * FF / 256}, F.G, F.c);
#if FFN1_FP8
        FORREP(1) { pg8::gemm_phase8<true>(F.lds, S, EpiSwiglu8{(unsigned char*)HID}); REPBAR(1); }
#else
        FORREP(1) { pg8::gemm_phase<true>(F.lds, S, EpiSwiglu{HID}); REPBAR(1); }
#endif
        SEAM(1);
    }
    if (IN(2)) {
        pg8::Order1 S; S.init(pg8::GDesc{HID, W1B, FF, FF, FF, M / 256, D / 256}, F.G, F.c);
#if FFN1_FP8
        FORREP(2) { pg8::gemm_phase8<true>(F.lds, S, EpiStore{Y, D, 1.f / 512.f}); REPBAR(2); }
#else
        FORREP(2) { pg8::gemm_phase<true>(F.lds, S, EpiStore{Y, D}); REPBAR(2); }
#endif
        SEAM(2);
    }
    if (IN(3)) { FORREP(3) { resnorm_phase<false, false, true>(F, in[0], Y, in[3], 0.5f, args.out, in[6], XN, ST(3)); REPBAR(3); } SEAM(3); }
    if (IN(4)) {
        pg8::Order2 S; S.d0 = pg8::GDesc{XN, (const bf16*)(ws + WS_WIN), D, D, D, M / 256, NIN / 256};
        S.d1 = pg8::GDesc{(const bf16*)(ws + WS_MEMN), (const bf16*)(ws + WS_WCKV), D, D, D, BATCH * MEML / 256, D / 256}; S.G = F.G; S.c = F.c;
        FORREP(4) { pg8::gemm_phase<true>(F.lds, S, EpiInproj{ws}); REPBAR(4); }
        SEAM(4);
    }
    if (IN(5)) {
        FORREP(5) {
        if (sub <= 0) { for (int u = F.c; u < 256; u += F.G) gla_state_unit(F, in, u); __syncthreads(); }
        if (sub != 0) for (int k = 0; k * F.G < 2048; ++k) { const int u = k * F.G + ((k & 1) ? F.G - 1 - F.c : F.c); if (u < 2048) idx_unit(F, u, ST(5), sub >= 2 ? sub - 1 : 0); }
        REPBAR(5); }
        SEAM(5);
    }
    if (IN(6)) {
        FORREP(6) {
        if (sub != 1) gla_scan_phase(F, ST(6));
#ifdef PROBE_EXTRA_PHASE
        if (sub >= 2) { for (int p = F.c; p < 256; p += F.G) { const int bh = p >> 4, x = p & 15;
            if (sub == 2) { dsa_att_unit<1>(F, in, bh, x, false); dsa_att_unit<1>(F, in, bh, 31 - x, false); }
            if (sub == 3) { dsa_att_unit<3>(F, in, bh, x, false); dsa_att_unit<3>(F, in, bh, 31 - x, false); }
            if (sub == 4) { dsa_att_unit<4>(F, in, bh, x, false); dsa_att_unit<4>(F, in, bh, 31 - x, false); }
            if (sub == 5) { dsa_att_unit<5>(F, in, bh, x, false); dsa_att_unit<5>(F, in, bh, 31 - x, false); }
            if (sub == 6) { dsa_att_unit<6>(F, in, bh, x, false); dsa_att_unit<6>(F, in, bh, 31 - x, false); } } } else
#endif
        if (sub != 0) for (int p = F.c; p < 256; p += F.G) { const int bh = p >> 4, x = p & 15; dsa_att_unit(F, in, bh, x, ST(6)); dsa_att_unit(F, in, bh, 31 - x, ST(6)); }
        REPBAR(6); }
        SEAM(6);
    }
    if (IN(7)) {
        FORREP(7) { for (int u = F.c; u < 256; u += F.G) { gla_out_unit(F, in, u, ST(7)); __syncthreads(); } REPBAR(7); }
        SEAM(7);
    }
    if (IN(8)) {
        pg8::Order1 S; S.init(pg8::GDesc{XN, (const bf16*)(ws + WS_WGT), D, D, D, M / 256, 2048 / 256}, F.G, F.c);
        FORREP(8) { pg8::gemm_phase<true>(F.lds, S, EpiGates{(bf16*)(ws + WS_SGA), (bf16*)(ws + WS_SGB)}); REPBAR(8); }
        SEAM(8);
    }
    if (IN(9)) {
        pg8::PairOrder S; S.d0 = pg8::GDesc{(const bf16*)(ws + WS_GR), (const bf16*)(ws + WS_WG), D, D, D, M / 256, D / 256};
        S.d1 = pg8::GDesc{(const bf16*)(ws + WS_DQKV), (const bf16*)(ws + WS_WD), 1536, 512, 512, M / 256, D / 256}; S.G = F.G; S.c = F.c;
        FORREP(9) { pg8::gemm_phase<false>(F.lds, S, EpiMerge{(const bf16*)(ws + WS_SGA), (const bf16*)(ws + WS_SGB), (bf16*)(ws + WS_MRG)}); REPBAR(9); }
        SEAM(9);
    }
    if (IN(10)) {
        pg8::Order1 S; S.init(pg8::GDesc{(const bf16*)(ws + WS_MRG), (const bf16*)(ws + WS_WO), D, D, D, M / 256, D / 256}, F.G, F.c);
        FORREP(10) { pg8::gemm_phase<true>(F.lds, S, EpiStore{(bf16*)(ws + WS_Y2), D}); REPBAR(10); }
        SEAM(10);
    }
    if (IN(11)) {
        FORREP(11) {
        resnorm_phase<false, true, true>(F, args.out, (const bf16*)(ws + WS_Y2), in[7], 1.0f, args.out, in[17], XN, ST(11));
        LAS float* scr = (LAS float*)(F.lds + F.wave * 16384);
        constexpr int NITEMS = 2816 + 1408;
        for (int it0 = gw; it0 < NITEMS; it0 += NGW) { int it = it0;
            if (conv_job8(it, in[24], 2 * FF, D, 2 * FF / 32, (unsigned char*)W1A, D, 64.f, ColFfn{}, scr, F.lane)) continue;
            conv_job8(it, in[25], D, FF, D / 32, (unsigned char*)W1B, FF, 64.f, ColIdent{0}, scr, F.lane);
        }
        REPBAR(11); }
        SEAM(11);
    }
    if (IN(12)) {
        pg8::Order1 S; S.init(pg8::GDesc{XN, (const bf16*)(ws + WS_WCQ), D, D, D, M / 256, 512 / 256}, F.G, F.c);
        FORREP(12) { pg8::gemm_phase<true>(F.lds, S, EpiStore{(bf16*)(ws + WS_QC), 512}); REPBAR(12); }
        SEAM(12);
    }
    if (IN(13)) {
        FORREP(13) { for (int u = F.c; u < 256; u += F.G) cross_att_unit(F, u); REPBAR(13); }
        SEAM(13);
    }
    if (IN(14)) {
        pg8::Order1 S; S.init(pg8::GDesc{(const bf16*)(ws + WS_OX), (const bf16*)(ws + WS_WCO), 512, 512, 512, M / 256, D / 256}, F.G, F.c);
        FORREP(14) { pg8::gemm_phase<true>(F.lds, S, EpiStore{(bf16*)(ws + WS_Y3), D}); REPBAR(14); }
        SEAM(14);
    }
    if (IN(15)) { FORREP(15) { resnorm_phase<true, true, true>(F, args.out, (const bf16*)(ws + WS_Y3), in[18], 1.0f, ws + WS_H3, in[22], XN, ST(15)); REPBAR(15); } SEAM(15); }
    if (IN(16)) {
        pg8::Order1 S; S.init(pg8::GDesc{XN, W1A, D, D, D, M / 256, 2 * FF / 256}, F.G, F.c);
        FORREP(16) { pg8::gemm_phase8<true>(F.lds, S, EpiSwiglu8{(unsigned char*)HID}); REPBAR(16); }
        SEAM(16);
    }
    if (IN(17)) {
        pg8::Order1 S; S.init(pg8::GDesc{HID, W1B, FF, FF, FF, M / 256, D / 256}, F.G, F.c);
        FORREP(17) { pg8::gemm_phase8<true>(F.lds, S, EpiStore{Y, D, 1.f / 512.f}); REPBAR(17); }
        SEAM(17);
    }
    if (IN(18)) { FORREP(18) { resnorm_phase<false, true, false>(F, ws + WS_H3, Y, in[23], 0.5f, args.out, nullptr, nullptr, ST(18)); REPBAR(18); } }
#ifdef PROBE_EXTRA_PHASE
    if (lo == 20) { f32x16 a0, a1, a2, a3; for (int r = 0; r < 16; ++r) { a0[r] = 0.f; a1[r] = 1.f; a2[r] = 2.f; a3[r] = 3.f; }
        bf16x8 x = pack8(1.f, 2.f, 3.f, 4.f, 5.f, 6.f, 7.f, (float)F.lane), y = pack8(.5f, .25f, .125f, 1.f, 2.f, 3.f, 4.f, (float)F.wave);
        for (int i = 0; i < 2048; ++i) { a0 = MFMA32(x, y, a0); a1 = MFMA32(x, y, a1); a2 = MFMA32(x, y, a2); a3 = MFMA32(x, y, a3); }
        if (a0[0] + a1[1] + a2[2] + a3[3] == 1.2345f) ctl[32] = 1u; }
    if (lo == 21) { float v0 = (float)F.lane, v1 = 1.f, v2 = 2.f, v3 = 3.f, v4 = 4.f, v5 = 5.f, v6 = 6.f, v7 = 7.f; const float m = 1.0000001f, c = 1e-9f;
        for (int i = 0; i < 8192; ++i) { v0 = fmaf(v0, m, c); v1 = fmaf(v1, m, c); v2 = fmaf(v2, m, c); v3 = fmaf(v3, m, c); v4 = fmaf(v4, m, c); v5 = fmaf(v5, m, c); v6 = fmaf(v6, m, c); v7 = fmaf(v7, m, c); }
        if (v0 + v1 + v2 + v3 + v4 + v5 + v6 + v7 == 1.2345f) ctl[32] = 1u; }
    if (lo == 22) { f32x4 a0 = {0, 0, 0, 0}, a1 = {1, 1, 1, 1}, a2 = {2, 2, 2, 2}, a3 = {3, 3, 3, 3};
        bf16x8 x = pack8(1.f, 2.f, 3.f, 4.f, 5.f, 6.f, 7.f, (float)F.lane), y = pack8(.5f, .25f, .125f, 1.f, 2.f, 3.f, 4.f, (float)F.wave);
        for (int i = 0; i < 4096; ++i) { a0 = __builtin_amdgcn_mfma_f32_16x16x32_bf16(x, y, a0, 0, 0, 0); a1 = __builtin_amdgcn_mfma_f32_16x16x32_bf16(x, y, a1, 0, 0, 0); a2 = __builtin_amdgcn_mfma_f32_16x16x32_bf16(x, y, a2, 0, 0, 0); a3 = __builtin_amdgcn_mfma_f32_16x16x32_bf16(x, y, a3, 0, 0, 0); }
        if (a0[0] + a1[1] + a2[2] + a3[3] == 1.2345f) ctl[32] = 1u; }
    if (lo == 23) { float v0 = (float)F.lane * 1e-3f, v1 = .1f, v2 = .2f, v3 = .3f;
        for (int i = 0; i < 8192; ++i) { v0 = fast_exp2(v0) - 1.f; v1 = fast_exp2(v1) - 1.f; v2 = fast_exp2(v2) - 1.f; v3 = fast_exp2(v3) - 1.f; }
        if (v0 + v1 + v2 + v3 == 1.2345f) ctl[32] = 1u; }
#endif
#undef IN
#undef SEAM
}

extern "C" void kernel_launch(void* const* d_in, const int* in_sizes, int n_in, void* d_out, int out_size, void* d_ws, size_t ws_size, hipStream_t stream) {
    static int grid = 0;
    if (grid == 0) {
        if (n_in != 26 || out_size != M * D || ws_size < WS_END) { fprintf(stderr, "kernel_launch: unexpected problem shape (n_in %d, out %d, ws %zu); nothing launched\n", n_in, out_size, ws_size); grid = -1; return; }
        int dev = 0, cus = 0, per_cu = 0;
        if (hipGetDevice(&dev) != hipSuccess || hipDeviceGetAttribute(&cus, hipDeviceAttributeMultiprocessorCount, dev) != hipSuccess) { grid = -1; return; }
        if (hipFuncSetAttribute((const void*)mega_fwd, hipFuncAttributeMaxDynamicSharedMemorySize, LDS_BYTES) != hipSuccess) { fprintf(stderr, "kernel_launch: hipFuncSetAttribute failed\n"); grid = -1; return; }
        if (hipOccupancyMaxActiveBlocksPerMultiprocessor(&per_cu, (const void*)mega_fwd, NT, LDS_BYTES) != hipSuccess || per_cu < 1) fprintf(stderr, "kernel_launch: occupancy query reports %d workgroups per CU\n", per_cu);
        (void)hipGetLastError();
        grid = cus;
    }
    if (grid < 0) return;
    (void)hipMemsetAsync((char*)d_ws + WS_CTL, 0, 65536, stream);
    Args a{};
    for (int i = 0; i < 26; ++i) a.in[i] = (const float*)d_in[i];
    a.out = (float*)d_out; a.ws = (unsigned char*)d_ws;
    a.nostore = 0; a.sub = -1;
#if MK_ONE_LAUNCH
    a.ph_lo = 0; a.ph_hi = N_PHASES;
    hipLaunchKernelGGL(mega_fwd, dim3(grid), dim3(NT), LDS_BYTES, stream, a);
#ifdef PROBE_EXTRA_PHASE
    for (int r = 0; r < PROBE_EXTRA_N; ++r) { a.ph_lo = PROBE_EXTRA_PHASE; a.ph_hi = PROBE_EXTRA_PHASE + 1; a.nostore = 1; a.sub = PROBE_EXTRA_SUB;
    hipLaunchKernelGGL(mega_fwd, dim3(grid), dim3(NT), LDS_BYTES, stream, a); }
#endif
#else
    for (int p = 0; p < N_PHASES; ++p) { a.ph_lo = p; a.ph_hi = p + 1; hipLaunchKernelGGL(mega_fwd, dim3(grid), dim3(NT), LDS_BYTES, stream, a); }
#endif
}
```

```cpp
#define MK_ONE_LAUNCH 1
#pragma clang diagnostic ignored "-Wint-to-pointer-cast"
#include <hip/hip_runtime.h>
#include <cstdio>
#include <cstdint>

#define DI __device__ __forceinline__
#define LAS __attribute__((address_space(3)))
#define GAS __attribute__((address_space(1)))
typedef unsigned short bf16;
typedef short bf16x8 __attribute__((ext_vector_type(8)));
typedef short s16x4 __attribute__((ext_vector_type(4)));
typedef float f32x4 __attribute__((ext_vector_type(4)));
typedef float f32x2 __attribute__((ext_vector_type(2)));
typedef float f32x16 __attribute__((ext_vector_type(16)));
typedef unsigned u32x4 __attribute__((ext_vector_type(4)));
typedef unsigned u32x2 __attribute__((ext_vector_type(2)));
typedef __bf16 bf16x2_t __attribute__((ext_vector_type(2)));

DI unsigned pk2(float lo, float hi) { f32x2 v = {lo, hi}; bf16x2_t b = __builtin_convertvector(v, bf16x2_t); return __builtin_bit_cast(unsigned, b); }
DI float bflo(unsigned w) { return __uint_as_float(w << 16); }
DI float bfhi(unsigned w) { return __uint_as_float(w & 0xffff0000u); }
DI float bf2f(bf16 v) { return __uint_as_float(((unsigned)v) << 16); }
DI float wave_sum(float v) {
#pragma unroll
    for (int o = 1; o < 64; o <<= 1) v += __shfl_xor(v, o);
    return v;
}
DI float fast_exp2(float x) { return __builtin_amdgcn_exp2f(x); }
DI float fast_exp(float x) { return __builtin_amdgcn_exp2f(x * 1.4426950408889634f); }
DI float fast_rcp(float x) { return __builtin_amdgcn_rcpf(x); }
DI float sigmoid_f(float x) { return fast_rcp(1.0f + fast_exp(-x)); }
#define MFMA32(a, b, c) __builtin_amdgcn_mfma_f32_32x32x16_bf16((a), (b), (c), 0, 0, 0)
DI int crow(int r, int hi) { return (r & 3) + 8 * (r >> 2) + 4 * hi; }
DI bf16x8 pack8(float a0, float a1, float a2, float a3, float a4, float a5, float a6, float a7) {
    u32x4 p; p.x = pk2(a0, a1); p.y = pk2(a2, a3); p.z = pk2(a4, a5); p.w = pk2(a6, a7); return __builtin_bit_cast(bf16x8, p);
}
DI bf16x8 pack_step(const f32x16& x, int s) { return pack8(x[8 * s], x[8 * s + 1], x[8 * s + 2], x[8 * s + 3], x[8 * s + 4], x[8 * s + 5], x[8 * s + 6], x[8 * s + 7]); }
typedef short v4i16_t __attribute__((ext_vector_type(4)));
DI s16x4 vtr(unsigned lds_byte_addr) { return __builtin_bit_cast(s16x4, __builtin_amdgcn_ds_read_tr16_b64_v4i16((LAS v4i16_t*)lds_byte_addr)); }
DI bf16x8 cat4(s16x4 lo, s16x4 hi) { return __builtin_shufflevector(lo, hi, 0, 1, 2, 3, 4, 5, 6, 7); }
DI bf16x8 lds_b128(unsigned lds_byte_addr) { return *(const LAS bf16x8*)lds_byte_addr; }

namespace pg8 {
#define PG8_LAS __attribute__((address_space(3)))
typedef unsigned short bf16_t;
constexpr int BM = 256, BK = 64, HALF = 128, HTB = HALF * BK * 2  , STAGE_BYTES = 8 * HTB, NXCD = 8, WGM = 8;

__host__ __device__ __forceinline__ int lds_byte(int r, int c) { const int st = (r >> 4) * 2 + (c >> 5), rr = r & 15, cc = c & 31, ob = rr * 64 + cc * 2; return st * 1024 + (ob ^ (((ob >> 9) & 1) << 5)); }
__host__ __device__ __forceinline__ void stage_rc(int b, int& R, int& C) { const int st = b / 1024, sb = b % 1024, swz = sb ^ (((sb >> 9) & 1) << 5); R = (st >> 1) * 16 + swz / 64; C = (st & 1) * 32 + (swz % 64) / 2; }
__host__ __device__ __forceinline__ int perm32(int rho) { const int n = rho >> 4, i = rho & 15; return 8 * (i >> 2) + 4 * n + (i & 3); }

struct Unit { int pm, pn, g; };
struct GDesc { const bf16_t* A; const bf16_t* Bt; int lda, ldb, K, nM, nN; };

__device__ __forceinline__ void tile_of(int l, int nM, int nN, int& pm, int& pn) {
    const int nwg = nM * nN; int wgid = l;
    { const int q = nwg / NXCD, r = nwg % NXCD, xcd = wgid % NXCD, off = wgid / NXCD; wgid = (xcd < r ? xcd * (q + 1) : r * (q + 1) + (xcd - r) * q) + off; }
    const int nig = WGM * nN, gid = wgid / nig, fm = gid * WGM, gsz = (nM - fm) < WGM ? (nM - fm) : WGM;
    pm = fm + ((wgid % nig) % gsz); pn = (wgid % nig) / gsz;
}
struct Order1 {
    GDesc d0; int G, c;
    __device__ __forceinline__ void init(const GDesc& a, int G_, int c_) { d0 = a; G = G_; c = c_; }
    __device__ __forceinline__ GDesc desc(int) const { return d0; }
    __device__ __forceinline__ bool next(int i, Unit& u) const {
        const long L = (long)i * G + c; if (L >= (long)(d0.nM * d0.nN)) return false;
        tile_of((int)L, d0.nM, d0.nN, u.pm, u.pn); u.g = 0; return true;
    }
};
struct Order2 {
    GDesc d0, d1; int G, c;
    __device__ __forceinline__ GDesc desc(int g) const { GDesc r; r.A = g == 0 ? d0.A : d1.A; r.Bt = g == 0 ? d0.Bt : d1.Bt; r.lda = d0.lda; r.ldb = d0.ldb; r.K = d0.K; r.nM = g == 0 ? d0.nM : d1.nM; r.nN = g == 0 ? d0.nN : d1.nN; return r; }
    __device__ __forceinline__ bool next(int i, Unit& u) const {
        const int n0 = d0.nM * d0.nN, n1 = d1.nM * d1.nN;
        const long L = (long)i * G + c; if (L >= (long)(n0 + n1)) return false;
        int l = (int)L, g = 0; if (l >= n0) { l -= n0; g = 1; }
        tile_of(l, g == 0 ? d0.nM : d1.nM, g == 0 ? d0.nN : d1.nN, u.pm, u.pn); u.g = g; return true;
    }
};
struct PairOrder {
    GDesc d0, d1; int G, c;
    __device__ __forceinline__ GDesc desc(int g) const { GDesc r; r.A = g == 0 ? d0.A : d1.A; r.Bt = g == 0 ? d0.Bt : d1.Bt; r.lda = g == 0 ? d0.lda : d1.lda; r.ldb = g == 0 ? d0.ldb : d1.ldb; r.K = g == 0 ? d0.K : d1.K; r.nM = d0.nM; r.nN = d0.nN; return r; }
    __device__ __forceinline__ bool next(int i, Unit& u) const {
        const long L = (long)(i >> 1) * G + c; if (L >= (long)(d0.nM * d0.nN)) return false;
        tile_of((int)L, d0.nM, d0.nN, u.pm, u.pn); u.g = i & 1; return true;
    }
};

template <bool UNIFORM  , class Epi, class Sched>
__device__ __forceinline__ void gemm_phase(PG8_LAS unsigned char* lds, const Sched& S, const Epi& E) {
    const int tid = threadIdx.x, wid = __builtin_amdgcn_readfirstlane(tid >> 6), lane = tid & 63, wr = wid >> 2, wc = wid & 3, fr = lane & 15, fq = lane >> 4;
    auto voff = [tid](int i, int ld, bool perm) -> unsigned { int R, C; stage_rc(tid * 16 + i * 8192, R, C); if (perm) R = (R & ~31) + perm32(R & 31); return (unsigned)(R * ld + C) * 2u; };
    const size_t kstep = (size_t)(BK * 2);
    const unsigned ldsw = (unsigned)wid * 1024u;
    const int aoff = lds_byte(wr * 64 + fr, fq * 8), boff = lds_byte(wc * 32 + fr, fq * 8);
#define PG8_SA(b, h) (((b) * 2 + (h)) * HTB)
#define PG8_SB(b, h) ((4 + (b) * 2 + (h)) * HTB)
#define PG8_STAGE(bufoff, gbase, v0, v1) do { \
        __builtin_amdgcn_global_load_lds((const unsigned*)((const char*)(gbase) + (v0)), (PG8_LAS unsigned*)(lds + (bufoff) + ldsw), 16, 0, 0); \
        __builtin_amdgcn_global_load_lds((const unsigned*)((const char*)(gbase) + (v1)), (PG8_LAS unsigned*)(lds + (bufoff) + ldsw + 8192), 16, 0, 0); } while (0)
#define PG8_LDA(dst, b, h) do { _Pragma("unroll") for (int m = 0; m < 4; ++m) _Pragma("unroll") for (int k = 0; k < 2; ++k) dst[m][k] = *(const PG8_LAS bf16x8*)(lds + PG8_SA(b, h) + aoff + m * 2048 + k * 1024); } while (0)
#define PG8_LDB(dst, b, h) do { _Pragma("unroll") for (int n = 0; n < 2; ++n) _Pragma("unroll") for (int k = 0; k < 2; ++k) dst[n][k] = *(const PG8_LAS bf16x8*)(lds + PG8_SB(b, h) + boff + n * 2048 + k * 1024); } while (0)
#define PG8_MMA(ai, bj, At, Bt) do { __builtin_amdgcn_s_setprio(1); _Pragma("unroll") for (int m = 0; m < 4; ++m) _Pragma("unroll") for (int n = 0; n < 2; ++n) _Pragma("unroll") for (int k = 0; k < 2; ++k) \
        acc[ai][bj][m][n] = __builtin_amdgcn_mfma_f32_16x16x32_bf16(Bt[n][k], At[m][k], acc[ai][bj][m][n], 0, 0, 0); __builtin_amdgcn_s_setprio(0); } while (0)
#define PG8_WAIT_V(n) asm volatile("s_waitcnt vmcnt(" #n ")" ::: "memory")
#define PG8_WAIT_L(n) asm volatile("s_waitcnt lgkmcnt(" #n ")" ::: "memory")
#define PG8_BAR __builtin_amdgcn_s_barrier()
#define PG8_SCHED __builtin_amdgcn_sched_barrier(0)
    Unit cur, nxt; int ui = 0;
    if (!S.next(0, cur)) return;
    GDesc dc = S.desc(cur.g);
    f32x4 acc[2][2][4][2];
#pragma unroll
    for (int a = 0; a < 2; ++a)
#pragma unroll
        for (int b = 0; b < 2; ++b)
#pragma unroll
            for (int m = 0; m < 4; ++m)
#pragma unroll
                for (int n = 0; n < 2; ++n) acc[a][b][m][n] = (f32x4){0.f, 0.f, 0.f, 0.f};
    bf16x8 At[4][2], B0[2][2], B1[2][2];
    unsigned vA0 = voff(0, dc.lda, false), vA1 = voff(1, dc.lda, false), vB0 = voff(0, dc.ldb, true), vB1 = voff(1, dc.ldb, true);
    size_t hA = (size_t)HALF * dc.lda * 2, hB = (size_t)HALF * dc.ldb * 2;
    const char* cA = (const char*)dc.A + (size_t)cur.pm * 2 * hA; const char* cB = (const char*)dc.Bt + (size_t)cur.pn * 2 * hB;
    PG8_STAGE(PG8_SB(0, 0), cB, vB0, vB1); PG8_STAGE(PG8_SB(0, 1), cB + hB, vB0, vB1); PG8_STAGE(PG8_SA(0, 0), cA, vA0, vA1); PG8_STAGE(PG8_SA(0, 1), cA + hA, vA0, vA1);
    if (wr == 1) PG8_BAR;
    PG8_WAIT_V(2); PG8_BAR;
    PG8_STAGE(PG8_SB(1, 0), cB + kstep, vB0, vB1); PG8_STAGE(PG8_SA(1, 0), cA + kstep, vA0, vA1); PG8_STAGE(PG8_SB(1, 1), cB + hB + kstep, vB0, vB1);
    PG8_WAIT_V(6); PG8_BAR;
    for (;;) {
        const bool has_next = S.next(ui + 1, nxt);
        GDesc dn = dc; if (has_next) dn = S.desc(nxt.g);
        unsigned nvA0 = vA0, nvA1 = vA1, nvB0 = vB0, nvB1 = vB1; size_t nhA = hA, nhB = hB;
        if constexpr (!UNIFORM) { if (has_next) { nvA0 = voff(0, dn.lda, false); nvA1 = voff(1, dn.lda, false); nvB0 = voff(0, dn.ldb, true); nvB1 = voff(1, dn.ldb, true); nhA = (size_t)HALF * dn.lda * 2; nhB = (size_t)HALF * dn.ldb * 2; } }
        const char* nA = has_next ? (const char*)dn.A + (size_t)nxt.pm * 2 * nhA : cA; const char* nB = has_next ? (const char*)dn.Bt + (size_t)nxt.pn * 2 * nhB : cB;
        const int nt = dc.K / BK;
        for (int t = 0; t < nt; t += 2) {
            const bool last = (t == nt - 2);
            const char* a1 = cA + (size_t)(t + 1) * kstep;
            const char* a2 = last ? nA : cA + (size_t)(t + 2) * kstep; const char* b2 = last ? nB : cB + (size_t)(t + 2) * kstep;
            const char* a3 = a2 + kstep; const char* b3 = b2 + kstep;
            unsigned xA0 = vA0, xA1 = vA1, xB0 = vB0, xB1 = vB1; size_t xhA = hA, xhB = hB;
            if constexpr (!UNIFORM) { if (last) { xA0 = nvA0; xA1 = nvA1; xB0 = nvB0; xB1 = nvB1; xhA = nhA; xhB = nhB; } }
            PG8_LDB(B0, 0, 0); PG8_LDB(B1, 0, 1); PG8_SCHED; PG8_LDA(At, 0, 0); PG8_STAGE(PG8_SA(1, 1), a1 + hA, vA0, vA1);
            PG8_WAIT_V(8); PG8_WAIT_L(0); PG8_BAR; PG8_MMA(0, 0, At, B0); PG8_MMA(0, 1, At, B1); PG8_BAR; PG8_SCHED;
            PG8_LDA(At, 0, 1); PG8_STAGE(PG8_SB(0, 0), b2, xB0, xB1); PG8_STAGE(PG8_SB(0, 1), b2 + xhB, xB0, xB1); PG8_STAGE(PG8_SA(0, 0), a2, xA0, xA1);
            PG8_WAIT_V(8); PG8_WAIT_L(0); PG8_BAR; PG8_MMA(1, 0, At, B0); PG8_MMA(1, 1, At, B1); PG8_BAR; PG8_SCHED;
            PG8_LDB(B0, 1, 0); PG8_LDB(B1, 1, 1); PG8_SCHED; PG8_LDA(At, 1, 0); PG8_STAGE(PG8_SA(0, 1), a2 + xhA, xA0, xA1);
            PG8_WAIT_V(8); PG8_WAIT_L(0); PG8_BAR; PG8_MMA(0, 0, At, B0); PG8_MMA(0, 1, At, B1); PG8_BAR; PG8_SCHED;
            PG8_LDA(At, 1, 1); PG8_STAGE(PG8_SB(1, 0), b3, xB0, xB1); PG8_STAGE(PG8_SB(1, 1), b3 + xhB, xB0, xB1); PG8_STAGE(PG8_SA(1, 0), a3, xA0, xA1);
            PG8_WAIT_V(8); PG8_WAIT_L(0); PG8_BAR; PG8_MMA(1, 0, At, B0); PG8_MMA(1, 1, At, B1); PG8_BAR; PG8_SCHED;
        }
        if (wr == 0) PG8_BAR;
        const bool keep = E(acc, cur, wr, wc, fr, fq);
        if (!has_next) break;
        if (!keep) {
#pragma unroll
            for (int a = 0; a < 2; ++a)
#pragma unroll
                for (int b = 0; b < 2; ++b)
#pragma unroll
                    for (int m = 0; m < 4; ++m)
#pragma unroll
                        for (int n = 0; n < 2; ++n) acc[a][b][m][n] = (f32x4){0.f, 0.f, 0.f, 0.f};
        }
        cur = nxt; dc = dn; cA = nA; cB = nB; vA0 = nvA0; vA1 = nvA1; vB0 = nvB0; vB1 = nvB1; hA = nhA; hB = nhB; ++ui;
        if (wr == 1) PG8_BAR;
    }
    PG8_WAIT_V(0);
    PG8_BAR;
#undef PG8_SA
#undef PG8_SB
#undef PG8_STAGE
#undef PG8_LDA
#undef PG8_LDB
#undef PG8_MMA
#undef PG8_WAIT_V
#undef PG8_WAIT_L
#undef PG8_BAR
#undef PG8_SCHED
}
template <bool UNIFORM, class Epi, class Sched>
__device__ __forceinline__ void gemm_phase8(PG8_LAS unsigned char* lds, const Sched& S, const Epi& E) {
    const int tid = threadIdx.x, wid = __builtin_amdgcn_readfirstlane(tid >> 6), lane = tid & 63, wr = wid >> 2, wc = wid & 3, fr = lane & 15, fq = lane >> 4;
    auto voff = [tid](int i, int ld, bool perm) -> unsigned { int R, C; stage_rc(tid * 16 + i * 8192, R, C); if (perm) R = (R & ~31) + perm32(R & 31); return (unsigned)(R * ld + 2 * C); };
    const size_t kstep = (size_t)(BK * 2);
    const unsigned ldsw = (unsigned)wid * 1024u;
    const int aoff0 = lds_byte(wr * 64 + fr, fq * 16), boff0 = lds_byte(wc * 32 + fr, fq * 16);
    constexpr int aoff1d = 16, boff1d = 16;
    typedef int v8i __attribute__((ext_vector_type(8))); typedef int v4i __attribute__((ext_vector_type(4)));
    const int unit_scale = 0x7f7f7f7f;
#define PG8_SA(b, h) (((b) * 2 + (h)) * HTB)
#define PG8_SB(b, h) ((4 + (b) * 2 + (h)) * HTB)
#define PG8_STAGE(bufoff, gbase, v0, v1) do { \
        __builtin_amdgcn_global_load_lds((const unsigned*)((const char*)(gbase) + (v0)), (PG8_LAS unsigned*)(lds + (bufoff) + ldsw), 16, 0, 0); \
        __builtin_amdgcn_global_load_lds((const unsigned*)((const char*)(gbase) + (v1)), (PG8_LAS unsigned*)(lds + (bufoff) + ldsw + 8192), 16, 0, 0); } while (0)
#define PG8_LDA(dst, b, h) do { _Pragma("unroll") for (int m = 0; m < 4; ++m) { const v4i lo_ = *(const PG8_LAS v4i*)(lds + PG8_SA(b, h) + aoff0 + m * 2048), hi_ = *(const PG8_LAS v4i*)(lds + PG8_SA(b, h) + aoff0 + aoff1d + m * 2048); dst[m] = __builtin_shufflevector(lo_, hi_, 0, 1, 2, 3, 4, 5, 6, 7); } } while (0)
#define PG8_LDB(dst, b, h) do { _Pragma("unroll") for (int n = 0; n < 2; ++n) { const v4i lo_ = *(const PG8_LAS v4i*)(lds + PG8_SB(b, h) + boff0 + n * 2048), hi_ = *(const PG8_LAS v4i*)(lds + PG8_SB(b, h) + boff0 + boff1d + n * 2048); dst[n] = __builtin_shufflevector(lo_, hi_, 0, 1, 2, 3, 4, 5, 6, 7); } } while (0)
#define PG8_MMA(ai, bj, At, Bt) do { __builtin_amdgcn_s_setprio(1); _Pragma("unroll") for (int m = 0; m < 4; ++m) _Pragma("unroll") for (int n = 0; n < 2; ++n) \
        asm volatile("v_mfma_scale_f32_16x16x128_f8f6f4 %0, %1, %2, %0, %3, %3 op_sel_hi:[0,0,0]" : "+v"(acc[ai][bj][m][n]) : "v"(Bt[n]), "v"(At[m]), "v"(unit_scale)); __builtin_amdgcn_s_setprio(0); } while (0)
#define PG8_WAIT_V(n) asm volatile("s_waitcnt vmcnt(" #n ")" ::: "memory")
#define PG8_WAIT_L(n) asm volatile("s_waitcnt lgkmcnt(" #n ")" ::: "memory")
#define PG8_BAR __builtin_amdgcn_s_barrier()
#define PG8_SCHED __builtin_amdgcn_sched_barrier(0)
    Unit cur, nxt; int ui = 0;
    if (!S.next(0, cur)) return;
    GDesc dc = S.desc(cur.g);
    f32x4 acc[2][2][4][2];
#pragma unroll
    for (int a = 0; a < 2; ++a)
#pragma unroll
        for (int b = 0; b < 2; ++b)
#pragma unroll
            for (int m = 0; m < 4; ++m)
#pragma unroll
                for (int n = 0; n < 2; ++n) acc[a][b][m][n] = (f32x4){0.f, 0.f, 0.f, 0.f};
    v8i At[4], B0[2], B1[2];
    unsigned vA0 = voff(0, dc.lda, false), vA1 = voff(1, dc.lda, false), vB0 = voff(0, dc.ldb, true), vB1 = voff(1, dc.ldb, true);
    size_t hA = (size_t)HALF * dc.lda, hB = (size_t)HALF * dc.ldb;
    const char* cA = (const char*)dc.A + (size_t)cur.pm * 2 * hA; const char* cB = (const char*)dc.Bt + (size_t)cur.pn * 2 * hB;
    PG8_STAGE(PG8_SB(0, 0), cB, vB0, vB1); PG8_STAGE(PG8_SB(0, 1), cB + hB, vB0, vB1); PG8_STAGE(PG8_SA(0, 0), cA, vA0, vA1); PG8_STAGE(PG8_SA(0, 1), cA + hA, vA0, vA1);
    if (wr == 1) PG8_BAR;
    PG8_WAIT_V(2); PG8_BAR;
    PG8_STAGE(PG8_SB(1, 0), cB + kstep, vB0, vB1); PG8_STAGE(PG8_SA(1, 0), cA + kstep, vA0, vA1); PG8_STAGE(PG8_SB(1, 1), cB + hB + kstep, vB0, vB1);
    PG8_WAIT_V(6); PG8_BAR;
    for (;;) {
        const bool has_next = S.next(ui + 1, nxt);
        GDesc dn = dc; if (has_next) dn = S.desc(nxt.g);
        unsigned nvA0 = vA0, nvA1 = vA1, nvB0 = vB0, nvB1 = vB1; size_t nhA = hA, nhB = hB;
        if constexpr (!UNIFORM) { if (has_next) { nvA0 = voff(0, dn.lda, false); nvA1 = voff(1, dn.lda, false); nvB0 = voff(0, dn.ldb, true); nvB1 = voff(1, dn.ldb, true); nhA = (size_t)HALF * dn.lda; nhB = (size_t)HALF * dn.ldb; } }
        const char* nA = has_next ? (const char*)dn.A + (size_t)nxt.pm * 2 * nhA : cA; const char* nB = has_next ? (const char*)dn.Bt + (size_t)nxt.pn * 2 * nhB : cB;
        const int nt = dc.K / 128;
        for (int t = 0; t < nt; t += 2) {
            const bool last = (t == nt - 2);
            const char* a1 = cA + (size_t)(t + 1) * kstep;
            const char* a2 = last ? nA : cA + (size_t)(t + 2) * kstep; const char* b2 = last ? nB : cB + (size_t)(t + 2) * kstep;
            const char* a3 = a2 + kstep; const char* b3 = b2 + kstep;
            unsigned xA0 = vA0, xA1 = vA1, xB0 = vB0, xB1 = vB1; size_t xhA = hA, xhB = hB;
            if constexpr (!UNIFORM) { if (last) { xA0 = nvA0; xA1 = nvA1; xB0 = nvB0; xB1 = nvB1; xhA = nhA; xhB = nhB; } }
            PG8_LDB(B0, 0, 0); PG8_LDB(B1, 0, 1); PG8_SCHED; PG8_LDA(At, 0, 0); PG8_STAGE(PG8_SA(1, 1), a1 + hA, vA0, vA1);
            PG8_WAIT_V(8); PG8_WAIT_L(0); PG8_BAR; PG8_MMA(0, 0, At, B0); PG8_MMA(0, 1, At, B1); PG8_BAR; PG8_SCHED;
            PG8_LDA(At, 0, 1); PG8_STAGE(PG8_SB(0, 0), b2, xB0, xB1); PG8_STAGE(PG8_SB(0, 1), b2 + xhB, xB0, xB1); PG8_STAGE(PG8_SA(0, 0), a2, xA0, xA1);
            PG8_WAIT_V(8); PG8_WAIT_L(0); PG8_BAR; PG8_MMA(1, 0, At, B0); PG8_MMA(1, 1, At, B1); PG8_BAR; PG8_SCHED;
            PG8_LDB(B0, 1, 0); PG8_LDB(B1, 1, 1); PG8_SCHED; PG8_LDA(At, 1, 0); PG8_STAGE(PG8_SA(0, 1), a2 + xhA, xA0, xA1);
            PG8_WAIT_V(8); PG8_WAIT_L(0); PG8_BAR; PG8_MMA(0, 0, At, B0); PG8_MMA(0, 1, At, B1); PG8_BAR; PG8_SCHED;
            PG8_LDA(At, 1, 1); PG8_STAGE(PG8_SB(1, 0), b3, xB0, xB1); PG8_STAGE(PG8_SB(1, 1), b3 + xhB, xB0, xB1); PG8_STAGE(PG8_SA(1, 0), a3, xA0, xA1);
            PG8_WAIT_V(8); PG8_WAIT_L(0); PG8_BAR; PG8_MMA(1, 0, At, B0); PG8_MMA(1, 1, At, B1); PG8_BAR; PG8_SCHED;
        }
        if (wr == 0) PG8_BAR;
#define PG8_PAD16(a_) asm volatile("s_nop 15\n\ts_nop 15" : "+v"(acc[a_][0][0][0]), "+v"(acc[a_][0][0][1]), "+v"(acc[a_][0][1][0]), "+v"(acc[a_][0][1][1]), "+v"(acc[a_][0][2][0]), "+v"(acc[a_][0][2][1]), "+v"(acc[a_][0][3][0]), "+v"(acc[a_][0][3][1]), \
            "+v"(acc[a_][1][0][0]), "+v"(acc[a_][1][0][1]), "+v"(acc[a_][1][1][0]), "+v"(acc[a_][1][1][1]), "+v"(acc[a_][1][2][0]), "+v"(acc[a_][1][2][1]), "+v"(acc[a_][1][3][0]), "+v"(acc[a_][1][3][1]))
        PG8_PAD16(0); PG8_PAD16(1);
#undef PG8_PAD16
        const bool keep = E(acc, cur, wr, wc, fr, fq);
        if (!has_next) break;
        if (!keep) {
#pragma unroll
            for (int a = 0; a < 2; ++a)
#pragma unroll
                for (int b = 0; b < 2; ++b)
#pragma unroll
                    for (int m = 0; m < 4; ++m)
#pragma unroll
                        for (int n = 0; n < 2; ++n) acc[a][b][m][n] = (f32x4){0.f, 0.f, 0.f, 0.f};
        }
        cur = nxt; dc = dn; cA = nA; cB = nB; vA0 = nvA0; vA1 = nvA1; vB0 = nvB0; vB1 = nvB1; hA = nhA; hB = nhB; ++ui;
        if (wr == 1) PG8_BAR;
    }
    PG8_WAIT_V(0);
    PG8_BAR;
#undef PG8_SA
#undef PG8_SB
#undef PG8_STAGE
#undef PG8_LDA
#undef PG8_LDB
#undef PG8_MMA
#undef PG8_WAIT_V
#undef PG8_WAIT_L
#undef PG8_BAR
#undef PG8_SCHED
}
}

constexpr int NWAVES = 8, NT = 512;
constexpr int BATCH = 2, T = 8192, D = 1024, M = BATCH * T, FF = 2816, MEML = 256;
constexpr float EPS = 1e-6f;
constexpr float LOG2E = 1.4426950408889634f;
constexpr int NIN = 5376;
constexpr size_t KiB = 1024, MiB = 1u << 20;
constexpr size_t WS_CTL = 0, CTL_ZERO_BYTES = 1 * MiB;
constexpr size_t WS_XN = 1 * MiB;
constexpr size_t WS_HID = 33 * MiB;
constexpr size_t WS_Y = 121 * MiB;
constexpr size_t WS_QKG = 33 * MiB, WS_GV = 65 * MiB, WS_GR = 97 * MiB, WS_DQKV = 129 * MiB, WS_IQ = 177 * MiB, WS_SM = 193 * MiB, WS_GST = 197 * MiB;
constexpr size_t WS_W1A = 153 * MiB, WS_W1B = 164 * MiB;
constexpr size_t WS_WIN = 229 * MiB, WS_WGT = 229 * MiB + 10752 * KiB, WS_WG = WS_WGT + 4 * MiB, WS_WD = WS_WG + 2 * MiB, WS_WO = WS_WD + 1 * MiB,
                 WS_WCQ = WS_WO + 2 * MiB, WS_WCKV = WS_WCQ + 1 * MiB, WS_WCO = WS_WCKV + 2 * MiB, WS_MEMN = WS_WCO + 1 * MiB, WS_KVM = WS_MEMN + 1 * MiB, WS_DEC = WS_KVM + 1 * MiB;
constexpr size_t WS_SGA = WS_QKG, WS_SGB = WS_GV, WS_MRG = WS_GST, WS_Y2 = WS_QKG;
constexpr size_t WS_QC = 65 * MiB, WS_OX = 81 * MiB, WS_Y3 = 97 * MiB;
constexpr size_t WS_H3 = 177 * MiB;
constexpr size_t WS_END = 256 * MiB;
static_assert(WS_DEC + 128 * KiB <= WS_END && WS_W1B + (size_t)D * FF * 2 <= WS_IQ && WS_HID + (size_t)M * FF * 2 <= WS_Y, "d_ws map");
constexpr int CW_BAR = 4096;
constexpr int LDS_BYTES = 163840;
constexpr int MISC_OFF = LDS_BYTES - 256;

#define XB_TMO      128
#define XB_XCNT(j)  (256  + 64 * (j))
#define XB_XSUB(j)  (1280 + 64 * (j))
#define XB_XGEN(j)  (2304 + 64 * (j))
#define XB_TOP      3328
#define XB_TOPGEN   3392
#define XCD_BAR_WORDS 3456
#define XB_SPIN_CAP (1u << 18)

__device__ __forceinline__ unsigned xb_ld(unsigned* p)              { return __hip_atomic_load(p, __ATOMIC_RELAXED, __HIP_MEMORY_SCOPE_AGENT); }
__device__ __forceinline__ unsigned xb_add(unsigned* p, unsigned v) { return __hip_atomic_fetch_add(p, v, __ATOMIC_RELAXED, __HIP_MEMORY_SCOPE_AGENT); }
__device__ __forceinline__ unsigned xb_xcc_id() { return (unsigned)__builtin_amdgcn_s_getreg((3 << 11) | 20) & 0xFu; }
#define XB_SPIN(cond, bar) do { unsigned _sp = 0; while (cond) { __builtin_amdgcn_s_sleep(1); \
    if ((++_sp & 255u) == 0u) { if (xb_ld(&(bar)[XB_TMO])) break; if (_sp > XB_SPIN_CAP) { atomicAdd(&(bar)[XB_TMO], 1u); break; } } } } while (0)

struct XcdBarrier {
    unsigned* bar; unsigned x;
    volatile LAS unsigned* st;
};

__device__ __forceinline__ XcdBarrier xcd_barrier_post(unsigned* bar, volatile LAS unsigned* st) {
    XcdBarrier b; b.bar = bar; b.x = xb_xcc_id(); b.st = st;
    if (threadIdx.x == 0) (void)xb_add(&bar[XB_XCNT(b.x)], 1u);
    return b;
}
__device__ __forceinline__ void xcd_barrier_complete(unsigned* bar, unsigned x, unsigned& nloc, unsigned& nx) {
    const unsigned G = gridDim.x * gridDim.y * gridDim.z;
    unsigned sum, cnt, mine, sp = 0u;
    for (;;) {
        sum = 0u; cnt = 0u; mine = 0u;
#pragma unroll
        for (unsigned j = 0; j < 16; ++j) { const unsigned c = xb_ld(&bar[XB_XCNT(j)]); sum += c; cnt += (c > 0u) ? 1u : 0u; mine = (j == x) ? c : mine; }
        if (sum == G) break;
        __builtin_amdgcn_s_sleep(1);
        if ((++sp & 255u) == 0u) { if (xb_ld(&bar[XB_TMO])) break; if (sp > XB_SPIN_CAP) { atomicAdd(&bar[XB_TMO], 1u); break; } }
    }
    nloc = mine > 0u ? mine : 1u; nx = cnt > 0u ? cnt : 1u;
}

__device__ __forceinline__ void xcd_barrier(const XcdBarrier& b) {
    asm volatile("s_waitcnt vmcnt(0)" ::: "memory");
    __syncthreads();
    if (threadIdx.x == 0) {
        unsigned* bar = b.bar;
        __builtin_amdgcn_s_waitcnt(0);
        unsigned nloc = b.st[0], nx = b.st[1];
        if (nloc == 0u) { xcd_barrier_complete(bar, b.x, nloc, nx); b.st[0] = nloc; b.st[1] = nx; }
        const unsigned old = xb_add(&bar[XB_XSUB(b.x)], 1u);
        const unsigned gen = old / nloc;
        if (old + 1u == (gen + 1u) * nloc) {
            __builtin_amdgcn_fence(__ATOMIC_RELEASE, "agent");
            asm volatile("s_waitcnt vmcnt(0)" ::: "memory");
            const unsigned og = xb_add(&bar[XB_TOP], 1u);
            const unsigned tg = og / nx;
            if (og + 1u == (tg + 1u) * nx) xb_add(&bar[XB_TOPGEN], 1u);
            else XB_SPIN(xb_ld(&bar[XB_TOPGEN]) == tg, bar);
            __builtin_amdgcn_fence(__ATOMIC_ACQUIRE, "agent");
            xb_add(&bar[XB_XGEN(b.x)], 1u);
            asm volatile("s_waitcnt vmcnt(0)" ::: "memory");
        } else {
            XB_SPIN(xb_ld(&bar[XB_XGEN(b.x)]) == gen, bar);
            __builtin_amdgcn_fence(__ATOMIC_ACQUIRE, "agent");
            asm volatile("s_waitcnt vmcnt(0)" ::: "memory");
        }
    }
    __syncthreads();
}

struct Args { const float* in[26]; float* out; unsigned char* ws; int ph_lo, ph_hi, nostore, sub; };
struct Frame {
    LAS unsigned char* lds;
    unsigned char* ws; unsigned char* dout;
    int tid, lane, wave, G, c;
};
#define LDS_WAIT() asm volatile("s_waitcnt lgkmcnt(0)" ::: "memory")
#define VM_WAIT() asm volatile("s_waitcnt vmcnt(0)" ::: "memory")

DI unsigned pk4_fp8(float a, float b, float c_, float d) {
    a = __builtin_amdgcn_fmed3f(a, -448.f, 448.f); b = __builtin_amdgcn_fmed3f(b, -448.f, 448.f); c_ = __builtin_amdgcn_fmed3f(c_, -448.f, 448.f); d = __builtin_amdgcn_fmed3f(d, -448.f, 448.f);
    int w = __builtin_amdgcn_cvt_pk_fp8_f32(a, b, 0, false); w = __builtin_amdgcn_cvt_pk_fp8_f32(c_, d, w, true); return (unsigned)w;
}

template <class ColFn>
DI void conv_item(const float* W, int ldw, int k0, bf16* WT, int ldt, int dr0, int dk0, ColFn srccol, LAS float* scr, int lane) {
    const int n4 = (lane & 7) * 4; const int sc = srccol(dr0 + n4);
#pragma unroll
    for (int i = 0; i < 8; ++i) { const int kk = 8 * i + (lane >> 3);
        const f32x4 v = sc >= 0 ? *(const f32x4*)(W + (size_t)(k0 + kk) * ldw + sc) : (f32x4){0.f, 0.f, 0.f, 0.f};
        LAS float* s = scr + kk * 33 + n4; s[0] = v.x; s[1] = v.y; s[2] = v.z; s[3] = v.w; }
    LDS_WAIT(); asm volatile("" ::: "memory");
    const int c = lane & 7;
#pragma unroll
    for (int j = 0; j < 4; ++j) { const int n = (lane >> 3) + 8 * j; const LAS float* s = scr + (8 * c) * 33 + n;
        u32x4 o; o.x = pk2(s[0 * 33], s[1 * 33]); o.y = pk2(s[2 * 33], s[3 * 33]); o.z = pk2(s[4 * 33], s[5 * 33]); o.w = pk2(s[6 * 33], s[7 * 33]);
        *(u32x4*)(WT + (size_t)(dr0 + n) * ldt + dk0 + k0 + 8 * c) = o; }
    LDS_WAIT(); asm volatile("" ::: "memory");
}
template <class ColFn>
DI void conv_item8(const float* W, int ldw, int k0, unsigned char* WT, int ldt, int dr0, float scale, ColFn srccol, LAS float* scr, int lane) {
    const int n4 = (lane & 7) * 4; const int sc = srccol(dr0 + n4);
#pragma unroll
    for (int i = 0; i < 8; ++i) { const int kk = 8 * i + (lane >> 3);
        const f32x4 v = sc >= 0 ? *(const f32x4*)(W + (size_t)(k0 + kk) * ldw + sc) : (f32x4){0.f, 0.f, 0.f, 0.f};
        LAS float* s = scr + kk * 33 + n4; s[0] = v.x; s[1] = v.y; s[2] = v.z; s[3] = v.w; }
    LDS_WAIT(); asm volatile("" ::: "memory");
    const int c = lane & 7;
#pragma unroll
    for (int j = 0; j < 4; ++j) { const int n = (lane >> 3) + 8 * j; const LAS float* s = scr + (8 * c) * 33 + n;
        u32x2 o; o.x = pk4_fp8(s[0 * 33] * scale, s[1 * 33] * scale, s[2 * 33] * scale, s[3 * 33] * scale); o.y = pk4_fp8(s[4 * 33] * scale, s[5 * 33] * scale, s[6 * 33] * scale, s[7 * 33] * scale);
        *(u32x2*)(WT + (size_t)(dr0 + n) * ldt + k0 + 8 * c) = o; }
    LDS_WAIT(); asm volatile("" ::: "memory");
}
template <class ColFn>
DI bool conv_job8(int& it, const float* W, int ldw, int K, int nb, unsigned char* WT, int ldt, float scale, ColFn f, LAS float* scr, int lane) {
    const int n_items = (K / 64) * nb;
    if (it >= n_items) { it -= n_items; return false; }
    const int kb = it / nb, b = it % nb;
    conv_item8(W, ldw, 64 * kb, WT, ldt, 32 * b, scale, f, scr, lane);
    return true;
}
struct ColIdent { int c0; DI int operator()(int r) const { return c0 + r; } };
struct ColFfn { DI int operator()(int r) const { const int tile = r >> 8, j = r & 255; return j < 128 ? tile * 128 + j : FF + tile * 128 + (j - 128); } };
struct ColInproj { DI int operator()(int r) const { return r < 3072 ? r : (r < 5192 ? r + 16 : (r < 5208 ? 3072 + (r - 5192) : -1)); } };
template <class ColFn>
DI bool conv_job(int& it, const float* W, int ldw, int K, int nb, bf16* WT, int ldt, ColFn f, LAS float* scr, int lane) {
    const int n_items = (K / 64) * nb;
    if (it >= n_items) { it -= n_items; return false; }
    const int kb = it / nb, b = it % nb;
    conv_item(W, ldw, 64 * kb, WT, ldt, 32 * b, 0, f, scr, lane);
    return true;
}
template <int NR, bool O8 = false  >
DI void rms_rows_bf16(const float* xrow, const float* g, bf16* orow, int lane, size_t rstride) {
    f32x4 v[NR][4]; float s[NR];
#pragma unroll
    for (int q = 0; q < NR; ++q) { const f32x4* xr = (const f32x4*)(xrow + q * rstride) + lane; float a = 0.f;
#pragma unroll
        for (int j = 0; j < 4; ++j) { v[q][j] = xr[64 * j]; a += (v[q][j].x * v[q][j].x + v[q][j].y * v[q][j].y) + (v[q][j].z * v[q][j].z + v[q][j].w * v[q][j].w); }
        s[q] = a; }
    const f32x4* gr = (const f32x4*)g + lane; f32x4 gg[4];
#pragma unroll
    for (int j = 0; j < 4; ++j) gg[j] = gr[64 * j];
#pragma unroll
    for (int o = 1; o < 64; o <<= 1)
#pragma unroll
        for (int q = 0; q < NR; ++q) s[q] += __shfl_xor(s[q], o);
#pragma unroll
    for (int q = 0; q < NR; ++q) { const float r = __builtin_amdgcn_rsqf(s[q] * (1.f / D) + EPS);
        if (O8) { const float r16 = r * 16.f; unsigned* o4 = (unsigned*)((unsigned char*)orow + q * rstride) + lane;
#pragma unroll
            for (int j = 0; j < 4; ++j) o4[64 * j] = pk4_fp8(v[q][j].x * r16 * gg[j].x, v[q][j].y * r16 * gg[j].y, v[q][j].z * r16 * gg[j].z, v[q][j].w * r16 * gg[j].w);
        } else { u32x2* o8 = (u32x2*)(orow + q * rstride) + lane;
#pragma unroll
        for (int j = 0; j < 4; ++j) { u32x2 w; w.x = pk2(v[q][j].x * r * gg[j].x, v[q][j].y * r * gg[j].y); w.y = pk2(v[q][j].z * r * gg[j].z, v[q][j].w * r * gg[j].w); o8[64 * j] = w; } } }
}
template <int NR, bool XN8, bool HIN16, bool HOUT16>
DI void resnorm_rows(const void* hin, const bf16* yrow, const float* gpost, float coef, void* hout, const float* gpre, void* xn, int lane, bool do_store, size_t rstride  ) {
    f32x4 y[NR][4], h[NR][4]; float s[NR], s2[NR];
#pragma unroll
    for (int q = 0; q < NR; ++q) { const u32x2* yr = (const u32x2*)(yrow + q * rstride) + lane;
#pragma unroll
        for (int j = 0; j < 4; ++j) { const u32x2 w = yr[64 * j]; y[q][j] = (f32x4){bflo(w.x), bfhi(w.x), bflo(w.y), bfhi(w.y)};
            if (HIN16) { const u32x2 hw = ((const u32x2*)((const bf16*)hin + q * rstride) + lane)[64 * j]; h[q][j] = (f32x4){bflo(hw.x), bfhi(hw.x), bflo(hw.y), bfhi(hw.y)}; }
            else h[q][j] = ((const f32x4*)((const float*)hin + q * rstride) + lane)[64 * j]; } }
    const f32x4* gp = (const f32x4*)gpost + lane; f32x4 g[4];
#pragma unroll
    for (int j = 0; j < 4; ++j) g[j] = gp[64 * j];
#pragma unroll
    for (int q = 0; q < NR; ++q) { float a = 0.f;
#pragma unroll
        for (int j = 0; j < 4; ++j) a += (y[q][j].x * y[q][j].x + y[q][j].y * y[q][j].y) + (y[q][j].z * y[q][j].z + y[q][j].w * y[q][j].w);
        s[q] = a; }
#pragma unroll
    for (int o = 1; o < 64; o <<= 1)
#pragma unroll
        for (int q = 0; q < NR; ++q) s[q] += __shfl_xor(s[q], o);
#pragma unroll
    for (int q = 0; q < NR; ++q) { const float r = __builtin_amdgcn_rsqf(s[q] * (1.f / D) + EPS) * coef; float a = 0.f;
#pragma unroll
        for (int j = 0; j < 4; ++j) { h[q][j] = h[q][j] + y[q][j] * r * g[j]; a += (h[q][j].x * h[q][j].x + h[q][j].y * h[q][j].y) + (h[q][j].z * h[q][j].z + h[q][j].w * h[q][j].w); }
        s2[q] = a;
        if (do_store) {
            if (HOUT16) { u32x2* ho = (u32x2*)((bf16*)hout + q * rstride) + lane;
#pragma unroll
                for (int j = 0; j < 4; ++j) { u32x2 w; w.x = pk2(h[q][j].x, h[q][j].y); w.y = pk2(h[q][j].z, h[q][j].w); ho[64 * j] = w; } }
            else { f32x4* ho = (f32x4*)((float*)hout + q * rstride) + lane;
#pragma unroll
                for (int j = 0; j < 4; ++j) ho[64 * j] = h[q][j]; } } }
    if (xn) {
        const f32x4* gq = (const f32x4*)gpre + lane;
#pragma unroll
        for (int j = 0; j < 4; ++j) g[j] = gq[64 * j];
#pragma unroll
        for (int o = 1; o < 64; o <<= 1)
#pragma unroll
            for (int q = 0; q < NR; ++q) s2[q] += __shfl_xor(s2[q], o);
#pragma unroll
        for (int q = 0; q < NR; ++q) { const float r2 = __builtin_amdgcn_rsqf(s2[q] * (1.f / D) + EPS);
            if (XN8) { const float r16 = r2 * 16.f; unsigned* o4 = (unsigned*)((unsigned char*)xn + q * rstride) + lane;
#pragma unroll
                for (int j = 0; j < 4; ++j) o4[64 * j] = pk4_fp8(h[q][j].x * r16 * g[j].x, h[q][j].y * r16 * g[j].y, h[q][j].z * r16 * g[j].z, h[q][j].w * r16 * g[j].w);
            } else { u32x2* o8 = (u32x2*)((bf16*)xn + q * rstride) + lane;
#pragma unroll
            for (int j = 0; j < 4; ++j) { u32x2 w; w.x = pk2(h[q][j].x * r2 * g[j].x, h[q][j].y * r2 * g[j].y); w.y = pk2(h[q][j].z * r2 * g[j].z, h[q][j].w * r2 * g[j].w); o8[64 * j] = w; } } }
    }
}
template <bool XN8, bool HIN16, bool HOUT16>
DI void resnorm_phase(Frame& F, const void* hin, const bf16* y, const float* gpost, float coef, void* hout, const float* gpre, void* xn, bool do_store = true) {
    const int gw = F.c * NWAVES + F.wave, NGW = F.G * NWAVES;
    const size_t hi_b = HIN16 ? 2 : 4, ho_b = HOUT16 ? 2 : 4, xn_b = XN8 ? 1 : 2;
    int m = gw;
    for (; m + NGW < M; m += 2 * NGW)
        resnorm_rows<2, XN8, HIN16, HOUT16>((const char*)hin + (size_t)m * D * hi_b, y + (size_t)m * D, gpost, coef, (char*)hout + (size_t)m * D * ho_b, gpre, xn ? (char*)xn + (size_t)m * D * xn_b : nullptr, F.lane, do_store, (size_t)NGW * D);
    for (; m < M; m += NGW)
        resnorm_rows<1, XN8, HIN16, HOUT16>((const char*)hin + (size_t)m * D * hi_b, y + (size_t)m * D, gpost, coef, (char*)hout + (size_t)m * D * ho_b, gpre, xn ? (char*)xn + (size_t)m * D * xn_b : nullptr, F.lane, do_store, 0);
}

using pg8::Unit;
typedef f32x4 Acc[2][2][4][2];
struct EpiStore {
    bf16* O; int ldo; float sc = 1.f;
    DI bool operator()(Acc& acc, const Unit& u, int wr, int wc, int fr, int fq) const {
        const int row0 = u.pm * 256 + wr * 64 + fr, col0 = u.pn * 256 + wc * 32 + 8 * fq;
#pragma unroll
        for (int ai = 0; ai < 2; ++ai)
#pragma unroll
            for (int m = 0; m < 4; ++m) { bf16* rowp = O + (size_t)(row0 + ai * 128 + m * 16) * ldo + col0;
#pragma unroll
                for (int bj = 0; bj < 2; ++bj) { const f32x4 v0 = acc[ai][bj][m][0] * sc, v1 = acc[ai][bj][m][1] * sc;
                    u32x4 w; w.x = pk2(v0[0], v0[1]); w.y = pk2(v0[2], v0[3]); w.z = pk2(v1[0], v1[1]); w.w = pk2(v1[2], v1[3]);
                    *(u32x4*)(rowp + bj * 128) = w; } }
        return false;
    }
};
struct EpiGates {
    bf16* SGA; bf16* SGB;
    DI bool operator()(Acc& acc, const Unit& u, int wr, int wc, int fr, int fq) const {
        bf16* O = u.pn < 4 ? SGA : SGB;
        const int row0 = u.pm * 256 + wr * 64 + fr, col0 = (u.pn & 3) * 256 + wc * 32 + 8 * fq;
#pragma unroll
        for (int ai = 0; ai < 2; ++ai)
#pragma unroll
            for (int m = 0; m < 4; ++m) { bf16* rowp = O + (size_t)(row0 + ai * 128 + m * 16) * 1024 + col0;
#pragma unroll
                for (int bj = 0; bj < 2; ++bj) { const f32x4 v0 = acc[ai][bj][m][0], v1 = acc[ai][bj][m][1];
                    u32x4 w; w.x = pk2(sigmoid_f(v0[0]), sigmoid_f(v0[1])); w.y = pk2(sigmoid_f(v0[2]), sigmoid_f(v0[3])); w.z = pk2(sigmoid_f(v1[0]), sigmoid_f(v1[1])); w.w = pk2(sigmoid_f(v1[2]), sigmoid_f(v1[3]));
                    *(u32x4*)(rowp + bj * 128) = w; } }
        return false;
    }
};
struct EpiSwiglu {
    bf16* H;
    DI bool operator()(Acc& acc, const Unit& u, int wr, int wc, int fr, int fq) const {
        const int row0 = u.pm * 256 + wr * 64 + fr, col0 = u.pn * 128 + wc * 32 + 8 * fq;
#pragma unroll
        for (int ai = 0; ai < 2; ++ai)
#pragma unroll
            for (int m = 0; m < 4; ++m) { bf16* rowp = H + (size_t)(row0 + ai * 128 + m * 16) * FF + col0;
                float o[8];
#pragma unroll
                for (int n = 0; n < 2; ++n)
#pragma unroll
                    for (int e = 0; e < 4; ++e) { const float a = acc[ai][0][m][n][e], b = acc[ai][1][m][n][e]; o[4 * n + e] = a * sigmoid_f(a) * b; }
                u32x4 w; w.x = pk2(o[0], o[1]); w.y = pk2(o[2], o[3]); w.z = pk2(o[4], o[5]); w.w = pk2(o[6], o[7]);
                *(u32x4*)rowp = w; }
        return false;
    }
};
struct EpiSwiglu8 {
    unsigned char* H;
    DI bool operator()(Acc& acc, const Unit& u, int wr, int wc, int fr, int fq) const {
        const int row0 = u.pm * 256 + wr * 64 + fr, col0 = u.pn * 128 + wc * 32 + 8 * fq;
        const float si = 1.f / 1024.f;
#pragma unroll
        for (int ai = 0; ai < 2; ++ai)
#pragma unroll
            for (int m = 0; m < 4; ++m) { unsigned char* rowp = H + (size_t)(row0 + ai * 128 + m * 16) * FF + col0;
                float o[8];
#pragma unroll
                for (int n = 0; n < 2; ++n)
#pragma unroll
                    for (int e = 0; e < 4; ++e) { const float a = acc[ai][0][m][n][e] * si, b = acc[ai][1][m][n][e] * si; o[4 * n + e] = a * sigmoid_f(a) * b * 8.f; }
                u32x2 w; w.x = pk4_fp8(o[0], o[1], o[2], o[3]); w.y = pk4_fp8(o[4], o[5], o[6], o[7]);
                *(u32x2*)rowp = w; }
        return false;
    }
};
constexpr size_t DO_W2 = 32 * MiB, DO_IKT = 44 * MiB;
struct EpiInproj {
    unsigned char* ws; unsigned char* dout;
    DI bool operator()(Acc& acc, const Unit& u, int wr, int wc, int fr, int fq) const {
        bf16* O; int ldo, ct; bool half_only = false; float sc = 1.f;
        if (u.g == 1) { O = (bf16*)(ws + WS_KVM); ldo = 1024; ct = u.pn; }
        else if (u.pn < 4) { O = (bf16*)(ws + WS_QKG); ldo = 1024; ct = u.pn; }
        else if (u.pn < 8) { O = (bf16*)(ws + WS_GV); ldo = 1024; ct = u.pn - 4; }
        else if (u.pn < 12) { O = (bf16*)(ws + WS_GR); ldo = 1024; ct = u.pn - 8; }
        else if (u.pn < 18) { O = (bf16*)(ws + WS_DQKV); ldo = 1536; ct = u.pn - 12; if (u.pn < 14) sc = 0.125f * LOG2E; }
        else if (u.pn < 20) { O = (bf16*)(ws + WS_IQ); ldo = 512; ct = u.pn - 18; }
        else { O = (bf16*)(ws + WS_SM); ldo = 128; ct = 0; half_only = true; }
        const int row0 = u.pm * 256 + wr * 64 + fr, col0 = ct * 256 + wc * 32 + 8 * fq;
#pragma unroll
        for (int ai = 0; ai < 2; ++ai)
#pragma unroll
            for (int m = 0; m < 4; ++m) { bf16* rowp = O + (size_t)(row0 + ai * 128 + m * 16) * ldo + col0;
#pragma unroll
                for (int bj = 0; bj < 2; ++bj) { const f32x4 v0 = acc[ai][bj][m][0] * sc, v1 = acc[ai][bj][m][1] * sc;
                    u32x4 w; w.x = pk2(v0[0], v0[1]); w.y = pk2(v0[2], v0[3]); w.z = pk2(v1[0], v1[1]); w.w = pk2(v1[2], v1[3]);
                    if (bj == 0 || !half_only) *(u32x4*)(rowp + bj * 128) = w;
                    if (half_only && bj == 0 && wc < 2) {
                        const int r = row0 + ai * 128 + m * 16, c0 = wc * 32 + 8 * fq;
                        *(u32x4*)(dout + DO_IKT + ((size_t)((r >> 5) * 4 + (c0 >> 4)) * 64 + (r & 31) + 32 * ((c0 >> 3) & 1)) * 16) = w; } } }
        return false;
    }
};
struct EpiMerge {
    const bf16* SGA; const bf16* SGB; bf16* O;
    DI bool operator()(Acc& acc, const Unit& u, int wr, int wc, int fr, int fq) const {
        const int row0 = u.pm * 256 + wr * 64 + fr, col0 = u.pn * 256 + wc * 32 + 8 * fq;
#pragma unroll
        for (int ai = 0; ai < 2; ++ai)
#pragma unroll
            for (int m = 0; m < 4; ++m) { const size_t off = (size_t)(row0 + ai * 128 + m * 16) * 1024 + col0;
#pragma unroll
                for (int bj = 0; bj < 2; ++bj) {
                    const u32x4 gb = *(const u32x4*)(SGB + off + bj * 128);
                    const float b[8] = {bflo(gb.x), bfhi(gb.x), bflo(gb.y), bfhi(gb.y), bflo(gb.z), bfhi(gb.z), bflo(gb.w), bfhi(gb.w)};
                    if (u.g == 0) {
                        const u32x4 ga = *(const u32x4*)(SGA + off + bj * 128);
                        const float a[8] = {bflo(ga.x), bfhi(ga.x), bflo(ga.y), bfhi(ga.y), bflo(ga.z), bfhi(ga.z), bflo(ga.w), bfhi(ga.w)};
#pragma unroll
                        for (int n = 0; n < 2; ++n)
#pragma unroll
                            for (int e = 0; e < 4; ++e) acc[ai][bj][m][n][e] *= a[4 * n + e] * fast_rcp(fmaxf(b[4 * n + e], 1e-30f));
                    } else {
                        const f32x4 v0 = acc[ai][bj][m][0], v1 = acc[ai][bj][m][1];
                        u32x4 w; w.x = pk2(v0[0] * b[0], v0[1] * b[1]); w.y = pk2(v0[2] * b[2], v0[3] * b[3]); w.z = pk2(v1[0] * b[4], v1[1] * b[5]); w.w = pk2(v1[2] * b[6], v1[3] * b[7]);
                        *(u32x4*)(O + off + bj * 128) = w;
                    } } }
        return u.g == 0;
    }
};

constexpr int GP = 272;
constexpr int LAP = 528;
template <bool GC_MODE>
DI void gla_prep(Frame& F, const float* const* in, int h, size_t row0, unsigned R0, unsigned R1, LAS float* bend, float* dec_out) {
    const int l = F.lane, w = F.wave, hh = l >> 5, c31 = l & 31;
    const bf16* SM = (const bf16*)(F.ws + WS_SM); const bf16* QKG = (const bf16*)(F.ws + WS_QKG);
    const float* wup = in[9]; const float* bal = in[10];
    const unsigned LA = R1;
    {
        const bf16x8 ga = *(const bf16x8*)(SM + (row0 + 32 * w + c31) * 128 + 72 + 8 * hh);
        f32x16 zero;
#pragma unroll
        for (int r = 0; r < 16; ++r) zero[r] = 0.f;
#pragma unroll
        for (int dt = 0; dt < 4; ++dt) { const int d = 32 * dt + c31;
            float wf[8];
#pragma unroll
            for (int j = 0; j < 8; ++j) wf[j] = wup[(8 * hh + j) * 512 + h * 128 + d];
            const f32x16 C = MFMA32(ga, pack8(wf[0], wf[1], wf[2], wf[3], wf[4], wf[5], wf[6], wf[7]), zero);
            const float bias = bal[h * 128 + d];
#pragma unroll
            for (int g = 0; g < 4; ++g) { float la[4];
#pragma unroll
                for (int i = 0; i < 4; ++i) { const float x = C[4 * g + i] + bias; la[i] = (fminf(x, 0.f) - __logf(1.f + fast_exp(-fabsf(x)))) * 0.0625f; }
                u32x2 o; o.x = pk2(la[0], la[1]); o.y = pk2(la[2], la[3]);
                *(LAS u32x2*)(LA + d * LAP + (32 * w + 8 * g + 4 * hh) * 2) = o; }
        }
    }
    __syncthreads();
    f32x16 Bc[4];
    {
#pragma unroll
        for (int dt = 0; dt < 4; ++dt)
#pragma unroll
            for (int r = 0; r < 16; ++r) Bc[dt][r] = 0.f;
        const unsigned la_lane = LA + c31 * LAP + 16 * hh;
        const bf16x8 ones = __builtin_bit_cast(bf16x8, (u32x4){0x3F803F80u, 0x3F803F80u, 0x3F803F80u, 0x3F803F80u});
        for (int s = 0; s < 2 * w; ++s) {
#pragma unroll
            for (int dt = 0; dt < 4; ++dt) Bc[dt] = MFMA32(lds_b128(la_lane + 32 * dt * LAP + 32 * s), ones, Bc[dt]);
        }
#pragma unroll
        for (int s2 = 0; s2 < 2; ++s2) {
            unsigned short v[8];
#pragma unroll
            for (int j = 0; j < 8; ++j) v[j] = (16 * s2 + 8 * hh + j <= c31) ? (unsigned short)0x3F80 : (unsigned short)0;
            u32x4 p; p.x = v[0] | ((unsigned)v[1] << 16); p.y = v[2] | ((unsigned)v[3] << 16); p.z = v[4] | ((unsigned)v[5] << 16); p.w = v[6] | ((unsigned)v[7] << 16);
            const bf16x8 tri = __builtin_bit_cast(bf16x8, p);
#pragma unroll
            for (int dt = 0; dt < 4; ++dt) Bc[dt] = MFMA32(lds_b128(la_lane + 32 * dt * LAP + 32 * (2 * w + s2)), tri, Bc[dt]);
        }
        if (w == 7 && c31 == 31) {
#pragma unroll
            for (int dt = 0; dt < 4; ++dt)
#pragma unroll
                for (int r = 0; r < 16; ++r) bend[32 * dt + crow(r, hh)] = Bc[dt][r];
        }
    }
    __syncthreads();
    {
        const size_t row = row0 + 32 * w + c31;
        const float qs = 0.08838834764831845f;
#pragma unroll
        for (int dt = 0; dt < 4; ++dt)
#pragma unroll
            for (int g = 0; g < 4; ++g) { const int d0 = 32 * dt + 8 * g + 4 * hh;
                const u32x2 kk = *(const u32x2*)(QKG + row * 1024 + 512 + h * 128 + d0);
                const float k0 = bflo(kk.x), k1 = bfhi(kk.x), k2 = bflo(kk.y), k3 = bfhi(kk.y);
                const float b0 = Bc[dt][4 * g], b1 = Bc[dt][4 * g + 1], b2 = Bc[dt][4 * g + 2], b3 = Bc[dt][4 * g + 3];
                if (GC_MODE) {
                    const u32x2 qq = *(const u32x2*)(QKG + row * 1024 + h * 128 + d0);
                    u32x2 o; o.x = pk2(bflo(qq.x) * qs * fast_exp(b0), bfhi(qq.x) * qs * fast_exp(b1)); o.y = pk2(bflo(qq.y) * qs * fast_exp(b2), bfhi(qq.y) * qs * fast_exp(b3));
                    *(LAS u32x2*)(R0 + (32 * w + c31) * GP + d0 * 2) = o;
                    u32x2 p; p.x = pk2(k0 * fast_exp(-b0), k1 * fast_exp(-b1)); p.y = pk2(k2 * fast_exp(-b2), k3 * fast_exp(-b3));
                    *(LAS u32x2*)(R1 + (32 * w + c31) * GP + d0 * 2) = p;
                } else {
                    const f32x4 be = *(const LAS f32x4*)(bend + d0);
                    u32x2 p; p.x = pk2(k0 * fast_exp(be.x - b0), k1 * fast_exp(be.y - b1)); p.y = pk2(k2 * fast_exp(be.z - b2), k3 * fast_exp(be.w - b3));
                    *(LAS u32x2*)(R0 + (32 * w + c31) * GP + d0 * 2) = p;
                } }
        if (!GC_MODE && w == 0) { dec_out[l] = fast_exp(bend[l]); dec_out[64 + l] = fast_exp(bend[64 + l]); }
    }
}
DI unsigned tr_lane(int pitch, int hmul, int lane) { const int i16 = lane & 15, q = i16 >> 2, p = i16 & 3, blk = (lane >> 4) & 1; return (unsigned)((hmul * (lane >> 5) + q) * pitch + (16 * blk + 4 * p) * 2); }
DI bf16x8 tr_frag(unsigned base_lane, int pitch, int row_lo, int row_hi, int n0) {
    return cat4(vtr(base_lane + (unsigned)(row_lo * pitch + n0 * 2)), vtr(base_lane + (unsigned)(row_hi * pitch + n0 * 2)));
}
DI void gla_load_v_half(Frame& F, unsigned vh, size_t row0, int h, int half) {
    const bf16* GV = (const bf16*)(F.ws + WS_GV);
#pragma unroll
    for (int it = 0; it < 8; ++it) { const int idx = it * NT + F.tid, row = idx >> 4, ch = idx & 15;
        const u32x4 v = *(const u32x4*)(GV + (row0 + row) * 1024 + h * 256 + half * 128 + ch * 8);
        *(LAS u32x4*)(vh + row * GP + ch * 16) = v; }
}
DI void gla_state_unit(Frame& F, const float* const* in, int u) {
    const int l = F.lane, w = F.wave, hh = l >> 5;
    const int bh = u >> 5, b = bh >> 2, h = bh & 3, sc = u & 31; const size_t row0 = (size_t)b * T + sc * 256;
    const unsigned KH = (unsigned)(size_t)F.lds, VH = KH + 256 * GP; LAS float* tot = (LAS float*)(F.lds + 2 * 256 * GP);
    const bf16* QKG = (const bf16*)(F.ws + WS_QKG);
    float* GST = (float*)(F.ws + WS_GST); float* DEC = (float*)(F.ws + WS_DEC);
    gla_prep<false>(F, in, h, row0, KH, VH, tot, DEC + (size_t)u * 128);
    const int etile = w >> 1, dt0 = 2 * (w & 1);
    const unsigned vhl = VH + tr_lane(GP, 8, l) + etile * 64, khl = KH + tr_lane(GP, 8, l) + dt0 * 64;
    for (int half = 0; half < 2; ++half) {
        gla_load_v_half(F, VH, row0, h, half);
        __syncthreads();
        f32x16 acc0, acc1;
#pragma unroll
        for (int r = 0; r < 16; ++r) { acc0[r] = 0.f; acc1[r] = 0.f; }
#pragma unroll 4
        for (int s = 0; s < 16; ++s) {
            const bf16x8 a = tr_frag(vhl, GP, 16 * s, 16 * s + 4, 0);
            const bf16x8 b0 = tr_frag(khl, GP, 16 * s, 16 * s + 4, 0), b1 = tr_frag(khl, GP, 16 * s, 16 * s + 4, 32);
            acc0 = MFMA32(a, b0, acc0); acc1 = MFMA32(a, b1, acc1);
        }
#pragma unroll
        for (int r = 0; r < 16; ++r) { const int e = half * 128 + etile * 32 + crow(r, hh); float* o = GST + ((size_t)u * 256 + e) * 128 + dt0 * 32 + (l & 31); o[0] = acc0[r]; o[32] = acc1[r]; }
        __syncthreads();
    }
}
DI void gla_scan_phase(Frame& F, bool do_store = true) {
    float* GST = (float*)(F.ws + WS_GST); const float* DEC = (const float*)(F.ws + WS_DEC);
    for (int idx = F.c * NT + F.tid; idx < 8 * 16384; idx += F.G * NT) {
        const int bh = idx >> 14, rem = idx & 16383, e = rem >> 6, d = (rem & 63) * 2;
        f32x2 st = {0.f, 0.f};
#pragma unroll 4
        for (int sc = 0; sc < 32; ++sc) { const int u = bh * 32 + sc; f32x2* p = (f32x2*)(GST + ((size_t)u * 256 + e) * 128 + d);
            const f32x2 uu = *p; const f32x2 dc = *(const f32x2*)(DEC + u * 128 + d); if (do_store) *p = st; st = dc * st + uu; }
        if (!do_store && st.x == 1.2345e-30f) GST[0] = st.y;
    }
}
DI void gla_out_unit(Frame& F, const float* const* in, int u, bool do_store = true) {
    const int l = F.lane, w = F.wave, hh = l >> 5;
    const int bh = u >> 5, b = bh >> 2, h = bh & 3, sc = u & 31; const size_t row0 = (size_t)b * T + sc * 256;
    const unsigned QS = (unsigned)(size_t)F.lds, KS = QS + 256 * GP; LAS float* tot = (LAS float*)(F.lds + 2 * 256 * GP);
    const bf16* QKG = (const bf16*)(F.ws + WS_QKG); const float* GST = (const float*)(F.ws + WS_GST); bf16* GR = (bf16*)(F.ws + WS_GR);
    gla_prep<true>(F, in, h, row0, QS, KS, tot, nullptr);
    __syncthreads();
    bf16x8 qf[8];
#pragma unroll
    for (int s = 0; s < 8; ++s) qf[s] = lds_b128(QS + (32 * w + (l & 31)) * GP + (16 * s + 8 * hh) * 2);
    __syncthreads();
    f32x16 acc[8];
#pragma unroll
    for (int et = 0; et < 8; ++et)
#pragma unroll
        for (int r = 0; r < 16; ++r) acc[et][r] = 0.f;
    const unsigned VH = QS;
#pragma unroll
    for (int half = 0; half < 2; ++half) {
        gla_load_v_half(F, VH, row0, h, half);
        __syncthreads();
        for (int j = 0; j <= w; ++j) {
            f32x16 X;
#pragma unroll
            for (int r = 0; r < 16; ++r) X[r] = 0.f;
            const unsigned ksj = KS + (l & 31) * GP + 16 * hh + 32 * j * GP, vhj = VH + tr_lane(GP, 4, l) + 32 * j * GP;
#pragma unroll
            for (int s = 0; s < 8; ++s) X = MFMA32(lds_b128(ksj + 32 * s), qf[s], X);
            if (j == w) {
#pragma unroll
                for (int r = 0; r < 16; ++r) if (crow(r, hh) > (l & 31)) X[r] = 0.f;
            }
            const bf16x8 xb0 = pack_step(X, 0), xb1 = pack_step(X, 1);
#pragma unroll
            for (int et = 0; et < 4; ++et) {
                const bf16x8 a0 = tr_frag(vhj, GP, 0, 8, et * 32), a1 = tr_frag(vhj, GP, 16, 24, et * 32);
                acc[half * 4 + et] = MFMA32(a0, xb0, acc[half * 4 + et]); acc[half * 4 + et] = MFMA32(a1, xb1, acc[half * 4 + et]);
            }
        }
        __syncthreads();
    }
    {
        const float* sg = GST + (size_t)u * 32768;
        int tv = F.tid; asm volatile("" : "+v"(tv));
        const float* sgl = sg + tv * 4; const unsigned dl = QS + (tv >> 5) * GP + (tv & 31) * 8;
#pragma unroll
        for (int i = 0; i < 16; i += 2) {
            const f32x4 v0 = *(const f32x4*)(sgl + i * 2048), v1 = *(const f32x4*)(sgl + (i + 1) * 2048);
            u32x2 o0, o1; o0.x = pk2(v0.x, v0.y); o0.y = pk2(v0.z, v0.w); o1.x = pk2(v1.x, v1.y); o1.y = pk2(v1.z, v1.w);
            *(LAS u32x2*)(dl + 16 * i * GP) = o0; *(LAS u32x2*)(dl + 16 * (i + 1) * GP) = o1;
        }
        __syncthreads();
        const unsigned sl = QS + (l & 31) * GP + 16 * hh;
#pragma unroll
        for (int et = 0; et < 8; ++et)
#pragma unroll
            for (int s = 0; s < 8; ++s) { acc[et] = MFMA32(lds_b128(sl + 32 * et * GP + 32 * s), qf[s], acc[et]); if ((s & 3) == 3) asm volatile("" ::: "memory"); }
    }
    float ss = 0.f;
#pragma unroll
    for (int et = 0; et < 8; ++et)
#pragma unroll
        for (int r = 0; r < 16; ++r) ss += acc[et][r] * acc[et][r];
    ss += __shfl_xor(ss, 32);
    const float rinv = __builtin_amdgcn_rsqf(ss * (1.f / 256.f) + EPS);
    const float* gn = in[11] + h * 256 + 4 * hh;
    bf16* orow = GR + (row0 + 32 * w + (l & 31)) * 1024 + h * 256 + 4 * hh;
#pragma unroll
    for (int et = 0; et < 8; ++et)
#pragma unroll
        for (int g = 0; g < 4; ++g) { const int e = et * 32 + 8 * g;
            const u32x2 gw = *(const u32x2*)(orow + e); const f32x4 gg = *(const f32x4*)(gn + e);
            const float r0 = bflo(gw.x), r1 = bfhi(gw.x), r2 = bflo(gw.y), r3 = bfhi(gw.y);
            u32x2 o; o.x = pk2(acc[et][4 * g] * rinv * gg.x * r0 * sigmoid_f(r0), acc[et][4 * g + 1] * rinv * gg.y * r1 * sigmoid_f(r1));
            o.y = pk2(acc[et][4 * g + 2] * rinv * gg.z * r2 * sigmoid_f(r2), acc[et][4 * g + 3] * rinv * gg.w * r3 * sigmoid_f(r3));
            if (do_store) *(u32x2*)(orow + e) = o; if (g == 3) __builtin_amdgcn_sched_barrier(0); }
}

DI void hist_find4(const u32x4 c, int lane, unsigned k, unsigned& bin, unsigned& above) {
    const unsigned s = c.x + c.y + c.z + c.w; unsigned suf = s;
#pragma unroll
    for (int o = 1; o < 64; o <<= 1) { const unsigned v = __shfl_down(suf, o); if (lane + o < 64) suf += v; }
    const unsigned excl = suf - s;
    const bool cross = excl < k && suf >= k;
    unsigned a = excl, bn = 0, ab = 0;
    if (a + c.w >= k) { bn = 4 * lane + 3; ab = a; } else { a += c.w;
        if (a + c.z >= k) { bn = 4 * lane + 2; ab = a; } else { a += c.z;
            if (a + c.y >= k) { bn = 4 * lane + 1; ab = a; } else { a += c.y; bn = 4 * lane; ab = a; } } }
    const unsigned long long m = __ballot(cross);
    const int src = m ? __builtin_ctzll(m) : 0;
    bin = __shfl(bn, src); above = __shfl(ab, src);
}
constexpr int IDX_H1 = 131072, IDX_H2 = IDX_H1 + 16384;
DI void idx_unit(Frame& F, int u, bool do_store = true, int mode = 0  ) {
    const int l = F.lane, w = F.wave, hh = l >> 5;
    const int b = u >> 10, t0 = (u & 1023) * 8; const size_t row0 = (size_t)b * T + t0;
    const bf16* IQ = (const bf16*)(F.ws + WS_IQ); const bf16* SM = (const bf16*)(F.ws + WS_SM);
    const unsigned SC = (unsigned)(size_t)F.lds; LAS unsigned* H1 = (LAS unsigned*)(F.lds + IDX_H1); LAS unsigned* H2 = (LAS unsigned*)(F.lds + IDX_H2);
    bf16x8 af[2][4]; float wv[2][16];
    {
        const int rho = l & 31;
#pragma unroll
        for (int tl = 0; tl < 2; ++tl) { const int q = 4 * tl + (rho >> 4) + 2 * ((rho >> 2) & 1), head = (rho & 3) + 4 * ((rho >> 3) & 1);
#pragma unroll
            for (int s = 0; s < 4; ++s) af[tl][s] = *(const bf16x8*)(IQ + (row0 + q) * 512 + head * 64 + 16 * s + 8 * hh);
#pragma unroll
            for (int r = 0; r < 16; ++r) { const int qq = 4 * tl + (r >> 3) + 2 * hh, hd = (r & 3) + 4 * ((r >> 2) & 1); wv[tl][r] = bf2f(SM[(row0 + qq) * 128 + 64 + hd]); } }
    }
#pragma unroll
    for (int i = 0; i < 8; ++i) H1[F.tid + i * NT] = 0u;
    __syncthreads();
    const int ntile = t0 / 32 + 1;
    const u32x4* kbase = (const u32x4*)(F.dout + DO_IKT) + (size_t)b * 256 * 256 + l;
    const unsigned hrep = (unsigned)(l & 3);
#define IDX_SCORE(CT, tl, b4, key, EDGE) do { float sc = (fl & 4) ? CT[8 * (b4)] : 0.f; \
        if (!(fl & 4)) _Pragma("unroll") for (int r = 0; r < 8; ++r) { const float xv = CT[8 * (b4) + r]; const int xi = __float_as_int(xv); sc = fmaf(wv[tl][8 * (b4) + r], __int_as_float(xi > 0 ? xi : 0), sc); } \
        const int q = 4 * (tl) + (b4) + 2 * hh; \
        const _Float16 hf = (_Float16)sc; unsigned h16 = (unsigned)__builtin_bit_cast(unsigned short, hf); \
        unsigned k16 = (h16 & 0x8000u) ? (~h16 & 0xffffu) : (h16 | 0x8000u); \
        if (fl & 8) { if (k16 == 0x12345u) H1[0] = k16; } else \
        if (EDGE) { const bool valid = (key) <= t0 + q; if (!valid) k16 = 0u; \
            *(LAS unsigned short*)(SC + q * 16384 + (key) * 2) = (unsigned short)k16; \
            if (valid) __hip_atomic_fetch_add(H1 + (q * 256 + (k16 >> 8)) * 2 + (hrep >> 1), 1u << (16 * (hrep & 1)), __ATOMIC_RELAXED, __HIP_MEMORY_SCOPE_WORKGROUP); } \
        else { *(LAS unsigned short*)(SC + q * 16384 + (key) * 2) = (unsigned short)k16; \
            __hip_atomic_fetch_add(H1 + (q * 256 + (k16 >> 8)) * 2 + (hrep >> 1), 1u << (16 * (hrep & 1)), __ATOMIC_RELAXED, __HIP_MEMORY_SCOPE_WORKGROUP); } } while (0)
#define IDX_MM(C0, C1, BF) do { _Pragma("unroll") for (int r = 0; r < 16; ++r) { C0[r] = 0.f; C1[r] = 0.f; } \
        if (fl & 2) { C0[0] = __int_as_float((int)BF[0][0]); C1[8] = __int_as_float((int)BF[3][1]); C0[8] = C1[8]; C1[0] = C0[0]; } else \
        _Pragma("unroll") for (int s = 0; s < 4; ++s) { C0 = MFMA32(af[0][s], BF[s], C0); C1 = MFMA32(af[1][s], BF[s], C1); } } while (0)
#define IDX_SC4(C0, C1, kt_, EDGE) do { const int key_ = 32 * (kt_) + (l & 31); IDX_SCORE(C0, 0, 0, key_, EDGE); IDX_SCORE(C0, 0, 1, key_, EDGE); IDX_SCORE(C1, 1, 0, key_, EDGE); IDX_SCORE(C1, 1, 1, key_, EDGE); } while (0)
#define IDX_LOAD(BF, kt_) do { if (!(fl & 1)) _Pragma("unroll") for (int s = 0; s < 4; ++s) BF[s] = __builtin_bit_cast(bf16x8, kbase[((kt_) * 4 + s) * 64]); } while (0)
    bf16x8 bA[4], bB[4], bC[4], bD[4];
    const int klast = ntile - 1;
    const int fl = mode >= 16 ? mode - 16 : 0;
    if (mode >= 16) { _Pragma("unroll") for (int s = 0; s < 4; ++s) { bA[s] = af[0][s]; bB[s] = af[1][s]; bC[s] = af[0][s]; bD[s] = af[1][s]; } }
    if (mode != 2 && mode != 8) {
        IDX_LOAD(bA, w < ntile ? w : klast); IDX_LOAD(bB, w + 8 < ntile ? w + 8 : klast);
        for (int kt = w; kt < ntile; kt += 32) {
            IDX_LOAD(bC, kt + 16 < ntile ? kt + 16 : klast); IDX_LOAD(bD, kt + 24 < ntile ? kt + 24 : klast);
            { f32x16 P0, P1, Q0, Q1; IDX_MM(P0, P1, bA); IDX_MM(Q0, Q1, bB);
              if (kt == klast) IDX_SC4(P0, P1, kt, true); else IDX_SC4(P0, P1, kt, false);
              if (kt + 8 < ntile) { if (kt + 8 == klast) IDX_SC4(Q0, Q1, kt + 8, true); else IDX_SC4(Q0, Q1, kt + 8, false); } }
            IDX_LOAD(bA, kt + 32 < ntile ? kt + 32 : klast); IDX_LOAD(bB, kt + 40 < ntile ? kt + 40 : klast);
            if (kt + 16 < ntile) { f32x16 P0, P1, Q0, Q1; IDX_MM(P0, P1, bC); IDX_MM(Q0, Q1, bD);
              if (kt + 16 == klast) IDX_SC4(P0, P1, kt + 16, true); else IDX_SC4(P0, P1, kt + 16, false);
              if (kt + 24 < ntile) { if (kt + 24 == klast) IDX_SC4(Q0, Q1, kt + 24, true); else IDX_SC4(Q0, Q1, kt + 24, false); } }
        }
    }
#undef IDX_SCORE
#undef IDX_MM
#undef IDX_SC4
#undef IDX_LOAD
    __syncthreads();
    if (mode == 0 || mode == 2)
    {
        const int t = t0 + w, n = t + 1, nit = (n + 511) >> 9;
        unsigned char* mrow = (unsigned char*)(F.ws + WS_IQ) + (row0 + w) * 1024;
        const unsigned scq = SC + w * 16384 + l * 16;
        LAS unsigned* H = H2 + w * 256;
        unsigned thr = 0u, rneed = 0u;
        if (n > 256) {
            unsigned B, above, L, above2;
            {
                const u32x4 a = *(const LAS u32x4*)(H1 + (w * 256 + 4 * l) * 2), bq = *(const LAS u32x4*)(H1 + (w * 256 + 4 * l) * 2 + 4);
                u32x4 cnt; cnt.x = (a.x & 0xffffu) + (a.x >> 16) + (a.y & 0xffffu) + (a.y >> 16); cnt.y = (a.z & 0xffffu) + (a.z >> 16) + (a.w & 0xffffu) + (a.w >> 16);
                cnt.z = (bq.x & 0xffffu) + (bq.x >> 16) + (bq.y & 0xffffu) + (bq.y >> 16); cnt.w = (bq.z & 0xffffu) + (bq.z >> 16) + (bq.w & 0xffffu) + (bq.w >> 16);
                hist_find4(cnt, l, 256u, B, above);
            }
            H[l] = 0u; H[l + 64] = 0u; H[l + 128] = 0u; H[l + 192] = 0u; LDS_WAIT();
            for (int it = 0; it < nit; ++it) { const u32x4 kk = *(const LAS u32x4*)(scq + it * 1024); const int i0 = 512 * it + 8 * l;
                const unsigned ks[8] = {kk.x & 0xffffu, kk.x >> 16, kk.y & 0xffffu, kk.y >> 16, kk.z & 0xffffu, kk.z >> 16, kk.w & 0xffffu, kk.w >> 16};
                bool m[8], any = false;
#pragma unroll
                for (int j = 0; j < 8; ++j) { m[j] = (i0 + j < n) && (ks[j] >> 8) == B; any = any || m[j]; }
                if (__ballot(any) == 0ull) continue;
#pragma unroll
                for (int j = 0; j < 8; ++j) if (m[j]) __hip_atomic_fetch_add(H + (ks[j] & 255u), 1u, __ATOMIC_RELAXED, __HIP_MEMORY_SCOPE_WORKGROUP); }
            LDS_WAIT(); hist_find4(*(const LAS u32x4*)(H + 4 * l), l, 256u - above, L, above2);
            thr = (B << 8) | L; rneed = 256u - above - above2;
        }
        unsigned running = 0u;
        for (int it = 0; it < nit; ++it) {
            const u32x4 kk = *(const LAS u32x4*)(scq + it * 1024); const int i0 = 512 * it + 8 * l;
            const unsigned ks[8] = {kk.x & 0xffffu, kk.x >> 16, kk.y & 0xffffu, kk.y >> 16, kk.z & 0xffffu, kk.z >> 16, kk.w & 0xffffu, kk.w >> 16};
            unsigned byte = 0u;
            if (n <= 256) {
#pragma unroll
                for (int j = 0; j < 8; ++j) byte |= (i0 + j < n) ? (1u << j) : 0u;
            } else {
                bool eq[8]; bool anyeq = false;
#pragma unroll
                for (int j = 0; j < 8; ++j) { eq[j] = (i0 + j < n) && ks[j] == thr; anyeq = anyeq || eq[j]; byte |= ((i0 + j < n) && ks[j] > thr) ? (1u << j) : 0u; }
                const unsigned long long anym = __ballot(anyeq);
                if (anym != 0ull) {
                    unsigned mine = 0u;
#pragma unroll
                    for (int j = 0; j < 8; ++j) mine += eq[j] ? 1u : 0u;
                    unsigned before = 0u; unsigned long long mm = anym;
                    while (mm) { const int src = __builtin_ctzll(mm); mm &= mm - 1; const unsigned v = (unsigned)__shfl((int)mine, src); if (src < l) before += v; }
                    unsigned cum = running + before; unsigned tot = 0u; mm = anym;
                    while (mm) { const int src = __builtin_ctzll(mm); mm &= mm - 1; tot += (unsigned)__shfl((int)mine, src); }
#pragma unroll
                    for (int j = 0; j < 8; ++j) { if (eq[j]) { if (cum < rneed) byte |= (1u << j); ++cum; } }
                    running += tot;
                }
            }
            if (do_store) mrow[it * 64 + l] = (unsigned char)byte;
        }
    }
    __syncthreads();
}

template <int DH, bool DSA, int VAR = 0>
DI void attn_unit(Frame& F, const bf16* Qp, int ldq, const bf16* Kp, const bf16* Vp, int ldkv, int nst, bf16* Op, int ldo, float c1,
                  const unsigned* mask0  , int tq0, const LAS float* BT, float cfar, bool do_store = true) {
    constexpr int PK = DH * 2 + 16  , PV = DH == 64 ? 192 : 320  ;
    constexpr int SBK = 64 * PK, SBV = 64 * PV, NS = DH / 16, ND = DH / 32, CH = DH / 8  , NLD = 64 * CH / NT;
    const int l = F.lane, w = F.wave, hh = l >> 5, tid = F.tid;
    const unsigned KT = (unsigned)(size_t)F.lds, VT = KT + 2 * SBK;
    const unsigned klane = (unsigned)((l & 31) * PK + 16 * hh), vlane = tr_lane(PV, 4, l);
    bf16x8 qf[NS];
#pragma unroll
    for (int s = 0; s < NS; ++s) qf[s] = *(const bf16x8*)(Qp + (size_t)(32 * w + (l & 31)) * ldq + 16 * s + 8 * hh);
    f32x16 O[ND];
#pragma unroll
    for (int d = 0; d < ND; ++d)
#pragma unroll
        for (int r = 0; r < 16; ++r) O[d][r] = 0.f;
    float lsum = 0.f;
    const int tq = tq0 + 32 * w + (l & 31), tq_hi = tq0 + 32 * w + 31, tq_lo = tq0 + 32 * w;
    const unsigned* mrow = DSA ? mask0 + (size_t)(32 * w + (l & 31)) * 256 : nullptr;
    u32x4 kr[NLD], vr[NLD];
    u32x2 mcur = {0u, 0u}, mnxt = {0u, 0u};
    if (DSA) mcur = *(const u32x2*)mrow;
#pragma unroll
    for (int i = 0; i < NLD; ++i) { const int idx = i * NT + tid, row = idx / CH, ch = idx % CH;
        kr[i] = *(const u32x4*)(Kp + (size_t)row * ldkv + ch * 8); vr[i] = *(const u32x4*)(Vp + (size_t)row * ldkv + ch * 8); }
#pragma unroll
    for (int i = 0; i < NLD; ++i) { const int idx = i * NT + tid, row = idx / CH, ch = idx % CH;
        *(LAS u32x4*)(KT + row * PK + ch * 16) = kr[i]; *(LAS u32x4*)(VT + row * PV + ch * 16) = vr[i]; }
    __syncthreads();
    __builtin_amdgcn_s_waitcnt(0x0F70);
    for (int st = 0; st < nst; ++st) {
        const unsigned kt = KT + (st & 1) * SBK, vt = VT + (st & 1) * SBV;
        const bool more = st + 1 < nst;
        if (more) {
#pragma unroll
            for (int i = 0; i < NLD; ++i) { const int idx = i * NT + tid, row = 64 * (st + 1) + idx / CH, ch = idx % CH;
                kr[i] = *(const u32x4*)(Kp + (size_t)row * ldkv + ch * 8); vr[i] = *(const u32x4*)(Vp + (size_t)row * ldkv + ch * 8); }
            if (DSA) mnxt = *(const u32x2*)(mrow + 2 * (st + 1));
        }
#pragma unroll
        for (int kb = 0; kb < 2; ++kb) {
            const int key0 = 64 * st + 32 * kb;
            if (VAR == 3) continue;
            if (DSA && key0 > tq_hi) continue;
            f32x16 X;
#pragma unroll
            for (int r = 0; r < 16; ++r) X[r] = 0.f;
#pragma unroll
            for (int s = 0; s < NS; ++s) X = MFMA32(lds_b128(kt + klane + 32 * kb * PK + 32 * s), qf[s], X);
            if (VAR == 2) { lsum += X[0]; }
            else if (DSA) {
                const unsigned mw = (kb ? mcur.y : mcur.x) >> (4 * hh);
                if (tq_lo - (key0 + 31) >= 113) {
#pragma unroll
                    for (int r = 0; r < 16; ++r) { const float p = fast_exp2(fmaf(X[r], c1, cfar)); const int bits = __builtin_amdgcn_sbfe((int)mw, (r & 3) + 8 * (r >> 2), 1);
                        const float pm = __uint_as_float(__float_as_uint(p) & (unsigned)bits); lsum += pm; X[r] = pm; }
                } else {
#pragma unroll
                    for (int r = 0; r < 16; ++r) { int di = tq - (key0 + crow(r, hh)); di = di < 0 ? 0 : (di > 127 ? 127 : di);
                        const float p = fast_exp2(fmaf(X[r], c1, BT[di])); const int bits = __builtin_amdgcn_sbfe((int)mw, (r & 3) + 8 * (r >> 2), 1);
                        const float pm = __uint_as_float(__float_as_uint(p) & (unsigned)bits); lsum += pm; X[r] = pm; }
                }
            } else {
#pragma unroll
                for (int r = 0; r < 16; ++r) { const float p = fast_exp2(X[r] * c1); lsum += p; X[r] = p; }
            }
            const bf16x8 xb0 = pack_step(X, 0), xb1 = pack_step(X, 1);
            if (VAR == 1) { asm volatile("" :: "v"(xb0), "v"(xb1)); }
            else {
#pragma unroll
            for (int d = 0; d < ND; ++d) {
                const bf16x8 a0 = tr_frag(vt + vlane, PV, 32 * kb, 32 * kb + 8, 32 * d), a1 = tr_frag(vt + vlane, PV, 32 * kb + 16, 32 * kb + 24, 32 * d);
                O[d] = MFMA32(a0, xb0, O[d]); O[d] = MFMA32(a1, xb1, O[d]);
            } }
        }
        asm volatile("" ::: "memory"); __builtin_amdgcn_sched_barrier(0);
        if (more) {
            const unsigned kn = KT + ((st + 1) & 1) * SBK, vn = VT + ((st + 1) & 1) * SBV;
#pragma unroll
            for (int i = 0; i < NLD; ++i) { const int idx = i * NT + tid, row = idx / CH, ch = idx % CH;
                *(LAS u32x4*)(kn + row * PK + ch * 16) = kr[i]; *(LAS u32x4*)(vn + row * PV + ch * 16) = vr[i]; }
            mcur = mnxt;
        }
        __syncthreads();
    }
    lsum += __shfl_xor(lsum, 32);
    const float inv = fast_rcp(lsum);
    bf16* orow = Op + (size_t)(32 * w + (l & 31)) * ldo;
#pragma unroll
    for (int d = 0; d < ND; ++d)
#pragma unroll
        for (int g = 0; g < 4; ++g) { u32x2 o; o.x = pk2(O[d][4 * g] * inv, O[d][4 * g + 1] * inv); o.y = pk2(O[d][4 * g + 2] * inv, O[d][4 * g + 3] * inv);
            if (do_store) *(u32x2*)(orow + 32 * d + 8 * g + 4 * hh) = o; }
}
DI int t5_bucket(int rel) {
    if (rel < 16) return rel;
    const float v = logf((float)rel * (1.f / 16.f)) / 2.0794415416798357f * 16.f;
    int lg = 16 + (int)v; return lg > 31 ? 31 : lg;
}
constexpr int A_PK = 144, A_PV = 192, A_SK = 128 * A_PK, A_SV = 128 * A_PV, A_BT = 2 * A_SK + 2 * A_SV;
#define A_SMR(r, pos) { const float p_ = (VAR == 4) ? X[r] : fast_exp2(X[r]); int t_ = -1; if (VAR != 5) asm("v_bfe_i32 %0, %1, %2, 1" : "=v"(t_) : "v"(mw_), "i"(pos)); const float pm_ = (VAR == 5) ? p_ : __uint_as_float(__float_as_uint(p_) & (unsigned)t_); if (VAR != 6) lsum += pm_; X[r] = pm_; }
#define A_SM16() do { A_SMR(0, 0) A_SMR(1, 1) A_SMR(2, 2) A_SMR(3, 3) A_SMR(4, 8) A_SMR(5, 9) A_SMR(6, 10) A_SMR(7, 11) A_SMR(8, 16) A_SMR(9, 17) A_SMR(10, 18) A_SMR(11, 19) A_SMR(12, 24) A_SMR(13, 25) A_SMR(14, 26) A_SMR(15, 27) } while (0)
template <int VAR = 0>
DI void dsa_att_unit(Frame& F, const float* const* in, int bh, int qb, bool do_store = true) {
    const int b = bh >> 3, h = bh & 7, l = F.lane, w = F.wave, hh = l >> 5, tid = F.tid;
    LAS float* BT = (LAS float*)(F.lds + A_BT);
    const float* tab = in[14];
    __syncthreads();
    if (tid < 128) BT[tid] = tab[t5_bucket(tid) * 8 + h] * LOG2E;
    const float cfar = tab[31 * 8 + h] * LOG2E;
    bf16* DQ = (bf16*)(F.ws + WS_DQKV);
    const size_t rowq = (size_t)b * T + qb * 256, rowk = (size_t)b * T;
    const bf16* Kp = DQ + rowk * 1536 + 512 + h * 64; const bf16* Vp = DQ + rowk * 1536 + 1024 + h * 64;
    const unsigned KT = (unsigned)(size_t)F.lds, VT = KT + 2 * A_SK;
    const unsigned klane = (unsigned)((l & 31) * A_PK + 16 * hh), vlane = tr_lane(A_PV, 4, l);
    bf16x8 qf[4];
#pragma unroll
    for (int s = 0; s < 4; ++s) qf[s] = *(const bf16x8*)(DQ + (rowq + 32 * w + (l & 31)) * 1536 + h * 64 + 16 * s + 8 * hh);
    f32x16 O[2], cf16;
#pragma unroll
    for (int r = 0; r < 16; ++r) { O[0][r] = 0.f; O[1][r] = 0.f; cf16[r] = cfar; }
    float lsum = 0.f;
    const int tq = qb * 256 + 32 * w + (l & 31), tq_lo = qb * 256 + 32 * w, tq_hi = tq_lo + 31, nst = 2 * (qb + 1);
    const u32x4* mrow = (const u32x4*)((const unsigned*)(F.ws + WS_IQ) + (rowq + 32 * w + (l & 31)) * 256);
    u32x4 kr[2], vr[2], mcur = mrow[0], mnxt = mcur;
#pragma unroll
    for (int i = 0; i < 2; ++i) { const int idx = i * NT + tid, row = idx >> 3, ch = idx & 7;
        kr[i] = *(const u32x4*)(Kp + (size_t)row * 1536 + ch * 8); vr[i] = *(const u32x4*)(Vp + (size_t)row * 1536 + ch * 8); }
#pragma unroll
    for (int i = 0; i < 2; ++i) { const int idx = i * NT + tid, row = idx >> 3, ch = idx & 7;
        *(LAS u32x4*)(KT + row * A_PK + ch * 16) = kr[i]; *(LAS u32x4*)(VT + row * A_PV + ch * 16) = vr[i]; }
    __syncthreads();
#define A_QK(Xv, kb, CI) do { Xv = MFMA32(lds_b128(kt + klane + 32 * (kb) * A_PK), qf[0], CI); Xv = MFMA32(lds_b128(kt + klane + 32 * (kb) * A_PK + 32), qf[1], Xv); \
        Xv = MFMA32(lds_b128(kt + klane + 32 * (kb) * A_PK + 64), qf[2], Xv); Xv = MFMA32(lds_b128(kt + klane + 32 * (kb) * A_PK + 96), qf[3], Xv); } while (0)
#define A_PVM(Xv, kb) do { const bf16x8 xb0_ = pack_step(Xv, 0), xb1_ = pack_step(Xv, 1); _Pragma("unroll") for (int d = 0; d < 2; ++d) { \
        const bf16x8 a0_ = tr_frag(vt + vlane, A_PV, 32 * (kb), 32 * (kb) + 8, 32 * d), a1_ = tr_frag(vt + vlane, A_PV, 32 * (kb) + 16, 32 * (kb) + 24, 32 * d); \
        O[d] = MFMA32(a0_, xb0_, O[d]); O[d] = MFMA32(a1_, xb1_, O[d]); } } while (0)
    __builtin_amdgcn_s_waitcnt(0x0F70);
    for (int st = 0; st < nst; ++st) {
        const unsigned kt = KT + (st & 1) * A_SK, vt = VT + (st & 1) * A_SV;
        const bool more = st + 1 < nst;
        if (more) {
#pragma unroll
            for (int i = 0; i < 2; ++i) { const int idx = i * NT + tid, row = 128 * (st + 1) + (idx >> 3), ch = idx & 7;
                kr[i] = *(const u32x4*)(Kp + (size_t)row * 1536 + ch * 8); vr[i] = *(const u32x4*)(Vp + (size_t)row * 1536 + ch * 8); }
            mnxt = mrow[st + 1];
        }
        asm volatile("" ::: "memory"); __builtin_amdgcn_sched_barrier(0);
        if (VAR != 3) {
        if (tq_lo - (128 * st + 127) >= 113) {
            f32x16 X, Y;
            A_QK(X, 0, cf16); A_QK(Y, 1, cf16);
            { const unsigned mw_ = mcur.x >> (4 * hh); A_SM16(); } A_PVM(X, 0);
            A_QK(X, 2, cf16);
            { f32x16& Xr = Y; const unsigned mw_ = mcur.y >> (4 * hh);
#define X Xr
              A_SM16();
#undef X
            } A_PVM(Y, 1);
            A_QK(Y, 3, cf16);
            { const unsigned mw_ = mcur.z >> (4 * hh); A_SM16(); } A_PVM(X, 2);
            { f32x16& Xr = Y; const unsigned mw_ = mcur.w >> (4 * hh);
#define X Xr
              A_SM16();
#undef X
            } A_PVM(Y, 3);
        } else {
#pragma unroll
            for (int kb = 0; kb < 4; ++kb) {
                const int key0 = 128 * st + 32 * kb;
                if (key0 > tq_hi) continue;
                f32x16 X, zero;
#pragma unroll
                for (int r = 0; r < 16; ++r) zero[r] = 0.f;
                const unsigned mw_ = (kb == 0 ? mcur.x : kb == 1 ? mcur.y : kb == 2 ? mcur.z : mcur.w) >> (4 * hh);
                if (tq_lo - (key0 + 31) >= 113) { A_QK(X, kb, cf16); }
                else { A_QK(X, kb, zero);
#pragma unroll
                    for (int r = 0; r < 16; ++r) { int di = tq - (key0 + crow(r, hh)); di = di < 0 ? 0 : (di > 127 ? 127 : di); X[r] += BT[di]; } }
                A_SM16();
                A_PVM(X, kb);
            }
        }
        }
        asm volatile("" ::: "memory"); __builtin_amdgcn_sched_barrier(0);
        if (more) {
            const unsigned kn = KT + ((st + 1) & 1) * A_SK, vn = VT + ((st + 1) & 1) * A_SV;
#pragma unroll
            for (int i = 0; i < 2; ++i) { const int idx = i * NT + tid, row = idx >> 3, ch = idx & 7;
                *(LAS u32x4*)(kn + row * A_PK + ch * 16) = kr[i]; *(LAS u32x4*)(vn + row * A_PV + ch * 16) = vr[i]; }
            mcur = mnxt;
        }
        __syncthreads();
    }
#undef A_QK
#undef A_PVM
    lsum += __shfl_xor(lsum, 32);
    const float inv = fast_rcp(lsum);
    bf16* orow = DQ + (rowq + 32 * w + (l & 31)) * 1536 + h * 64;
#pragma unroll
    for (int d = 0; d < 2; ++d)
#pragma unroll
        for (int g = 0; g < 4; ++g) { u32x2 o; o.x = pk2(O[d][4 * g] * inv, O[d][4 * g + 1] * inv); o.y = pk2(O[d][4 * g + 2] * inv, O[d][4 * g + 3] * inv);
            if (do_store) *(u32x2*)(orow + 32 * d + 8 * g + 4 * hh) = o; }
}
DI void cross_att_unit(Frame& F, int u) {
    const int b = u >> 7, h = (u >> 5) & 3, qb = u & 31;
    const bf16* QC = (const bf16*)(F.ws + WS_QC); const bf16* KVM = (const bf16*)(F.ws + WS_KVM); bf16* OX = (bf16*)(F.ws + WS_OX);
    const size_t rowq = (size_t)b * T + qb * 256;
    __syncthreads();
    attn_unit<128, false>(F, QC + rowq * 512 + h * 128, 512, KVM + (size_t)b * MEML * 1024 + h * 128, KVM + (size_t)b * MEML * 1024 + 512 + h * 128, 1024, MEML / 64,
                          OX + rowq * 512 + h * 128, 512, 0.08838834764831845f * LOG2E, nullptr, 0, nullptr, 0.f);
}

constexpr int N_PHASES = 19;
#ifndef MK_ONE_LAUNCH
#define MK_ONE_LAUNCH 1
#endif
__global__ void __launch_bounds__(NT, 2) mega_fwd(Args args) {
    extern __shared__ __attribute__((aligned(16))) unsigned char lds_raw[];
    Frame F;
    F.lds = (LAS unsigned char*)lds_raw; F.ws = args.ws; F.dout = (unsigned char*)args.out;
    F.tid = threadIdx.x; F.lane = F.tid & 63; F.wave = __builtin_amdgcn_readfirstlane(F.tid >> 6);
    F.G = gridDim.x; F.c = blockIdx.x;
    volatile LAS unsigned* MISC = (volatile LAS unsigned*)(F.lds + MISC_OFF);
    if (F.tid < 64) MISC[F.tid] = 0u;
    __syncthreads();
    unsigned* ctl = (unsigned*)(args.ws + WS_CTL);
    const int lo = args.ph_lo, hi = args.ph_hi;
    XcdBarrier bar; bar.bar = ctl + CW_BAR; bar.x = 0; bar.st = MISC + 8;
    if (hi - lo > 1) bar = xcd_barrier_post(ctl + CW_BAR, MISC + 8);
    const float* const* in = args.in;
    const bool st_ok = args.nostore == 0; const int sub = args.sub;
    unsigned char* ws = args.ws;
    const int gw = F.c * NWAVES + F.wave, NGW = F.G * NWAVES;
#ifndef PHMASK
#define PHMASK 0x7ffff
#endif
#define IN(k) (((PHMASK >> (k)) & 1) && lo <= (k) && (k) < hi)
#define SEAM(k) do { if ((k) + 1 < hi) xcd_barrier(bar); } while (0)
#ifndef DUP_PHASE
#define DUP_PHASE -1
#endif
#ifndef DUP_N
#define DUP_N 1
#endif
#define REPS(k) ((k) == DUP_PHASE ? 1 + DUP_N : 1)
#define FORREP(k) _Pragma("unroll 1") for (int rep = 0; rep < REPS(k); ++rep)
#define ST(k) (st_ok)
#define REPBAR(k) do { if (rep + 1 < REPS(k)) xcd_barrier(bar); } while (0)
    bf16* XN = (bf16*)(ws + WS_XN); bf16* HID = (bf16*)(ws + WS_HID); bf16* Y = (bf16*)(ws + WS_Y);
    bf16* W1A = (bf16*)(ws + WS_W1A); bf16* W1B = (bf16*)(ws + WS_W1B);

    if (IN(0)) { FORREP(0) {
        LAS float* scr = (LAS float*)(F.lds + F.wave * 16384);
        constexpr int NITEMS = 2816;
        for (int it0 = gw; it0 < NITEMS; it0 += NGW) { int it = it0;
            conv_job(it, in[4], 2 * FF, D, 2 * FF / 32, W1A, D, ColFfn{}, scr, F.lane);
        }
        { int m = gw;
          for (; m + 3 * NGW < M; m += 4 * NGW) rms_rows_bf16<4>(in[0] + (size_t)m * D, in[2], XN + (size_t)m * D, F.lane, (size_t)NGW * D);
          for (; m < M; m += NGW) rms_rows_bf16<1>(in[0] + (size_t)m * D, in[2], XN + (size_t)m * D, F.lane, 0); }
        for (int m = gw; m < BATCH * MEML; m += NGW) rms_rows_bf16<1>(in[1] + (size_t)m * D, in[16], (bf16*)(ws + WS_MEMN) + (size_t)m * D, F.lane, 0);
        REPBAR(0); }
        SEAM(0);
    }
    if (IN(1)) {
        pg8::Order1 S; S.init(pg8::GDesc{XN, W1A, D, D, D, M / 256, 2 * FF / 256}, F.G, F.c);
        FORREP(1) { pg8::gemm_phase<true>(F.lds, S, EpiSwiglu{HID}); REPBAR(1); }
        {
            const int total = (M / 256) * (2 * FF / 256), first_idle = total % F.G;
            if (F.c >= first_idle) {
                LAS float* scr = (LAS float*)(F.lds + F.wave * 16384);
                const int gwi = (F.c - first_idle) * NWAVES + F.wave, ngwi = (F.G - first_idle) * NWAVES;
                constexpr int NIT = 1408 + 2688 + 512;
                for (int it0 = gwi; it0 < NIT; it0 += ngwi) { int it = it0;
                    if (conv_job(it, in[5], D, FF, D / 32, W1B, FF, ColIdent{0}, scr, F.lane)) continue;
                    if (conv_job(it, in[8], 7256, D, NIN / 32, (bf16*)(ws + WS_WIN), D, ColInproj{}, scr, F.lane)) continue;
                    conv_job(it, in[20], D, D, D / 32, (bf16*)(ws + WS_WCKV), D, ColIdent{0}, scr, F.lane);
                }
            }
        }
        SEAM(1);
    }
    if (IN(2)) {
        pg8::Order1 S; S.init(pg8::GDesc{HID, W1B, FF, FF, FF, M / 256, D / 256}, F.G, F.c);
        FORREP(2) { pg8::gemm_phase<true>(F.lds, S, EpiStore{Y, D}); REPBAR(2); }
        SEAM(2);
    }
    if (IN(3)) { FORREP(3) { resnorm_phase<false, false, true>(F, in[0], Y, in[3], 0.5f, args.out, in[6], XN, ST(3)); REPBAR(3); } SEAM(3); }
    if (IN(4)) {
        pg8::Order2 S; S.d0 = pg8::GDesc{XN, (const bf16*)(ws + WS_WIN), D, D, D, M / 256, NIN / 256};
        S.d1 = pg8::GDesc{(const bf16*)(ws + WS_MEMN), (const bf16*)(ws + WS_WCKV), D, D, D, BATCH * MEML / 256, D / 256}; S.G = F.G; S.c = F.c;
        FORREP(4) { pg8::gemm_phase<true>(F.lds, S, EpiInproj{ws, (unsigned char*)args.out}); REPBAR(4); }
        {
            const int total = (M / 256) * (NIN / 256) + (BATCH * MEML / 256) * (D / 256), first_idle = total % F.G;
            if (F.c >= first_idle) {
                LAS float* scr = (LAS float*)(F.lds + F.wave * 16384);
                const int gwi = (F.c - first_idle) * NWAVES + F.wave, ngwi = (F.G - first_idle) * NWAVES;
                unsigned char* W2A8 = (unsigned char*)args.out + 32 * MiB; unsigned char* W2B8 = W2A8 + (size_t)2 * FF * D;
                constexpr int NIT = 1024 + 512 + 256 + 512 + 256 + 256 + 2816 + 1408;
                for (int it0 = gwi; it0 < NIT; it0 += ngwi) { int it = it0;
                    if (conv_job(it, in[8], 7256, D, 2048 / 32, (bf16*)(ws + WS_WGT), D, ColIdent{5208}, scr, F.lane)) continue;
                    if (conv_job(it, in[12], D, D, D / 32, (bf16*)(ws + WS_WG), D, ColIdent{0}, scr, F.lane)) continue;
                    if (conv_job(it, in[13], D, 512, D / 32, (bf16*)(ws + WS_WD), 512, ColIdent{0}, scr, F.lane)) continue;
                    if (conv_job(it, in[15], D, D, D / 32, (bf16*)(ws + WS_WO), D, ColIdent{0}, scr, F.lane)) continue;
                    if (conv_job(it, in[19], 512, D, 512 / 32, (bf16*)(ws + WS_WCQ), D, ColIdent{0}, scr, F.lane)) continue;
                    if (conv_job(it, in[21], D, 512, D / 32, (bf16*)(ws + WS_WCO), 512, ColIdent{0}, scr, F.lane)) continue;
                    if (conv_job8(it, in[24], 2 * FF, D, 2 * FF / 32, W2A8, D, 64.f, ColFfn{}, scr, F.lane)) continue;
                    conv_job8(it, in[25], D, FF, D / 32, W2B8, FF, 64.f, ColIdent{0}, scr, F.lane);
                }
            }
        }
        SEAM(4);
    }
    if (IN(5)) {
        FORREP(5) {
        if (sub <= 0) { for (int u = F.c; u < 256; u += F.G) gla_state_unit(F, in, u); __syncthreads(); }
        if (sub != 0) for (int k = 0; k * F.G < 2048; ++k) { const int u = k * F.G + ((k & 1) ? F.G - 1 - F.c : F.c); if (u < 2048) idx_unit(F, u, ST(5), sub >= 2 ? sub - 1 : 0); }
        REPBAR(5); }
        SEAM(5);
    }
    if (IN(6)) {
        FORREP(6) {
        if (sub != 1) gla_scan_phase(F, ST(6));
#ifdef PROBE_EXTRA_PHASE
        if (sub >= 2) { for (int p = F.c; p < 256; p += F.G) { const int bh = p >> 4, x = p & 15;
            if (sub == 2) { dsa_att_unit<1>(F, in, bh, x, false); dsa_att_unit<1>(F, in, bh, 31 - x, false); }
            if (sub == 3) { dsa_att_unit<3>(F, in, bh, x, false); dsa_att_unit<3>(F, in, bh, 31 - x, false); }
            if (sub == 4) { dsa_att_unit<4>(F, in, bh, x, false); dsa_att_unit<4>(F, in, bh, 31 - x, false); }
            if (sub == 5) { dsa_att_unit<5>(F, in, bh, x, false); dsa_att_unit<5>(F, in, bh, 31 - x, false); }
            if (sub == 6) { dsa_att_unit<6>(F, in, bh, x, false); dsa_att_unit<6>(F, in, bh, 31 - x, false); } } } else
#endif
        if (sub != 0) for (int p = F.c; p < 256; p += F.G) { const int bh = p >> 4, x = p & 15; dsa_att_unit(F, in, bh, x, ST(6)); dsa_att_unit(F, in, bh, 31 - x, ST(6)); }
        REPBAR(6); }
        SEAM(6);
    }
    if (IN(7)) {
        FORREP(7) { for (int u = F.c; u < 256; u += F.G) { gla_out_unit(F, in, u, ST(7)); __syncthreads(); } REPBAR(7); }
        SEAM(7);
    }
    if (IN(8)) {
        pg8::Order1 S; S.init(pg8::GDesc{XN, (const bf16*)(ws + WS_WGT), D, D, D, M / 256, 2048 / 256}, F.G, F.c);
        FORREP(8) { pg8::gemm_phase<true>(F.lds, S, EpiGates{(bf16*)(ws + WS_SGA), (bf16*)(ws + WS_SGB)}); REPBAR(8); }
        SEAM(8);
    }
    if (IN(9)) {
        pg8::PairOrder S; S.d0 = pg8::GDesc{(const bf16*)(ws + WS_GR), (const bf16*)(ws + WS_WG), D, D, D, M / 256, D / 256};
        S.d1 = pg8::GDesc{(const bf16*)(ws + WS_DQKV), (const bf16*)(ws + WS_WD), 1536, 512, 512, M / 256, D / 256}; S.G = F.G; S.c = F.c;
        FORREP(9) { pg8::gemm_phase<false>(F.lds, S, EpiMerge{(const bf16*)(ws + WS_SGA), (const bf16*)(ws + WS_SGB), (bf16*)(ws + WS_MRG)}); REPBAR(9); }
        SEAM(9);
    }
    if (IN(10)) {
        pg8::Order1 S; S.init(pg8::GDesc{(const bf16*)(ws + WS_MRG), (const bf16*)(ws + WS_WO), D, D, D, M / 256, D / 256}, F.G, F.c);
        FORREP(10) { pg8::gemm_phase<true>(F.lds, S, EpiStore{(bf16*)(ws + WS_Y2), D}); REPBAR(10); }
        SEAM(10);
    }
    if (IN(11)) {
        FORREP(11) {
        resnorm_phase<false, true, true>(F, args.out, (const bf16*)(ws + WS_Y2), in[7], 1.0f, args.out, in[17], XN, ST(11));
        REPBAR(11); }
        SEAM(11);
    }
    if (IN(12)) {
        pg8::Order1 S; S.init(pg8::GDesc{XN, (const bf16*)(ws + WS_WCQ), D, D, D, M / 256, 512 / 256}, F.G, F.c);
        FORREP(12) { pg8::gemm_phase<true>(F.lds, S, EpiStore{(bf16*)(ws + WS_QC), 512}); REPBAR(12); }
        SEAM(12);
    }
    if (IN(13)) {
        FORREP(13) { for (int u = F.c; u < 256; u += F.G) cross_att_unit(F, u); REPBAR(13); }
        SEAM(13);
    }
    if (IN(14)) {
        pg8::Order1 S; S.init(pg8::GDesc{(const bf16*)(ws + WS_OX), (const bf16*)(ws + WS_WCO), 512, 512, 512, M / 256, D / 256}, F.G, F.c);
        FORREP(14) { pg8::gemm_phase<true>(F.lds, S, EpiStore{(bf16*)(ws + WS_Y3), D}); REPBAR(14); }
        SEAM(14);
    }
    if (IN(15)) { FORREP(15) { resnorm_phase<true, true, true>(F, args.out, (const bf16*)(ws + WS_Y3), in[18], 1.0f, ws + WS_H3, in[22], XN, ST(15)); REPBAR(15); } SEAM(15); }
    if (IN(16)) {
        pg8::Order1 S; S.init(pg8::GDesc{XN, (const bf16*)((unsigned char*)args.out + 32 * MiB), D, D, D, M / 256, 2 * FF / 256}, F.G, F.c);
        FORREP(16) { pg8::gemm_phase8<true>(F.lds, S, EpiSwiglu8{(unsigned char*)HID}); REPBAR(16); }
        SEAM(16);
    }
    if (IN(17)) {
        pg8::Order1 S; S.init(pg8::GDesc{HID, (const bf16*)((unsigned char*)args.out + 32 * MiB + (size_t)2 * FF * D), FF, FF, FF, M / 256, D / 256}, F.G, F.c);
        FORREP(17) { pg8::gemm_phase8<true>(F.lds, S, EpiStore{Y, D, 1.f / 512.f}); REPBAR(17); }
        SEAM(17);
    }
    if (IN(18)) { FORREP(18) { resnorm_phase<false, true, false>(F, ws + WS_H3, Y, in[23], 0.5f, args.out, nullptr, nullptr, ST(18)); REPBAR(18); } }
#ifdef PROBE_EXTRA_PHASE
    if (lo == 20) { f32x16 a0, a1, a2, a3; for (int r = 0; r < 16; ++r) { a0[r] = 0.f; a1[r] = 1.f; a2[r] = 2.f; a3[r] = 3.f; }
        bf16x8 x = pack8(1.f, 2.f, 3.f, 4.f, 5.f, 6.f, 7.f, (float)F.lane), y = pack8(.5f, .25f, .125f, 1.f, 2.f, 3.f, 4.f, (float)F.wave);
        for (int i = 0; i < 2048; ++i) { a0 = MFMA32(x, y, a0); a1 = MFMA32(x, y, a1); a2 = MFMA32(x, y, a2); a3 = MFMA32(x, y, a3); }
        if (a0[0] + a1[1] + a2[2] + a3[3] == 1.2345f) ctl[32] = 1u; }
    if (lo == 21) { float v0 = (float)F.lane, v1 = 1.f, v2 = 2.f, v3 = 3.f, v4 = 4.f, v5 = 5.f, v6 = 6.f, v7 = 7.f; const float m = 1.0000001f, c = 1e-9f;
        for (int i = 0; i < 8192; ++i) { v0 = fmaf(v0, m, c); v1 = fmaf(v1, m, c); v2 = fmaf(v2, m, c); v3 = fmaf(v3, m, c); v4 = fmaf(v4, m, c); v5 = fmaf(v5, m, c); v6 = fmaf(v6, m, c); v7 = fmaf(v7, m, c); }
        if (v0 + v1 + v2 + v3 + v4 + v5 + v6 + v7 == 1.2345f) ctl[32] = 1u; }
    if (lo == 22) { f32x4 a0 = {0, 0, 0, 0}, a1 = {1, 1, 1, 1}, a2 = {2, 2, 2, 2}, a3 = {3, 3, 3, 3};
        bf16x8 x = pack8(1.f, 2.f, 3.f, 4.f, 5.f, 6.f, 7.f, (float)F.lane), y = pack8(.5f, .25f, .125f, 1.f, 2.f, 3.f, 4.f, (float)F.wave);
        for (int i = 0; i < 4096; ++i) { a0 = __builtin_amdgcn_mfma_f32_16x16x32_bf16(x, y, a0, 0, 0, 0); a1 = __builtin_amdgcn_mfma_f32_16x16x32_bf16(x, y, a1, 0, 0, 0); a2 = __builtin_amdgcn_mfma_f32_16x16x32_bf16(x, y, a2, 0, 0, 0); a3 = __builtin_amdgcn_mfma_f32_16x16x32_bf16(x, y, a3, 0, 0, 0); }
        if (a0[0] + a1[1] + a2[2] + a3[3] == 1.2345f) ctl[32] = 1u; }
    if (lo == 23) { float v0 = (float)F.lane * 1e-3f, v1 = .1f, v2 = .2f, v3 = .3f;
        for (int i = 0; i < 8192; ++i) { v0 = fast_exp2(v0) - 1.f; v1 = fast_exp2(v1) - 1.f; v2 = fast_exp2(v2) - 1.f; v3 = fast_exp2(v3) - 1.f; }
        if (v0 + v1 + v2 + v3 == 1.2345f) ctl[32] = 1u; }
#endif
#undef IN
#undef SEAM
}

extern "C" void kernel_launch(void* const* d_in, const int* in_sizes, int n_in, void* d_out, int out_size, void* d_ws, size_t ws_size, hipStream_t stream) {
    static int grid = 0;
    if (grid == 0) {
        if (n_in != 26 || out_size != M * D || ws_size < WS_END) { fprintf(stderr, "kernel_launch: unexpected problem shape (n_in %d, out %d, ws %zu); nothing launched\n", n_in, out_size, ws_size); grid = -1; return; }
        int dev = 0, cus = 0, per_cu = 0;
        if (hipGetDevice(&dev) != hipSuccess || hipDeviceGetAttribute(&cus, hipDeviceAttributeMultiprocessorCount, dev) != hipSuccess) { grid = -1; return; }
        if (hipFuncSetAttribute((const void*)mega_fwd, hipFuncAttributeMaxDynamicSharedMemorySize, LDS_BYTES) != hipSuccess) { fprintf(stderr, "kernel_launch: hipFuncSetAttribute failed\n"); grid = -1; return; }
        if (hipOccupancyMaxActiveBlocksPerMultiprocessor(&per_cu, (const void*)mega_fwd, NT, LDS_BYTES) != hipSuccess || per_cu < 1) fprintf(stderr, "kernel_launch: occupancy query reports %d workgroups per CU\n", per_cu);
        (void)hipGetLastError();
        grid = cus;
    }
    if (grid < 0) return;
    (void)hipMemsetAsync((char*)d_ws + WS_CTL, 0, 65536, stream);
    Args a{};
    for (int i = 0; i < 26; ++i) a.in[i] = (const float*)d_in[i];
    a.out = (float*)d_out; a.ws = (unsigned char*)d_ws;
    a.nostore = 0; a.sub = -1;
#if MK_ONE_LAUNCH
    a.ph_lo = 0; a.ph_hi = N_PHASES;
    hipLaunchKernelGGL(mega_fwd, dim3(grid), dim3(NT), LDS_BYTES, stream, a);
#ifdef PROBE_EXTRA_PHASE
    for (int r = 0; r < PROBE_EXTRA_N; ++r) { a.ph_lo = PROBE_EXTRA_PHASE; a.ph_hi = PROBE_EXTRA_PHASE + 1; a.nostore = 1; a.sub = PROBE_EXTRA_SUB;
    hipLaunchKernelGGL(mega_fwd, dim3(grid), dim3(NT), LDS_BYTES, stream, a); }
#endif
#else
    for (int p = 0; p < N_PHASES; ++p) { a.ph_lo = p; a.ph_hi = p + 1; hipLaunchKernelGGL(mega_fwd, dim3(grid), dim3(NT), LDS_BYTES, stream, a); }
#endif
}
```
